# Optimizing an MI355X kernel written in HIP

```python
import jax, jax.numpy as jnp
from jax import lax
import numpy as np

D_MODEL = 1024
BATCH = 4
SEQ = 8192
DEPTH = 2

N_A_LAYERS = DEPTH // 2
N_B_LAYERS = DEPTH - N_A_LAYERS
NORM_EPS = 1e-6
RWKV_HEAD_DIM = 64
RWKV_HEADS = D_MODEL // RWKV_HEAD_DIM
DECAY_LORA = 64
AAA_LORA = 64
GATE_LORA = 128
GN_EPS = 64e-5
MLA_HEADS = 16
Q_LORA = 384
KV_LORA = 256
QK_NOPE = 64
QK_ROPE = 32
V_HEAD = 64
ROPE_THETA = 10000.0
ATTN_BLOCK = 128
N_EXPERTS = 16
N_GROUPS = 4
EXPERTS_PER_GROUP = N_EXPERTS // N_GROUPS
TOP_K = 2
D_EXPERT = 256
POS_OFFSET_MAX = 4096

kernel_name = 'hybrid_rwkv7_mla_yoco_grouped_moe'


def rmsnorm(x, g):
    xf = x.astype(jnp.float32)
    y = xf * lax.rsqrt(jnp.mean(xf * xf, axis=-1, keepdims=True) + NORM_EPS)
    return (y * g.astype(jnp.float32)).astype(x.dtype)


def ada_params(c, w, b, n):
    m = (jax.nn.silu(c) @ w + b)[:, None, :]
    return jnp.split(m, n, axis=-1)


def modulate(x, g, shift, scale):
    return rmsnorm(x, g) * (1.0 + scale) + shift


def rope_tables(positions):
    inv_freq = ROPE_THETA ** (-jnp.arange(0, QK_ROPE, 2, dtype=jnp.float32) / QK_ROPE)
    ang = positions.astype(jnp.float32)[..., None] * inv_freq
    return jnp.cos(ang), jnp.sin(ang)


def apply_rope(x, cos, sin):
    xf = x.astype(jnp.float32)
    x1, x2 = jnp.split(xf, 2, axis=-1)
    return jnp.concatenate([x1 * cos - x2 * sin, x2 * cos + x1 * sin], axis=-1).astype(x.dtype)


def wkv7_scan(r, w, k, v, a, b):
    bsz, _, nh, n = r.shape
    to_tm = lambda t: jnp.moveaxis(t.astype(jnp.float32), 1, 0)

    def step(state, inp):
        r_t, w_t, k_t, v_t, a_t, b_t = inp
        sa = jnp.einsum('bhij,bhj->bhi', state, a_t)
        state = (state * w_t[:, :, None, :] + sa[..., None] * b_t[:, :, None, :]
                 + v_t[..., None] * k_t[:, :, None, :])
        return state, jnp.einsum('bhij,bhj->bhi', state, r_t)

    s0 = jnp.zeros((bsz, nh, n, n), jnp.float32)
    _, ys = lax.scan(step, s0, (to_tm(r), to_tm(w), to_tm(k), to_tm(v), to_tm(a), to_tm(b)))
    return jnp.moveaxis(ys, 0, 1)


def rwkv7_time_mix(h, mu, w_rkv, w0, w1, w2, a0, a1, a2, g1, g2, k_k, k_a, r_k, lnx_w, lnx_b, w_o):
    bsz, s, d = h.shape
    f32 = jnp.float32
    xx = jnp.pad(h, ((0, 0), (1, 0), (0, 0)))[:, :-1] - h
    xr = h + xx * mu[0]
    xw = h + xx * mu[1]
    xk = h + xx * mu[2]
    xv = h + xx * mu[3]
    xa = h + xx * mu[4]
    xg = h + xx * mu[5]
    r = xr @ w_rkv[0]
    k = xk @ w_rkv[1]
    v = xv @ w_rkv[2]
    w_log = -jax.nn.softplus(-(w0 + jnp.tanh(xw @ w1) @ w2).astype(f32)) - 0.5
    decay = jnp.exp(-jnp.exp(w_log))
    a = jax.nn.sigmoid((a0 + (xa @ a1) @ a2).astype(f32))
    g = jax.nn.sigmoid(xg @ g1) @ g2
    hs = lambda t: t.reshape(bsz, s, RWKV_HEADS, RWKV_HEAD_DIM)
    kk = hs((k * k_k).astype(f32))
    kk = kk / jnp.maximum(jnp.sqrt(jnp.sum(kk * kk, axis=-1, keepdims=True)), 1e-12)
    k = k.astype(f32) * (1.0 + (a - 1.0) * k_a.astype(f32))
    r_h, k_h, v_h, a_h = hs(r.astype(f32)), hs(k), hs(v.astype(f32)), hs(a)
    y = wkv7_scan(r_h, hs(decay), k_h, v_h, -kk, kk * a_h)
    mean = jnp.mean(y, axis=-1, keepdims=True)
    var = jnp.mean(jnp.square(y - mean), axis=-1, keepdims=True)
    y = ((y - mean) * lax.rsqrt(var + GN_EPS)).reshape(bsz, s, d) * lnx_w + lnx_b
    bonus = jnp.sum(r_h * k_h * r_k.astype(f32), axis=-1, keepdims=True) * v_h
    y = y + bonus.reshape(bsz, s, d)
    return (y * g).astype(h.dtype) @ w_o


def mla_shared_kv(h, cos, sin, w_dkv, g_kv, w_uk, w_uv, w_kr):
    c_kv = rmsnorm(h @ w_dkv, g_kv)
    k_nope = jnp.einsum('bsc,chd->bhsd', c_kv, w_uk)
    v = jnp.einsum('bsc,chd->bhsd', c_kv, w_uv)
    k_rope = apply_rope(h @ w_kr, cos, sin)
    return k_nope, k_rope, v


def mla_causal_attention(q_nope, q_rope, k_nope, k_rope, v):
    bsz, nh, s, _ = q_nope.shape
    n_blk = s // ATTN_BLOCK
    scale = (QK_NOPE + QK_ROPE) ** -0.5
    offs = jnp.arange(ATTN_BLOCK)
    f32 = jnp.float32

    def query_block(i):
        q0 = i * ATTN_BLOCK
        qn = lax.dynamic_slice_in_dim(q_nope, q0, ATTN_BLOCK, axis=2)
        qr = lax.dynamic_slice_in_dim(q_rope, q0, ATTN_BLOCK, axis=2)
        q_idx = q0 + offs

        def key_block(j, carry):
            m, l, acc = carry
            k0 = j * ATTN_BLOCK
            kn = lax.dynamic_slice_in_dim(k_nope, k0, ATTN_BLOCK, axis=2)
            kr = lax.dynamic_slice_in_dim(k_rope, k0, ATTN_BLOCK, axis=1)
            vb = lax.dynamic_slice_in_dim(v, k0, ATTN_BLOCK, axis=2)
            sc = (jnp.einsum('bhqd,bhkd->bhqk', qn, kn).astype(f32)
                  + jnp.einsum('bhqd,bkd->bhqk', qr, kr).astype(f32)) * scale
            sc = jnp.where((k0 + offs)[None, :] <= q_idx[:, None], sc, -jnp.inf)
            m_new = jnp.maximum(m, jnp.max(sc, axis=-1))
            p = jnp.exp(sc - m_new[..., None])
            corr = jnp.exp(m - m_new)
            l = l * corr + jnp.sum(p, axis=-1)
            acc = acc * corr[..., None] + jnp.einsum('bhqk,bhkd->bhqd', p, vb.astype(f32))
            return m_new, l, acc

        init = (jnp.full((bsz, nh, ATTN_BLOCK), -jnp.inf, f32),
                jnp.zeros((bsz, nh, ATTN_BLOCK), f32),
                jnp.zeros((bsz, nh, ATTN_BLOCK, V_HEAD), f32))
        _, l, acc = lax.fori_loop(0, i + 1, key_block, init)
        return (acc / l[..., None]).astype(v.dtype)

    out = lax.map(query_block, jnp.arange(n_blk))
    return jnp.transpose(out, (1, 0, 3, 2, 4)).reshape(bsz, s, nh * V_HEAD)


def mla_layer(h, cos, sin, w_dq, g_q, w_uq, w_qr, w_o, k_nope, k_rope, v):
    c_q = rmsnorm(h @ w_dq, g_q)
    q_nope = jnp.einsum('bsc,chd->bhsd', c_q, w_uq)
    q_rope = apply_rope(jnp.einsum('bsc,chd->bshd', c_q, w_qr), cos[:, :, None, :], sin[:, :, None, :])
    q_rope = jnp.transpose(q_rope, (0, 2, 1, 3))
    o = mla_causal_attention(q_nope, q_rope, k_nope, k_rope, v)
    return o @ w_o


def grouped_moe(h, router_w, router_b, w_gu, w_down):
    bsz, s, _ = h.shape
    f32 = jnp.float32
    aff = jax.nn.sigmoid((h @ router_w).astype(f32))
    sel = aff + router_b
    grp = sel.reshape(bsz, s, N_GROUPS, EXPERTS_PER_GROUP)
    group_score = jnp.sum(lax.top_k(grp, TOP_K)[0], axis=-1)
    best_group = jnp.argmax(group_score, axis=-1)
    in_group = (jnp.arange(N_EXPERTS) // EXPERTS_PER_GROUP)[None, None, :] == best_group[..., None]
    _, idx = lax.top_k(jnp.where(in_group, sel, -jnp.inf), TOP_K)
    top_aff = jnp.take_along_axis(aff, idx, axis=-1)
    gates = top_aff / jnp.sum(top_aff, axis=-1, keepdims=True)
    combine = jnp.sum(jax.nn.one_hot(idx, N_EXPERTS, dtype=f32) * gates[..., None], axis=-2)

    def per_sequence(args):
        hs, cs = args
        gu = jnp.einsum('sd,edf->sef', hs, w_gu)
        gt, up = jnp.split(gu, 2, axis=-1)
        act = jax.nn.silu(gt) * up * cs[..., None].astype(hs.dtype)
        return jnp.einsum('sef,efd->sd', act, w_down)

    return lax.map(per_sequence, (h, combine))


def setup_inputs(seed: int = 0) -> dict:
    key = jax.random.key(seed)
    ks = iter(jax.random.split(key, 64))
    f32 = jnp.float32
    D = D_MODEL
    NA, NB = N_A_LAYERS, N_B_LAYERS

    def nrm(shape, fan_in, scale=1.0):
        return jax.random.normal(next(ks), shape, f32) * (scale * fan_in ** -0.5)

    def gain(shape):
        return 1.0 + 0.02 * jax.random.normal(next(ks), shape, f32)

    def small(shape, s=0.02):
        return s * jax.random.normal(next(ks), shape, f32)

    x = jax.random.normal(next(ks), (BATCH, SEQ, D), f32)
    c = jax.random.normal(next(ks), (BATCH, D), f32)
    positions = (jax.random.randint(next(ks), (BATCH, 1), 0, POS_OFFSET_MAX)
                 + jnp.arange(SEQ)[None, :]).astype(jnp.int32)
    return {
        'x': x, 'c': c, 'positions': positions,
        'ada_w': nrm((DEPTH, 2, D, 3 * D), D, 0.5),
        'ada_b': small((DEPTH, 2, 3 * D)),
        'norm_g': gain((DEPTH, 2, D)),
        'rwkv_mu': jax.random.uniform(next(ks), (NA, 6, D), f32),
        'rwkv_w_rkv': nrm((NA, 3, D, D), D),
        'rwkv_w0': jax.random.uniform(next(ks), (NA, D), f32, -6.5, -1.5),
        'rwkv_w1': nrm((NA, D, DECAY_LORA), D),
        'rwkv_w2': nrm((NA, DECAY_LORA, D), DECAY_LORA, 0.1),
        'rwkv_a0': small((NA, D), 0.1),
        'rwkv_a1': nrm((NA, D, AAA_LORA), D),
        'rwkv_a2': nrm((NA, AAA_LORA, D), AAA_LORA, 0.1),
        'rwkv_g1': nrm((NA, D, GATE_LORA), D),
        'rwkv_g2': nrm((NA, GATE_LORA, D), GATE_LORA),
        'rwkv_k_k': 0.85 + small((NA, D)),
        'rwkv_k_a': gain((NA, D)),
        'rwkv_r_k': small((NA, RWKV_HEADS, RWKV_HEAD_DIM), 0.1),
        'rwkv_lnx_w': gain((NA, D)),
        'rwkv_lnx_b': small((NA, D)),
        'rwkv_w_o': nrm((NA, D, D), D),
        'kv_ada_w': nrm((D, 2 * D), D, 0.5),
        'kv_ada_b': small((2 * D,)),
        'kv_norm_g': gain((D,)),
        'mla_w_dkv': nrm((D, KV_LORA), D),
        'mla_g_kv': gain((KV_LORA,)),
        'mla_w_uk': nrm((KV_LORA, MLA_HEADS, QK_NOPE), KV_LORA),
        'mla_w_uv': nrm((KV_LORA, MLA_HEADS, V_HEAD), KV_LORA),
        'mla_w_kr': nrm((D, QK_ROPE), D),
        'mla_w_dq': nrm((NB, D, Q_LORA), D),
        'mla_g_q': gain((NB, Q_LORA)),
        'mla_w_uq': nrm((NB, Q_LORA, MLA_HEADS, QK_NOPE), Q_LORA),
        'mla_w_qr': nrm((NB, Q_LORA, MLA_HEADS, QK_ROPE), Q_LORA),
        'mla_w_o': nrm((NB, MLA_HEADS * V_HEAD, D), MLA_HEADS * V_HEAD),
        'router_w': nrm((D, N_EXPERTS), D),
        'router_b': small((N_EXPERTS,), 0.01),
        'moe_w_gu': nrm((DEPTH, N_EXPERTS, D, 2 * D_EXPERT), D),
        'moe_w_down': nrm((DEPTH, N_EXPERTS, D_EXPERT, D), D_EXPERT),
        'final_g': gain((D,)),
    }


def reference(x, c, positions, ada_w, ada_b, norm_g,
              rwkv_mu, rwkv_w_rkv, rwkv_w0, rwkv_w1, rwkv_w2, rwkv_a0, rwkv_a1, rwkv_a2,
              rwkv_g1, rwkv_g2, rwkv_k_k, rwkv_k_a, rwkv_r_k, rwkv_lnx_w, rwkv_lnx_b, rwkv_w_o,
              kv_ada_w, kv_ada_b, kv_norm_g, mla_w_dkv, mla_g_kv, mla_w_uk, mla_w_uv, mla_w_kr,
              mla_w_dq, mla_g_q, mla_w_uq, mla_w_qr, mla_w_o,
              router_w, router_b, moe_w_gu, moe_w_down, final_g):
    cos, sin = rope_tables(positions)
    k_nope = k_rope = v_shared = None
    for layer in range(DEPTH):
        if layer == N_A_LAYERS:
            kv_shift, kv_scale = ada_params(c, kv_ada_w, kv_ada_b, 2)
            h_kv = modulate(x, kv_norm_g, kv_shift, kv_scale)
            k_nope, k_rope, v_shared = mla_shared_kv(h_kv, cos, sin, mla_w_dkv, mla_g_kv,
                                                     mla_w_uk, mla_w_uv, mla_w_kr)
        shift, scale, gate = ada_params(c, ada_w[layer, 0], ada_b[layer, 0], 3)
        h = modulate(x, norm_g[layer, 0], shift, scale)
        if layer < N_A_LAYERS:
            a = layer
            mix = rwkv7_time_mix(h, rwkv_mu[a], rwkv_w_rkv[a], rwkv_w0[a], rwkv_w1[a], rwkv_w2[a],
                                 rwkv_a0[a], rwkv_a1[a], rwkv_a2[a], rwkv_g1[a], rwkv_g2[a],
                                 rwkv_k_k[a], rwkv_k_a[a], rwkv_r_k[a], rwkv_lnx_w[a],
                                 rwkv_lnx_b[a], rwkv_w_o[a])
        else:
            bl = layer - N_A_LAYERS
            mix = mla_layer(h, cos, sin, mla_w_dq[bl], mla_g_q[bl], mla_w_uq[bl], mla_w_qr[bl],
                            mla_w_o[bl], k_nope, k_rope, v_shared)
        x = x + gate * mix
        shift, scale, gate = ada_params(c, ada_w[layer, 1], ada_b[layer, 1], 3)
        h = modulate(x, norm_g[layer, 1], shift, scale)
        x = x + gate * grouped_moe(h, router_w, router_b, moe_w_gu[layer], moe_w_down[layer])
    return rmsnorm(x, final_g)
```

```cpp
#include <hip/hip_runtime.h>
#include <cstdio>
#include <cstdint>

#define LAS __attribute__((address_space(3)))
#define GAS __attribute__((address_space(1)))
typedef unsigned short bf16_t;
typedef short bf16x8 __attribute__((ext_vector_type(8)));
typedef short s16x4 __attribute__((ext_vector_type(4)));
typedef float f32x2 __attribute__((ext_vector_type(2)));
typedef float f32x4 __attribute__((ext_vector_type(4)));
typedef float f32x16 __attribute__((ext_vector_type(16)));
typedef unsigned u32x2 __attribute__((ext_vector_type(2)));
typedef unsigned u32x4 __attribute__((ext_vector_type(4)));
typedef __bf16 bf16x2_t __attribute__((ext_vector_type(2)));

__device__ __forceinline__ unsigned cvtpk(float lo, float hi) { f32x2 v = {lo, hi}; bf16x2_t b = __builtin_convertvector(v, bf16x2_t); return __builtin_bit_cast(unsigned, b); }
__device__ __forceinline__ float bf2f(unsigned short b) { return __uint_as_float((unsigned)b << 16); }
__device__ __forceinline__ float bflo(unsigned w) { return __uint_as_float(w << 16); }
__device__ __forceinline__ float bfhi(unsigned w) { return __uint_as_float(w & 0xffff0000u); }
__device__ __forceinline__ float wave_sum(float v) {
#pragma unroll
    for (int o = 1; o < 64; o <<= 1) v += __shfl_xor(v, o);
    return v;
}
__device__ __forceinline__ float sigmoidf_(float x) { return 1.0f / (1.0f + __expf(-x)); }

namespace pg8 {
constexpr int BM = 256, BK = 64, HALF = 128, HTB = HALF * BK * 2  , STAGE_BYTES = 8 * HTB;
__host__ __device__ __forceinline__ int lds_byte(int r, int c) { const int st = (r >> 4) * 2 + (c >> 5), rr = r & 15, cc = c & 31, ob = rr * 64 + cc * 2; return st * 1024 + (ob ^ (((ob >> 9) & 1) << 5)); }
__host__ __device__ __forceinline__ void stage_rc(int b, int& R, int& C) { const int st = b / 1024, sb = b % 1024, swz = sb ^ (((sb >> 9) & 1) << 5); R = (st >> 1) * 16 + swz / 64; C = (st & 1) * 32 + (swz % 64) / 2; }
__host__ __device__ __forceinline__ int perm32(int rho) { const int n = rho >> 4, i = rho & 15; return 8 * (i >> 2) + 4 * n + (i & 3); }

struct Unit { int pm, pn, aux, nt, nt0; const char* A0; const char* A1; const char* B0; const char* B1; };
__device__ __forceinline__ const char* tile_ptr(const char* p0, const char* p1, int nt0, int t) { return t < nt0 ? p0 + (size_t)t * 128 : p1 + (size_t)(t - nt0) * 128; }

template <class Epi, class Sched, bool GA>
__device__ __forceinline__ void gemm_phase(LAS unsigned char* lds, const Sched& S, const Epi& E, const int lda, const int ldb) {
    const int tid = threadIdx.x, wid = __builtin_amdgcn_readfirstlane(tid >> 6), lane = tid & 63, wr = wid >> 2, wc = wid & 3, fr = lane & 15, fq = lane >> 4;
    unsigned voffB[2]; int RA[2], CA[2];
#pragma unroll
    for (int i = 0; i < 2; ++i) { int R, C; stage_rc(tid * 16 + i * 8192, R, C); const int Rb = Epi::PERM ? ((R & ~31) + perm32(R & 31)) : R;
        voffB[i] = (unsigned)(Rb * ldb + C) * 2u; RA[i] = R; CA[i] = C; }
    const size_t hstepB = (size_t)HALF * ldb * 2;
    unsigned voC[2][2], voN[2][2];
    const unsigned ldsw = (unsigned)wid * 1024u;
    const int aoff = lds_byte(wr * 64 + fr, fq * 8), boff = lds_byte(wc * 32 + fr, fq * 8);
#define PG8_SA(b, h) (((b) * 2 + (h)) * HTB)
#define PG8_SB(b, h) ((4 + (b) * 2 + (h)) * HTB)
#define PG8_STAGE_B(bufoff, gbase) do { _Pragma("unroll") for (int _i = 0; _i < 2; ++_i) \
        __builtin_amdgcn_global_load_lds((const unsigned*)((const char*)(gbase) + voffB[_i]), (LAS unsigned*)(lds + (bufoff) + ldsw + _i * 8192), 16, 0, 0); } while (0)
#define PG8_STAGE_A(bufoff, gbase, VO, hh) do { _Pragma("unroll") for (int _i = 0; _i < 2; ++_i) \
        __builtin_amdgcn_global_load_lds((const unsigned*)((const char*)(gbase) + VO[hh][_i]), (LAS unsigned*)(lds + (bufoff) + ldsw + _i * 8192), 16, 0, 0); } while (0)
#define PG8_LDA(dst, b, h) do { _Pragma("unroll") for (int m = 0; m < 4; ++m) _Pragma("unroll") for (int k = 0; k < 2; ++k) dst[m][k] = *(const LAS bf16x8*)(lds + PG8_SA(b, h) + aoff + m * 2048 + k * 1024); } while (0)
#define PG8_LDB(dst, b, h) do { _Pragma("unroll") for (int n = 0; n < 2; ++n) _Pragma("unroll") for (int k = 0; k < 2; ++k) dst[n][k] = *(const LAS bf16x8*)(lds + PG8_SB(b, h) + boff + n * 2048 + k * 1024); } while (0)
#define PG8_MMA(ai, bj, At, Bt) do { __builtin_amdgcn_s_setprio(1); _Pragma("unroll") for (int m = 0; m < 4; ++m) _Pragma("unroll") for (int n = 0; n < 2; ++n) _Pragma("unroll") for (int k = 0; k < 2; ++k) \
        acc[ai][bj][m][n] = __builtin_amdgcn_mfma_f32_16x16x32_bf16(Bt[n][k], At[m][k], acc[ai][bj][m][n], 0, 0, 0); __builtin_amdgcn_s_setprio(0); } while (0)
#define PG8_WAIT_V(n) asm volatile("s_waitcnt vmcnt(" #n ")" ::: "memory")
#define PG8_WAIT_L(n) asm volatile("s_waitcnt lgkmcnt(" #n ")" ::: "memory")
#define PG8_BAR __builtin_amdgcn_s_barrier()
#define PG8_SCHED __builtin_amdgcn_sched_barrier(0)
#define PG8_SETVO(VO, ui_) do { _Pragma("unroll") for (int _h = 0; _h < 2; ++_h) _Pragma("unroll") for (int _i = 0; _i < 2; ++_i) { \
        if constexpr (GA) VO[_h][_i] = (unsigned)(S.row((ui_), _h * HALF + RA[_i]) * lda + CA[_i]) * 2u; else VO[_h][_i] = (unsigned)((_h * HALF + RA[_i]) * lda + CA[_i]) * 2u; } } while (0)
    Unit cur, nxt; int ui = 0;
    if (!S.next(0, cur)) return;
    PG8_SETVO(voC, 0);
#pragma unroll
    for (int _h = 0; _h < 2; ++_h)
#pragma unroll
        for (int _i = 0; _i < 2; ++_i) voN[_h][_i] = 0u;
    f32x4 acc[2][2][4][2];
#pragma unroll
    for (int a = 0; a < 2; ++a)
#pragma unroll
        for (int b = 0; b < 2; ++b)
#pragma unroll
            for (int m = 0; m < 4; ++m)
#pragma unroll
                for (int n = 0; n < 2; ++n) acc[a][b][m][n] = (f32x4){0.f, 0.f, 0.f, 0.f};
    bf16x8 At[4][2], B0[2][2], B1[2][2];
    {
        const char* cA = cur.A0; const char* cB = cur.B0;
        PG8_STAGE_B(PG8_SB(0, 0), cB); PG8_STAGE_B(PG8_SB(0, 1), cB + hstepB); PG8_STAGE_A(PG8_SA(0, 0), cA, voC, 0); PG8_STAGE_A(PG8_SA(0, 1), cA, voC, 1);
        if (wr == 1) PG8_BAR;
        PG8_WAIT_V(2); PG8_BAR;
        PG8_STAGE_B(PG8_SB(1, 0), cB + 128); PG8_STAGE_A(PG8_SA(1, 0), cA + 128, voC, 0); PG8_STAGE_B(PG8_SB(1, 1), cB + hstepB + 128);
        PG8_WAIT_V(6); PG8_BAR;
    }
    for (;;) {
        const bool has_next = S.next(ui + 1, nxt);
        if (has_next) { if constexpr (GA) { PG8_SETVO(voN, ui + 1);
#pragma unroll
                for (int _h = 0; _h < 2; ++_h)
#pragma unroll
                    for (int _i = 0; _i < 2; ++_i) voN[_h][_i] -= voC[_h][_i]; } }
        else { nxt = cur;
#pragma unroll
            for (int _h = 0; _h < 2; ++_h)
#pragma unroll
                for (int _i = 0; _i < 2; ++_i) voN[_h][_i] = 0u; }
        const int nt = cur.nt;
        for (int t = 0; t < nt; t += 2) {
            const bool last = (t == nt - 2);
            const char* a1 = tile_ptr(cur.A0, cur.A1, cur.nt0, t + 1);
            const char* a2 = last ? nxt.A0 : tile_ptr(cur.A0, cur.A1, cur.nt0, t + 2);
            const char* b2 = last ? nxt.B0 : tile_ptr(cur.B0, cur.B1, cur.nt0, t + 2);
            const char* a3 = a2 + 128; const char* b3 = b2 + 128;
            unsigned vo2[2][2];
#pragma unroll
            for (int _h = 0; _h < 2; ++_h)
#pragma unroll
                for (int _i = 0; _i < 2; ++_i) vo2[_h][_i] = GA ? voC[_h][_i] + (last ? 1u : 0u) * voN[_h][_i] : voC[_h][_i];
            PG8_LDB(B0, 0, 0); PG8_LDB(B1, 0, 1); PG8_SCHED; PG8_LDA(At, 0, 0); PG8_STAGE_A(PG8_SA(1, 1), a1, voC, 1);
            PG8_WAIT_V(8); PG8_WAIT_L(0); PG8_BAR; PG8_MMA(0, 0, At, B0); PG8_MMA(0, 1, At, B1); PG8_BAR; PG8_SCHED;
            PG8_LDA(At, 0, 1); PG8_STAGE_B(PG8_SB(0, 0), b2); PG8_STAGE_B(PG8_SB(0, 1), b2 + hstepB); PG8_STAGE_A(PG8_SA(0, 0), a2, vo2, 0);
            PG8_WAIT_V(8); PG8_WAIT_L(0); PG8_BAR; PG8_MMA(1, 0, At, B0); PG8_MMA(1, 1, At, B1); PG8_BAR; PG8_SCHED;
            PG8_LDB(B0, 1, 0); PG8_LDB(B1, 1, 1); PG8_SCHED; PG8_LDA(At, 1, 0); PG8_STAGE_A(PG8_SA(0, 1), a2, vo2, 1);
            PG8_WAIT_V(8); PG8_WAIT_L(0); PG8_BAR; PG8_MMA(0, 0, At, B0); PG8_MMA(0, 1, At, B1); PG8_BAR; PG8_SCHED;
            PG8_LDA(At, 1, 1); PG8_STAGE_B(PG8_SB(1, 0), b3); PG8_STAGE_B(PG8_SB(1, 1), b3 + hstepB); PG8_STAGE_A(PG8_SA(1, 0), a3, vo2, 0);
            PG8_WAIT_V(8); PG8_WAIT_L(0); PG8_BAR; PG8_MMA(1, 0, At, B0); PG8_MMA(1, 1, At, B1); PG8_BAR; PG8_SCHED;
        }
        if (wr == 0) PG8_BAR;
        E(acc, cur, wr, wc, fr, fq);
        if (!has_next) break;
#pragma unroll
        for (int a = 0; a < 2; ++a)
#pragma unroll
            for (int b = 0; b < 2; ++b)
#pragma unroll
                for (int m = 0; m < 4; ++m)
#pragma unroll
                    for (int n = 0; n < 2; ++n) acc[a][b][m][n] = (f32x4){0.f, 0.f, 0.f, 0.f};
        cur = nxt; ++ui;
        if constexpr (GA) {
#pragma unroll
            for (int _h = 0; _h < 2; ++_h)
#pragma unroll
                for (int _i = 0; _i < 2; ++_i) voC[_h][_i] += voN[_h][_i];
        }
        if (wr == 1) PG8_BAR;
    }
    PG8_WAIT_V(0);
    PG8_BAR;
#undef PG8_SA
#undef PG8_SB
#undef PG8_STAGE_A
#undef PG8_STAGE_B
#undef PG8_LDA
#undef PG8_LDB
#undef PG8_MMA
#undef PG8_WAIT_V
#undef PG8_WAIT_L
#undef PG8_BAR
#undef PG8_SCHED
#undef PG8_SETVO
}
}
constexpr int NB = 4, SEQ = 8192, D = 1024, T = NB * SEQ;
constexpr int NHEAD = 16, HD = 64;
constexpr int QLORA = 384, KVLORA = 256, ROPE = 32, QKD = 96;
constexpr int NEXP = 16, NCLS = 24, DEXP = 256;
constexpr int MODW = 14336;
constexpr float NORM_EPS = 1e-6f, GN_EPS = 64e-5f;
constexpr float QSCALE = 0.10206207261596577f * 1.4426950408889634f;
constexpr int NWAVES = 8, NTHREADS = 512;

constexpr size_t MiB = 1u << 20;
constexpr size_t SLOT = 64 * MiB;
constexpr size_t WS_W0 = 0, WS_W1 = SLOT, WS_W2 = 2 * SLOT, WS_W3 = 3 * SLOT, WS_W4 = 4 * SLOT, WS_W5 = 5 * SLOT, WS_W6 = 6 * SLOT;
constexpr size_t WS_MISC = 7 * SLOT;
constexpr size_t WS_CTL = WS_MISC, CTL_ZERO_BYTES = 1 * MiB;
constexpr size_t WS_MOD = WS_MISC + 1 * MiB;
constexpr size_t WS_TAB = WS_MISC + 2 * MiB;
constexpr size_t WS_LIST = WS_MISC + 6 * MiB;
constexpr size_t WS_GATES = WS_MISC + 9 * MiB;
constexpr size_t WS_SSQKV = WS_MISC + 9 * MiB + 512 * 1024;
constexpr size_t WS_SSQQ = WS_MISC + 10 * MiB;
constexpr size_t WS_KR = WS_MISC + 11 * MiB;
constexpr size_t WS_WR = WS_MISC + 13 * MiB, WS_WK = WS_MISC + 15 * MiB, WS_WV = WS_MISC + 17 * MiB;
constexpr size_t WS_LD = WS_MISC + 19 * MiB;
constexpr size_t WS_WO = WS_MISC + 20 * MiB;
constexpr size_t WS_DKV = WS_MISC + 22 * MiB;
constexpr size_t WS_DQ = WS_MISC + 23 * MiB;
constexpr size_t WS_UQ = WS_MISC + 24 * MiB;
constexpr size_t WS_UKV = WS_MISC + 26 * MiB;
constexpr size_t WS_MWO = WS_MISC + 27 * MiB;
constexpr size_t WS_WGU = WS_MISC + 29 * MiB;
constexpr size_t WS_WDN = WS_MISC + 45 * MiB;
constexpr size_t WS_END = WS_MISC + 53 * MiB;
static_assert(WS_END <= 512 * MiB, "d_ws map");
constexpr int CW_BAR = 4096;
constexpr int CW_CNT = 16384;

constexpr int RING_OFF = 0, RING_BYTES = 131072;
constexpr int TAB_OFF = 131072;
constexpr int ROWTAB_OFF = TAB_OFF, GATETAB_OFF = TAB_OFF + 4096, UDESC_OFF = TAB_OFF + 12288, CLSTAB_OFF = UDESC_OFF + 256;
constexpr int MISC_OFF = 151552;
constexpr int LDS_BYTES = 155648;

#define XB_TMO      128
#define XB_XCNT(j)  (256  + 64 * (j))
#define XB_XSUB(j)  (1280 + 64 * (j))
#define XB_XGEN(j)  (2304 + 64 * (j))
#define XB_TOP      3328
#define XB_TOPGEN   3392
#define XCD_BAR_WORDS 3456
#define XB_SPIN_CAP (1u << 18)

__device__ __forceinline__ unsigned xb_ld(unsigned* p)              { return __hip_atomic_load(p, __ATOMIC_RELAXED, __HIP_MEMORY_SCOPE_AGENT); }
__device__ __forceinline__ unsigned xb_add(unsigned* p, unsigned v) { return __hip_atomic_fetch_add(p, v, __ATOMIC_RELAXED, __HIP_MEMORY_SCOPE_AGENT); }
__device__ __forceinline__ unsigned xb_xcc_id() { return (unsigned)__builtin_amdgcn_s_getreg((3 << 11) | 20) & 0xFu; }
#define XB_SPIN(cond, bar) do { unsigned _sp = 0; while (cond) { __builtin_amdgcn_s_sleep(1); \
    if ((++_sp & 255u) == 0u) { if (xb_ld(&(bar)[XB_TMO])) break; if (_sp > XB_SPIN_CAP) { atomicAdd(&(bar)[XB_TMO], 1u); break; } } } } while (0)

struct XcdBarrier { unsigned* bar; unsigned x; volatile LAS unsigned* st; };

__device__ __forceinline__ XcdBarrier xcd_barrier_post(unsigned* bar, volatile LAS unsigned* st) {
    XcdBarrier b; b.bar = bar; b.x = xb_xcc_id(); b.st = st;
    if (threadIdx.x == 0) (void)xb_add(&bar[XB_XCNT(b.x)], 1u);
    return b;
}
__device__ __forceinline__ void xcd_barrier_complete(unsigned* bar, unsigned x, unsigned& nloc, unsigned& nx) {
    const unsigned G = gridDim.x * gridDim.y * gridDim.z;
    unsigned sum, cnt, mine, sp = 0u;
    for (;;) {
        sum = 0u; cnt = 0u; mine = 0u;
#pragma unroll
        for (unsigned j = 0; j < 16; ++j) { const unsigned c = xb_ld(&bar[XB_XCNT(j)]); sum += c; cnt += (c > 0u) ? 1u : 0u; mine = (j == x) ? c : mine; }
        if (sum == G) break;
        __builtin_amdgcn_s_sleep(1);
        if ((++sp & 255u) == 0u) { if (xb_ld(&bar[XB_TMO])) break; if (sp > XB_SPIN_CAP) { atomicAdd(&bar[XB_TMO], 1u); break; } }
    }
    nloc = mine > 0u ? mine : 1u; nx = cnt > 0u ? cnt : 1u;
}
__device__ __forceinline__ void xcd_barrier(const XcdBarrier& b) {
    asm volatile("s_waitcnt vmcnt(0)" ::: "memory");
    __syncthreads();
    if (threadIdx.x == 0) {
        unsigned* bar = b.bar;
        __builtin_amdgcn_s_waitcnt(0);
        unsigned nloc = b.st[0], nx = b.st[1];
        if (nloc == 0u) { xcd_barrier_complete(bar, b.x, nloc, nx); b.st[0] = nloc; b.st[1] = nx; }
        const unsigned old = xb_add(&bar[XB_XSUB(b.x)], 1u);
        const unsigned gen = old / nloc;
        if (old + 1u == (gen + 1u) * nloc) {
            __builtin_amdgcn_fence(__ATOMIC_RELEASE, "agent");
            asm volatile("s_waitcnt vmcnt(0)" ::: "memory");
            const unsigned og = xb_add(&bar[XB_TOP], 1u);
            const unsigned tg = og / nx;
            if (og + 1u == (tg + 1u) * nx) xb_add(&bar[XB_TOPGEN], 1u);
            else XB_SPIN(xb_ld(&bar[XB_TOPGEN]) == tg, bar);
            __builtin_amdgcn_fence(__ATOMIC_ACQUIRE, "agent");
            xb_add(&bar[XB_XGEN(b.x)], 1u);
            asm volatile("s_waitcnt vmcnt(0)" ::: "memory");
        } else {
            XB_SPIN(xb_ld(&bar[XB_XGEN(b.x)]) == gen, bar);
            __builtin_amdgcn_fence(__ATOMIC_ACQUIRE, "agent");
            asm volatile("s_waitcnt vmcnt(0)" ::: "memory");
        }
    }
    __syncthreads();
}

enum { I_X = 0, I_C, I_POS, I_ADAW, I_ADAB, I_NORMG, I_MU, I_WRKV, I_W0, I_W1, I_W2, I_A0, I_A1, I_A2, I_G1, I_G2, I_KK, I_KA, I_RK, I_LNW, I_LNB, I_RWO,
       I_KVADAW, I_KVADAB, I_KVNG, I_WDKV, I_GKV, I_WUK, I_WUV, I_WKR, I_WDQ, I_GQ, I_WUQ, I_WQR, I_MWO, I_RTW, I_RTB, I_WGU, I_WDOWN, I_FG, N_IN };
struct Params { const float* in[N_IN]; float* out; unsigned char* ws; int ph_lo, ph_hi, li, pad; };

struct Ctx {
    LAS unsigned char* lds;
    int tid, lane, wave, G, bid;
};
__device__ __forceinline__ bf16_t* wsb(const Params& p, size_t off) { return (bf16_t*)(p.ws + off); }
__device__ __forceinline__ float* wsf(const Params& p, size_t off) { return (float*)(p.ws + off); }
struct DenseSched {
    int nM, nN, nwg, G, c, nt, nt0, lda, pad; const char* A; const char* B; size_t btile; long a1d, b1d;
    __device__ __forceinline__ void init(const void* A_, int lda_, const void* B_, int ldb_, int M, int N, int K, int G_, int c_) {
        nM = M / 256; nN = N / 256; nwg = nM * nN; G = G_; c = c_; nt = K / 64; nt0 = nt; lda = lda_; pad = 0; A = (const char*)A_; B = (const char*)B_;
        btile = (size_t)256 * ldb_ * 2; a1d = 0; b1d = 0; }
    __device__ __forceinline__ bool next(int i, pg8::Unit& u) const {
        const long L = (long)i * G + c; if (L >= nwg) return false;
        int wgid = (int)L; { const int q = nwg / 8, r = nwg % 8, xcd = wgid % 8, off = wgid / 8; wgid = (xcd < r ? xcd * (q + 1) : r * (q + 1) + (xcd - r) * q) + off; }
        const int nig = 8 * nN, gid = wgid / nig, fm = gid * 8, gsz = (nM - fm) < 8 ? (nM - fm) : 8;
        u.pm = fm + ((wgid % nig) % gsz); u.pn = (wgid % nig) / gsz; u.aux = 0; u.nt = nt; u.nt0 = nt0;
        const size_t arow = pad ? (size_t)((u.pm >> 5) * (SEQ + 1) + 1 + 256 * (u.pm & 31)) : (size_t)u.pm * 256;
        u.A0 = A + arow * (size_t)lda * 2; u.A1 = u.A0 + a1d; u.B0 = B + (size_t)u.pn * btile; u.B1 = u.B0 + b1d; return true;
    }
    __device__ __forceinline__ int row(int, int) const { return 0; }
};

struct MoeSched {
    LAS const int* ud; LAS const int* rowtab; int down; const char* A; const char* Wgu; const char* Wdn;
    __device__ __forceinline__ bool next(int i, pg8::Unit& u) const {
        if (i >= 4) return false;
        const int valid = __builtin_amdgcn_readfirstlane(ud[i * 16 + 0]); if (!valid) return false;
        const int st = __builtin_amdgcn_readfirstlane(ud[i * 16 + 1]), pn = __builtin_amdgcn_readfirstlane(ud[i * 16 + 2]);
        const int elo = __builtin_amdgcn_readfirstlane(ud[i * 16 + 3]), ehi = __builtin_amdgcn_readfirstlane(ud[i * 16 + 4]);
        u.pm = st; u.pn = pn; u.aux = i;
        if (!down) { u.nt = 16; u.nt0 = 16; u.A0 = A; u.A1 = A; const int e = (pn >> 1) ? ehi : elo;
            u.B0 = Wgu + ((size_t)e * 512 + (size_t)(pn & 1) * 256) * 1024 * 2; u.B1 = u.B0; }
        else { u.nt = 8; u.nt0 = 4; u.A0 = A + (size_t)st * 256 * 512 * 2; u.A1 = u.A0 + 4 * 128;
            u.B0 = Wdn + ((size_t)elo * 1024 + (size_t)pn * 256) * 256 * 2; u.B1 = Wdn + ((size_t)ehi * 1024 + (size_t)pn * 256) * 256 * 2; }
        return true;
    }
    __device__ __forceinline__ int row(int i, int r) const { const int t = rowtab[i * 256 + r]; return t < 0 ? 0 : t; }
};

typedef f32x4 AccT[2][2][4][2];
#define EPI_ARGS const AccT& acc, const pg8::Unit& u, int wr, int wc, int fr, int fq
__device__ __forceinline__ u32x4 pack8(f32x4 a, f32x4 b) { u32x4 w; w.x = cvtpk(a[0], a[1]); w.y = cvtpk(a[2], a[3]); w.z = cvtpk(b[0], b[1]); w.w = cvtpk(b[2], b[3]); return w; }
__device__ __forceinline__ u32x2 pack4(f32x4 a) { u32x2 w; w.x = cvtpk(a[0], a[1]); w.y = cvtpk(a[2], a[3]); return w; }

struct EpiBf16 {
    static constexpr bool PERM = true; bf16_t* O; int ldc;
    __device__ __forceinline__ void operator()(EPI_ARGS) const {
        const int row0 = u.pm * 256 + wr * 64 + fr, col0 = u.pn * 256 + wc * 32 + 8 * fq;
#pragma unroll
        for (int ai = 0; ai < 2; ++ai)
#pragma unroll
            for (int m = 0; m < 4; ++m) { bf16_t* rowp = O + (size_t)(row0 + ai * 128 + m * 16) * ldc + col0;
#pragma unroll
                for (int bj = 0; bj < 2; ++bj) *(u32x4*)(rowp + bj * 128) = pack8(acc[ai][bj][m][0], acc[ai][bj][m][1]); }
    }
};
struct EpiLoraDown {
    static constexpr bool PERM = true; bf16_t* O;
    __device__ __forceinline__ void operator()(EPI_ARGS) const {
        const int row0 = u.pm * 256 + wr * 64 + fr, col0 = wc * 32 + 8 * fq;
#pragma unroll
        for (int ai = 0; ai < 2; ++ai)
#pragma unroll
            for (int m = 0; m < 4; ++m) { bf16_t* rowp = O + (size_t)(row0 + ai * 128 + m * 16) * 256 + col0;
#pragma unroll
                for (int bj = 0; bj < 2; ++bj) { f32x4 v0 = acc[ai][bj][m][0], v1 = acc[ai][bj][m][1];
                    if (bj == 1) {
#pragma unroll
                        for (int i = 0; i < 4; ++i) { v0[i] = sigmoidf_(v0[i]); v1[i] = sigmoidf_(v1[i]); } }
                    else if (wc < 2) {
#pragma unroll
                        for (int i = 0; i < 4; ++i) { v0[i] = tanhf(v0[i]); v1[i] = tanhf(v1[i]); } }
                    *(u32x4*)(rowp + bj * 128) = pack8(v0, v1); } }
    }
};
struct EpiResid {
    static constexpr bool PERM = false; const float* xin; float* xout; const float* gate;
    __device__ __forceinline__ void operator()(EPI_ARGS) const {
        const int row0 = u.pm * 256 + wr * 64 + fr, col0 = u.pn * 256 + wc * 32 + 4 * fq; const int b = u.pm >> 5;
        f32x4 gv[2][2];
#pragma unroll
        for (int bj = 0; bj < 2; ++bj)
#pragma unroll
            for (int n = 0; n < 2; ++n) gv[bj][n] = *(const f32x4*)(gate + (size_t)b * MODW + col0 + bj * 128 + n * 16);
#pragma unroll
        for (int ai = 0; ai < 2; ++ai)
#pragma unroll
            for (int m = 0; m < 4; ++m) { const size_t off = (size_t)(row0 + ai * 128 + m * 16) * D + col0;
#pragma unroll
                for (int bj = 0; bj < 2; ++bj)
#pragma unroll
                    for (int n = 0; n < 2; ++n) { const f32x4 xv = *(const f32x4*)(xin + off + bj * 128 + n * 16);
                        *(f32x4*)(xout + off + bj * 128 + n * 16) = xv + gv[bj][n] * acc[ai][bj][m][n]; } }
    }
};
struct EpiMoeUp {
    static constexpr bool PERM = true; bf16_t* act; LAS const float* gatetab;
    __device__ __forceinline__ void operator()(EPI_ARGS) const {
        const int eidx = u.pn >> 1, half = u.pn & 1; const int rl0 = wr * 64 + fr, col0 = eidx * 256 + half * 128 + wc * 32 + 8 * fq;
#pragma unroll
        for (int ai = 0; ai < 2; ++ai)
#pragma unroll
            for (int m = 0; m < 4; ++m) { const int rl = rl0 + ai * 128 + m * 16; const float cb = gatetab[(u.aux * 256 + rl) * 2 + eidx];
                f32x4 o[2];
#pragma unroll
                for (int n = 0; n < 2; ++n)
#pragma unroll
                    for (int i = 0; i < 4; ++i) { const float g = acc[ai][0][m][n][i], up = acc[ai][1][m][n][i]; o[n][i] = g * sigmoidf_(g) * up * cb; }
                *(u32x4*)(act + (size_t)(u.pm * 256 + rl) * 512 + col0) = pack8(o[0], o[1]); }
    }
};
struct EpiMoeDown {
    static constexpr bool PERM = false; float* X; const float* gate; LAS const int* rowtab;
    __device__ __forceinline__ void operator()(EPI_ARGS) const {
        const int rl0 = wr * 64 + fr, col0 = u.pn * 256 + wc * 32 + 4 * fq;
#pragma unroll
        for (int ai = 0; ai < 2; ++ai)
#pragma unroll
            for (int m = 0; m < 4; ++m) { const int rl = rl0 + ai * 128 + m * 16; const int tok = rowtab[u.aux * 256 + rl];
                if (tok >= 0) { const float* gp = gate + (size_t)(tok >> 13) * MODW + col0; float* xp = X + (size_t)tok * D + col0;
#pragma unroll
                    for (int bj = 0; bj < 2; ++bj)
#pragma unroll
                        for (int n = 0; n < 2; ++n) { const f32x4 gv = *(const f32x4*)(gp + bj * 128 + n * 16); const f32x4 xv = *(const f32x4*)(xp + bj * 128 + n * 16);
                            *(f32x4*)(xp + bj * 128 + n * 16) = xv + gv * acc[ai][bj][m][n]; } } }
    }
};
struct EpiDown {
    static constexpr bool PERM = false; bf16_t* O; int ldc; int ncols1; float* ssq; int ssq_ld; bf16_t* Kr; const float* tab;
    __device__ __forceinline__ void operator()(EPI_ARGS) const {
        const int row0 = u.pm * 256 + wr * 64 + fr;
#pragma unroll
        for (int ai = 0; ai < 2; ++ai)
#pragma unroll
            for (int m = 0; m < 4; ++m) { const int row = row0 + ai * 128 + m * 16;
                if (u.pn == 0 || ncols1 > 0) { float ss = 0.f;
#pragma unroll
                    for (int bj = 0; bj < 2; ++bj) { if (u.pn == 0 || bj * 128 < ncols1) {
#pragma unroll
                        for (int n = 0; n < 2; ++n) { const f32x4 v = acc[ai][bj][m][n]; ss += (v[0] * v[0] + v[1] * v[1]) + (v[2] * v[2] + v[3] * v[3]);
                            *(u32x2*)(O + (size_t)row * ldc + u.pn * 256 + bj * 128 + wc * 32 + n * 16 + 4 * fq) = pack4(v); } } }
                    ss += __shfl_xor(ss, 16); ss += __shfl_xor(ss, 32);
                    if (fq == 0) ssq[(size_t)row * ssq_ld + u.pn * 4 + wc] = ss; }
                if (Kr != nullptr && u.pn == 1 && wc == 0) { const f32x4 x1 = acc[ai][0][m][0], x2 = acc[ai][0][m][1];
                    const f32x4 c4 = *(const f32x4*)(tab + (size_t)row * 32 + 4 * fq), s4 = *(const f32x4*)(tab + (size_t)row * 32 + 16 + 4 * fq);
                    *(u32x2*)(Kr + (size_t)row * 32 + 4 * fq) = pack4(x1 * c4 - x2 * s4); *(u32x2*)(Kr + (size_t)row * 32 + 16 + 4 * fq) = pack4(x2 * c4 + x1 * s4); } }
    }
};
struct EpiQ {
    static constexpr bool PERM = false; bf16_t* Q; const float* ssq; const float* tab;
    __device__ __forceinline__ void operator()(EPI_ARGS) const {
        const int row0 = u.pm * 256 + wr * 64 + fr;
#pragma unroll
        for (int ai = 0; ai < 2; ++ai)
#pragma unroll
            for (int m = 0; m < 4; ++m) { const int row = row0 + ai * 128 + m * 16;
                const f32x4 sa = *(const f32x4*)(ssq + (size_t)row * 8), sb = *(const f32x4*)(ssq + (size_t)row * 8 + 4);
                const float sc = rsqrtf(((sa[0] + sa[1]) + (sa[2] + sa[3]) + (sb[0] + sb[1]) + (sb[2] + sb[3])) * (1.0f / QLORA) + NORM_EPS) * QSCALE;
                bf16_t* qrow = Q + (size_t)row * (NHEAD * QKD);
                if (u.pn < 4) {
#pragma unroll
                    for (int bj = 0; bj < 2; ++bj)
#pragma unroll
                        for (int n = 0; n < 2; ++n) { const int col = u.pn * 256 + bj * 128 + wc * 32 + n * 16 + 4 * fq;
                            *(u32x2*)(qrow + (col >> 6) * QKD + (col & 63)) = pack4(acc[ai][bj][m][n] * sc); }
                } else { const f32x4 c4 = *(const f32x4*)(tab + (size_t)row * 32 + 4 * fq), s4 = *(const f32x4*)(tab + (size_t)row * 32 + 16 + 4 * fq);
#pragma unroll
                    for (int bj = 0; bj < 2; ++bj) { const int h = (u.pn - 4) * 8 + bj * 4 + wc; const f32x4 x1 = acc[ai][bj][m][0] * sc, x2 = acc[ai][bj][m][1] * sc;
                        *(u32x2*)(qrow + h * QKD + 64 + 4 * fq) = pack4(x1 * c4 - x2 * s4); *(u32x2*)(qrow + h * QKD + 80 + 4 * fq) = pack4(x2 * c4 + x1 * s4); } } }
    }
};
struct EpiKV {
    static constexpr bool PERM = true; bf16_t* Kn; bf16_t* V; const float* ssq;
    __device__ __forceinline__ void operator()(EPI_ARGS) const {
        const int row0 = u.pm * 256 + wr * 64 + fr; bf16_t* base = (u.pn < 4) ? Kn : V; const int col0 = (u.pn & 3) * 256 + wc * 32 + 8 * fq;
#pragma unroll
        for (int ai = 0; ai < 2; ++ai)
#pragma unroll
            for (int m = 0; m < 4; ++m) { const int row = row0 + ai * 128 + m * 16; const f32x4 sa = *(const f32x4*)(ssq + (size_t)row * 4);
                const float sc = rsqrtf(((sa[0] + sa[1]) + (sa[2] + sa[3])) * (1.0f / KVLORA) + NORM_EPS);
#pragma unroll
                for (int bj = 0; bj < 2; ++bj) *(u32x4*)(base + (size_t)row * D + col0 + bj * 128) = pack8(acc[ai][bj][m][0] * sc, acc[ai][bj][m][1] * sc); }
    }
};
__device__ __forceinline__ float srcval(const Params& p, int kind, int e, int k, int n) {
    switch (kind) {
    case 0: case 1: case 2: return p.in[I_WRKV][((size_t)kind * D + k) * D + n];
    case 3: { const int kk = k & 1023, hi = k >> 10; float w, mu;
        if (n < 64) { w = p.in[I_W1][kk * 64 + n]; mu = p.in[I_MU][1 * D + kk]; }
        else if (n < 128) { w = p.in[I_A1][kk * 64 + n - 64]; mu = p.in[I_MU][4 * D + kk]; }
        else { w = p.in[I_G1][kk * 128 + n - 128]; mu = p.in[I_MU][5 * D + kk]; }
        return w * (hi ? mu : 1.0f - mu); }
    case 4: return p.in[I_RWO][(size_t)k * D + n];
    case 5: return n < 256 ? p.in[I_WDKV][k * 256 + n] : (n < 288 ? p.in[I_WKR][k * 32 + n - 256] : 0.f);
    case 6: return n < 384 ? p.in[I_WDQ][k * 384 + n] : 0.f;
    case 7: return p.in[I_GQ][k] * (n < 1024 ? p.in[I_WUQ][(size_t)k * 1024 + n] : p.in[I_WQR][(size_t)k * 512 + n - 1024]);
    case 8: return p.in[I_GKV][k] * (n < 1024 ? p.in[I_WUK][(size_t)k * 1024 + n] : p.in[I_WUV][(size_t)k * 1024 + n - 1024]);
    case 9: return p.in[I_MWO][(size_t)k * D + n];
    case 10: { const int pp = n >> 8, w = n & 255; const int col = (w < 128) ? (128 * pp + w) : (256 + 128 * pp + (w - 128));
        return p.in[I_WGU][((size_t)e * D + k) * 512 + col]; }
    default: return p.in[I_WDOWN][((size_t)e * 256 + k) * D + n];
    }
}
__device__ __forceinline__ void transpose_item(const Params& p, int kind, int e, bf16_t* dst, int ldd, LAS float* scr, int kb, int nb, int lane) {
    const int k0 = 64 * kb, n0 = 32 * nb;
#pragma unroll 4
    for (int i = 0; i < 32; ++i) { const int kk = 2 * i + (lane >> 5); scr[kk * 33 + (lane & 31)] = srcval(p, kind, e, k0 + kk, n0 + (lane & 31)); }
    asm volatile("s_waitcnt lgkmcnt(0)" ::: "memory");
    const int c = lane & 7;
#pragma unroll
    for (int j = 0; j < 4; ++j) { const int n = (lane >> 3) + 8 * j; const LAS float* s = scr + (8 * c) * 33 + n;
        u32x4 o; o.x = cvtpk(s[0 * 33], s[1 * 33]); o.y = cvtpk(s[2 * 33], s[3 * 33]); o.z = cvtpk(s[4 * 33], s[5 * 33]); o.w = cvtpk(s[6 * 33], s[7 * 33]);
        *(u32x4*)(dst + (size_t)(n0 + n) * ldd + k0 + 8 * c) = o; }
    asm volatile("s_waitcnt lgkmcnt(0)" ::: "memory");
}
__device__ __forceinline__ bool tjob(const Params& p, int& r, int kind, int e, size_t ws_off, int Kd, int Nd, LAS float* scr, int lane) {
    const int nkb = Kd / 64, nnb = Nd / 32, cnt = nkb * nnb;
    if (r < cnt) { transpose_item(p, kind, e, wsb(p, ws_off), Kd, scr, r / nnb, r % nnb, lane); return true; }
    r -= cnt; return false;
}
__device__ __forceinline__ void convert_moe_weights(const Params& p, const Ctx& c, int layer) {
    LAS float* scr = (LAS float*)(c.lds + RING_OFF + c.wave * 16384);
    const int gw = c.bid * NWAVES + c.wave, NGW = c.G * NWAVES;
    for (int it = gw; it < 16 * 384; it += NGW) { const int e = it / 384; int r = it % 384;
        if (r < 256) transpose_item(p, 10, layer * 16 + e, wsb(p, WS_WGU) + (size_t)e * 512 * 1024, 1024, scr, r / 16, r % 16, c.lane);
        else { r -= 256; transpose_item(p, 11, layer * 16 + e, wsb(p, WS_WDN) + (size_t)e * 1024 * 256, 256, scr, r / 32, r % 32, c.lane); } }
}
__device__ __forceinline__ void phase_prologue(const Params& p, const Ctx& c) {
    LAS float* sc = (LAS float*)(c.lds);
    LAS float* part = (LAS float*)(c.lds + 16384);
    for (int i = c.tid; i < NB * D; i += NTHREADS) { const float v = p.in[I_C][i]; sc[i] = v / (1.0f + __expf(-v)); }
    __syncthreads();
    for (int it = c.bid; it < MODW / 64; it += c.G) {
        const int col0 = it * 64, set = col0 < 12288 ? col0 / 3072 : 4, cin = col0 - (set < 4 ? set * 3072 : 12288);
        const float* W = set < 4 ? p.in[I_ADAW] + (size_t)set * D * 3072 : p.in[I_KVADAW]; const int ldw = set < 4 ? 3072 : 2048;
        const float* bias = set < 4 ? p.in[I_ADAB] + set * 3072 : p.in[I_KVADAB];
        float a0 = 0.f, a1 = 0.f, a2 = 0.f, a3 = 0.f;
#pragma unroll 8
        for (int kk = 0; kk < 128; ++kk) { const int k = c.wave * 128 + kk; const float w = W[(size_t)k * ldw + cin + c.lane];
            a0 += sc[k] * w; a1 += sc[D + k] * w; a2 += sc[2 * D + k] * w; a3 += sc[3 * D + k] * w; }
        part[(c.wave * 4 + 0) * 64 + c.lane] = a0; part[(c.wave * 4 + 1) * 64 + c.lane] = a1; part[(c.wave * 4 + 2) * 64 + c.lane] = a2; part[(c.wave * 4 + 3) * 64 + c.lane] = a3;
        __syncthreads();
        if (c.tid < 256) { const int b = c.tid >> 6, l = c.tid & 63; float s = bias[cin + l];
#pragma unroll
            for (int w = 0; w < 8; ++w) s += part[(w * 4 + b) * 64 + l];
            wsf(p, WS_MOD)[(size_t)b * MODW + col0 + l] = s; }
        __syncthreads();
    }
    __syncthreads();
    LAS float* scr = (LAS float*)(c.lds + RING_OFF + c.wave * 16384);
    const int gw = c.bid * NWAVES + c.wave, NGW = c.G * NWAVES;
    constexpr int NITEMS = 3 * 512 + 256 + 512 + 256 + 256 + 288 + 256 + 512;
    for (int it = gw; it < NITEMS; it += NGW) { int r = it;
        if (tjob(p, r, 0, 0, WS_WR, 1024, 1024, scr, c.lane)) continue;
        if (tjob(p, r, 1, 0, WS_WK, 1024, 1024, scr, c.lane)) continue;
        if (tjob(p, r, 2, 0, WS_WV, 1024, 1024, scr, c.lane)) continue;
        if (tjob(p, r, 3, 0, WS_LD, 2048, 256, scr, c.lane)) continue;
        if (tjob(p, r, 4, 0, WS_WO, 1024, 1024, scr, c.lane)) continue;
        if (tjob(p, r, 5, 0, WS_DKV, 1024, 512, scr, c.lane)) continue;
        if (tjob(p, r, 6, 0, WS_DQ, 1024, 512, scr, c.lane)) continue;
        if (tjob(p, r, 7, 0, WS_UQ, 384, 1536, scr, c.lane)) continue;
        if (tjob(p, r, 8, 0, WS_UKV, 256, 2048, scr, c.lane)) continue;
        tjob(p, r, 9, 0, WS_MWO, 1024, 1024, scr, c.lane);
    }
    convert_moe_weights(p, c, 0);
    const int* pos = (const int*)p.in[I_POS]; float* tab = wsf(p, WS_TAB);
    for (int i = c.bid * NTHREADS + c.tid; i < T * 16; i += c.G * NTHREADS) { const int t = i >> 4, f = i & 15;
        const float inv = powf(10000.0f, -(float)(2 * f) / 32.0f); float s, co; sincosf((float)pos[t] * inv, &s, &co);
        tab[(size_t)t * 32 + f] = co; tab[(size_t)t * 32 + 16 + f] = s; }
}

__device__ __forceinline__ void load_row(const float* rowp, int lane, f32x4 (&v)[4]) {
#pragma unroll
    for (int j = 0; j < 4; ++j) v[j] = *(const f32x4*)(rowp + 4 * lane + 256 * j);
}
__device__ __forceinline__ float row_rstd(const f32x4 (&v)[4]) {
    float s = 0.f;
#pragma unroll
    for (int j = 0; j < 4; ++j) s += (v[j][0] * v[j][0] + v[j][1] * v[j][1]) + (v[j][2] * v[j][2] + v[j][3] * v[j][3]);
    return rsqrtf(wave_sum(s) * (1.0f / D) + NORM_EPS);
}
__device__ __forceinline__ void store_row_bf16(bf16_t* rowp, int lane, const f32x4 (&v)[4]) {
#pragma unroll
    for (int j = 0; j < 4; ++j) *(u32x2*)(rowp + 4 * lane + 256 * j) = pack4(v[j]);
}
__device__ __forceinline__ void load_mod(const Params& p, const float* g, int set, int b, int lane, f32x4 (&P)[4], f32x4 (&SH)[4]) {
    const float* m = wsf(p, WS_MOD) + (size_t)b * MODW + (set < 4 ? set * 3072 : 12288);
#pragma unroll
    for (int j = 0; j < 4; ++j) { const int o = 4 * lane + 256 * j; const f32x4 gg = *(const f32x4*)(g + o), sc = *(const f32x4*)(m + 1024 + o); SH[j] = *(const f32x4*)(m + o); P[j] = gg * (sc + 1.0f); }
}

__device__ __forceinline__ void phase_n0(const Params& p, const Ctx& c) {
    const int row0 = (c.bid * NWAVES + c.wave) * 16;
    if (row0 >= T) return;
    const int b = row0 >> 13, t0 = row0 & (SEQ - 1);
    f32x4 P[4], SH[4], mr[4], mk[4], mv[4];
    load_mod(p, p.in[I_NORMG] + 0 * D, 0, b, c.lane, P, SH);
#pragma unroll
    for (int j = 0; j < 4; ++j) { const int o = 4 * c.lane + 256 * j; mr[j] = *(const f32x4*)(p.in[I_MU] + 0 * D + o); mk[j] = *(const f32x4*)(p.in[I_MU] + 2 * D + o); mv[j] = *(const f32x4*)(p.in[I_MU] + 3 * D + o); }
    bf16_t* hpad = (bf16_t*)p.out; bf16_t* xr = wsb(p, WS_W0); bf16_t* xk = wsb(p, WS_W1); bf16_t* xv = wsb(p, WS_W2);
    f32x4 hp[4];
    if (t0 == 0) {
#pragma unroll
        for (int j = 0; j < 4; ++j) hp[j] = (f32x4){0.f, 0.f, 0.f, 0.f};
        store_row_bf16(hpad + (size_t)b * (SEQ + 1) * D, c.lane, hp);
    } else { f32x4 v[4]; load_row(p.in[I_X] + (size_t)(row0 - 1) * D, c.lane, v); const float rs = row_rstd(v);
#pragma unroll
        for (int j = 0; j < 4; ++j) hp[j] = v[j] * rs * P[j] + SH[j]; }
    for (int r = 0; r < 16; ++r) { const int row = row0 + r; f32x4 v[4], o[4]; load_row(p.in[I_X] + (size_t)row * D, c.lane, v); const float rs = row_rstd(v);
#pragma unroll
        for (int j = 0; j < 4; ++j) v[j] = v[j] * rs * P[j] + SH[j];
        store_row_bf16(hpad + ((size_t)b * (SEQ + 1) + 1 + t0 + r) * D, c.lane, v);
#pragma unroll
        for (int j = 0; j < 4; ++j) o[j] = v[j] + (hp[j] - v[j]) * mr[j];
        store_row_bf16(xr + (size_t)row * D, c.lane, o);
#pragma unroll
        for (int j = 0; j < 4; ++j) o[j] = v[j] + (hp[j] - v[j]) * mk[j];
        store_row_bf16(xk + (size_t)row * D, c.lane, o);
#pragma unroll
        for (int j = 0; j < 4; ++j) o[j] = v[j] + (hp[j] - v[j]) * mv[j];
        store_row_bf16(xv + (size_t)row * D, c.lane, o);
#pragma unroll
        for (int j = 0; j < 4; ++j) hp[j] = v[j]; }
}

__device__ __forceinline__ void phase_router(const Params& p, const Ctx& c, int layer) {
    LAS float* rwt = (LAS float*)(c.lds);
    LAS int* rcls = (LAS int*)(c.lds + 65536);
    LAS float* rgate = (LAS float*)(c.lds + 65536 + 512);
    LAS int* rpos = (LAS int*)(c.lds + 65536 + 2048);
    LAS int* hist = (LAS int*)(c.lds + 65536 + 4096);
    for (int i = c.tid; i < D * NEXP; i += NTHREADS) { const int k = i >> 4, e = i & 15; rwt[e * D + k] = p.in[I_RTW][i]; }
    if (c.tid < 64) hist[c.tid] = 0;
    __syncthreads();
    const int set = layer * 2 + 1; const int rowb = c.bid * 128; const int b = rowb >> 13;
    f32x4 P[4], SH[4]; load_mod(p, p.in[I_NORMG] + (size_t)set * D, set, b, c.lane, P, SH);
    float rb[16];
#pragma unroll
    for (int e = 0; e < 16; ++e) rb[e] = p.in[I_RTB][e];
    const float* X = p.out; bf16_t* h2 = wsb(p, WS_W1);
    for (int r = 0; r < 16; ++r) { const int rl = c.wave * 16 + r, row = rowb + rl; f32x4 v[4]; load_row(X + (size_t)row * D, c.lane, v); const float rs = row_rstd(v);
#pragma unroll
        for (int j = 0; j < 4; ++j) v[j] = v[j] * rs * P[j] + SH[j];
        store_row_bf16(h2 + (size_t)row * D, c.lane, v);
        float sel[16], aff[16];
#pragma unroll
        for (int e = 0; e < 16; ++e) { float s = 0.f;
#pragma unroll
            for (int j = 0; j < 4; ++j) { const f32x4 w = *(const LAS f32x4*)(rwt + e * D + 4 * c.lane + 256 * j); s += (v[j][0] * w[0] + v[j][1] * w[1]) + (v[j][2] * w[2] + v[j][3] * w[3]); }
            s = wave_sum(s); aff[e] = 1.0f / (1.0f + __expf(-s)); sel[e] = aff[e] + rb[e]; }
        int bg = 0; float bs = -INFINITY;
#pragma unroll
        for (int g = 0; g < 4; ++g) { const float a0 = sel[4 * g], a1 = sel[4 * g + 1], a2 = sel[4 * g + 2], a3 = sel[4 * g + 3];
            const float m01 = fmaxf(a0, a1), n01 = fminf(a0, a1), m23 = fmaxf(a2, a3), n23 = fminf(a2, a3);
            const float top = fmaxf(m01, m23), second = fmaxf(fminf(m01, m23), (m01 >= m23) ? n01 : n23); const float gs = top + second;
            if (gs > bs) { bs = gs; bg = g; } }
        float s4[4], a4[4];
#pragma unroll
        for (int g = 0; g < 4; ++g) if (g == bg) {
#pragma unroll
            for (int i = 0; i < 4; ++i) { s4[i] = sel[4 * g + i]; a4[i] = aff[4 * g + i]; } }
        int i0 = 0;
#pragma unroll
        for (int i = 1; i < 4; ++i) if (s4[i] > s4[i0]) i0 = i;
        int i1 = (i0 == 0) ? 1 : 0;
#pragma unroll
        for (int i = 0; i < 4; ++i) if (i != i0 && i != i1 && s4[i] > s4[i1]) i1 = i;
        float af0 = 0.f, af1 = 0.f;
#pragma unroll
        for (int i = 0; i < 4; ++i) { if (i == i0) af0 = a4[i]; if (i == i1) af1 = a4[i]; }
        const float inv = 1.0f / (af0 + af1);
        const int lo = i0 < i1 ? i0 : i1, hi = i0 < i1 ? i1 : i0; const float glo = (i0 < i1 ? af0 : af1) * inv, ghi = (i0 < i1 ? af1 : af0) * inv;
        const int pair = (lo == 0) ? (hi - 1) : (lo == 1 ? hi + 1 : 5);
        if (c.lane == 0) { rcls[rl] = bg * 6 + pair; rgate[rl * 2] = glo; rgate[rl * 2 + 1] = ghi; }
    }
    __syncthreads();
    if (c.tid < 128) rpos[c.tid] = atomicAdd((int*)(hist + rcls[c.tid]), 1);
    __syncthreads();
    unsigned* gcnt = (unsigned*)(p.ws + WS_CTL) + CW_CNT + 64 * layer;
    if (c.tid < NCLS) { const int n = hist[c.tid]; hist[32 + c.tid] = n ? (int)atomicAdd(gcnt + c.tid, (unsigned)n) : 0; }
    __syncthreads();
    if (c.tid < 128) { const int cl = rcls[c.tid], pos = hist[32 + cl] + rpos[c.tid], tok = rowb + c.tid;
        ((int*)(p.ws + WS_LIST))[(size_t)cl * T + pos] = tok;
        *(f32x2*)(wsf(p, WS_GATES) + (size_t)tok * 2) = (f32x2){rgate[c.tid * 2], rgate[c.tid * 2 + 1]}; }
}

__device__ __forceinline__ void moe_setup(const Params& p, const Ctx& c, int layer) {
    LAS int* ud = (LAS int*)(c.lds + UDESC_OFF); LAS int* ct = (LAS int*)(c.lds + CLSTAB_OFF);
    LAS int* rowtab = (LAS int*)(c.lds + ROWTAB_OFF); LAS float* gatetab = (LAS float*)(c.lds + GATETAB_OFF);
    const unsigned* gcnt = (const unsigned*)(p.ws + WS_CTL) + CW_CNT + 64 * layer;
    if (c.tid < NCLS) ct[c.tid] = (int)__hip_atomic_load(gcnt + c.tid, __ATOMIC_RELAXED, __HIP_MEMORY_SCOPE_AGENT);
    __syncthreads();
    if (c.tid == 0) { int acc = 0; for (int k = 0; k < NCLS; ++k) { ct[32 + k] = acc; acc += (ct[k] + 255) >> 8; } ct[32 + NCLS] = acc;
        const int total = acc * 4;
        for (int i = 0; i < 4; ++i) { const long L0 = (long)i * c.G + c.bid; int valid = 0, st = 0, pn = 0, elo = 0, ehi = 0, cls = 0, j = 0;
            if (L0 < total) { int L = (int)L0; { const int q = total / 8, r = total % 8, xcd = L % 8, off = L / 8; L = (xcd < r ? xcd * (q + 1) : r * (q + 1) + (xcd - r) * q) + off; }
                valid = 1; pn = L & 3; st = L >> 2; cls = 0; while (cls < NCLS - 1 && ct[32 + cls + 1] <= st) ++cls; j = st - ct[32 + cls];
                const int g = cls / 6, pr = cls % 6; const int lo = pr < 3 ? 0 : (pr < 5 ? 1 : 2), hi = pr < 3 ? pr + 1 : (pr < 5 ? pr - 1 : 3); elo = 4 * g + lo; ehi = 4 * g + hi; }
            ud[i * 16 + 0] = valid; ud[i * 16 + 1] = st; ud[i * 16 + 2] = pn; ud[i * 16 + 3] = elo; ud[i * 16 + 4] = ehi; ud[i * 16 + 5] = cls; ud[i * 16 + 6] = j; } }
    __syncthreads();
    const int* list = (const int*)(p.ws + WS_LIST); const float* gates = wsf(p, WS_GATES);
    for (int i = 0; i < 4; ++i) { if (!ud[i * 16]) continue; const int cls = ud[i * 16 + 5], j = ud[i * 16 + 6], n = ct[cls];
        if (c.tid < 256) { const int pos = j * 256 + c.tid; int tok = -1; f32x2 g = {0.f, 0.f};
            if (pos < n) { tok = list[(size_t)cls * T + pos]; g = *(const f32x2*)(gates + (size_t)tok * 2); }
            rowtab[i * 256 + c.tid] = tok; gatetab[(i * 256 + c.tid) * 2] = g.x; gatetab[(i * 256 + c.tid) * 2 + 1] = g.y; } }
    __syncthreads();
}

__device__ __forceinline__ void phase_n2(const Params& p, const Ctx& c) {
    const int row0 = (c.bid * NWAVES + c.wave) * 16; if (row0 >= T) return; const int b = row0 >> 13;
    f32x4 P1[4], S1[4], P2[4], S2[4];
    load_mod(p, p.in[I_NORMG] + 2 * D, 2, b, c.lane, P1, S1); load_mod(p, p.in[I_KVNG], 4, b, c.lane, P2, S2);
    const float* X = p.out; bf16_t* h1 = wsb(p, WS_W0); bf16_t* hkv = wsb(p, WS_W1);
    for (int r = 0; r < 16; ++r) { const int row = row0 + r; f32x4 v[4], o[4]; load_row(X + (size_t)row * D, c.lane, v); const float rs = row_rstd(v);
#pragma unroll
        for (int j = 0; j < 4; ++j) { v[j] = v[j] * rs; o[j] = v[j] * P1[j] + S1[j]; }
        store_row_bf16(h1 + (size_t)row * D, c.lane, o);
#pragma unroll
        for (int j = 0; j < 4; ++j) o[j] = v[j] * P2[j] + S2[j];
        store_row_bf16(hkv + (size_t)row * D, c.lane, o); }
}
__device__ __forceinline__ void phase_final(const Params& p, const Ctx& c) {
    const int row0 = (c.bid * NWAVES + c.wave) * 16; if (row0 >= T) return;
    f32x4 g[4];
#pragma unroll
    for (int j = 0; j < 4; ++j) g[j] = *(const f32x4*)(p.in[I_FG] + 4 * c.lane + 256 * j);
    for (int r = 0; r < 16; ++r) { float* rowp = p.out + (size_t)(row0 + r) * D; f32x4 v[4]; load_row(rowp, c.lane, v); const float rs = row_rstd(v);
#pragma unroll
        for (int j = 0; j < 4; ++j) *(f32x4*)(rowp + 4 * c.lane + 256 * j) = v[j] * rs * g[j]; }
}
constexpr int WK_TT = 32;
__device__ __forceinline__ void phase_wkv_seq(const Params& p, const Ctx& c) {
    if (c.bid >= NB * NHEAD) return;
    const int b = c.bid >> 4, h = c.bid & 15, tid = c.tid;
    LAS float* W2h = (LAS float*)(c.lds);
    LAS float* A2h = (LAS float*)(c.lds + 16384);
    LAS float* G2h = (LAS float*)(c.lds + 32768);
    LAS unsigned short* L1t = (LAS unsigned short*)(c.lds + 65536);
    LAS float* rT = (LAS float*)(c.lds + 81920);
    LAS float* kT = rT + 2048; LAS float* vT = kT + 2048; LAS float* dT = vT + 2048; LAS float* aT = dT + 2048; LAS float* bT = aT + 2048; LAS float* gT = bT + 2048; LAS float* yT = gT + 2048;
    for (int i = tid; i < 64 * 64; i += NTHREADS) { const int k = i >> 6, j = i & 63; W2h[i] = p.in[I_W2][(size_t)k * D + h * 64 + j]; A2h[i] = p.in[I_A2][(size_t)k * D + h * 64 + j]; }
    for (int i = tid; i < 128 * 64; i += NTHREADS) { const int k = i >> 6, j = i & 63; G2h[i] = p.in[I_G2][(size_t)k * D + h * 64 + j]; }
    const bf16_t* Rg = wsb(p, WS_W3); const bf16_t* Kg = wsb(p, WS_W4); const bf16_t* Vg = wsb(p, WS_W5); const bf16_t* L1 = wsb(p, WS_W6); bf16_t* YG = wsb(p, WS_W0);
    const int tt = tid >> 4, jq = tid & 15, ch = h * 64 + 4 * jq;
    const f32x4 w0v = *(const f32x4*)(p.in[I_W0] + ch), a0v = *(const f32x4*)(p.in[I_A0] + ch), kkv = *(const f32x4*)(p.in[I_KK] + ch), kav = *(const f32x4*)(p.in[I_KA] + ch);
    const f32x4 rkv = *(const f32x4*)(p.in[I_RK] + ch), lnw = *(const f32x4*)(p.in[I_LNW] + ch), lnb = *(const f32x4*)(p.in[I_LNB] + ch);
    const int si = tid >> 3, jb = tid & 7;
    float S[8];
#pragma unroll
    for (int q = 0; q < 8; ++q) S[q] = 0.f;
    __syncthreads();
    for (int tile = 0; tile < SEQ / WK_TT; ++tile) {
        const size_t rowb = (size_t)b * SEQ + (size_t)tile * WK_TT;
        { const int r = tid >> 4, cc = tid & 15; const u32x4* src = (const u32x4*)(L1 + (rowb + r) * 256 + cc * 16); u32x4 x0 = src[0], x1 = src[1];
          *(LAS u32x4*)(L1t + r * 256 + cc * 16) = x0; *(LAS u32x4*)(L1t + r * 256 + cc * 16 + 8) = x1; }
        const u32x2 r2 = *(const u32x2*)(Rg + (rowb + tt) * D + ch), k2 = *(const u32x2*)(Kg + (rowb + tt) * D + ch), v2 = *(const u32x2*)(Vg + (rowb + tt) * D + ch);
        __syncthreads();
        f32x4 wl = w0v, al = a0v, gl = (f32x4){0.f, 0.f, 0.f, 0.f};
        for (int k = 0; k < 64; ++k) { const float lw = bf2f(L1t[tt * 256 + k]), la = bf2f(L1t[tt * 256 + 64 + k]);
            wl += lw * *(const LAS f32x4*)(W2h + k * 64 + 4 * jq); al += la * *(const LAS f32x4*)(A2h + k * 64 + 4 * jq); }
        for (int k = 0; k < 128; ++k) { const float lg = bf2f(L1t[tt * 256 + 128 + k]); gl += lg * *(const LAS f32x4*)(G2h + k * 64 + 4 * jq); }
        f32x4 rv = {bflo(r2.x), bfhi(r2.x), bflo(r2.y), bfhi(r2.y)}, kv = {bflo(k2.x), bfhi(k2.x), bflo(k2.y), bfhi(k2.y)}, vv = {bflo(v2.x), bfhi(v2.x), bflo(v2.y), bfhi(v2.y)};
        f32x4 dec, av, kk = kv * kkv; float ss = (kk[0] * kk[0] + kk[1] * kk[1]) + (kk[2] * kk[2] + kk[3] * kk[3]);
        ss += __shfl_xor(ss, 1); ss += __shfl_xor(ss, 2); ss += __shfl_xor(ss, 4); ss += __shfl_xor(ss, 8);
        const float inrm = 1.0f / fmaxf(sqrtf(ss), 1e-12f);
#pragma unroll
        for (int q = 0; q < 4; ++q) { const float x = -wl[q]; const float sp = fmaxf(x, 0.f) + log1pf(__expf(-fabsf(x)));
            dec[q] = __expf(-__expf(-sp - 0.5f)); av[q] = 1.0f / (1.0f + __expf(-al[q])); }
        kk = kk * inrm; const f32x4 km = kv * ((av - 1.0f) * kav + 1.0f);
        *(LAS f32x4*)(rT + tt * 64 + 4 * jq) = rv; *(LAS f32x4*)(kT + tt * 64 + 4 * jq) = km; *(LAS f32x4*)(vT + tt * 64 + 4 * jq) = vv; *(LAS f32x4*)(dT + tt * 64 + 4 * jq) = dec;
        *(LAS f32x4*)(aT + tt * 64 + 4 * jq) = -kk; *(LAS f32x4*)(bT + tt * 64 + 4 * jq) = kk * av; *(LAS f32x4*)(gT + tt * 64 + 4 * jq) = gl;
        __syncthreads();
        for (int t = 0; t < WK_TT; ++t) {
            const f32x4 a0 = *(const LAS f32x4*)(aT + t * 64 + 8 * jb), a1 = *(const LAS f32x4*)(aT + t * 64 + 8 * jb + 4);
            float sa = (S[0] * a0[0] + S[1] * a0[1]) + (S[2] * a0[2] + S[3] * a0[3]) + (S[4] * a1[0] + S[5] * a1[1]) + (S[6] * a1[2] + S[7] * a1[3]);
            sa += __shfl_xor(sa, 1); sa += __shfl_xor(sa, 2); sa += __shfl_xor(sa, 4);
            const f32x4 d0 = *(const LAS f32x4*)(dT + t * 64 + 8 * jb), d1 = *(const LAS f32x4*)(dT + t * 64 + 8 * jb + 4);
            const f32x4 b0 = *(const LAS f32x4*)(bT + t * 64 + 8 * jb), b1 = *(const LAS f32x4*)(bT + t * 64 + 8 * jb + 4);
            const f32x4 k0 = *(const LAS f32x4*)(kT + t * 64 + 8 * jb), k1 = *(const LAS f32x4*)(kT + t * 64 + 8 * jb + 4);
            const f32x4 r0 = *(const LAS f32x4*)(rT + t * 64 + 8 * jb), r1 = *(const LAS f32x4*)(rT + t * 64 + 8 * jb + 4);
            const float vi = vT[t * 64 + si];
#pragma unroll
            for (int q = 0; q < 4; ++q) { S[q] = S[q] * d0[q] + sa * b0[q] + vi * k0[q]; S[4 + q] = S[4 + q] * d1[q] + sa * b1[q] + vi * k1[q]; }
            float y = (S[0] * r0[0] + S[1] * r0[1]) + (S[2] * r0[2] + S[3] * r0[3]) + (S[4] * r1[0] + S[5] * r1[1]) + (S[6] * r1[2] + S[7] * r1[3]);
            y += __shfl_xor(y, 1); y += __shfl_xor(y, 2); y += __shfl_xor(y, 4);
            if (jb == 0) yT[t * 64 + si] = y;
        }
        __syncthreads();
        { const f32x4 y4 = *(const LAS f32x4*)(yT + tt * 64 + 4 * jq); float s = (y4[0] + y4[1]) + (y4[2] + y4[3]);
          s += __shfl_xor(s, 1); s += __shfl_xor(s, 2); s += __shfl_xor(s, 4); s += __shfl_xor(s, 8); const float mean = s * (1.0f / 64.0f);
          const f32x4 dv = y4 - mean; float q2 = (dv[0] * dv[0] + dv[1] * dv[1]) + (dv[2] * dv[2] + dv[3] * dv[3]);
          q2 += __shfl_xor(q2, 1); q2 += __shfl_xor(q2, 2); q2 += __shfl_xor(q2, 4); q2 += __shfl_xor(q2, 8); const float rstd = rsqrtf(q2 * (1.0f / 64.0f) + GN_EPS);
          const f32x4 rr = *(const LAS f32x4*)(rT + tt * 64 + 4 * jq), kq = *(const LAS f32x4*)(kT + tt * 64 + 4 * jq), vq = *(const LAS f32x4*)(vT + tt * 64 + 4 * jq), gq = *(const LAS f32x4*)(gT + tt * 64 + 4 * jq);
          float bsum = (rr[0] * kq[0] * rkv[0] + rr[1] * kq[1] * rkv[1]) + (rr[2] * kq[2] * rkv[2] + rr[3] * kq[3] * rkv[3]);
          bsum += __shfl_xor(bsum, 1); bsum += __shfl_xor(bsum, 2); bsum += __shfl_xor(bsum, 4); bsum += __shfl_xor(bsum, 8);
          const f32x4 o = ((dv * rstd) * lnw + lnb + vq * bsum) * gq;
          *(u32x2*)(YG + (rowb + tt) * D + ch) = pack4(o); }
        __syncthreads();
    }
}

constexpr int AT_KSTR = 208;
constexpr int AT_KBUF = 64 * AT_KSTR, AT_VBUF = 8192;
__device__ __forceinline__ s16x4 vtr(const LAS unsigned char* pp) { typedef short v4i16_t __attribute__((ext_vector_type(4)));
    return __builtin_bit_cast(s16x4, __builtin_amdgcn_ds_read_tr16_b64_v4i16((LAS v4i16_t*)pp)); }
__device__ __forceinline__ void attn_unit(const Params& p, const Ctx& c, int b, int h, int qb) {
    const int tid = c.tid, lane = c.lane, wid = c.wave, r32 = lane & 31, hi = lane >> 5;
    const bf16_t* Q = wsb(p, WS_W2); const bf16_t* Kn = wsb(p, WS_W4); const bf16_t* V = wsb(p, WS_W5); const bf16_t* Kr = wsb(p, WS_KR); bf16_t* O = wsb(p, WS_W0);
    const size_t rowbase = (size_t)b * SEQ; const int q0 = qb * 256, qrow = q0 + 32 * wid + r32;
    LAS unsigned char* Kb = c.lds; LAS unsigned char* Vb = c.lds + 2 * AT_KBUF;
    bf16x8 qr[6];
#pragma unroll
    for (int d0 = 0; d0 < 6; ++d0) qr[d0] = *(const bf16x8*)(Q + (rowbase + qrow) * (NHEAD * QKD) + h * QKD + 16 * d0 + 8 * hi);
    const int NTL = (q0 + 256) / 64;
    const int lrow = tid >> 3, lch = tid & 7, lrow2 = (tid & 255) >> 2, lch2 = tid & 3;
    u32x4 kreg, vreg, rreg;
#define AT_LOAD(t) do { const size_t _r = rowbase + (size_t)(t) * 64; kreg = *(const u32x4*)(Kn + (_r + lrow) * D + h * HD + lch * 8); vreg = *(const u32x4*)(V + (_r + lrow) * D + h * HD + lch * 8); \
        if (tid < 256) rreg = *(const u32x4*)(Kr + (_r + lrow2) * ROPE + lch2 * 8); } while (0)
#define AT_STORE(buf) do { *(LAS u32x4*)(Kb + (buf) * AT_KBUF + lrow * AT_KSTR + lch * 16) = kreg; *(LAS u32x4*)(Vb + (buf) * AT_VBUF + (lch >> 2) * 4096 + lrow * 64 + (lch & 3) * 16) = vreg; \
        if (tid < 256) *(LAS u32x4*)(Kb + (buf) * AT_KBUF + lrow2 * AT_KSTR + 128 + lch2 * 16) = rreg; } while (0)
    AT_LOAD(0); AT_STORE(0);
    __syncthreads();
    f32x16 o0 = {}, o1 = {}; float mrun = -1e30f, lrun = 0.f;
    const int vlane = ((lane >> 4) & 1) * 32 + (lane & 3) * 8 + (4 * hi + ((lane & 15) >> 2)) * 64;
    for (int t = 0; t < NTL; ++t) {
        const int buf = t & 1;
        if (t + 1 < NTL) AT_LOAD(t + 1);
        if (64 * t <= q0 + 32 * wid + 31) {
            const LAS unsigned char* kb = Kb + buf * AT_KBUF; const LAS unsigned char* vb = Vb + buf * AT_VBUF;
            f32x16 s0 = {}, s1 = {};
#pragma unroll
            for (int d0 = 0; d0 < 6; ++d0) { const bf16x8 k0 = *(const LAS bf16x8*)(kb + r32 * AT_KSTR + d0 * 32 + hi * 16), k1 = *(const LAS bf16x8*)(kb + (32 + r32) * AT_KSTR + d0 * 32 + hi * 16);
                s0 = __builtin_amdgcn_mfma_f32_32x32x16_bf16(k0, qr[d0], s0, 0, 0, 0); s1 = __builtin_amdgcn_mfma_f32_32x32x16_bf16(k1, qr[d0], s1, 0, 0, 0); }
            if (64 * t + 63 > q0 + 32 * wid) {
                const int kb0 = 64 * t + 4 * hi;
#pragma unroll
                for (int r = 0; r < 16; ++r) { const int kv = kb0 + (r & 3) + 8 * (r >> 2); if (kv > qrow) s0[r] = -INFINITY; if (kv + 32 > qrow) s1[r] = -INFINITY; } }
            float mx = s0[0];
#pragma unroll
            for (int r = 1; r < 16; ++r) mx = fmaxf(mx, s0[r]);
#pragma unroll
            for (int r = 0; r < 16; ++r) mx = fmaxf(mx, s1[r]);
            mx = fmaxf(mx, __shfl_xor(mx, 32));
            const float mnew = fmaxf(mrun, mx), alpha = __builtin_amdgcn_exp2f(mrun - mnew); mrun = mnew;
            float rs = 0.f;
#pragma unroll
            for (int r = 0; r < 16; ++r) { s0[r] = __builtin_amdgcn_exp2f(s0[r] - mnew); s1[r] = __builtin_amdgcn_exp2f(s1[r] - mnew); rs += s0[r] + s1[r]; }
            lrun = lrun * alpha + rs;
#pragma unroll
            for (int r = 0; r < 16; ++r) { o0[r] *= alpha; o1[r] *= alpha; }
            u32x4 pw[4];
#pragma unroll
            for (int s = 0; s < 2; ++s) { pw[s] = (u32x4){cvtpk(s0[8 * s], s0[8 * s + 1]), cvtpk(s0[8 * s + 2], s0[8 * s + 3]), cvtpk(s0[8 * s + 4], s0[8 * s + 5]), cvtpk(s0[8 * s + 6], s0[8 * s + 7])};
                pw[2 + s] = (u32x4){cvtpk(s1[8 * s], s1[8 * s + 1]), cvtpk(s1[8 * s + 2], s1[8 * s + 3]), cvtpk(s1[8 * s + 4], s1[8 * s + 5]), cvtpk(s1[8 * s + 6], s1[8 * s + 7])}; }
#pragma unroll
            for (int s = 0; s < 4; ++s) { const bf16x8 pb = __builtin_bit_cast(bf16x8, pw[s]);
                const s16x4 a0 = vtr(vb + vlane + s * 1024), a1 = vtr(vb + vlane + s * 1024 + 512), c0 = vtr(vb + 4096 + vlane + s * 1024), c1 = vtr(vb + 4096 + vlane + s * 1024 + 512);
                const bf16x8 va = {a0[0], a0[1], a0[2], a0[3], a1[0], a1[1], a1[2], a1[3]}, vc = {c0[0], c0[1], c0[2], c0[3], c1[0], c1[1], c1[2], c1[3]};
                o0 = __builtin_amdgcn_mfma_f32_32x32x16_bf16(va, pb, o0, 0, 0, 0); o1 = __builtin_amdgcn_mfma_f32_32x32x16_bf16(vc, pb, o1, 0, 0, 0); }
        }
        if (t + 1 < NTL) AT_STORE(buf ^ 1);
        __syncthreads();
    }
    lrun += __shfl_xor(lrun, 32); const float inv = 1.0f / lrun;
    bf16_t* orow = O + (rowbase + qrow) * D + h * HD;
#pragma unroll
    for (int g = 0; g < 4; ++g) { const f32x4 x0 = {o0[4 * g] * inv, o0[4 * g + 1] * inv, o0[4 * g + 2] * inv, o0[4 * g + 3] * inv}, x1 = {o1[4 * g] * inv, o1[4 * g + 1] * inv, o1[4 * g + 2] * inv, o1[4 * g + 3] * inv};
        *(u32x2*)(orow + 8 * g + 4 * hi) = pack4(x0); *(u32x2*)(orow + 32 + 8 * g + 4 * hi) = pack4(x1); }
#undef AT_LOAD
#undef AT_STORE
}
__device__ __forceinline__ void phase_attention(const Params& p, const Ctx& c) {
    const int v = (c.G % 8 == 0) ? (c.bid % 8) * (c.G / 8) + c.bid / 8 : c.bid; const int bh = v >> 2, s = v & 3;
    if (bh >= NB * NHEAD) return;
    for (int i = 0; i < 8; ++i) { const int qb = 8 * (i >> 1) + ((i & 1) ? 7 - s : s); attn_unit(p, c, bh >> 4, bh & 15, qb); }
}
#ifndef MK_N_LAUNCHES
#define MK_N_LAUNCHES 1
#endif
constexpr int N_PHASES = 17;
constexpr int N_LAUNCHES = MK_N_LAUNCHES;

__device__ __forceinline__ void run_dense(const Ctx& c, DenseSched& S, const void* A, int lda, const void* B, int ldb, int M, int N, int K) { S.init(A, lda, B, ldb, M, N, K, c.G, c.bid); }

__global__ void __launch_bounds__(NTHREADS, 2) fwd_kernel(Params p) {
    extern __shared__ __attribute__((aligned(16))) unsigned char lds_raw[];
    Ctx c; c.lds = (LAS unsigned char*)lds_raw; c.tid = threadIdx.x; c.lane = c.tid & 63; c.wave = __builtin_amdgcn_readfirstlane(c.tid >> 6); c.G = gridDim.x; c.bid = blockIdx.x;
    volatile LAS unsigned* MISC = (volatile LAS unsigned*)(c.lds + MISC_OFF);
    if (c.tid < 64) ((LAS unsigned*)(c.lds + MISC_OFF))[c.tid] = 0u;
    __syncthreads();
    unsigned* ctl = (unsigned*)(p.ws + WS_CTL);
    XcdBarrier bar; bar.bar = ctl + CW_BAR; bar.x = 0; bar.st = nullptr;
    if (N_LAUNCHES == 1) bar = xcd_barrier_post(ctl + CW_BAR, MISC + 8);
    const int lo = p.ph_lo, hi = p.ph_hi;
#ifndef PH_MASK
#define PH_MASK 0x1ffff
#endif
#define IN(k) ((((PH_MASK) >> (k)) & 1) && lo <= (k) && (k) < hi)
#define SEAM(k) do { if (IN(k) && IN((k) + 1)) xcd_barrier(bar); } while (0)
    LAS unsigned char* ring = c.lds + RING_OFF;

    if (IN(0)) { phase_prologue(p, c); } SEAM(0);
    if (IN(1)) { phase_n0(p, c); } SEAM(1);
    if (IN(2)) {
        { DenseSched S; S.init((const bf16_t*)p.out, D, wsb(p, WS_LD), 2048, T, 256, 2048, c.G, c.bid); S.pad = 1; S.nt0 = 16; S.a1d = -(long)(D * 2); S.b1d = 1024 * 2;
          EpiLoraDown E{wsb(p, WS_W6)}; pg8::gemm_phase<EpiLoraDown, DenseSched, false>(ring, S, E, D, 2048); }
        { DenseSched S; S.init(wsb(p, WS_W0), D, wsb(p, WS_WR), D, T, D, D, c.G, c.bid); EpiBf16 E{wsb(p, WS_W3), D}; pg8::gemm_phase<EpiBf16, DenseSched, false>(ring, S, E, D, D); }
        { DenseSched S; S.init(wsb(p, WS_W1), D, wsb(p, WS_WK), D, T, D, D, c.G, c.bid); EpiBf16 E{wsb(p, WS_W4), D}; pg8::gemm_phase<EpiBf16, DenseSched, false>(ring, S, E, D, D); }
        { DenseSched S; S.init(wsb(p, WS_W2), D, wsb(p, WS_WV), D, T, D, D, c.G, c.bid); EpiBf16 E{wsb(p, WS_W5), D}; pg8::gemm_phase<EpiBf16, DenseSched, false>(ring, S, E, D, D); }
    } SEAM(2);
    if (IN(3)) { phase_wkv_seq(p, c); } SEAM(3);
    if (IN(4)) {
        DenseSched S; S.init(wsb(p, WS_W0), D, wsb(p, WS_WO), D, T, D, D, c.G, c.bid); EpiResid E{p.in[I_X], p.out, wsf(p, WS_MOD) + 0 * 3072 + 2048};
        pg8::gemm_phase<EpiResid, DenseSched, false>(ring, S, E, D, D);
    } SEAM(4);
#define MOE_PHASES(layer, pb) do { \
        if (IN(pb)) { phase_router(p, c, layer); } SEAM(pb); \
        if (IN((pb) + 1)) { \
            moe_setup(p, c, layer); \
            MoeSched S{(LAS const int*)(c.lds + UDESC_OFF), (LAS const int*)(c.lds + ROWTAB_OFF), 0, (const char*)wsb(p, WS_W1), (const char*)wsb(p, WS_WGU), (const char*)wsb(p, WS_WDN)}; \
            EpiMoeUp E{wsb(p, WS_W2), (LAS const float*)(c.lds + GATETAB_OFF)}; \
            pg8::gemm_phase<EpiMoeUp, MoeSched, true>(ring, S, E, D, D); \
        } SEAM((pb) + 1); \
        if (IN((pb) + 2)) { \
            moe_setup(p, c, layer); \
            MoeSched S{(LAS const int*)(c.lds + UDESC_OFF), (LAS const int*)(c.lds + ROWTAB_OFF), 1, (const char*)wsb(p, WS_W2), (const char*)wsb(p, WS_WGU), (const char*)wsb(p, WS_WDN)}; \
            EpiMoeDown E{p.out, wsf(p, WS_MOD) + ((layer) * 2 + 1) * 3072 + 2048, (LAS const int*)(c.lds + ROWTAB_OFF)}; \
            pg8::gemm_phase<EpiMoeDown, MoeSched, false>(ring, S, E, 512, 256); \
        } SEAM((pb) + 2); } while (0)
    MOE_PHASES(0, 5);
            if (IN(8)) { phase_n2(p, c); convert_moe_weights(p, c, 1); } SEAM(8);
            if (IN(9)) {
                { DenseSched S; S.init(wsb(p, WS_W1), D, wsb(p, WS_DKV), D, T, 512, D, c.G, c.bid); EpiDown E{wsb(p, WS_W6), KVLORA, 0, wsf(p, WS_SSQKV), 4, wsb(p, WS_KR), wsf(p, WS_TAB)};
                  pg8::gemm_phase<EpiDown, DenseSched, false>(ring, S, E, D, D); }
                { DenseSched S; S.init(wsb(p, WS_W0), D, wsb(p, WS_DQ), D, T, 512, D, c.G, c.bid); EpiDown E{wsb(p, WS_W6 + 16 * MiB), QLORA, 128, wsf(p, WS_SSQQ), 8, nullptr, nullptr};
                  pg8::gemm_phase<EpiDown, DenseSched, false>(ring, S, E, D, D); }
            } SEAM(9);
            if (IN(10)) {
                { DenseSched S; S.init(wsb(p, WS_W6 + 16 * MiB), QLORA, wsb(p, WS_UQ), QLORA, T, 1536, QLORA, c.G, c.bid); EpiQ E{wsb(p, WS_W2), wsf(p, WS_SSQQ), wsf(p, WS_TAB)};
                  pg8::gemm_phase<EpiQ, DenseSched, false>(ring, S, E, QLORA, QLORA); }
                { DenseSched S; S.init(wsb(p, WS_W6), KVLORA, wsb(p, WS_UKV), KVLORA, T, 2048, KVLORA, c.G, c.bid); EpiKV E{wsb(p, WS_W4), wsb(p, WS_W5), wsf(p, WS_SSQKV)};
                  pg8::gemm_phase<EpiKV, DenseSched, false>(ring, S, E, KVLORA, KVLORA); }
            } SEAM(10);
            if (IN(11)) { phase_attention(p, c); } SEAM(11);
            if (IN(12)) {
                DenseSched S; S.init(wsb(p, WS_W0), D, wsb(p, WS_MWO), D, T, D, D, c.G, c.bid); EpiResid E{p.out, p.out, wsf(p, WS_MOD) + 2 * 3072 + 2048};
                pg8::gemm_phase<EpiResid, DenseSched, false>(ring, S, E, D, D);
            } SEAM(12);
    MOE_PHASES(1, 13);
    if (IN(16)) { phase_final(p, c); }
#undef IN
#undef SEAM
}

extern "C" void kernel_launch(void* const* d_in, const int* in_sizes, int n_in, void* d_out, int out_size, void* d_ws, size_t ws_size, hipStream_t stream) {
    static int ready = 0;
    if (ready == 0) {
        ready = 1;
        if (n_in != N_IN || out_size != T * D || ws_size < WS_END) { fprintf(stderr, "kernel_launch: unexpected shapes (n_in %d, out %d, ws %zu)\n", n_in, out_size, ws_size); ready = -1; }
        else if (hipFuncSetAttribute((const void*)fwd_kernel, hipFuncAttributeMaxDynamicSharedMemorySize, LDS_BYTES) != hipSuccess) { fprintf(stderr, "kernel_launch: hipFuncSetAttribute failed\n"); ready = -1; }
        int per_cu = 0;
        if (ready > 0 && (hipOccupancyMaxActiveBlocksPerMultiprocessor(&per_cu, (const void*)fwd_kernel, NTHREADS, LDS_BYTES) != hipSuccess || per_cu < 1)) fprintf(stderr, "kernel_launch: occupancy query reports %d\n", per_cu);
        (void)hipGetLastError();
    }
    if (ready < 0) return;
    (void)hipMemsetAsync((char*)d_ws + WS_CTL, 0, CTL_ZERO_BYTES, stream);
    Params a{};
    for (int i = 0; i < N_IN; ++i) a.in[i] = (const float*)d_in[i];
    a.out = (float*)d_out; a.ws = (unsigned char*)d_ws; a.li = 0; a.pad = 0;
    const int grid = 256;
    if (N_LAUNCHES == 1) { a.ph_lo = 0; a.ph_hi = N_PHASES; hipLaunchKernelGGL(fwd_kernel, dim3(grid), dim3(NTHREADS), LDS_BYTES, stream, a); }
    else { for (int k = 0; k < N_PHASES; ++k) { a.ph_lo = k; a.ph_hi = k + 1; a.li = k; hipLaunchKernelGGL(fwd_kernel, dim3(grid), dim3(NTHREADS), LDS_BYTES, stream, a); } }
}
```

```cpp
#include <hip/hip_runtime.h>
#include <cstdio>
#include <cstdint>

#define LAS __attribute__((address_space(3)))
#define GAS __attribute__((address_space(1)))
typedef unsigned short bf16_t;
typedef short bf16x8 __attribute__((ext_vector_type(8)));
typedef short s16x4 __attribute__((ext_vector_type(4)));
typedef float f32x2 __attribute__((ext_vector_type(2)));
typedef float f32x4 __attribute__((ext_vector_type(4)));
typedef float f32x16 __attribute__((ext_vector_type(16)));
typedef unsigned u32x2 __attribute__((ext_vector_type(2)));
typedef unsigned u32x4 __attribute__((ext_vector_type(4)));
typedef __bf16 bf16x2_t __attribute__((ext_vector_type(2)));

__device__ __forceinline__ unsigned cvtpk(float lo, float hi) { f32x2 v = {lo, hi}; bf16x2_t b = __builtin_convertvector(v, bf16x2_t); return __builtin_bit_cast(unsigned, b); }
__device__ __forceinline__ float bf2f(unsigned short b) { return __uint_as_float((unsigned)b << 16); }
__device__ __forceinline__ float bflo(unsigned w) { return __uint_as_float(w << 16); }
__device__ __forceinline__ float bfhi(unsigned w) { return __uint_as_float(w & 0xffff0000u); }
__device__ __forceinline__ float wave_sum(float v) {
#pragma unroll
    for (int o = 1; o < 64; o <<= 1) v += __shfl_xor(v, o);
    return v;
}
__device__ __forceinline__ float sigmoidf_(float x) { return 1.0f / (1.0f + __expf(-x)); }

namespace pg8 {
constexpr int BM = 256, BK = 64, HALF = 128, HTB = HALF * BK * 2  , STAGE_BYTES = 8 * HTB;
__host__ __device__ __forceinline__ int lds_byte(int r, int c) { const int st = (r >> 4) * 2 + (c >> 5), rr = r & 15, cc = c & 31, ob = rr * 64 + cc * 2; return st * 1024 + (ob ^ (((ob >> 9) & 1) << 5)); }
__host__ __device__ __forceinline__ void stage_rc(int b, int& R, int& C) { const int st = b / 1024, sb = b % 1024, swz = sb ^ (((sb >> 9) & 1) << 5); R = (st >> 1) * 16 + swz / 64; C = (st & 1) * 32 + (swz % 64) / 2; }
__host__ __device__ __forceinline__ int perm32(int rho) { const int n = rho >> 4, i = rho & 15; return 8 * (i >> 2) + 4 * n + (i & 3); }

struct Unit { int pm, pn, aux, nt, nt0; const char* A0; const char* A1; const char* B0; const char* B1; };
__device__ __forceinline__ const char* tile_ptr(const char* p0, const char* p1, int nt0, int t) { return t < nt0 ? p0 + (size_t)t * 128 : p1 + (size_t)(t - nt0) * 128; }

template <class Epi, class Sched, bool GA>
__device__ __forceinline__ void gemm_phase(LAS unsigned char* lds, const Sched& S, const Epi& E, const int lda, const int ldb) {
    const int tid = threadIdx.x, wid = __builtin_amdgcn_readfirstlane(tid >> 6), lane = tid & 63, wr = wid >> 2, wc = wid & 3, fr = lane & 15, fq = lane >> 4;
    unsigned voffB[2]; int RA[2], CA[2];
#pragma unroll
    for (int i = 0; i < 2; ++i) { int R, C; stage_rc(tid * 16 + i * 8192, R, C); const int Rb = Epi::PERM ? ((R & ~31) + perm32(R & 31)) : R;
        voffB[i] = (unsigned)(Rb * ldb + C) * 2u; RA[i] = R; CA[i] = C; }
    const size_t hstepB = (size_t)HALF * ldb * 2;
    unsigned voC[2][2], voN[2][2];
    const unsigned ldsw = (unsigned)wid * 1024u;
    const int aoff = lds_byte(wr * 64 + fr, fq * 8), boff = lds_byte(wc * 32 + fr, fq * 8);
#define PG8_SA(b, h) (((b) * 2 + (h)) * HTB)
#define PG8_SB(b, h) ((4 + (b) * 2 + (h)) * HTB)
#define PG8_STAGE_B(bufoff, gbase) do { _Pragma("unroll") for (int _i = 0; _i < 2; ++_i) \
        __builtin_amdgcn_global_load_lds((const unsigned*)((const char*)(gbase) + voffB[_i]), (LAS unsigned*)(lds + (bufoff) + ldsw + _i * 8192), 16, 0, 0); } while (0)
#define PG8_STAGE_A(bufoff, gbase, VO, hh) do { _Pragma("unroll") for (int _i = 0; _i < 2; ++_i) \
        __builtin_amdgcn_global_load_lds((const unsigned*)((const char*)(gbase) + VO[hh][_i]), (LAS unsigned*)(lds + (bufoff) + ldsw + _i * 8192), 16, 0, 0); } while (0)
#define PG8_LDA(dst, b, h) do { _Pragma("unroll") for (int m = 0; m < 4; ++m) _Pragma("unroll") for (int k = 0; k < 2; ++k) dst[m][k] = *(const LAS bf16x8*)(lds + PG8_SA(b, h) + aoff + m * 2048 + k * 1024); } while (0)
#define PG8_LDB(dst, b, h) do { _Pragma("unroll") for (int n = 0; n < 2; ++n) _Pragma("unroll") for (int k = 0; k < 2; ++k) dst[n][k] = *(const LAS bf16x8*)(lds + PG8_SB(b, h) + boff + n * 2048 + k * 1024); } while (0)
#define PG8_MMA(ai, bj, At, Bt) do { __builtin_amdgcn_s_setprio(1); _Pragma("unroll") for (int m = 0; m < 4; ++m) _Pragma("unroll") for (int n = 0; n < 2; ++n) _Pragma("unroll") for (int k = 0; k < 2; ++k) \
        acc[ai][bj][m][n] = __builtin_amdgcn_mfma_f32_16x16x32_bf16(Bt[n][k], At[m][k], acc[ai][bj][m][n], 0, 0, 0); __builtin_amdgcn_s_setprio(0); } while (0)
#define PG8_WAIT_V(n) asm volatile("s_waitcnt vmcnt(" #n ")" ::: "memory")
#define PG8_WAIT_L(n) asm volatile("s_waitcnt lgkmcnt(" #n ")" ::: "memory")
#define PG8_BAR __builtin_amdgcn_s_barrier()
#define PG8_SCHED __builtin_amdgcn_sched_barrier(0)
#define PG8_SETVO(VO, ui_) do { _Pragma("unroll") for (int _h = 0; _h < 2; ++_h) _Pragma("unroll") for (int _i = 0; _i < 2; ++_i) { \
        if constexpr (GA) VO[_h][_i] = (unsigned)(S.row((ui_), _h * HALF + RA[_i]) * lda + CA[_i]) * 2u; else VO[_h][_i] = (unsigned)((_h * HALF + RA[_i]) * lda + CA[_i]) * 2u; } } while (0)
    Unit cur, nxt; int ui = 0;
    if (!S.next(0, cur)) return;
    PG8_SETVO(voC, 0);
#pragma unroll
    for (int _h = 0; _h < 2; ++_h)
#pragma unroll
        for (int _i = 0; _i < 2; ++_i) voN[_h][_i] = 0u;
    f32x4 acc[2][2][4][2];
#pragma unroll
    for (int a = 0; a < 2; ++a)
#pragma unroll
        for (int b = 0; b < 2; ++b)
#pragma unroll
            for (int m = 0; m < 4; ++m)
#pragma unroll
                for (int n = 0; n < 2; ++n) acc[a][b][m][n] = (f32x4){0.f, 0.f, 0.f, 0.f};
    bf16x8 At[4][2], B0[2][2], B1[2][2];
    {
        const char* cA = cur.A0; const char* cB = cur.B0;
        PG8_STAGE_B(PG8_SB(0, 0), cB); PG8_STAGE_B(PG8_SB(0, 1), cB + hstepB); PG8_STAGE_A(PG8_SA(0, 0), cA, voC, 0); PG8_STAGE_A(PG8_SA(0, 1), cA, voC, 1);
        if (wr == 1) PG8_BAR;
        PG8_WAIT_V(2); PG8_BAR;
        PG8_STAGE_B(PG8_SB(1, 0), cB + 128); PG8_STAGE_A(PG8_SA(1, 0), cA + 128, voC, 0); PG8_STAGE_B(PG8_SB(1, 1), cB + hstepB + 128);
        PG8_WAIT_V(6); PG8_BAR;
    }
    for (;;) {
        const bool has_next = S.next(ui + 1, nxt);
        if (has_next) { if constexpr (GA) { PG8_SETVO(voN, ui + 1);
#pragma unroll
                for (int _h = 0; _h < 2; ++_h)
#pragma unroll
                    for (int _i = 0; _i < 2; ++_i) voN[_h][_i] -= voC[_h][_i]; } }
        else { nxt = cur;
#pragma unroll
            for (int _h = 0; _h < 2; ++_h)
#pragma unroll
                for (int _i = 0; _i < 2; ++_i) voN[_h][_i] = 0u; }
        const int nt = cur.nt;
        for (int t = 0; t < nt; t += 2) {
            const bool last = (t == nt - 2);
            const char* a1 = tile_ptr(cur.A0, cur.A1, cur.nt0, t + 1);
            const char* a2 = last ? nxt.A0 : tile_ptr(cur.A0, cur.A1, cur.nt0, t + 2);
            const char* b2 = last ? nxt.B0 : tile_ptr(cur.B0, cur.B1, cur.nt0, t + 2);
            const char* a3 = a2 + 128; const char* b3 = b2 + 128;
            unsigned vo2[2][2];
#pragma unroll
            for (int _h = 0; _h < 2; ++_h)
#pragma unroll
                for (int _i = 0; _i < 2; ++_i) vo2[_h][_i] = GA ? voC[_h][_i] + (last ? 1u : 0u) * voN[_h][_i] : voC[_h][_i];
            PG8_LDB(B0, 0, 0); PG8_LDB(B1, 0, 1); PG8_SCHED; PG8_LDA(At, 0, 0); PG8_STAGE_A(PG8_SA(1, 1), a1, voC, 1);
            PG8_WAIT_V(8); PG8_WAIT_L(0); PG8_BAR; PG8_MMA(0, 0, At, B0); PG8_MMA(0, 1, At, B1); PG8_BAR; PG8_SCHED;
            PG8_LDA(At, 0, 1); PG8_STAGE_B(PG8_SB(0, 0), b2); PG8_STAGE_B(PG8_SB(0, 1), b2 + hstepB); PG8_STAGE_A(PG8_SA(0, 0), a2, vo2, 0);
            PG8_WAIT_V(8); PG8_WAIT_L(0); PG8_BAR; PG8_MMA(1, 0, At, B0); PG8_MMA(1, 1, At, B1); PG8_BAR; PG8_SCHED;
            PG8_LDB(B0, 1, 0); PG8_LDB(B1, 1, 1); PG8_SCHED; PG8_LDA(At, 1, 0); PG8_STAGE_A(PG8_SA(0, 1), a2, vo2, 1);
            PG8_WAIT_V(8); PG8_WAIT_L(0); PG8_BAR; PG8_MMA(0, 0, At, B0); PG8_MMA(0, 1, At, B1); PG8_BAR; PG8_SCHED;
            PG8_LDA(At, 1, 1); PG8_STAGE_B(PG8_SB(1, 0), b3); PG8_STAGE_B(PG8_SB(1, 1), b3 + hstepB); PG8_STAGE_A(PG8_SA(1, 0), a3, vo2, 0);
            PG8_WAIT_V(8); PG8_WAIT_L(0); PG8_BAR; PG8_MMA(1, 0, At, B0); PG8_MMA(1, 1, At, B1); PG8_BAR; PG8_SCHED;
        }
        if (wr == 0) PG8_BAR;
        E(acc, cur, wr, wc, fr, fq);
        if (!has_next) break;
#pragma unroll
        for (int a = 0; a < 2; ++a)
#pragma unroll
            for (int b = 0; b < 2; ++b)
#pragma unroll
                for (int m = 0; m < 4; ++m)
#pragma unroll
                    for (int n = 0; n < 2; ++n) acc[a][b][m][n] = (f32x4){0.f, 0.f, 0.f, 0.f};
        cur = nxt; ++ui;
        if constexpr (GA) {
#pragma unroll
            for (int _h = 0; _h < 2; ++_h)
#pragma unroll
                for (int _i = 0; _i < 2; ++_i) voC[_h][_i] += voN[_h][_i];
        }
        if (wr == 1) PG8_BAR;
    }
    PG8_WAIT_V(0);
    PG8_BAR;
#undef PG8_SA
#undef PG8_SB
#undef PG8_STAGE_A
#undef PG8_STAGE_B
#undef PG8_LDA
#undef PG8_LDB
#undef PG8_MMA
#undef PG8_WAIT_V
#undef PG8_WAIT_L
#undef PG8_BAR
#undef PG8_SCHED
#undef PG8_SETVO
}
}
constexpr int NB = 4, SEQ = 8192, D = 1024, T = NB * SEQ;
constexpr int NHEAD = 16, HD = 64;
constexpr int QLORA = 384, KVLORA = 256, ROPE = 32, QKD = 96;
constexpr int NEXP = 16, NCLS = 24, DEXP = 256;
constexpr int MODW = 14336;
constexpr float NORM_EPS = 1e-6f, GN_EPS = 64e-5f;
constexpr float QSCALE = 0.10206207261596577f * 1.4426950408889634f;
constexpr int NWAVES = 8, NTHREADS = 512;

constexpr size_t MiB = 1u << 20;
constexpr size_t SLOT = 64 * MiB;
constexpr size_t WS_W0 = 0, WS_W1 = SLOT, WS_W2 = 2 * SLOT, WS_W3 = 3 * SLOT, WS_W4 = 4 * SLOT, WS_W5 = 5 * SLOT, WS_W6 = 6 * SLOT;
constexpr size_t WS_MISC = 7 * SLOT;
constexpr size_t WS_CTL = WS_MISC, CTL_ZERO_BYTES = 1 * MiB;
constexpr size_t WS_MOD = WS_MISC + 1 * MiB;
constexpr size_t WS_TAB = WS_MISC + 2 * MiB;
constexpr size_t WS_LIST = WS_MISC + 6 * MiB;
constexpr size_t WS_GATES = WS_MISC + 9 * MiB;
constexpr size_t WS_SSQKV = WS_MISC + 9 * MiB + 512 * 1024;
constexpr size_t WS_SSQQ = WS_MISC + 10 * MiB;
constexpr size_t WS_KR = WS_MISC + 11 * MiB;
constexpr size_t WS_WR = WS_MISC + 13 * MiB, WS_WK = WS_MISC + 15 * MiB, WS_WV = WS_MISC + 17 * MiB;
constexpr size_t WS_LD = WS_MISC + 19 * MiB;
constexpr size_t WS_WO = WS_MISC + 20 * MiB;
constexpr size_t WS_DKV = WS_MISC + 22 * MiB;
constexpr size_t WS_DQ = WS_MISC + 23 * MiB;
constexpr size_t WS_UQ = WS_MISC + 24 * MiB;
constexpr size_t WS_UKV = WS_MISC + 26 * MiB;
constexpr size_t WS_MWO = WS_MISC + 27 * MiB;
constexpr size_t WS_WGU = WS_MISC + 29 * MiB;
constexpr size_t WS_WDN = WS_MISC + 45 * MiB;
constexpr size_t WS_W2T = WS_MISC + 53 * MiB;
constexpr size_t WS_A2T = WS_MISC + 53 * MiB + 256 * 1024;
constexpr size_t WS_G2T = WS_MISC + 53 * MiB + 512 * 1024;
constexpr size_t WS_BSUM = WS_MISC + 54 * MiB;
constexpr size_t WS_END = WS_MISC + 62 * MiB;
static_assert(WS_END <= 512 * MiB, "d_ws map");
constexpr int CW_BAR = 4096;
constexpr int CW_CNT = 16384;

constexpr int RING_OFF = 0, RING_BYTES = 131072;
constexpr int TAB_OFF = 131072;
constexpr int ROWTAB_OFF = TAB_OFF, GATETAB_OFF = TAB_OFF + 4096, UDESC_OFF = TAB_OFF + 12288, CLSTAB_OFF = UDESC_OFF + 256;
constexpr int MISC_OFF = 151552;
constexpr int LDS_BYTES = 155648;

#define XB_TMO      128
#define XB_XCNT(j)  (256  + 64 * (j))
#define XB_XSUB(j)  (1280 + 64 * (j))
#define XB_XGEN(j)  (2304 + 64 * (j))
#define XB_TOP      3328
#define XB_TOPGEN   3392
#define XCD_BAR_WORDS 3456
#define XB_SPIN_CAP (1u << 18)

__device__ __forceinline__ unsigned xb_ld(unsigned* p)              { return __hip_atomic_load(p, __ATOMIC_RELAXED, __HIP_MEMORY_SCOPE_AGENT); }
__device__ __forceinline__ unsigned xb_add(unsigned* p, unsigned v) { return __hip_atomic_fetch_add(p, v, __ATOMIC_RELAXED, __HIP_MEMORY_SCOPE_AGENT); }
__device__ __forceinline__ unsigned xb_xcc_id() { return (unsigned)__builtin_amdgcn_s_getreg((3 << 11) | 20) & 0xFu; }
#define XB_SPIN(cond, bar) do { unsigned _sp = 0; while (cond) { __builtin_amdgcn_s_sleep(1); \
    if ((++_sp & 255u) == 0u) { if (xb_ld(&(bar)[XB_TMO])) break; if (_sp > XB_SPIN_CAP) { atomicAdd(&(bar)[XB_TMO], 1u); break; } } } } while (0)

struct XcdBarrier { unsigned* bar; unsigned x; volatile LAS unsigned* st; };

__device__ __forceinline__ XcdBarrier xcd_barrier_post(unsigned* bar, volatile LAS unsigned* st) {
    XcdBarrier b; b.bar = bar; b.x = xb_xcc_id(); b.st = st;
    if (threadIdx.x == 0) (void)xb_add(&bar[XB_XCNT(b.x)], 1u);
    return b;
}
__device__ __forceinline__ void xcd_barrier_complete(unsigned* bar, unsigned x, unsigned& nloc, unsigned& nx) {
    const unsigned G = gridDim.x * gridDim.y * gridDim.z;
    unsigned sum, cnt, mine, sp = 0u;
    for (;;) {
        sum = 0u; cnt = 0u; mine = 0u;
#pragma unroll
        for (unsigned j = 0; j < 16; ++j) { const unsigned c = xb_ld(&bar[XB_XCNT(j)]); sum += c; cnt += (c > 0u) ? 1u : 0u; mine = (j == x) ? c : mine; }
        if (sum == G) break;
        __builtin_amdgcn_s_sleep(1);
        if ((++sp & 255u) == 0u) { if (xb_ld(&bar[XB_TMO])) break; if (sp > XB_SPIN_CAP) { atomicAdd(&bar[XB_TMO], 1u); break; } }
    }
    nloc = mine > 0u ? mine : 1u; nx = cnt > 0u ? cnt : 1u;
}
__device__ __forceinline__ void xcd_barrier(const XcdBarrier& b) {
    asm volatile("s_waitcnt vmcnt(0)" ::: "memory");
    __syncthreads();
    if (threadIdx.x == 0) {
        unsigned* bar = b.bar;
        __builtin_amdgcn_s_waitcnt(0);
        unsigned nloc = b.st[0], nx = b.st[1];
        if (nloc == 0u) { xcd_barrier_complete(bar, b.x, nloc, nx); b.st[0] = nloc; b.st[1] = nx; }
        const unsigned old = xb_add(&bar[XB_XSUB(b.x)], 1u);
        const unsigned gen = old / nloc;
        if (old + 1u == (gen + 1u) * nloc) {
            __builtin_amdgcn_fence(__ATOMIC_RELEASE, "agent");
            asm volatile("s_waitcnt vmcnt(0)" ::: "memory");
            const unsigned og = xb_add(&bar[XB_TOP], 1u);
            const unsigned tg = og / nx;
            if (og + 1u == (tg + 1u) * nx) xb_add(&bar[XB_TOPGEN], 1u);
            else XB_SPIN(xb_ld(&bar[XB_TOPGEN]) == tg, bar);
            __builtin_amdgcn_fence(__ATOMIC_ACQUIRE, "agent");
            xb_add(&bar[XB_XGEN(b.x)], 1u);
            asm volatile("s_waitcnt vmcnt(0)" ::: "memory");
        } else {
            XB_SPIN(xb_ld(&bar[XB_XGEN(b.x)]) == gen, bar);
            __builtin_amdgcn_fence(__ATOMIC_ACQUIRE, "agent");
            asm volatile("s_waitcnt vmcnt(0)" ::: "memory");
        }
    }
    __syncthreads();
}

enum { I_X = 0, I_C, I_POS, I_ADAW, I_ADAB, I_NORMG, I_MU, I_WRKV, I_W0, I_W1, I_W2, I_A0, I_A1, I_A2, I_G1, I_G2, I_KK, I_KA, I_RK, I_LNW, I_LNB, I_RWO,
       I_KVADAW, I_KVADAB, I_KVNG, I_WDKV, I_GKV, I_WUK, I_WUV, I_WKR, I_WDQ, I_GQ, I_WUQ, I_WQR, I_MWO, I_RTW, I_RTB, I_WGU, I_WDOWN, I_FG, N_IN };
struct Params { const float* in[N_IN]; float* out; unsigned char* ws; int ph_lo, ph_hi, li, pad; };

struct Ctx {
    LAS unsigned char* lds;
    int tid, lane, wave, G, bid;
};
__device__ __forceinline__ bf16_t* wsb(const Params& p, size_t off) { return (bf16_t*)(p.ws + off); }
__device__ __forceinline__ float* wsf(const Params& p, size_t off) { return (float*)(p.ws + off); }
struct DenseSched {
    int nM, nN, nwg, G, c, nt, nt0, lda, pad; const char* A; const char* B; size_t btile; long a1d, b1d;
    __device__ __forceinline__ void init(const void* A_, int lda_, const void* B_, int ldb_, int M, int N, int K, int G_, int c_) {
        nM = M / 256; nN = N / 256; nwg = nM * nN; G = G_; c = c_; nt = K / 64; nt0 = nt; lda = lda_; pad = 0; A = (const char*)A_; B = (const char*)B_;
        btile = (size_t)256 * ldb_ * 2; a1d = 0; b1d = 0; }
    __device__ __forceinline__ bool next(int i, pg8::Unit& u) const {
        const long L = (long)i * G + c; if (L >= nwg) return false;
        int wgid = (int)L; { const int q = nwg / 8, r = nwg % 8, xcd = wgid % 8, off = wgid / 8; wgid = (xcd < r ? xcd * (q + 1) : r * (q + 1) + (xcd - r) * q) + off; }
        const int nig = 8 * nN, gid = wgid / nig, fm = gid * 8, gsz = (nM - fm) < 8 ? (nM - fm) : 8;
        u.pm = fm + ((wgid % nig) % gsz); u.pn = (wgid % nig) / gsz; u.aux = 0; u.nt = nt; u.nt0 = nt0;
        const size_t arow = pad ? (size_t)((u.pm >> 5) * (SEQ + 1) + 1 + 256 * (u.pm & 31)) : (size_t)u.pm * 256;
        u.A0 = A + arow * (size_t)lda * 2; u.A1 = u.A0 + a1d; u.B0 = B + (size_t)u.pn * btile; u.B1 = u.B0 + b1d; return true;
    }
    __device__ __forceinline__ int row(int, int) const { return 0; }
};

struct MoeSched {
    LAS const int* ud; LAS const int* rowtab; int down; const char* A; const char* Wgu; const char* Wdn;
    __device__ __forceinline__ bool next(int i, pg8::Unit& u) const {
        if (i >= 4) return false;
        const int valid = __builtin_amdgcn_readfirstlane(ud[i * 16 + 0]); if (!valid) return false;
        const int st = __builtin_amdgcn_readfirstlane(ud[i * 16 + 1]), pn = __builtin_amdgcn_readfirstlane(ud[i * 16 + 2]);
        const int elo = __builtin_amdgcn_readfirstlane(ud[i * 16 + 3]), ehi = __builtin_amdgcn_readfirstlane(ud[i * 16 + 4]);
        u.pm = st; u.pn = pn; u.aux = i;
        if (!down) { u.nt = 16; u.nt0 = 16; u.A0 = A; u.A1 = A; const int e = (pn >> 1) ? ehi : elo;
            u.B0 = Wgu + ((size_t)e * 512 + (size_t)(pn & 1) * 256) * 1024 * 2; u.B1 = u.B0; }
        else { u.nt = 8; u.nt0 = 4; u.A0 = A + (size_t)st * 256 * 512 * 2; u.A1 = u.A0 + 4 * 128;
            u.B0 = Wdn + ((size_t)elo * 1024 + (size_t)pn * 256) * 256 * 2; u.B1 = Wdn + ((size_t)ehi * 1024 + (size_t)pn * 256) * 256 * 2; }
        return true;
    }
    __device__ __forceinline__ int row(int i, int r) const { const int t = rowtab[i * 256 + r]; return t < 0 ? 0 : t; }
};

typedef f32x4 AccT[2][2][4][2];
#define EPI_ARGS const AccT& acc, const pg8::Unit& u, int wr, int wc, int fr, int fq
__device__ __forceinline__ u32x4 pack8(f32x4 a, f32x4 b) { u32x4 w; w.x = cvtpk(a[0], a[1]); w.y = cvtpk(a[2], a[3]); w.z = cvtpk(b[0], b[1]); w.w = cvtpk(b[2], b[3]); return w; }
__device__ __forceinline__ u32x2 pack4(f32x4 a) { u32x2 w; w.x = cvtpk(a[0], a[1]); w.y = cvtpk(a[2], a[3]); return w; }

struct EpiBf16 {
    static constexpr bool PERM = true; bf16_t* O; int ldc;
    __device__ __forceinline__ void operator()(EPI_ARGS) const {
        const int row0 = u.pm * 256 + wr * 64 + fr, col0 = u.pn * 256 + wc * 32 + 8 * fq;
#pragma unroll
        for (int ai = 0; ai < 2; ++ai)
#pragma unroll
            for (int m = 0; m < 4; ++m) { bf16_t* rowp = O + (size_t)(row0 + ai * 128 + m * 16) * ldc + col0;
#pragma unroll
                for (int bj = 0; bj < 2; ++bj) *(u32x4*)(rowp + bj * 128) = pack8(acc[ai][bj][m][0], acc[ai][bj][m][1]); }
    }
};
struct EpiLoraDown {
    static constexpr bool PERM = true; bf16_t* O;
    __device__ __forceinline__ void operator()(EPI_ARGS) const {
        const int row0 = u.pm * 256 + wr * 64 + fr, col0 = wc * 32 + 8 * fq;
#pragma unroll
        for (int ai = 0; ai < 2; ++ai)
#pragma unroll
            for (int m = 0; m < 4; ++m) { bf16_t* rowp = O + (size_t)(row0 + ai * 128 + m * 16) * 256 + col0;
#pragma unroll
                for (int bj = 0; bj < 2; ++bj) { f32x4 v0 = acc[ai][bj][m][0], v1 = acc[ai][bj][m][1];
                    if (bj == 1) {
#pragma unroll
                        for (int i = 0; i < 4; ++i) { v0[i] = sigmoidf_(v0[i]); v1[i] = sigmoidf_(v1[i]); } }
                    else if (wc < 2) {
#pragma unroll
                        for (int i = 0; i < 4; ++i) { v0[i] = tanhf(v0[i]); v1[i] = tanhf(v1[i]); } }
                    *(u32x4*)(rowp + bj * 128) = pack8(v0, v1); } }
    }
};
struct EpiResid {
    static constexpr bool PERM = false; const float* xin; float* xout; const float* gate;
    __device__ __forceinline__ void operator()(EPI_ARGS) const {
        const int row0 = u.pm * 256 + wr * 64 + fr, col0 = u.pn * 256 + wc * 32 + 4 * fq; const int b = u.pm >> 5;
        f32x4 gv[2][2];
#pragma unroll
        for (int bj = 0; bj < 2; ++bj)
#pragma unroll
            for (int n = 0; n < 2; ++n) gv[bj][n] = *(const f32x4*)(gate + (size_t)b * MODW + col0 + bj * 128 + n * 16);
#pragma unroll
        for (int ai = 0; ai < 2; ++ai)
#pragma unroll
            for (int m = 0; m < 4; ++m) { const size_t off = (size_t)(row0 + ai * 128 + m * 16) * D + col0;
#pragma unroll
                for (int bj = 0; bj < 2; ++bj)
#pragma unroll
                    for (int n = 0; n < 2; ++n) { const f32x4 xv = *(const f32x4*)(xin + off + bj * 128 + n * 16);
                        *(f32x4*)(xout + off + bj * 128 + n * 16) = xv + gv[bj][n] * acc[ai][bj][m][n]; } }
    }
};
struct EpiMoeUp {
    static constexpr bool PERM = true; bf16_t* act; LAS const float* gatetab;
    __device__ __forceinline__ void operator()(EPI_ARGS) const {
        const int eidx = u.pn >> 1, half = u.pn & 1; const int rl0 = wr * 64 + fr, col0 = eidx * 256 + half * 128 + wc * 32 + 8 * fq;
#pragma unroll
        for (int ai = 0; ai < 2; ++ai)
#pragma unroll
            for (int m = 0; m < 4; ++m) { const int rl = rl0 + ai * 128 + m * 16; const float cb = gatetab[(u.aux * 256 + rl) * 2 + eidx];
                f32x4 o[2];
#pragma unroll
                for (int n = 0; n < 2; ++n)
#pragma unroll
                    for (int i = 0; i < 4; ++i) { const float g = acc[ai][0][m][n][i], up = acc[ai][1][m][n][i]; o[n][i] = g * sigmoidf_(g) * up * cb; }
                *(u32x4*)(act + (size_t)(u.pm * 256 + rl) * 512 + col0) = pack8(o[0], o[1]); }
    }
};
struct EpiMoeDown {
    static constexpr bool PERM = false; float* X; const float* gate; LAS const int* rowtab;
    __device__ __forceinline__ void operator()(EPI_ARGS) const {
        const int rl0 = wr * 64 + fr, col0 = u.pn * 256 + wc * 32 + 4 * fq;
#pragma unroll
        for (int ai = 0; ai < 2; ++ai)
#pragma unroll
            for (int m = 0; m < 4; ++m) { const int rl = rl0 + ai * 128 + m * 16; const int tok = rowtab[u.aux * 256 + rl];
                if (tok >= 0) { const float* gp = gate + (size_t)(tok >> 13) * MODW + col0; float* xp = X + (size_t)tok * D + col0;
#pragma unroll
                    for (int bj = 0; bj < 2; ++bj)
#pragma unroll
                        for (int n = 0; n < 2; ++n) { const f32x4 gv = *(const f32x4*)(gp + bj * 128 + n * 16); const f32x4 xv = *(const f32x4*)(xp + bj * 128 + n * 16);
                            *(f32x4*)(xp + bj * 128 + n * 16) = xv + gv * acc[ai][bj][m][n]; } } }
    }
};
struct EpiDown {
    static constexpr bool PERM = false; bf16_t* O; int ldc; int ncols1; float* ssq; int ssq_ld; bf16_t* Kr; const float* tab;
    __device__ __forceinline__ void operator()(EPI_ARGS) const {
        const int row0 = u.pm * 256 + wr * 64 + fr;
#pragma unroll
        for (int ai = 0; ai < 2; ++ai)
#pragma unroll
            for (int m = 0; m < 4; ++m) { const int row = row0 + ai * 128 + m * 16;
                if (u.pn == 0 || ncols1 > 0) { float ss = 0.f;
#pragma unroll
                    for (int bj = 0; bj < 2; ++bj) { if (u.pn == 0 || bj * 128 < ncols1) {
#pragma unroll
                        for (int n = 0; n < 2; ++n) { const f32x4 v = acc[ai][bj][m][n]; ss += (v[0] * v[0] + v[1] * v[1]) + (v[2] * v[2] + v[3] * v[3]);
                            *(u32x2*)(O + (size_t)row * ldc + u.pn * 256 + bj * 128 + wc * 32 + n * 16 + 4 * fq) = pack4(v); } } }
                    ss += __shfl_xor(ss, 16); ss += __shfl_xor(ss, 32);
                    if (fq == 0) ssq[(size_t)row * ssq_ld + u.pn * 4 + wc] = ss; }
                if (Kr != nullptr && u.pn == 1 && wc == 0) { const f32x4 x1 = acc[ai][0][m][0], x2 = acc[ai][0][m][1];
                    const f32x4 c4 = *(const f32x4*)(tab + (size_t)row * 32 + 4 * fq), s4 = *(const f32x4*)(tab + (size_t)row * 32 + 16 + 4 * fq);
                    *(u32x2*)(Kr + (size_t)row * 32 + 4 * fq) = pack4(x1 * c4 - x2 * s4); *(u32x2*)(Kr + (size_t)row * 32 + 16 + 4 * fq) = pack4(x2 * c4 + x1 * s4); } }
    }
};
struct EpiQ {
    static constexpr bool PERM = false; bf16_t* Q; const float* ssq; const float* tab;
    __device__ __forceinline__ void operator()(EPI_ARGS) const {
        const int row0 = u.pm * 256 + wr * 64 + fr;
#pragma unroll
        for (int ai = 0; ai < 2; ++ai)
#pragma unroll
            for (int m = 0; m < 4; ++m) { const int row = row0 + ai * 128 + m * 16;
                const f32x4 sa = *(const f32x4*)(ssq + (size_t)row * 8), sb = *(const f32x4*)(ssq + (size_t)row * 8 + 4);
                const float sc = rsqrtf(((sa[0] + sa[1]) + (sa[2] + sa[3]) + (sb[0] + sb[1]) + (sb[2] + sb[3])) * (1.0f / QLORA) + NORM_EPS) * QSCALE;
                bf16_t* qrow = Q + (size_t)row * (NHEAD * QKD);
                if (u.pn < 4) {
#pragma unroll
                    for (int bj = 0; bj < 2; ++bj)
#pragma unroll
                        for (int n = 0; n < 2; ++n) { const int col = u.pn * 256 + bj * 128 + wc * 32 + n * 16 + 4 * fq;
                            *(u32x2*)(qrow + (col >> 6) * QKD + (col & 63)) = pack4(acc[ai][bj][m][n] * sc); }
                } else { const f32x4 c4 = *(const f32x4*)(tab + (size_t)row * 32 + 4 * fq), s4 = *(const f32x4*)(tab + (size_t)row * 32 + 16 + 4 * fq);
#pragma unroll
                    for (int bj = 0; bj < 2; ++bj) { const int h = (u.pn - 4) * 8 + bj * 4 + wc; const f32x4 x1 = acc[ai][bj][m][0] * sc, x2 = acc[ai][bj][m][1] * sc;
                        *(u32x2*)(qrow + h * QKD + 64 + 4 * fq) = pack4(x1 * c4 - x2 * s4); *(u32x2*)(qrow + h * QKD + 80 + 4 * fq) = pack4(x2 * c4 + x1 * s4); } } }
    }
};
struct EpiKV {
    static constexpr bool PERM = true; bf16_t* Kn; bf16_t* V; const float* ssq;
    __device__ __forceinline__ void operator()(EPI_ARGS) const {
        const int row0 = u.pm * 256 + wr * 64 + fr; bf16_t* base = (u.pn < 4) ? Kn : V; const int col0 = (u.pn & 3) * 256 + wc * 32 + 8 * fq;
#pragma unroll
        for (int ai = 0; ai < 2; ++ai)
#pragma unroll
            for (int m = 0; m < 4; ++m) { const int row = row0 + ai * 128 + m * 16; const f32x4 sa = *(const f32x4*)(ssq + (size_t)row * 4);
                const float sc = rsqrtf(((sa[0] + sa[1]) + (sa[2] + sa[3])) * (1.0f / KVLORA) + NORM_EPS);
#pragma unroll
                for (int bj = 0; bj < 2; ++bj) *(u32x4*)(base + (size_t)row * D + col0 + bj * 128) = pack8(acc[ai][bj][m][0] * sc, acc[ai][bj][m][1] * sc); }
    }
};
__device__ __forceinline__ float srcval(const Params& p, int kind, int e, int k, int n) {
    switch (kind) {
    case 0: case 1: case 2: return p.in[I_WRKV][((size_t)kind * D + k) * D + n];
    case 3: { const int kk = k & 1023, hi = k >> 10; float w, mu;
        if (n < 64) { w = p.in[I_W1][kk * 64 + n]; mu = p.in[I_MU][1 * D + kk]; }
        else if (n < 128) { w = p.in[I_A1][kk * 64 + n - 64]; mu = p.in[I_MU][4 * D + kk]; }
        else { w = p.in[I_G1][kk * 128 + n - 128]; mu = p.in[I_MU][5 * D + kk]; }
        return w * (hi ? mu : 1.0f - mu); }
    case 4: return p.in[I_RWO][(size_t)k * D + n];
    case 5: return n < 256 ? p.in[I_WDKV][k * 256 + n] : (n < 288 ? p.in[I_WKR][k * 32 + n - 256] : 0.f);
    case 6: return n < 384 ? p.in[I_WDQ][k * 384 + n] : 0.f;
    case 7: return p.in[I_GQ][k] * (n < 1024 ? p.in[I_WUQ][(size_t)k * 1024 + n] : p.in[I_WQR][(size_t)k * 512 + n - 1024]);
    case 8: return p.in[I_GKV][k] * (n < 1024 ? p.in[I_WUK][(size_t)k * 1024 + n] : p.in[I_WUV][(size_t)k * 1024 + n - 1024]);
    case 9: return p.in[I_MWO][(size_t)k * D + n];
    case 10: { const int pp = n >> 8, w = n & 255; const int col = (w < 128) ? (128 * pp + w) : (256 + 128 * pp + (w - 128));
        return p.in[I_WGU][((size_t)e * D + k) * 512 + col]; }
    case 11: return p.in[I_WDOWN][((size_t)e * 256 + k) * D + n];
    case 12: return p.in[I_W2][(size_t)k * D + n];
    case 13: return p.in[I_A2][(size_t)k * D + n];
    default: return p.in[I_G2][(size_t)k * D + n];
    }
}
__device__ __forceinline__ void transpose_item(const Params& p, int kind, int e, bf16_t* dst, int ldd, LAS float* scr, int kb, int nb, int lane) {
    const int k0 = 64 * kb, n0 = 32 * nb;
#pragma unroll 4
    for (int i = 0; i < 32; ++i) { const int kk = 2 * i + (lane >> 5); scr[kk * 33 + (lane & 31)] = srcval(p, kind, e, k0 + kk, n0 + (lane & 31)); }
    asm volatile("s_waitcnt lgkmcnt(0)" ::: "memory");
    const int c = lane & 7;
#pragma unroll
    for (int j = 0; j < 4; ++j) { const int n = (lane >> 3) + 8 * j; const LAS float* s = scr + (8 * c) * 33 + n;
        u32x4 o; o.x = cvtpk(s[0 * 33], s[1 * 33]); o.y = cvtpk(s[2 * 33], s[3 * 33]); o.z = cvtpk(s[4 * 33], s[5 * 33]); o.w = cvtpk(s[6 * 33], s[7 * 33]);
        *(u32x4*)(dst + (size_t)(n0 + n) * ldd + k0 + 8 * c) = o; }
    asm volatile("s_waitcnt lgkmcnt(0)" ::: "memory");
}
__device__ __forceinline__ bool tjob(const Params& p, int& r, int kind, int e, size_t ws_off, int Kd, int Nd, LAS float* scr, int lane) {
    const int nkb = Kd / 64, nnb = Nd / 32, cnt = nkb * nnb;
    if (r < cnt) { transpose_item(p, kind, e, wsb(p, ws_off), Kd, scr, r / nnb, r % nnb, lane); return true; }
    r -= cnt; return false;
}
__device__ __forceinline__ void convert_moe_weights(const Params& p, const Ctx& c, int layer) {
    LAS float* scr = (LAS float*)(c.lds + RING_OFF + c.wave * 16384);
    const int gw = c.bid * NWAVES + c.wave, NGW = c.G * NWAVES;
    for (int it = gw; it < 16 * 384; it += NGW) { const int e = it / 384; int r = it % 384;
        if (r < 256) transpose_item(p, 10, layer * 16 + e, wsb(p, WS_WGU) + (size_t)e * 512 * 1024, 1024, scr, r / 16, r % 16, c.lane);
        else { r -= 256; transpose_item(p, 11, layer * 16 + e, wsb(p, WS_WDN) + (size_t)e * 1024 * 256, 256, scr, r / 32, r % 32, c.lane); } }
}
__device__ __forceinline__ void phase_prologue(const Params& p, const Ctx& c) {
    LAS float* sc = (LAS float*)(c.lds);
    LAS float* part = (LAS float*)(c.lds + 16384);
    for (int i = c.tid; i < NB * D; i += NTHREADS) { const float v = p.in[I_C][i]; sc[i] = v / (1.0f + __expf(-v)); }
    __syncthreads();
    for (int it = c.bid; it < MODW / 64; it += c.G) {
        const int col0 = it * 64, set = col0 < 12288 ? col0 / 3072 : 4, cin = col0 - (set < 4 ? set * 3072 : 12288);
        const float* W = set < 4 ? p.in[I_ADAW] + (size_t)set * D * 3072 : p.in[I_KVADAW]; const int ldw = set < 4 ? 3072 : 2048;
        const float* bias = set < 4 ? p.in[I_ADAB] + set * 3072 : p.in[I_KVADAB];
        float a0 = 0.f, a1 = 0.f, a2 = 0.f, a3 = 0.f;
#pragma unroll 8
        for (int kk = 0; kk < 128; ++kk) { const int k = c.wave * 128 + kk; const float w = W[(size_t)k * ldw + cin + c.lane];
            a0 += sc[k] * w; a1 += sc[D + k] * w; a2 += sc[2 * D + k] * w; a3 += sc[3 * D + k] * w; }
        part[(c.wave * 4 + 0) * 64 + c.lane] = a0; part[(c.wave * 4 + 1) * 64 + c.lane] = a1; part[(c.wave * 4 + 2) * 64 + c.lane] = a2; part[(c.wave * 4 + 3) * 64 + c.lane] = a3;
        __syncthreads();
        if (c.tid < 256) { const int b = c.tid >> 6, l = c.tid & 63; float s = bias[cin + l];
#pragma unroll
            for (int w = 0; w < 8; ++w) s += part[(w * 4 + b) * 64 + l];
            wsf(p, WS_MOD)[(size_t)b * MODW + col0 + l] = s; }
        __syncthreads();
    }
    __syncthreads();
    LAS float* scr = (LAS float*)(c.lds + RING_OFF + c.wave * 16384);
    const int gw = c.bid * NWAVES + c.wave, NGW = c.G * NWAVES;
    constexpr int NITEMS = 3 * 512 + 256 + 512 + 256 + 256 + 288 + 256 + 512 + 32 + 32 + 64;
    for (int it = gw; it < NITEMS; it += NGW) { int r = it;
        if (tjob(p, r, 0, 0, WS_WR, 1024, 1024, scr, c.lane)) continue;
        if (tjob(p, r, 1, 0, WS_WK, 1024, 1024, scr, c.lane)) continue;
        if (tjob(p, r, 2, 0, WS_WV, 1024, 1024, scr, c.lane)) continue;
        if (tjob(p, r, 3, 0, WS_LD, 2048, 256, scr, c.lane)) continue;
        if (tjob(p, r, 4, 0, WS_WO, 1024, 1024, scr, c.lane)) continue;
        if (tjob(p, r, 5, 0, WS_DKV, 1024, 512, scr, c.lane)) continue;
        if (tjob(p, r, 6, 0, WS_DQ, 1024, 512, scr, c.lane)) continue;
        if (tjob(p, r, 7, 0, WS_UQ, 384, 1536, scr, c.lane)) continue;
        if (tjob(p, r, 8, 0, WS_UKV, 256, 2048, scr, c.lane)) continue;
        if (tjob(p, r, 9, 0, WS_MWO, 1024, 1024, scr, c.lane)) continue;
        if (tjob(p, r, 12, 0, WS_W2T, 64, 1024, scr, c.lane)) continue;
        if (tjob(p, r, 13, 0, WS_A2T, 64, 1024, scr, c.lane)) continue;
        tjob(p, r, 14, 0, WS_G2T, 128, 1024, scr, c.lane);
    }
    convert_moe_weights(p, c, 0);
    const int* pos = (const int*)p.in[I_POS]; float* tab = wsf(p, WS_TAB);
    for (int i = c.bid * NTHREADS + c.tid; i < T * 16; i += c.G * NTHREADS) { const int t = i >> 4, f = i & 15;
        const float inv = powf(10000.0f, -(float)(2 * f) / 32.0f); float s, co; sincosf((float)pos[t] * inv, &s, &co);
        tab[(size_t)t * 32 + f] = co; tab[(size_t)t * 32 + 16 + f] = s; }
}

__device__ __forceinline__ void load_row(const float* rowp, int lane, f32x4 (&v)[4]) {
#pragma unroll
    for (int j = 0; j < 4; ++j) v[j] = *(const f32x4*)(rowp + 4 * lane + 256 * j);
}
__device__ __forceinline__ float row_rstd(const f32x4 (&v)[4]) {
    float s = 0.f;
#pragma unroll
    for (int j = 0; j < 4; ++j) s += (v[j][0] * v[j][0] + v[j][1] * v[j][1]) + (v[j][2] * v[j][2] + v[j][3] * v[j][3]);
    return rsqrtf(wave_sum(s) * (1.0f / D) + NORM_EPS);
}
__device__ __forceinline__ void store_row_bf16(bf16_t* rowp, int lane, const f32x4 (&v)[4]) {
#pragma unroll
    for (int j = 0; j < 4; ++j) *(u32x2*)(rowp + 4 * lane + 256 * j) = pack4(v[j]);
}
__device__ __forceinline__ void load_mod(const Params& p, const float* g, int set, int b, int lane, f32x4 (&P)[4], f32x4 (&SH)[4]) {
    const float* m = wsf(p, WS_MOD) + (size_t)b * MODW + (set < 4 ? set * 3072 : 12288);
#pragma unroll
    for (int j = 0; j < 4; ++j) { const int o = 4 * lane + 256 * j; const f32x4 gg = *(const f32x4*)(g + o), sc = *(const f32x4*)(m + 1024 + o); SH[j] = *(const f32x4*)(m + o); P[j] = gg * (sc + 1.0f); }
}

__device__ __forceinline__ void phase_n0(const Params& p, const Ctx& c) {
    const int row0 = (c.bid * NWAVES + c.wave) * 16;
    if (row0 >= T) return;
    const int b = row0 >> 13, t0 = row0 & (SEQ - 1);
    f32x4 P[4], SH[4], mr[4], mk[4], mv[4];
    load_mod(p, p.in[I_NORMG] + 0 * D, 0, b, c.lane, P, SH);
#pragma unroll
    for (int j = 0; j < 4; ++j) { const int o = 4 * c.lane + 256 * j; mr[j] = *(const f32x4*)(p.in[I_MU] + 0 * D + o); mk[j] = *(const f32x4*)(p.in[I_MU] + 2 * D + o); mv[j] = *(const f32x4*)(p.in[I_MU] + 3 * D + o); }
    bf16_t* hpad = (bf16_t*)p.out; bf16_t* xr = wsb(p, WS_W0); bf16_t* xk = wsb(p, WS_W1); bf16_t* xv = wsb(p, WS_W2);
    f32x4 hp[4];
    if (t0 == 0) {
#pragma unroll
        for (int j = 0; j < 4; ++j) hp[j] = (f32x4){0.f, 0.f, 0.f, 0.f};
        store_row_bf16(hpad + (size_t)b * (SEQ + 1) * D, c.lane, hp);
    } else { f32x4 v[4]; load_row(p.in[I_X] + (size_t)(row0 - 1) * D, c.lane, v); const float rs = row_rstd(v);
#pragma unroll
        for (int j = 0; j < 4; ++j) hp[j] = v[j] * rs * P[j] + SH[j]; }
    for (int r = 0; r < 16; ++r) { const int row = row0 + r; f32x4 v[4], o[4]; load_row(p.in[I_X] + (size_t)row * D, c.lane, v); const float rs = row_rstd(v);
#pragma unroll
        for (int j = 0; j < 4; ++j) v[j] = v[j] * rs * P[j] + SH[j];
        store_row_bf16(hpad + ((size_t)b * (SEQ + 1) + 1 + t0 + r) * D, c.lane, v);
#pragma unroll
        for (int j = 0; j < 4; ++j) o[j] = v[j] + (hp[j] - v[j]) * mr[j];
        store_row_bf16(xr + (size_t)row * D, c.lane, o);
#pragma unroll
        for (int j = 0; j < 4; ++j) o[j] = v[j] + (hp[j] - v[j]) * mk[j];
        store_row_bf16(xk + (size_t)row * D, c.lane, o);
#pragma unroll
        for (int j = 0; j < 4; ++j) o[j] = v[j] + (hp[j] - v[j]) * mv[j];
        store_row_bf16(xv + (size_t)row * D, c.lane, o);
#pragma unroll
        for (int j = 0; j < 4; ++j) hp[j] = v[j]; }
}

__device__ __forceinline__ void phase_router(const Params& p, const Ctx& c, int layer) {
    LAS float* rwt = (LAS float*)(c.lds);
    LAS int* rcls = (LAS int*)(c.lds + 65536);
    LAS float* rgate = (LAS float*)(c.lds + 65536 + 512);
    LAS int* rpos = (LAS int*)(c.lds + 65536 + 2048);
    LAS int* hist = (LAS int*)(c.lds + 65536 + 4096);
    for (int i = c.tid; i < D * NEXP; i += NTHREADS) { const int k = i >> 4, e = i & 15; rwt[e * D + k] = p.in[I_RTW][i]; }
    if (c.tid < 64) hist[c.tid] = 0;
    __syncthreads();
    const int set = layer * 2 + 1; const int rowb = c.bid * 128; const int b = rowb >> 13;
    f32x4 P[4], SH[4]; load_mod(p, p.in[I_NORMG] + (size_t)set * D, set, b, c.lane, P, SH);
    float rb[16];
#pragma unroll
    for (int e = 0; e < 16; ++e) rb[e] = p.in[I_RTB][e];
    const float* X = p.out; bf16_t* h2 = wsb(p, WS_W1);
    for (int r = 0; r < 16; ++r) { const int rl = c.wave * 16 + r, row = rowb + rl; f32x4 v[4]; load_row(X + (size_t)row * D, c.lane, v); const float rs = row_rstd(v);
#pragma unroll
        for (int j = 0; j < 4; ++j) v[j] = v[j] * rs * P[j] + SH[j];
        store_row_bf16(h2 + (size_t)row * D, c.lane, v);
        float sel[16], aff[16];
#pragma unroll
        for (int e = 0; e < 16; ++e) { float s = 0.f;
#pragma unroll
            for (int j = 0; j < 4; ++j) { const f32x4 w = *(const LAS f32x4*)(rwt + e * D + 4 * c.lane + 256 * j); s += (v[j][0] * w[0] + v[j][1] * w[1]) + (v[j][2] * w[2] + v[j][3] * w[3]); }
            s = wave_sum(s); aff[e] = 1.0f / (1.0f + __expf(-s)); sel[e] = aff[e] + rb[e]; }
        int bg = 0; float bs = -INFINITY;
#pragma unroll
        for (int g = 0; g < 4; ++g) { const float a0 = sel[4 * g], a1 = sel[4 * g + 1], a2 = sel[4 * g + 2], a3 = sel[4 * g + 3];
            const float m01 = fmaxf(a0, a1), n01 = fminf(a0, a1), m23 = fmaxf(a2, a3), n23 = fminf(a2, a3);
            const float top = fmaxf(m01, m23), second = fmaxf(fminf(m01, m23), (m01 >= m23) ? n01 : n23); const float gs = top + second;
            if (gs > bs) { bs = gs; bg = g; } }
        float s4[4], a4[4];
#pragma unroll
        for (int g = 0; g < 4; ++g) if (g == bg) {
#pragma unroll
            for (int i = 0; i < 4; ++i) { s4[i] = sel[4 * g + i]; a4[i] = aff[4 * g + i]; } }
        int i0 = 0;
#pragma unroll
        for (int i = 1; i < 4; ++i) if (s4[i] > s4[i0]) i0 = i;
        int i1 = (i0 == 0) ? 1 : 0;
#pragma unroll
        for (int i = 0; i < 4; ++i) if (i != i0 && i != i1 && s4[i] > s4[i1]) i1 = i;
        float af0 = 0.f, af1 = 0.f;
#pragma unroll
        for (int i = 0; i < 4; ++i) { if (i == i0) af0 = a4[i]; if (i == i1) af1 = a4[i]; }
        const float inv = 1.0f / (af0 + af1);
        const int lo = i0 < i1 ? i0 : i1, hi = i0 < i1 ? i1 : i0; const float glo = (i0 < i1 ? af0 : af1) * inv, ghi = (i0 < i1 ? af1 : af0) * inv;
        const int pair = (lo == 0) ? (hi - 1) : (lo == 1 ? hi + 1 : 5);
        if (c.lane == 0) { rcls[rl] = bg * 6 + pair; rgate[rl * 2] = glo; rgate[rl * 2 + 1] = ghi; }
    }
    __syncthreads();
    if (c.tid < 128) rpos[c.tid] = atomicAdd((int*)(hist + rcls[c.tid]), 1);
    __syncthreads();
    unsigned* gcnt = (unsigned*)(p.ws + WS_CTL) + CW_CNT + 64 * layer;
    if (c.tid < NCLS) { const int n = hist[c.tid]; hist[32 + c.tid] = n ? (int)atomicAdd(gcnt + c.tid, (unsigned)n) : 0; }
    __syncthreads();
    if (c.tid < 128) { const int cl = rcls[c.tid], pos = hist[32 + cl] + rpos[c.tid], tok = rowb + c.tid;
        ((int*)(p.ws + WS_LIST))[(size_t)cl * T + pos] = tok;
        *(f32x2*)(wsf(p, WS_GATES) + (size_t)tok * 2) = (f32x2){rgate[c.tid * 2], rgate[c.tid * 2 + 1]}; }
}

__device__ __forceinline__ void moe_setup(const Params& p, const Ctx& c, int layer) {
    LAS int* ud = (LAS int*)(c.lds + UDESC_OFF); LAS int* ct = (LAS int*)(c.lds + CLSTAB_OFF);
    LAS int* rowtab = (LAS int*)(c.lds + ROWTAB_OFF); LAS float* gatetab = (LAS float*)(c.lds + GATETAB_OFF);
    const unsigned* gcnt = (const unsigned*)(p.ws + WS_CTL) + CW_CNT + 64 * layer;
    if (c.tid < NCLS) ct[c.tid] = (int)__hip_atomic_load(gcnt + c.tid, __ATOMIC_RELAXED, __HIP_MEMORY_SCOPE_AGENT);
    __syncthreads();
    if (c.tid == 0) { int acc = 0; for (int k = 0; k < NCLS; ++k) { ct[32 + k] = acc; acc += (ct[k] + 255) >> 8; } ct[32 + NCLS] = acc;
        const int total = acc * 4;
        for (int i = 0; i < 4; ++i) { const long L0 = (long)i * c.G + c.bid; int valid = 0, st = 0, pn = 0, elo = 0, ehi = 0, cls = 0, j = 0;
            if (L0 < total) { int L = (int)L0; { const int q = total / 8, r = total % 8, xcd = L % 8, off = L / 8; L = (xcd < r ? xcd * (q + 1) : r * (q + 1) + (xcd - r) * q) + off; }
                valid = 1; pn = L & 3; st = L >> 2; cls = 0; while (cls < NCLS - 1 && ct[32 + cls + 1] <= st) ++cls; j = st - ct[32 + cls];
                const int g = cls / 6, pr = cls % 6; const int lo = pr < 3 ? 0 : (pr < 5 ? 1 : 2), hi = pr < 3 ? pr + 1 : (pr < 5 ? pr - 1 : 3); elo = 4 * g + lo; ehi = 4 * g + hi; }
            ud[i * 16 + 0] = valid; ud[i * 16 + 1] = st; ud[i * 16 + 2] = pn; ud[i * 16 + 3] = elo; ud[i * 16 + 4] = ehi; ud[i * 16 + 5] = cls; ud[i * 16 + 6] = j; } }
    __syncthreads();
    const int* list = (const int*)(p.ws + WS_LIST); const float* gates = wsf(p, WS_GATES);
    for (int i = 0; i < 4; ++i) { if (!ud[i * 16]) continue; const int cls = ud[i * 16 + 5], j = ud[i * 16 + 6], n = ct[cls];
        if (c.tid < 256) { const int pos = j * 256 + c.tid; int tok = -1; f32x2 g = {0.f, 0.f};
            if (pos < n) { tok = list[(size_t)cls * T + pos]; g = *(const f32x2*)(gates + (size_t)tok * 2); }
            rowtab[i * 256 + c.tid] = tok; gatetab[(i * 256 + c.tid) * 2] = g.x; gatetab[(i * 256 + c.tid) * 2 + 1] = g.y; } }
    __syncthreads();
}

__device__ __forceinline__ void phase_n2(const Params& p, const Ctx& c) {
    const int row0 = (c.bid * NWAVES + c.wave) * 16; if (row0 >= T) return; const int b = row0 >> 13;
    f32x4 P1[4], S1[4], P2[4], S2[4];
    load_mod(p, p.in[I_NORMG] + 2 * D, 2, b, c.lane, P1, S1); load_mod(p, p.in[I_KVNG], 4, b, c.lane, P2, S2);
    const float* X = p.out; bf16_t* h1 = wsb(p, WS_W0); bf16_t* hkv = wsb(p, WS_W1);
    for (int r = 0; r < 16; ++r) { const int row = row0 + r; f32x4 v[4], o[4]; load_row(X + (size_t)row * D, c.lane, v); const float rs = row_rstd(v);
#pragma unroll
        for (int j = 0; j < 4; ++j) { v[j] = v[j] * rs; o[j] = v[j] * P1[j] + S1[j]; }
        store_row_bf16(h1 + (size_t)row * D, c.lane, o);
#pragma unroll
        for (int j = 0; j < 4; ++j) o[j] = v[j] * P2[j] + S2[j];
        store_row_bf16(hkv + (size_t)row * D, c.lane, o); }
}
__device__ __forceinline__ void phase_final(const Params& p, const Ctx& c) {
    const int row0 = (c.bid * NWAVES + c.wave) * 16; if (row0 >= T) return;
    f32x4 g[4];
#pragma unroll
    for (int j = 0; j < 4; ++j) g[j] = *(const f32x4*)(p.in[I_FG] + 4 * c.lane + 256 * j);
    for (int r = 0; r < 16; ++r) { float* rowp = p.out + (size_t)(row0 + r) * D; f32x4 v[4]; load_row(rowp, c.lane, v); const float rs = row_rstd(v);
#pragma unroll
        for (int j = 0; j < 4; ++j) *(f32x4*)(rowp + 4 * c.lane + 256 * j) = v[j] * rs * g[j]; }
}
constexpr int WK_TT = 32;
__device__ __forceinline__ void phase_wkv_seq(const Params& p, const Ctx& c) {
    if (c.bid >= NB * NHEAD) return;
    const int b = c.bid >> 4, h = c.bid & 15, tid = c.tid;
    LAS float* W2h = (LAS float*)(c.lds);
    LAS float* A2h = (LAS float*)(c.lds + 16384);
    LAS float* G2h = (LAS float*)(c.lds + 32768);
    LAS unsigned short* L1t = (LAS unsigned short*)(c.lds + 65536);
    LAS float* rT = (LAS float*)(c.lds + 81920);
    LAS float* kT = rT + 2048; LAS float* vT = kT + 2048; LAS float* dT = vT + 2048; LAS float* aT = dT + 2048; LAS float* bT = aT + 2048; LAS float* gT = bT + 2048; LAS float* yT = gT + 2048;
    for (int i = tid; i < 64 * 64; i += NTHREADS) { const int k = i >> 6, j = i & 63; W2h[i] = p.in[I_W2][(size_t)k * D + h * 64 + j]; A2h[i] = p.in[I_A2][(size_t)k * D + h * 64 + j]; }
    for (int i = tid; i < 128 * 64; i += NTHREADS) { const int k = i >> 6, j = i & 63; G2h[i] = p.in[I_G2][(size_t)k * D + h * 64 + j]; }
    const bf16_t* Rg = wsb(p, WS_W3); const bf16_t* Kg = wsb(p, WS_W4); const bf16_t* Vg = wsb(p, WS_W5); const bf16_t* L1 = wsb(p, WS_W6); bf16_t* YG = wsb(p, WS_W0);
    const int tt = tid >> 4, jq = tid & 15, ch = h * 64 + 4 * jq;
    const f32x4 w0v = *(const f32x4*)(p.in[I_W0] + ch), a0v = *(const f32x4*)(p.in[I_A0] + ch), kkv = *(const f32x4*)(p.in[I_KK] + ch), kav = *(const f32x4*)(p.in[I_KA] + ch);
    const f32x4 rkv = *(const f32x4*)(p.in[I_RK] + ch), lnw = *(const f32x4*)(p.in[I_LNW] + ch), lnb = *(const f32x4*)(p.in[I_LNB] + ch);
    const int si = tid >> 3, jb = tid & 7;
    float S[8];
#pragma unroll
    for (int q = 0; q < 8; ++q) S[q] = 0.f;
    __syncthreads();
    for (int tile = 0; tile < SEQ / WK_TT; ++tile) {
        const size_t rowb = (size_t)b * SEQ + (size_t)tile * WK_TT;
        { const int r = tid >> 4, cc = tid & 15; const u32x4* src = (const u32x4*)(L1 + (rowb + r) * 256 + cc * 16); u32x4 x0 = src[0], x1 = src[1];
          *(LAS u32x4*)(L1t + r * 256 + cc * 16) = x0; *(LAS u32x4*)(L1t + r * 256 + cc * 16 + 8) = x1; }
        const u32x2 r2 = *(const u32x2*)(Rg + (rowb + tt) * D + ch), k2 = *(const u32x2*)(Kg + (rowb + tt) * D + ch), v2 = *(const u32x2*)(Vg + (rowb + tt) * D + ch);
        __syncthreads();
        f32x4 wl = w0v, al = a0v, gl = (f32x4){0.f, 0.f, 0.f, 0.f};
        for (int k = 0; k < 64; ++k) { const float lw = bf2f(L1t[tt * 256 + k]), la = bf2f(L1t[tt * 256 + 64 + k]);
            wl += lw * *(const LAS f32x4*)(W2h + k * 64 + 4 * jq); al += la * *(const LAS f32x4*)(A2h + k * 64 + 4 * jq); }
        for (int k = 0; k < 128; ++k) { const float lg = bf2f(L1t[tt * 256 + 128 + k]); gl += lg * *(const LAS f32x4*)(G2h + k * 64 + 4 * jq); }
        f32x4 rv = {bflo(r2.x), bfhi(r2.x), bflo(r2.y), bfhi(r2.y)}, kv = {bflo(k2.x), bfhi(k2.x), bflo(k2.y), bfhi(k2.y)}, vv = {bflo(v2.x), bfhi(v2.x), bflo(v2.y), bfhi(v2.y)};
        f32x4 dec, av, kk = kv * kkv; float ss = (kk[0] * kk[0] + kk[1] * kk[1]) + (kk[2] * kk[2] + kk[3] * kk[3]);
        ss += __shfl_xor(ss, 1); ss += __shfl_xor(ss, 2); ss += __shfl_xor(ss, 4); ss += __shfl_xor(ss, 8);
        const float inrm = 1.0f / fmaxf(sqrtf(ss), 1e-12f);
#pragma unroll
        for (int q = 0; q < 4; ++q) { const float x = -wl[q]; const float sp = fmaxf(x, 0.f) + log1pf(__expf(-fabsf(x)));
            dec[q] = __expf(-__expf(-sp - 0.5f)); av[q] = 1.0f / (1.0f + __expf(-al[q])); }
        kk = kk * inrm; const f32x4 km = kv * ((av - 1.0f) * kav + 1.0f);
        *(LAS f32x4*)(rT + tt * 64 + 4 * jq) = rv; *(LAS f32x4*)(kT + tt * 64 + 4 * jq) = km; *(LAS f32x4*)(vT + tt * 64 + 4 * jq) = vv; *(LAS f32x4*)(dT + tt * 64 + 4 * jq) = dec;
        *(LAS f32x4*)(aT + tt * 64 + 4 * jq) = -kk; *(LAS f32x4*)(bT + tt * 64 + 4 * jq) = kk * av; *(LAS f32x4*)(gT + tt * 64 + 4 * jq) = gl;
        __syncthreads();
        for (int t = 0; t < WK_TT; ++t) {
            const f32x4 a0 = *(const LAS f32x4*)(aT + t * 64 + 8 * jb), a1 = *(const LAS f32x4*)(aT + t * 64 + 8 * jb + 4);
            float sa = (S[0] * a0[0] + S[1] * a0[1]) + (S[2] * a0[2] + S[3] * a0[3]) + (S[4] * a1[0] + S[5] * a1[1]) + (S[6] * a1[2] + S[7] * a1[3]);
            sa += __shfl_xor(sa, 1); sa += __shfl_xor(sa, 2); sa += __shfl_xor(sa, 4);
            const f32x4 d0 = *(const LAS f32x4*)(dT + t * 64 + 8 * jb), d1 = *(const LAS f32x4*)(dT + t * 64 + 8 * jb + 4);
            const f32x4 b0 = *(const LAS f32x4*)(bT + t * 64 + 8 * jb), b1 = *(const LAS f32x4*)(bT + t * 64 + 8 * jb + 4);
            const f32x4 k0 = *(const LAS f32x4*)(kT + t * 64 + 8 * jb), k1 = *(const LAS f32x4*)(kT + t * 64 + 8 * jb + 4);
            const f32x4 r0 = *(const LAS f32x4*)(rT + t * 64 + 8 * jb), r1 = *(const LAS f32x4*)(rT + t * 64 + 8 * jb + 4);
            const float vi = vT[t * 64 + si];
#pragma unroll
            for (int q = 0; q < 4; ++q) { S[q] = S[q] * d0[q] + sa * b0[q] + vi * k0[q]; S[4 + q] = S[4 + q] * d1[q] + sa * b1[q] + vi * k1[q]; }
            float y = (S[0] * r0[0] + S[1] * r0[1]) + (S[2] * r0[2] + S[3] * r0[3]) + (S[4] * r1[0] + S[5] * r1[1]) + (S[6] * r1[2] + S[7] * r1[3]);
            y += __shfl_xor(y, 1); y += __shfl_xor(y, 2); y += __shfl_xor(y, 4);
            if (jb == 0) yT[t * 64 + si] = y;
        }
        __syncthreads();
        { const f32x4 y4 = *(const LAS f32x4*)(yT + tt * 64 + 4 * jq); float s = (y4[0] + y4[1]) + (y4[2] + y4[3]);
          s += __shfl_xor(s, 1); s += __shfl_xor(s, 2); s += __shfl_xor(s, 4); s += __shfl_xor(s, 8); const float mean = s * (1.0f / 64.0f);
          const f32x4 dv = y4 - mean; float q2 = (dv[0] * dv[0] + dv[1] * dv[1]) + (dv[2] * dv[2] + dv[3] * dv[3]);
          q2 += __shfl_xor(q2, 1); q2 += __shfl_xor(q2, 2); q2 += __shfl_xor(q2, 4); q2 += __shfl_xor(q2, 8); const float rstd = rsqrtf(q2 * (1.0f / 64.0f) + GN_EPS);
          const f32x4 rr = *(const LAS f32x4*)(rT + tt * 64 + 4 * jq), kq = *(const LAS f32x4*)(kT + tt * 64 + 4 * jq), vq = *(const LAS f32x4*)(vT + tt * 64 + 4 * jq), gq = *(const LAS f32x4*)(gT + tt * 64 + 4 * jq);
          float bsum = (rr[0] * kq[0] * rkv[0] + rr[1] * kq[1] * rkv[1]) + (rr[2] * kq[2] * rkv[2] + rr[3] * kq[3] * rkv[3]);
          bsum += __shfl_xor(bsum, 1); bsum += __shfl_xor(bsum, 2); bsum += __shfl_xor(bsum, 4); bsum += __shfl_xor(bsum, 8);
          const f32x4 o = ((dv * rstd) * lnw + lnb + vq * bsum) * gq;
          *(u32x2*)(YG + (rowb + tt) * D + ch) = pack4(o); }
        __syncthreads();
    }
}

constexpr int AT_KSTR = 208;
constexpr int AT_KBUF = 64 * AT_KSTR, AT_VBUF = 8192;
__device__ __forceinline__ s16x4 vtr(const LAS unsigned char* pp) { typedef short v4i16_t __attribute__((ext_vector_type(4)));
    return __builtin_bit_cast(s16x4, __builtin_amdgcn_ds_read_tr16_b64_v4i16((LAS v4i16_t*)pp)); }
__device__ __forceinline__ void attn_unit(const Params& p, const Ctx& c, int b, int h, int qb) {
    const int tid = c.tid, lane = c.lane, wid = c.wave, r32 = lane & 31, hi = lane >> 5;
    const bf16_t* Q = wsb(p, WS_W2); const bf16_t* Kn = wsb(p, WS_W4); const bf16_t* V = wsb(p, WS_W5); const bf16_t* Kr = wsb(p, WS_KR); bf16_t* O = wsb(p, WS_W0);
    const size_t rowbase = (size_t)b * SEQ; const int q0 = qb * 256, qrow = q0 + 32 * wid + r32;
    LAS unsigned char* Kb = c.lds; LAS unsigned char* Vb = c.lds + 2 * AT_KBUF;
    bf16x8 qr[6];
#pragma unroll
    for (int d0 = 0; d0 < 6; ++d0) qr[d0] = *(const bf16x8*)(Q + (rowbase + qrow) * (NHEAD * QKD) + h * QKD + 16 * d0 + 8 * hi);
    const int NTL = (q0 + 256) / 64;
    const int lrow = tid >> 3, lch = tid & 7, lrow2 = (tid & 255) >> 2, lch2 = tid & 3;
    u32x4 kreg, vreg, rreg;
#define AT_LOAD(t) do { const size_t _r = rowbase + (size_t)(t) * 64; kreg = *(const u32x4*)(Kn + (_r + lrow) * D + h * HD + lch * 8); vreg = *(const u32x4*)(V + (_r + lrow) * D + h * HD + lch * 8); \
        if (tid < 256) rreg = *(const u32x4*)(Kr + (_r + lrow2) * ROPE + lch2 * 8); } while (0)
#define AT_STORE(buf) do { *(LAS u32x4*)(Kb + (buf) * AT_KBUF + lrow * AT_KSTR + lch * 16) = kreg; *(LAS u32x4*)(Vb + (buf) * AT_VBUF + (lch >> 2) * 4096 + lrow * 64 + (lch & 3) * 16) = vreg; \
        if (tid < 256) *(LAS u32x4*)(Kb + (buf) * AT_KBUF + lrow2 * AT_KSTR + 128 + lch2 * 16) = rreg; } while (0)
    AT_LOAD(0); AT_STORE(0);
    __syncthreads();
    f32x16 o0 = {}, o1 = {}; float mrun = -1e30f, lrun = 0.f;
    const int vlane = ((lane >> 4) & 1) * 32 + (lane & 3) * 8 + (4 * hi + ((lane & 15) >> 2)) * 64;
    for (int t = 0; t < NTL; ++t) {
        const int buf = t & 1;
        if (t + 1 < NTL) AT_LOAD(t + 1);
        if (64 * t <= q0 + 32 * wid + 31) {
            const LAS unsigned char* kb = Kb + buf * AT_KBUF; const LAS unsigned char* vb = Vb + buf * AT_VBUF;
            f32x16 s0 = {}, s1 = {};
#pragma unroll
            for (int d0 = 0; d0 < 6; ++d0) { const bf16x8 k0 = *(const LAS bf16x8*)(kb + r32 * AT_KSTR + d0 * 32 + hi * 16), k1 = *(const LAS bf16x8*)(kb + (32 + r32) * AT_KSTR + d0 * 32 + hi * 16);
                s0 = __builtin_amdgcn_mfma_f32_32x32x16_bf16(k0, qr[d0], s0, 0, 0, 0); s1 = __builtin_amdgcn_mfma_f32_32x32x16_bf16(k1, qr[d0], s1, 0, 0, 0); }
            if (64 * t + 63 > q0 + 32 * wid) {
                const int kb0 = 64 * t + 4 * hi;
#pragma unroll
                for (int r = 0; r < 16; ++r) { const int kv = kb0 + (r & 3) + 8 * (r >> 2); if (kv > qrow) s0[r] = -INFINITY; if (kv + 32 > qrow) s1[r] = -INFINITY; } }
            float mx = s0[0];
#pragma unroll
            for (int r = 1; r < 16; ++r) mx = fmaxf(mx, s0[r]);
#pragma unroll
            for (int r = 0; r < 16; ++r) mx = fmaxf(mx, s1[r]);
            mx = fmaxf(mx, __shfl_xor(mx, 32));
            const float mnew = fmaxf(mrun, mx), alpha = __builtin_amdgcn_exp2f(mrun - mnew); mrun = mnew;
            float rs = 0.f;
#pragma unroll
            for (int r = 0; r < 16; ++r) { s0[r] = __builtin_amdgcn_exp2f(s0[r] - mnew); s1[r] = __builtin_amdgcn_exp2f(s1[r] - mnew); rs += s0[r] + s1[r]; }
            lrun = lrun * alpha + rs;
#pragma unroll
            for (int r = 0; r < 16; ++r) { o0[r] *= alpha; o1[r] *= alpha; }
            u32x4 pw[4];
#pragma unroll
            for (int s = 0; s < 2; ++s) { pw[s] = (u32x4){cvtpk(s0[8 * s], s0[8 * s + 1]), cvtpk(s0[8 * s + 2], s0[8 * s + 3]), cvtpk(s0[8 * s + 4], s0[8 * s + 5]), cvtpk(s0[8 * s + 6], s0[8 * s + 7])};
                pw[2 + s] = (u32x4){cvtpk(s1[8 * s], s1[8 * s + 1]), cvtpk(s1[8 * s + 2], s1[8 * s + 3]), cvtpk(s1[8 * s + 4], s1[8 * s + 5]), cvtpk(s1[8 * s + 6], s1[8 * s + 7])}; }
#pragma unroll
            for (int s = 0; s < 4; ++s) { const bf16x8 pb = __builtin_bit_cast(bf16x8, pw[s]);
                const s16x4 a0 = vtr(vb + vlane + s * 1024), a1 = vtr(vb + vlane + s * 1024 + 512), c0 = vtr(vb + 4096 + vlane + s * 1024), c1 = vtr(vb + 4096 + vlane + s * 1024 + 512);
                const bf16x8 va = {a0[0], a0[1], a0[2], a0[3], a1[0], a1[1], a1[2], a1[3]}, vc = {c0[0], c0[1], c0[2], c0[3], c1[0], c1[1], c1[2], c1[3]};
                o0 = __builtin_amdgcn_mfma_f32_32x32x16_bf16(va, pb, o0, 0, 0, 0); o1 = __builtin_amdgcn_mfma_f32_32x32x16_bf16(vc, pb, o1, 0, 0, 0); }
        }
        if (t + 1 < NTL) AT_STORE(buf ^ 1);
        __syncthreads();
    }
    lrun += __shfl_xor(lrun, 32); const float inv = 1.0f / lrun;
    bf16_t* orow = O + (rowbase + qrow) * D + h * HD;
#pragma unroll
    for (int g = 0; g < 4; ++g) { const f32x4 x0 = {o0[4 * g] * inv, o0[4 * g + 1] * inv, o0[4 * g + 2] * inv, o0[4 * g + 3] * inv}, x1 = {o1[4 * g] * inv, o1[4 * g + 1] * inv, o1[4 * g + 2] * inv, o1[4 * g + 3] * inv};
        *(u32x2*)(orow + 8 * g + 4 * hi) = pack4(x0); *(u32x2*)(orow + 32 + 8 * g + 4 * hi) = pack4(x1); }
#undef AT_LOAD
#undef AT_STORE
}
__device__ __forceinline__ void phase_attention(const Params& p, const Ctx& c) {
    const int v = (c.G % 8 == 0) ? (c.bid % 8) * (c.G / 8) + c.bid / 8 : c.bid; const int bh = v >> 2, s = v & 3;
    if (bh >= NB * NHEAD) return;
    for (int i = 0; i < 8; ++i) { const int qb = 8 * (i >> 1) + ((i & 1) ? 7 - s : s); attn_unit(p, c, bh >> 4, bh & 15, qb); }
}
constexpr int WS_STR = 72, WBUF = 64 * WS_STR * 2;
constexpr int WK_NCH = SEQ / 64;
constexpr size_t WU = 64 * 64;
__device__ __forceinline__ bf16x8 ldsfrag(const LAS unsigned char* M, int row, int s, int hi) { return *(const LAS bf16x8*)(M + (row * WS_STR + 16 * s + 8 * hi) * 2); }
__device__ __forceinline__ bf16x8 glbfrag(const bf16_t* M, int ld, int row, int s, int hi) { return *(const bf16x8*)(M + (size_t)row * ld + 16 * s + 8 * hi); }
__device__ __forceinline__ f32x16 prod_ll(const LAS unsigned char* P1, const LAS unsigned char* P2, int xt, int yt, int r32, int hi, f32x16 acc) {
#pragma unroll
    for (int s = 0; s < 4; ++s) acc = __builtin_amdgcn_mfma_f32_32x32x16_bf16(ldsfrag(P2, 32 * yt + r32, s, hi), ldsfrag(P1, 32 * xt + r32, s, hi), acc, 0, 0, 0);
    return acc;
}
__device__ __forceinline__ void st_tile_lds(LAS unsigned char* dst, int xt, int yt, int r32, int hi, const f32x16& v) {
#pragma unroll
    for (int q = 0; q < 4; ++q) *(LAS u32x2*)(dst + ((32 * xt + r32) * WS_STR + 32 * yt + 8 * q + 4 * hi) * 2) = pack4((f32x4){v[4 * q], v[4 * q + 1], v[4 * q + 2], v[4 * q + 3]});
}
__device__ __forceinline__ void st_tile_glb(bf16_t* dst, int xt, int yt, int r32, int hi, const f32x16& v) {
#pragma unroll
    for (int q = 0; q < 4; ++q) *(u32x2*)(dst + (size_t)(32 * xt + r32) * 64 + 32 * yt + 8 * q + 4 * hi) = pack4((f32x4){v[4 * q], v[4 * q + 1], v[4 * q + 2], v[4 * q + 3]});
}
__device__ __forceinline__ f32x4 ld4_lds_bf16(const LAS unsigned char* M, int row, int col) { const u32x2 w = *(const LAS u32x2*)(M + (row * WS_STR + col) * 2); return (f32x4){bflo(w.x), bfhi(w.x), bflo(w.y), bfhi(w.y)}; }
__device__ __forceinline__ bf16x8 trifrag(int t, int s, int hi, int strict) {
    const int k0 = 16 * s + 8 * hi + strict; u32x4 w;
    w.x = (k0 + 0 <= t ? 0x3F80u : 0u) | (k0 + 1 <= t ? 0x3F800000u : 0u); w.y = (k0 + 2 <= t ? 0x3F80u : 0u) | (k0 + 3 <= t ? 0x3F800000u : 0u);
    w.z = (k0 + 4 <= t ? 0x3F80u : 0u) | (k0 + 5 <= t ? 0x3F800000u : 0u); w.w = (k0 + 6 <= t ? 0x3F80u : 0u) | (k0 + 7 <= t ? 0x3F800000u : 0u);
    return __builtin_bit_cast(bf16x8, w);
}
#define WK_Y(r) (32 * yt + ((r) & 3) + 8 * ((r) >> 2) + 4 * hi)

__device__ __forceinline__ void phase_wkv_a(const Params& p, const Ctx& c) {
    const int tid = c.tid, lane = c.lane, w = c.wave, r32 = lane & 31, hi = lane >> 5, team = w >> 2, xt = (w >> 1) & 1, yt = w & 1;
    const int bh = c.bid >> 2, b = bh >> 4, h = bh & 15;
    LAS unsigned char* B0 = c.lds;
#define WB(i) (B0 + (i) * WBUF)
    LAS unsigned char *bR = WB(0), *bKraw = WB(1), *bVraw = WB(2), *bLDh = WB(3), *bLDl = WB(4), *bAt = WB(5), *bBt = WB(6), *bKt = WB(7), *bXA0 = WB(8), *bXA1 = WB(9), *bBtr = WB(10), *bVtr = WB(11), *bMNa = WB(12), *bMTa = WB(13), *bMbr = WB(14);
    LAS unsigned char *bXB0 = WB(1), *bXB1 = WB(2), *bMNb = WB(3), *bMTb = WB(4), *bGT = WB(5), *bHT = WB(6);
    LAS float* cst = (LAS float*)(B0 + 15 * WBUF);
    if (tid < 64) { cst[tid] = p.in[I_A0][h * 64 + tid]; cst[64 + tid] = p.in[I_KK][h * 64 + tid]; cst[128 + tid] = p.in[I_KA][h * 64 + tid]; cst[192 + tid] = p.in[I_RK][h * 64 + tid]; }
    const bf16_t* Rg = wsb(p, WS_W3); const bf16_t* Kg = wsb(p, WS_W4); const bf16_t* Vg = wsb(p, WS_W5); const bf16_t* L1 = wsb(p, WS_W6);
    const bf16_t* W2T = wsb(p, WS_W2T); const bf16_t* A2T = wsb(p, WS_A2T);
    bf16_t* PTg = wsb(p, WS_W0); bf16_t* Zg = wsb(p, WS_W1); bf16_t* QTg = wsb(p, WS_W2); bf16_t* YLg = (bf16_t*)p.out; float* bsg = wsf(p, WS_BSUM);
    const float w0c = p.in[I_W0][h * 64 + 32 * xt + r32];
    const int lrow = tid >> 3, lch = tid & 7;
    for (int u = 0; u < 32; ++u) {
        const int chunk = (c.bid & 3) * 32 + u; const size_t row0 = (size_t)b * SEQ + (size_t)chunk * 64; const size_t unit = (size_t)bh * WK_NCH + chunk;
        { const size_t g = (row0 + lrow) * D + h * 64 + lch * 8; const u32x4 rr = *(const u32x4*)(Rg + g), kk = *(const u32x4*)(Kg + g), vv = *(const u32x4*)(Vg + g);
          const int o = (lrow * WS_STR + lch * 8) * 2; *(LAS u32x4*)(bR + o) = rr; *(LAS u32x4*)(bKraw + o) = kk; *(LAS u32x4*)(bVraw + o) = vv; }
        f32x16 aTL = {};
#pragma unroll
        for (int s = 0; s < 4; ++s) aTL = __builtin_amdgcn_mfma_f32_32x32x16_bf16(glbfrag(A2T, 64, h * 64 + 32 * yt + r32, s, hi), glbfrag(L1 + 64, 256, (int)row0 + 32 * xt + r32, s, hi), aTL, 0, 0, 0);
        if (team == 0) { f32x16 a = {};
#pragma unroll
            for (int s = 0; s < 4; ++s) a = __builtin_amdgcn_mfma_f32_32x32x16_bf16(glbfrag(L1, 256, (int)row0 + 32 * yt + r32, s, hi), glbfrag(W2T, 64, h * 64 + 32 * xt + r32, s, hi), a, 0, 0, 0);
            f32x16 lo;
#pragma unroll
            for (int r = 0; r < 16; ++r) { const float x = -(w0c + a[r]); const float sp = fmaxf(x, 0.f) + log1pf(__expf(-fabsf(x))); const float ld = -__expf(-sp - 0.5f);
                const float ldh = bf2f((unsigned short)(cvtpk(ld, 0.f) & 0xffffu)); a[r] = ldh; lo[r] = ld - ldh; }
            st_tile_lds(bLDh, xt, yt, r32, hi, a); st_tile_lds(bLDl, xt, yt, r32, hi, lo); }
        __syncthreads();
        { f32x16 cl = {}, cle = {};
#pragma unroll
          for (int s = 0; s < 4; ++s) { const bf16x8 fh = ldsfrag(bLDh, 32 * yt + r32, s, hi), fl = ldsfrag(bLDl, 32 * yt + r32, s, hi); const bf16x8 ti = trifrag(32 * xt + r32, s, hi, 0), ts = trifrag(32 * xt + r32, s, hi, 1);
              cl = __builtin_amdgcn_mfma_f32_32x32x16_bf16(fh, ti, cl, 0, 0, 0); cl = __builtin_amdgcn_mfma_f32_32x32x16_bf16(fl, ti, cl, 0, 0, 0);
              cle = __builtin_amdgcn_mfma_f32_32x32x16_bf16(fh, ts, cle, 0, 0, 0); cle = __builtin_amdgcn_mfma_f32_32x32x16_bf16(fl, ts, cle, 0, 0, 0); }
          const int t = 32 * xt + r32;
          float ss = 0.f;
#pragma unroll
          for (int q = 0; q < 8; ++q) { const f32x4 kv = ld4_lds_bf16(bKraw, t, 32 * hi + 4 * q); const f32x4 kc = *(const LAS f32x4*)(cst + 64 + 32 * hi + 4 * q); const f32x4 z = kv * kc; ss += (z[0] * z[0] + z[1] * z[1]) + (z[2] * z[2] + z[3] * z[3]); }
          ss += __shfl_xor(ss, 32); const float inrm = 1.0f / fmaxf(sqrtf(ss), 1e-12f);
          float bs = 0.f; float aS[8], clS[8], cleS[8];
#pragma unroll
          for (int j = 0; j < 8; ++j) { aS[j] = team ? aTL[8 + j] : aTL[j]; clS[j] = team ? cl[8 + j] : cl[j]; cleS[j] = team ? cle[8 + j] : cle[j]; }
#pragma unroll
          for (int qq = 0; qq < 2; ++qq) { const int q = 2 * team + qq, c0 = 32 * yt + 8 * q + 4 * hi;
              const f32x4 kv = ld4_lds_bf16(bKraw, t, c0), rv = ld4_lds_bf16(bR, t, c0), vv = ld4_lds_bf16(bVraw, t, c0);
              const f32x4 a0 = *(const LAS f32x4*)(cst + c0), kkc = *(const LAS f32x4*)(cst + 64 + c0), kac = *(const LAS f32x4*)(cst + 128 + c0), rkc = *(const LAS f32x4*)(cst + 192 + c0);
              f32x4 at4, bt4, kt4, rt4;
#pragma unroll
              for (int i = 0; i < 4; ++i) { const int r = 4 * qq + i; const float a = 1.0f / (1.0f + __expf(-(a0[i] + aS[r]))); const float kkv = kv[i] * kkc[i] * inrm, km = kv[i] * (1.0f + (a - 1.0f) * kac[i]);
                  const float cw = __expf(clS[r]), cwm1 = __expf(cleS[r]), icw = __expf(-clS[r]);
                  at4[i] = -kkv * cwm1; bt4[i] = kkv * a * icw; kt4[i] = km * icw; rt4[i] = rv[i] * cw; bs += rv[i] * km * rkc[i];
                  if (t == 63) cst[256 + c0 + i] = cw; }
              const int o = (t * WS_STR + c0) * 2;
              *(LAS u32x2*)(bAt + o) = pack4(at4); *(LAS u32x2*)(bBt + o) = pack4(bt4); *(LAS u32x2*)(bKt + o) = pack4(kt4); *(LAS u32x2*)(bR + o) = pack4(rt4);
#pragma unroll
              for (int i = 0; i < 4; ++i) { const int ot = ((c0 + i) * WS_STR + t) * 2;
                  *(LAS unsigned short*)(bXA0 + ot) = (unsigned short)(cvtpk(at4[i], 0.f) & 0xffffu); *(LAS unsigned short*)(bBtr + ot) = (unsigned short)(cvtpk(bt4[i], 0.f) & 0xffffu); *(LAS unsigned short*)(bVtr + ot) = (unsigned short)(cvtpk(vv[i], 0.f) & 0xffffu); } }
          bs += __shfl_xor(bs, 32);
          if (hi == 0) bsg[((row0 + t) * NHEAD + h) * 4 + team * 2 + yt] = bs; }
        __syncthreads();
        { const int x = 32 * xt + r32;
          if (team == 0) { f32x16 m = prod_ll(bBt, bAt, xt, yt, r32, hi, (f32x16){});
#pragma unroll
              for (int r = 0; r < 16; ++r) if (!(x < WK_Y(r))) m[r] = 0.f;
              st_tile_lds(bMNa, xt, yt, r32, hi, m);
              m = prod_ll(bAt, bBt, xt, yt, r32, hi, (f32x16){});
#pragma unroll
              for (int r = 0; r < 16; ++r) if (!(WK_Y(r) < x)) m[r] = 0.f;
              st_tile_lds(bMTa, xt, yt, r32, hi, m); }
          else { f32x16 m = prod_ll(bKt, bAt, xt, yt, r32, hi, (f32x16){});
#pragma unroll
              for (int r = 0; r < 16; ++r) if (!(x < WK_Y(r))) m[r] = 0.f;
              st_tile_lds(bXA1, xt, yt, r32, hi, m);
              m = prod_ll(bR, bBt, xt, yt, r32, hi, (f32x16){});
#pragma unroll
              for (int r = 0; r < 16; ++r) if (!(WK_Y(r) <= x)) m[r] = 0.f;
              st_tile_lds(bMbr, xt, yt, r32, hi, m); } }
        __syncthreads();
#pragma unroll
        for (int kq = 0; kq < 6; ++kq) {
            LAS unsigned char* Xs = (kq & 1) ? (team ? bXB1 : bXB0) : (team ? bXA1 : bXA0); LAS unsigned char* Xd = (kq & 1) ? (team ? bXA1 : bXA0) : (team ? bXB1 : bXB0);
            LAS unsigned char* MNs = (kq & 1) ? bMNb : bMNa; LAS unsigned char* MTs = (kq & 1) ? bMTb : bMTa; LAS unsigned char* MNd = (kq & 1) ? bMNa : bMNb; LAS unsigned char* MTd = (kq & 1) ? bMTa : bMTb;
            f32x16 xa;
#pragma unroll
            for (int q = 0; q < 4; ++q) { const f32x4 o = ld4_lds_bf16(Xs, 32 * xt + r32, 32 * yt + 8 * q + 4 * hi); xa[4 * q] = o[0]; xa[4 * q + 1] = o[1]; xa[4 * q + 2] = o[2]; xa[4 * q + 3] = o[3]; }
            xa = prod_ll(Xs, MTs, xt, yt, r32, hi, xa);
            st_tile_lds(Xd, xt, yt, r32, hi, xa);
            if (kq < 5) { if (team == 0) st_tile_lds(MNd, xt, yt, r32, hi, prod_ll(MNs, MTs, xt, yt, r32, hi, (f32x16){}));
                          else st_tile_lds(MTd, xt, yt, r32, hi, prod_ll(MTs, MNs, xt, yt, r32, hi, (f32x16){})); }
            __syncthreads();
        }
        { const int x = 32 * xt + r32;
          if (team == 0) { f32x16 m = prod_ll(bBtr, bXA0, xt, yt, r32, hi, (f32x16){}); const float cx = cst[256 + x];
#pragma unroll
              for (int r = 0; r < 16; ++r) m[r] = cx * (m[r] + (WK_Y(r) == x ? 1.0f : 0.0f));
              st_tile_glb(PTg + unit * WU, xt, yt, r32, hi, m);
              f32x16 qv;
#pragma unroll
              for (int q = 0; q < 4; ++q) { const f32x4 o = ld4_lds_bf16(bR, x, 32 * yt + 8 * q + 4 * hi); qv[4 * q] = o[0]; qv[4 * q + 1] = o[1]; qv[4 * q + 2] = o[2]; qv[4 * q + 3] = o[3]; }
              qv = prod_ll(bMbr, bXA0, xt, yt, r32, hi, qv);
              st_tile_glb(QTg + unit * WU, xt, yt, r32, hi, qv); }
          else { f32x16 m = prod_ll(bBtr, bXA1, xt, yt, r32, hi, (f32x16){}); const float cx = cst[256 + x];
#pragma unroll
              for (int r = 0; r < 16; ++r) m[r] = cx * (m[r] + bf2f(*(const LAS unsigned short*)(bKt + (WK_Y(r) * WS_STR + x) * 2)));
              f32x16 hv = prod_ll(bR, bKt, xt, yt, r32, hi, (f32x16){});
#pragma unroll
              for (int r = 0; r < 16; ++r) if (!(WK_Y(r) <= x)) hv[r] = 0.f;
              hv = prod_ll(bMbr, bXA1, xt, yt, r32, hi, hv);
              st_tile_lds(bGT, xt, yt, r32, hi, m); st_tile_lds(bHT, xt, yt, r32, hi, hv); } }
        __syncthreads();
        if (team == 0) st_tile_glb(Zg + unit * WU, xt, yt, r32, hi, prod_ll(bVtr, bGT, xt, yt, r32, hi, (f32x16){}));
        else st_tile_glb(YLg + unit * WU, xt, yt, r32, hi, prod_ll(bHT, bVtr, xt, yt, r32, hi, (f32x16){}));
        __syncthreads();
    }
#undef WB
}

__device__ __forceinline__ void phase_wkv_b(const Params& p, const Ctx& c) {
    if (c.wave != 0 || c.bid >= 2 * NB * NHEAD) return;
    const int lane = c.lane, r32 = lane & 31, hi = lane >> 5, bh = c.bid >> 1, xt = c.bid & 1;
    const bf16_t* PTg = wsb(p, WS_W0); const bf16_t* Zg = wsb(p, WS_W1); bf16_t* Sg = (bf16_t*)((unsigned char*)p.out + SLOT);
    f32x16 S0 = {}, S1 = {};
    u32x2 pa[2][4][2], pn[2][4][2], z[2][4], zn[2][4];
#define WKB_LOAD(P, Zr, ch) do { const bf16_t* pt = PTg + ((size_t)bh * WK_NCH + (ch)) * WU; const bf16_t* zz = Zg + ((size_t)bh * WK_NCH + (ch)) * WU; \
        _Pragma("unroll") for (int yt = 0; yt < 2; ++yt) { _Pragma("unroll") for (int s = 0; s < 4; ++s) { P[yt][s][0] = *(const u32x2*)(pt + (32 * yt + r32) * 64 + 16 * s + 4 * hi); P[yt][s][1] = *(const u32x2*)(pt + (32 * yt + r32) * 64 + 16 * s + 8 + 4 * hi); } \
            _Pragma("unroll") for (int q = 0; q < 4; ++q) Zr[yt][q] = *(const u32x2*)(zz + (32 * xt + r32) * 64 + 32 * yt + 8 * q + 4 * hi); } } while (0)
    WKB_LOAD(pa, z, 0);
    for (int ch = 0; ch < WK_NCH; ++ch) {
        if (ch + 1 < WK_NCH) WKB_LOAD(pn, zn, ch + 1);
        bf16x8 bf[4]; bf16_t* sg = Sg + ((size_t)bh * WK_NCH + ch) * WU + (size_t)(32 * xt + r32) * 64;
#pragma unroll
        for (int s = 0; s < 4; ++s) { const f32x16& St = (s >> 1) ? S1 : S0; const int r0 = 8 * (s & 1);
            u32x4 wv; wv.x = cvtpk(St[r0], St[r0 + 1]); wv.y = cvtpk(St[r0 + 2], St[r0 + 3]); wv.z = cvtpk(St[r0 + 4], St[r0 + 5]); wv.w = cvtpk(St[r0 + 6], St[r0 + 7]);
            bf[s] = __builtin_bit_cast(bf16x8, wv);
            *(u32x2*)(sg + 16 * s + 4 * hi) = (u32x2){wv.x, wv.y}; *(u32x2*)(sg + 16 * s + 8 + 4 * hi) = (u32x2){wv.z, wv.w}; }
        f32x16 n0, n1;
#pragma unroll
        for (int q = 0; q < 4; ++q) { n0[4 * q] = bflo(z[0][q].x); n0[4 * q + 1] = bfhi(z[0][q].x); n0[4 * q + 2] = bflo(z[0][q].y); n0[4 * q + 3] = bfhi(z[0][q].y);
            n1[4 * q] = bflo(z[1][q].x); n1[4 * q + 1] = bfhi(z[1][q].x); n1[4 * q + 2] = bflo(z[1][q].y); n1[4 * q + 3] = bfhi(z[1][q].y); }
#pragma unroll
        for (int s = 0; s < 4; ++s) { const bf16x8 a0 = __builtin_bit_cast(bf16x8, (u32x4){pa[0][s][0].x, pa[0][s][0].y, pa[0][s][1].x, pa[0][s][1].y}), a1 = __builtin_bit_cast(bf16x8, (u32x4){pa[1][s][0].x, pa[1][s][0].y, pa[1][s][1].x, pa[1][s][1].y});
            n0 = __builtin_amdgcn_mfma_f32_32x32x16_bf16(a0, bf[s], n0, 0, 0, 0); n1 = __builtin_amdgcn_mfma_f32_32x32x16_bf16(a1, bf[s], n1, 0, 0, 0); }
        S0 = n0; S1 = n1;
#pragma unroll
        for (int yt = 0; yt < 2; ++yt) {
#pragma unroll
            for (int s = 0; s < 4; ++s) { pa[yt][s][0] = pn[yt][s][0]; pa[yt][s][1] = pn[yt][s][1]; }
#pragma unroll
            for (int q = 0; q < 4; ++q) z[yt][q] = zn[yt][q]; }
    }
#undef WKB_LOAD
}

__device__ __forceinline__ void phase_wkv_c(const Params& p, const Ctx& c) {
    const int lane = c.lane, r32 = lane & 31, hi = lane >> 5;
    const bf16_t* QTg = wsb(p, WS_W2); const bf16_t* YLg = (const bf16_t*)p.out; const bf16_t* Sg = (const bf16_t*)((const unsigned char*)p.out + SLOT);
    const bf16_t* Vg = wsb(p, WS_W5); const bf16_t* L1 = wsb(p, WS_W6); const bf16_t* G2T = wsb(p, WS_G2T); const float* bsg = wsf(p, WS_BSUM); bf16_t* YG = wsb(p, WS_W0);
    for (int task = c.bid * NWAVES + c.wave; task < NB * NHEAD * WK_NCH * 2; task += c.G * NWAVES) {
        const int unit = task >> 1, xt = task & 1, bh = unit / WK_NCH, chunk = unit % WK_NCH, b = bh >> 4, h = bh & 15;
        const size_t row = (size_t)b * SEQ + (size_t)chunk * 64 + 32 * xt + r32;
        const bf16_t* qt = QTg + (size_t)unit * WU; const bf16_t* sc = Sg + (size_t)unit * WU; const bf16_t* yl = YLg + (size_t)unit * WU;
        f32x16 y[2], g[2];
#pragma unroll
        for (int yt = 0; yt < 2; ++yt) {
#pragma unroll
            for (int q = 0; q < 4; ++q) { const u32x2 wv = *(const u32x2*)(yl + (size_t)(32 * xt + r32) * 64 + 32 * yt + 8 * q + 4 * hi);
                y[yt][4 * q] = bflo(wv.x); y[yt][4 * q + 1] = bfhi(wv.x); y[yt][4 * q + 2] = bflo(wv.y); y[yt][4 * q + 3] = bfhi(wv.y); }
#pragma unroll
            for (int s = 0; s < 4; ++s) y[yt] = __builtin_amdgcn_mfma_f32_32x32x16_bf16(glbfrag(sc, 64, 32 * yt + r32, s, hi), glbfrag(qt, 64, 32 * xt + r32, s, hi), y[yt], 0, 0, 0);
            g[yt] = (f32x16){};
#pragma unroll
            for (int s = 0; s < 8; ++s) g[yt] = __builtin_amdgcn_mfma_f32_32x32x16_bf16(glbfrag(G2T, 128, h * 64 + 32 * yt + r32, s, hi), glbfrag(L1 + 128, 256, (int)row, s, hi), g[yt], 0, 0, 0);
        }
        float sm = 0.f;
#pragma unroll
        for (int r = 0; r < 16; ++r) sm += y[0][r] + y[1][r];
        sm += __shfl_xor(sm, 32); const float mean = sm * (1.0f / 64.0f);
        float q2 = 0.f;
#pragma unroll
        for (int r = 0; r < 16; ++r) { const float d0 = y[0][r] - mean, d1 = y[1][r] - mean; q2 += d0 * d0 + d1 * d1; }
        q2 += __shfl_xor(q2, 32); const float rstd = rsqrtf(q2 * (1.0f / 64.0f) + GN_EPS);
        const f32x4 b4 = *(const f32x4*)(bsg + (row * NHEAD + h) * 4); const float bsum = (b4[0] + b4[1]) + (b4[2] + b4[3]);
#pragma unroll
        for (int yt = 0; yt < 2; ++yt)
#pragma unroll
            for (int q = 0; q < 4; ++q) { const int ch = h * 64 + 32 * yt + 8 * q + 4 * hi; const f32x4 lw = *(const f32x4*)(p.in[I_LNW] + ch), lb = *(const f32x4*)(p.in[I_LNB] + ch);
                const u32x2 vw = *(const u32x2*)(Vg + row * D + ch); const f32x4 vv = {bflo(vw.x), bfhi(vw.x), bflo(vw.y), bfhi(vw.y)}; f32x4 o;
#pragma unroll
                for (int i = 0; i < 4; ++i) o[i] = ((y[yt][4 * q + i] - mean) * rstd * lw[i] + lb[i] + bsum * vv[i]) * g[yt][4 * q + i];
                *(u32x2*)(YG + row * D + ch) = pack4(o); }
    }
}
#undef WK_Y
#ifndef MK_N_LAUNCHES
#define MK_N_LAUNCHES 1
#endif
constexpr int N_PHASES = 19;
constexpr int N_LAUNCHES = MK_N_LAUNCHES;

__device__ __forceinline__ void run_dense(const Ctx& c, DenseSched& S, const void* A, int lda, const void* B, int ldb, int M, int N, int K) { S.init(A, lda, B, ldb, M, N, K, c.G, c.bid); }

__global__ void __launch_bounds__(NTHREADS, 2) fwd_kernel(Params p) {
    extern __shared__ __attribute__((aligned(16))) unsigned char lds_raw[];
    Ctx c; c.lds = (LAS unsigned char*)lds_raw; c.tid = threadIdx.x; c.lane = c.tid & 63; c.wave = __builtin_amdgcn_readfirstlane(c.tid >> 6); c.G = gridDim.x; c.bid = blockIdx.x;
    volatile LAS unsigned* MISC = (volatile LAS unsigned*)(c.lds + MISC_OFF);
    if (c.tid < 64) ((LAS unsigned*)(c.lds + MISC_OFF))[c.tid] = 0u;
    __syncthreads();
    unsigned* ctl = (unsigned*)(p.ws + WS_CTL);
    XcdBarrier bar; bar.bar = ctl + CW_BAR; bar.x = 0; bar.st = nullptr;
    if (N_LAUNCHES == 1) bar = xcd_barrier_post(ctl + CW_BAR, MISC + 8);
    const int lo = p.ph_lo, hi = p.ph_hi;
#ifndef PH_MASK
#define PH_MASK 0x7ffff
#endif
#define IN(k) ((((PH_MASK) >> (k)) & 1) && lo <= (k) && (k) < hi)
#define SEAM(k) do { if (IN(k) && IN((k) + 1)) xcd_barrier(bar); } while (0)
    LAS unsigned char* ring = c.lds + RING_OFF;

    if (IN(0)) { phase_prologue(p, c); } SEAM(0);
    if (IN(1)) { phase_n0(p, c); } SEAM(1);
    if (IN(2)) {
        { DenseSched S; S.init((const bf16_t*)p.out, D, wsb(p, WS_LD), 2048, T, 256, 2048, c.G, c.bid); S.pad = 1; S.nt0 = 16; S.a1d = -(long)(D * 2); S.b1d = 1024 * 2;
          EpiLoraDown E{wsb(p, WS_W6)}; pg8::gemm_phase<EpiLoraDown, DenseSched, false>(ring, S, E, D, 2048); }
        { DenseSched S; S.init(wsb(p, WS_W0), D, wsb(p, WS_WR), D, T, D, D, c.G, c.bid); EpiBf16 E{wsb(p, WS_W3), D}; pg8::gemm_phase<EpiBf16, DenseSched, false>(ring, S, E, D, D); }
        { DenseSched S; S.init(wsb(p, WS_W1), D, wsb(p, WS_WK), D, T, D, D, c.G, c.bid); EpiBf16 E{wsb(p, WS_W4), D}; pg8::gemm_phase<EpiBf16, DenseSched, false>(ring, S, E, D, D); }
        { DenseSched S; S.init(wsb(p, WS_W2), D, wsb(p, WS_WV), D, T, D, D, c.G, c.bid); EpiBf16 E{wsb(p, WS_W5), D}; pg8::gemm_phase<EpiBf16, DenseSched, false>(ring, S, E, D, D); }
    } SEAM(2);
#ifdef WKV_SEQ
    if (IN(3)) { phase_wkv_seq(p, c); } SEAM(3); SEAM(4); SEAM(5);
#else
    if (IN(3)) { phase_wkv_a(p, c); } SEAM(3);
    if (IN(4)) { phase_wkv_b(p, c); } SEAM(4);
    if (IN(5)) { phase_wkv_c(p, c); } SEAM(5);
#endif
    if (IN(6)) {
        DenseSched S; S.init(wsb(p, WS_W0), D, wsb(p, WS_WO), D, T, D, D, c.G, c.bid); EpiResid E{p.in[I_X], p.out, wsf(p, WS_MOD) + 0 * 3072 + 2048};
        pg8::gemm_phase<EpiResid, DenseSched, false>(ring, S, E, D, D);
    } SEAM(6);
#define MOE_PHASES(layer, pb) do { \
        if (IN(pb)) { phase_router(p, c, layer); } SEAM(pb); \
        if (IN((pb) + 1)) { \
            moe_setup(p, c, layer); \
            MoeSched S{(LAS const int*)(c.lds + UDESC_OFF), (LAS const int*)(c.lds + ROWTAB_OFF), 0, (const char*)wsb(p, WS_W1), (const char*)wsb(p, WS_WGU), (const char*)wsb(p, WS_WDN)}; \
            EpiMoeUp E{wsb(p, WS_W2), (LAS const float*)(c.lds + GATETAB_OFF)}; \
            pg8::gemm_phase<EpiMoeUp, MoeSched, true>(ring, S, E, D, D); \
        } SEAM((pb) + 1); \
        if (IN((pb) + 2)) { \
            moe_setup(p, c, layer); \
            MoeSched S{(LAS const int*)(c.lds + UDESC_OFF), (LAS const int*)(c.lds + ROWTAB_OFF), 1, (const char*)wsb(p, WS_W2), (const char*)wsb(p, WS_WGU), (const char*)wsb(p, WS_WDN)}; \
            EpiMoeDown E{p.out, wsf(p, WS_MOD) + ((layer) * 2 + 1) * 3072 + 2048, (LAS const int*)(c.lds + ROWTAB_OFF)}; \
            pg8::gemm_phase<EpiMoeDown, MoeSched, false>(ring, S, E, 512, 256); \
        } SEAM((pb) + 2); } while (0)
    MOE_PHASES(0, 7);
            if (IN(10)) { phase_n2(p, c); convert_moe_weights(p, c, 1); } SEAM(10);
            if (IN(11)) {
                { DenseSched S; S.init(wsb(p, WS_W1), D, wsb(p, WS_DKV), D, T, 512, D, c.G, c.bid); EpiDown E{wsb(p, WS_W6), KVLORA, 0, wsf(p, WS_SSQKV), 4, wsb(p, WS_KR), wsf(p, WS_TAB)};
                  pg8::gemm_phase<EpiDown, DenseSched, false>(ring, S, E, D, D); }
                { DenseSched S; S.init(wsb(p, WS_W0), D, wsb(p, WS_DQ), D, T, 512, D, c.G, c.bid); EpiDown E{wsb(p, WS_W6 + 16 * MiB), QLORA, 128, wsf(p, WS_SSQQ), 8, nullptr, nullptr};
                  pg8::gemm_phase<EpiDown, DenseSched, false>(ring, S, E, D, D); }
            } SEAM(11);
            if (IN(12)) {
                { DenseSched S; S.init(wsb(p, WS_W6 + 16 * MiB), QLORA, wsb(p, WS_UQ), QLORA, T, 1536, QLORA, c.G, c.bid); EpiQ E{wsb(p, WS_W2), wsf(p, WS_SSQQ), wsf(p, WS_TAB)};
                  pg8::gemm_phase<EpiQ, DenseSched, false>(ring, S, E, QLORA, QLORA); }
                { DenseSched S; S.init(wsb(p, WS_W6), KVLORA, wsb(p, WS_UKV), KVLORA, T, 2048, KVLORA, c.G, c.bid); EpiKV E{wsb(p, WS_W4), wsb(p, WS_W5), wsf(p, WS_SSQKV)};
                  pg8::gemm_phase<EpiKV, DenseSched, false>(ring, S, E, KVLORA, KVLORA); }
            } SEAM(12);
            if (IN(13)) { phase_attention(p, c); } SEAM(13);
#if defined(PROBE_DUP) && PROBE_DUP == 13
            if (IN(13)) { phase_attention(p, c); } SEAM(13);
#endif
            if (IN(14)) {
                DenseSched S; S.init(wsb(p, WS_W0), D, wsb(p, WS_MWO), D, T, D, D, c.G, c.bid); EpiResid E{p.out, p.out, wsf(p, WS_MOD) + 2 * 3072 + 2048};
                pg8::gemm_phase<EpiResid, DenseSched, false>(ring, S, E, D, D);
            } SEAM(14);
    MOE_PHASES(1, 15);
    if (IN(18)) { phase_final(p, c); }
#undef IN
#undef SEAM
}

extern "C" void kernel_launch(void* const* d_in, const int* in_sizes, int n_in, void* d_out, int out_size, void* d_ws, size_t ws_size, hipStream_t stream) {
    static int ready = 0;
    if (ready == 0) {
        ready = 1;
        if (n_in != N_IN || out_size != T * D || ws_size < WS_END) { fprintf(stderr, "kernel_launch: unexpected shapes (n_in %d, out %d, ws %zu)\n", n_in, out_size, ws_size); ready = -1; }
        else if (hipFuncSetAttribute((const void*)fwd_kernel, hipFuncAttributeMaxDynamicSharedMemorySize, LDS_BYTES) != hipSuccess) { fprintf(stderr, "kernel_launch: hipFuncSetAttribute failed\n"); ready = -1; }
        int per_cu = 0;
        if (ready > 0 && (hipOccupancyMaxActiveBlocksPerMultiprocessor(&per_cu, (const void*)fwd_kernel, NTHREADS, LDS_BYTES) != hipSuccess || per_cu < 1)) fprintf(stderr, "kernel_launch: occupancy query reports %d\n", per_cu);
        (void)hipGetLastError();
    }
    if (ready < 0) return;
    (void)hipMemsetAsync((char*)d_ws + WS_CTL, 0, CTL_ZERO_BYTES, stream);
    Params a{};
    for (int i = 0; i < N_IN; ++i) a.in[i] = (const float*)d_in[i];
    a.out = (float*)d_out; a.ws = (unsigned char*)d_ws; a.li = 0; a.pad = 0;
    const int grid = 256;
    if (N_LAUNCHES == 1) { a.ph_lo = 0; a.ph_hi = N_PHASES; hipLaunchKernelGGL(fwd_kernel, dim3(grid), dim3(NTHREADS), LDS_BYTES, stream, a); }
    else { for (int k = 0; k < N_PHASES; ++k) { a.ph_lo = k; a.ph_hi = k + 1; a.li = k; hipLaunchKernelGGL(fwd_kernel, dim3(grid), dim3(NTHREADS), LDS_BYTES, stream, a); } }
}
```

```cpp
#include <hip/hip_runtime.h>
#include <cstdio>
#include <cstdint>

#define LAS __attribute__((address_space(3)))
#define GAS __attribute__((address_space(1)))
typedef unsigned short bf16_t;
typedef short bf16x8 __attribute__((ext_vector_type(8)));
typedef short s16x4 __attribute__((ext_vector_type(4)));
typedef float f32x2 __attribute__((ext_vector_type(2)));
typedef float f32x4 __attribute__((ext_vector_type(4)));
typedef float f32x16 __attribute__((ext_vector_type(16)));
typedef unsigned u32x2 __attribute__((ext_vector_type(2)));
typedef unsigned u32x4 __attribute__((ext_vector_type(4)));
typedef __bf16 bf16x2_t __attribute__((ext_vector_type(2)));

__device__ __forceinline__ unsigned cvtpk(float lo, float hi) { f32x2 v = {lo, hi}; bf16x2_t b = __builtin_convertvector(v, bf16x2_t); return __builtin_bit_cast(unsigned, b); }
__device__ __forceinline__ float bf2f(unsigned short b) { return __uint_as_float((unsigned)b << 16); }
__device__ __forceinline__ float bflo(unsigned w) { return __uint_as_float(w << 16); }
__device__ __forceinline__ float bfhi(unsigned w) { return __uint_as_float(w & 0xffff0000u); }
__device__ __forceinline__ float wave_sum(float v) {
#pragma unroll
    for (int o = 1; o < 64; o <<= 1) v += __shfl_xor(v, o);
    return v;
}
__device__ __forceinline__ float fexp2(float x) { return __builtin_amdgcn_exp2f(x); }
__device__ __forceinline__ float fexp(float x) { return __builtin_amdgcn_exp2f(x * 1.4426950408889634f); }
__device__ __forceinline__ float frcp(float x) { return __builtin_amdgcn_rcpf(x); }
__device__ __forceinline__ float sigmoidf_(float x) { return frcp(1.0f + fexp(-x)); }

namespace pg8 {
constexpr int BM = 256, BK = 64, HALF = 128, HTB = HALF * BK * 2  , STAGE_BYTES = 8 * HTB;
__host__ __device__ __forceinline__ int lds_byte(int r, int c) { const int st = (r >> 4) * 2 + (c >> 5), rr = r & 15, cc = c & 31, ob = rr * 64 + cc * 2; return st * 1024 + (ob ^ (((ob >> 9) & 1) << 5)); }
__host__ __device__ __forceinline__ void stage_rc(int b, int& R, int& C) { const int st = b / 1024, sb = b % 1024, swz = sb ^ (((sb >> 9) & 1) << 5); R = (st >> 1) * 16 + swz / 64; C = (st & 1) * 32 + (swz % 64) / 2; }
__host__ __device__ __forceinline__ int perm32(int rho) { const int n = rho >> 4, i = rho & 15; return 8 * (i >> 2) + 4 * n + (i & 3); }

struct Unit { int pm, pn, aux, nt, nt0; const char* A0; const char* A1; const char* B0; const char* B1; };
__device__ __forceinline__ const char* tile_ptr(const char* p0, const char* p1, int nt0, int t) { return t < nt0 ? p0 + (size_t)t * 128 : p1 + (size_t)(t - nt0) * 128; }

template <class Epi, class Sched, bool GA>
__device__ __forceinline__ void gemm_phase(LAS unsigned char* lds, const Sched& S, const Epi& E, const int lda, const int ldb) {
    const int tid = threadIdx.x, wid = __builtin_amdgcn_readfirstlane(tid >> 6), lane = tid & 63, wr = wid >> 2, wc = wid & 3, fr = lane & 15, fq = lane >> 4;
    unsigned voffB[2]; int RA[2], CA[2];
#pragma unroll
    for (int i = 0; i < 2; ++i) { int R, C; stage_rc(tid * 16 + i * 8192, R, C); const int Rb = Epi::PERM ? ((R & ~31) + perm32(R & 31)) : R;
        voffB[i] = (unsigned)(Rb * ldb + C) * 2u; RA[i] = R; CA[i] = C; }
    const size_t hstepB = (size_t)HALF * ldb * 2;
    unsigned voC[2][2], voN[2][2];
    const unsigned ldsw = (unsigned)wid * 1024u;
    const int aoff = lds_byte(wr * 64 + fr, fq * 8), boff = lds_byte(wc * 32 + fr, fq * 8);
#define PG8_SA(b, h) (((b) * 2 + (h)) * HTB)
#define PG8_SB(b, h) ((4 + (b) * 2 + (h)) * HTB)
#define PG8_STAGE_B(bufoff, gbase) do { _Pragma("unroll") for (int _i = 0; _i < 2; ++_i) \
        __builtin_amdgcn_global_load_lds((const unsigned*)((const char*)(gbase) + voffB[_i]), (LAS unsigned*)(lds + (bufoff) + ldsw + _i * 8192), 16, 0, 0); } while (0)
#define PG8_STAGE_A(bufoff, gbase, VO, hh) do { _Pragma("unroll") for (int _i = 0; _i < 2; ++_i) \
        __builtin_amdgcn_global_load_lds((const unsigned*)((const char*)(gbase) + VO[hh][_i]), (LAS unsigned*)(lds + (bufoff) + ldsw + _i * 8192), 16, 0, 0); } while (0)
#define PG8_LDA(dst, b, h) do { _Pragma("unroll") for (int m = 0; m < 4; ++m) _Pragma("unroll") for (int k = 0; k < 2; ++k) dst[m][k] = *(const LAS bf16x8*)(lds + PG8_SA(b, h) + aoff + m * 2048 + k * 1024); } while (0)
#define PG8_LDB(dst, b, h) do { _Pragma("unroll") for (int n = 0; n < 2; ++n) _Pragma("unroll") for (int k = 0; k < 2; ++k) dst[n][k] = *(const LAS bf16x8*)(lds + PG8_SB(b, h) + boff + n * 2048 + k * 1024); } while (0)
#define PG8_MMA(ai, bj, At, Bt) do { __builtin_amdgcn_s_setprio(1); _Pragma("unroll") for (int m = 0; m < 4; ++m) _Pragma("unroll") for (int n = 0; n < 2; ++n) _Pragma("unroll") for (int k = 0; k < 2; ++k) \
        acc[ai][bj][m][n] = __builtin_amdgcn_mfma_f32_16x16x32_bf16(Bt[n][k], At[m][k], acc[ai][bj][m][n], 0, 0, 0); __builtin_amdgcn_s_setprio(0); } while (0)
#define PG8_WAIT_V(n) asm volatile("s_waitcnt vmcnt(" #n ")" ::: "memory")
#define PG8_WAIT_L(n) asm volatile("s_waitcnt lgkmcnt(" #n ")" ::: "memory")
#define PG8_BAR __builtin_amdgcn_s_barrier()
#define PG8_SCHED __builtin_amdgcn_sched_barrier(0)
#define PG8_SETVO(VO, ui_) do { _Pragma("unroll") for (int _h = 0; _h < 2; ++_h) _Pragma("unroll") for (int _i = 0; _i < 2; ++_i) { \
        if constexpr (GA) VO[_h][_i] = (unsigned)(S.row((ui_), _h * HALF + RA[_i]) * lda + CA[_i]) * 2u; else VO[_h][_i] = (unsigned)((_h * HALF + RA[_i]) * lda + CA[_i]) * 2u; } } while (0)
    Unit cur, nxt; int ui = 0;
    if (!S.next(0, cur)) return;
    PG8_SETVO(voC, 0);
#pragma unroll
    for (int _h = 0; _h < 2; ++_h)
#pragma unroll
        for (int _i = 0; _i < 2; ++_i) voN[_h][_i] = 0u;
    f32x4 acc[2][2][4][2];
#pragma unroll
    for (int a = 0; a < 2; ++a)
#pragma unroll
        for (int b = 0; b < 2; ++b)
#pragma unroll
            for (int m = 0; m < 4; ++m)
#pragma unroll
                for (int n = 0; n < 2; ++n) acc[a][b][m][n] = (f32x4){0.f, 0.f, 0.f, 0.f};
    bf16x8 At[4][2], B0[2][2], B1[2][2];
    {
        const char* cA = cur.A0; const char* cB = cur.B0;
        PG8_STAGE_B(PG8_SB(0, 0), cB); PG8_STAGE_B(PG8_SB(0, 1), cB + hstepB); PG8_STAGE_A(PG8_SA(0, 0), cA, voC, 0); PG8_STAGE_A(PG8_SA(0, 1), cA, voC, 1);
        if (wr == 1) PG8_BAR;
        PG8_WAIT_V(2); PG8_BAR;
        PG8_STAGE_B(PG8_SB(1, 0), cB + 128); PG8_STAGE_A(PG8_SA(1, 0), cA + 128, voC, 0); PG8_STAGE_B(PG8_SB(1, 1), cB + hstepB + 128);
        PG8_WAIT_V(6); PG8_BAR;
    }
    for (;;) {
        const bool has_next = S.next(ui + 1, nxt);
        if (has_next) { if constexpr (GA) { PG8_SETVO(voN, ui + 1);
#pragma unroll
                for (int _h = 0; _h < 2; ++_h)
#pragma unroll
                    for (int _i = 0; _i < 2; ++_i) voN[_h][_i] -= voC[_h][_i]; } }
        else { nxt = cur;
#pragma unroll
            for (int _h = 0; _h < 2; ++_h)
#pragma unroll
                for (int _i = 0; _i < 2; ++_i) voN[_h][_i] = 0u; }
        const int nt = cur.nt;
        for (int t = 0; t < nt; t += 2) {
            const bool last = (t == nt - 2);
            const char* a1 = tile_ptr(cur.A0, cur.A1, cur.nt0, t + 1);
            const char* a2 = last ? nxt.A0 : tile_ptr(cur.A0, cur.A1, cur.nt0, t + 2);
            const char* b2 = last ? nxt.B0 : tile_ptr(cur.B0, cur.B1, cur.nt0, t + 2);
            const char* a3 = a2 + 128; const char* b3 = b2 + 128;
            unsigned vo2[2][2];
#pragma unroll
            for (int _h = 0; _h < 2; ++_h)
#pragma unroll
                for (int _i = 0; _i < 2; ++_i) vo2[_h][_i] = GA ? voC[_h][_i] + (last ? 1u : 0u) * voN[_h][_i] : voC[_h][_i];
            PG8_LDB(B0, 0, 0); PG8_LDB(B1, 0, 1); PG8_SCHED; PG8_LDA(At, 0, 0); PG8_STAGE_A(PG8_SA(1, 1), a1, voC, 1);
            PG8_WAIT_V(8); PG8_WAIT_L(0); PG8_BAR; PG8_MMA(0, 0, At, B0); PG8_MMA(0, 1, At, B1); PG8_BAR; PG8_SCHED;
            PG8_LDA(At, 0, 1); PG8_STAGE_B(PG8_SB(0, 0), b2); PG8_STAGE_B(PG8_SB(0, 1), b2 + hstepB); PG8_STAGE_A(PG8_SA(0, 0), a2, vo2, 0);
            PG8_WAIT_V(8); PG8_WAIT_L(0); PG8_BAR; PG8_MMA(1, 0, At, B0); PG8_MMA(1, 1, At, B1); PG8_BAR; PG8_SCHED;
            PG8_LDB(B0, 1, 0); PG8_LDB(B1, 1, 1); PG8_SCHED; PG8_LDA(At, 1, 0); PG8_STAGE_A(PG8_SA(0, 1), a2, vo2, 1);
            PG8_WAIT_V(8); PG8_WAIT_L(0); PG8_BAR; PG8_MMA(0, 0, At, B0); PG8_MMA(0, 1, At, B1); PG8_BAR; PG8_SCHED;
            PG8_LDA(At, 1, 1); PG8_STAGE_B(PG8_SB(1, 0), b3); PG8_STAGE_B(PG8_SB(1, 1), b3 + hstepB); PG8_STAGE_A(PG8_SA(1, 0), a3, vo2, 0);
            PG8_WAIT_V(8); PG8_WAIT_L(0); PG8_BAR; PG8_MMA(1, 0, At, B0); PG8_MMA(1, 1, At, B1); PG8_BAR; PG8_SCHED;
        }
        if (wr == 0) PG8_BAR;
        E(acc, cur, wr, wc, fr, fq);
        if (!has_next) break;
#pragma unroll
        for (int a = 0; a < 2; ++a)
#pragma unroll
            for (int b = 0; b < 2; ++b)
#pragma unroll
                for (int m = 0; m < 4; ++m)
#pragma unroll
                    for (int n = 0; n < 2; ++n) acc[a][b][m][n] = (f32x4){0.f, 0.f, 0.f, 0.f};
        cur = nxt; ++ui;
        if constexpr (GA) {
#pragma unroll
            for (int _h = 0; _h < 2; ++_h)
#pragma unroll
                for (int _i = 0; _i < 2; ++_i) voC[_h][_i] += voN[_h][_i];
        }
        if (wr == 1) PG8_BAR;
    }
    PG8_WAIT_V(0);
    PG8_BAR;
#undef PG8_SA
#undef PG8_SB
#undef PG8_STAGE_A
#undef PG8_STAGE_B
#undef PG8_LDA
#undef PG8_LDB
#undef PG8_MMA
#undef PG8_WAIT_V
#undef PG8_WAIT_L
#undef PG8_BAR
#undef PG8_SCHED
#undef PG8_SETVO
}
}
constexpr int NB = 4, SEQ = 8192, D = 1024, T = NB * SEQ;
constexpr int NHEAD = 16, HD = 64;
constexpr int QLORA = 384, KVLORA = 256, ROPE = 32, QKD = 96;
constexpr int NEXP = 16, NCLS = 24, DEXP = 256;
constexpr int MODW = 14336;
constexpr float NORM_EPS = 1e-6f, GN_EPS = 64e-5f;
constexpr float QSCALE = 0.10206207261596577f * 1.4426950408889634f;
constexpr int NWAVES = 8, NTHREADS = 512;

constexpr size_t MiB = 1u << 20;
constexpr size_t SLOT = 64 * MiB;
constexpr size_t WS_W0 = 0, WS_W1 = SLOT, WS_W2 = 2 * SLOT, WS_W3 = 3 * SLOT, WS_W4 = 4 * SLOT, WS_W5 = 5 * SLOT, WS_W6 = 6 * SLOT;
constexpr size_t WS_MISC = 7 * SLOT;
constexpr size_t WS_CTL = WS_MISC, CTL_ZERO_BYTES = 1 * MiB;
constexpr size_t WS_MOD = WS_MISC + 1 * MiB;
constexpr size_t WS_TAB = WS_MISC + 2 * MiB;
constexpr size_t WS_LIST = WS_MISC + 6 * MiB;
constexpr size_t WS_GATES = WS_MISC + 9 * MiB;
constexpr size_t WS_SSQKV = WS_MISC + 9 * MiB + 512 * 1024;
constexpr size_t WS_SSQQ = WS_MISC + 10 * MiB;
constexpr size_t WS_KR = WS_MISC + 11 * MiB;
constexpr size_t WS_WR = WS_MISC + 13 * MiB, WS_WK = WS_MISC + 15 * MiB, WS_WV = WS_MISC + 17 * MiB;
constexpr size_t WS_LD = WS_MISC + 19 * MiB;
constexpr size_t WS_WO = WS_MISC + 20 * MiB;
constexpr size_t WS_DKV = WS_MISC + 22 * MiB;
constexpr size_t WS_DQ = WS_MISC + 23 * MiB;
constexpr size_t WS_UQ = WS_MISC + 24 * MiB;
constexpr size_t WS_UKV = WS_MISC + 26 * MiB;
constexpr size_t WS_MWO = WS_MISC + 27 * MiB;
constexpr size_t WS_WGU = WS_MISC + 29 * MiB;
constexpr size_t WS_WDN = WS_MISC + 45 * MiB;
constexpr size_t WS_W2T = WS_MISC + 53 * MiB;
constexpr size_t WS_A2T = WS_MISC + 53 * MiB + 256 * 1024;
constexpr size_t WS_G2T = WS_MISC + 53 * MiB + 512 * 1024;
constexpr size_t WS_BSUM = WS_MISC + 54 * MiB;
constexpr size_t WS_END = WS_MISC + 62 * MiB;
constexpr size_t WS_WGU1 = WS_W3 + 32 * MiB, WS_WDN1 = WS_W3 + 48 * MiB;
static_assert(WS_END <= 512 * MiB, "d_ws map");
constexpr int CW_BAR = 4096;
constexpr int CW_CNT = 16384;

constexpr int RING_OFF = 0, RING_BYTES = 131072;
constexpr int TAB_OFF = 131072;
constexpr int ROWTAB_OFF = TAB_OFF, GATETAB_OFF = TAB_OFF + 4096, UDESC_OFF = TAB_OFF + 12288, CLSTAB_OFF = UDESC_OFF + 256;
constexpr int MISC_OFF = 151552;
constexpr int LDS_BYTES = 155648;

#define XB_TMO      128
#define XB_XCNT(j)  (256  + 64 * (j))
#define XB_XSUB(j)  (1280 + 64 * (j))
#define XB_XGEN(j)  (2304 + 64 * (j))
#define XB_TOP      3328
#define XB_TOPGEN   3392
#define XCD_BAR_WORDS 3456
#define XB_SPIN_CAP (1u << 18)

__device__ __forceinline__ unsigned xb_ld(unsigned* p)              { return __hip_atomic_load(p, __ATOMIC_RELAXED, __HIP_MEMORY_SCOPE_AGENT); }
__device__ __forceinline__ unsigned xb_add(unsigned* p, unsigned v) { return __hip_atomic_fetch_add(p, v, __ATOMIC_RELAXED, __HIP_MEMORY_SCOPE_AGENT); }
__device__ __forceinline__ unsigned xb_xcc_id() { return (unsigned)__builtin_amdgcn_s_getreg((3 << 11) | 20) & 0xFu; }
#define XB_SPIN(cond, bar) do { unsigned _sp = 0; while (cond) { __builtin_amdgcn_s_sleep(1); \
    if ((++_sp & 255u) == 0u) { if (xb_ld(&(bar)[XB_TMO])) break; if (_sp > XB_SPIN_CAP) { atomicAdd(&(bar)[XB_TMO], 1u); break; } } } } while (0)

struct XcdBarrier { unsigned* bar; unsigned x; volatile LAS unsigned* st; };

__device__ __forceinline__ XcdBarrier xcd_barrier_post(unsigned* bar, volatile LAS unsigned* st) {
    XcdBarrier b; b.bar = bar; b.x = xb_xcc_id(); b.st = st;
    if (threadIdx.x == 0) (void)xb_add(&bar[XB_XCNT(b.x)], 1u);
    return b;
}
__device__ __forceinline__ void xcd_barrier_complete(unsigned* bar, unsigned x, unsigned& nloc, unsigned& nx) {
    const unsigned G = gridDim.x * gridDim.y * gridDim.z;
    unsigned sum, cnt, mine, sp = 0u;
    for (;;) {
        sum = 0u; cnt = 0u; mine = 0u;
#pragma unroll
        for (unsigned j = 0; j < 16; ++j) { const unsigned c = xb_ld(&bar[XB_XCNT(j)]); sum += c; cnt += (c > 0u) ? 1u : 0u; mine = (j == x) ? c : mine; }
        if (sum == G) break;
        __builtin_amdgcn_s_sleep(1);
        if ((++sp & 255u) == 0u) { if (xb_ld(&bar[XB_TMO])) break; if (sp > XB_SPIN_CAP) { atomicAdd(&bar[XB_TMO], 1u); break; } }
    }
    nloc = mine > 0u ? mine : 1u; nx = cnt > 0u ? cnt : 1u;
}
__device__ __forceinline__ void xcd_barrier(const XcdBarrier& b) {
    asm volatile("s_waitcnt vmcnt(0)" ::: "memory");
    __syncthreads();
    if (threadIdx.x == 0) {
        unsigned* bar = b.bar;
        __builtin_amdgcn_s_waitcnt(0);
        unsigned nloc = b.st[0], nx = b.st[1];
        if (nloc == 0u) { xcd_barrier_complete(bar, b.x, nloc, nx); b.st[0] = nloc; b.st[1] = nx; }
        const unsigned old = xb_add(&bar[XB_XSUB(b.x)], 1u);
        const unsigned gen = old / nloc;
        if (old + 1u == (gen + 1u) * nloc) {
            __builtin_amdgcn_fence(__ATOMIC_RELEASE, "agent");
            asm volatile("s_waitcnt vmcnt(0)" ::: "memory");
            const unsigned og = xb_add(&bar[XB_TOP], 1u);
            const unsigned tg = og / nx;
            if (og + 1u == (tg + 1u) * nx) xb_add(&bar[XB_TOPGEN], 1u);
            else XB_SPIN(xb_ld(&bar[XB_TOPGEN]) == tg, bar);
            __builtin_amdgcn_fence(__ATOMIC_ACQUIRE, "agent");
            xb_add(&bar[XB_XGEN(b.x)], 1u);
            asm volatile("s_waitcnt vmcnt(0)" ::: "memory");
        } else {
            XB_SPIN(xb_ld(&bar[XB_XGEN(b.x)]) == gen, bar);
            __builtin_amdgcn_fence(__ATOMIC_ACQUIRE, "agent");
            asm volatile("s_waitcnt vmcnt(0)" ::: "memory");
        }
    }
    __syncthreads();
}

enum { I_X = 0, I_C, I_POS, I_ADAW, I_ADAB, I_NORMG, I_MU, I_WRKV, I_W0, I_W1, I_W2, I_A0, I_A1, I_A2, I_G1, I_G2, I_KK, I_KA, I_RK, I_LNW, I_LNB, I_RWO,
       I_KVADAW, I_KVADAB, I_KVNG, I_WDKV, I_GKV, I_WUK, I_WUV, I_WKR, I_WDQ, I_GQ, I_WUQ, I_WQR, I_MWO, I_RTW, I_RTB, I_WGU, I_WDOWN, I_FG, N_IN };
struct Params { const float* in[N_IN]; float* out; unsigned char* ws; int ph_lo, ph_hi, li, pad; };

struct Ctx {
    LAS unsigned char* lds;
    int tid, lane, wave, G, bid;
};
__device__ __forceinline__ bf16_t* wsb(const Params& p, size_t off) { return (bf16_t*)(p.ws + off); }
__device__ __forceinline__ float* wsf(const Params& p, size_t off) { return (float*)(p.ws + off); }
struct DenseSched {
    int nM, nN, nwg, G, c, nt, nt0, lda, pad, rep; const char* A; const char* B; size_t btile; long a1d, b1d;
    __device__ __forceinline__ void init(const void* A_, int lda_, const void* B_, int ldb_, int M, int N, int K, int G_, int c_) {
        nM = M / 256; nN = N / 256; nwg = nM * nN; G = G_; c = c_; nt = K / 64; nt0 = nt; lda = lda_; pad = 0; rep = 1; A = (const char*)A_; B = (const char*)B_;
        btile = (size_t)256 * ldb_ * 2; a1d = 0; b1d = 0; }
    __device__ __forceinline__ bool next(int i, pg8::Unit& u) const {
        const long L0 = (long)i * G + c; if (L0 >= (long)nwg * rep) return false; const long L = L0 >= nwg ? L0 - nwg : L0;
        int wgid = (int)L; { const int q = nwg / 8, r = nwg % 8, xcd = wgid % 8, off = wgid / 8; wgid = (xcd < r ? xcd * (q + 1) : r * (q + 1) + (xcd - r) * q) + off; }
        const int nig = 8 * nN, gid = wgid / nig, fm = gid * 8, gsz = (nM - fm) < 8 ? (nM - fm) : 8;
        u.pm = fm + ((wgid % nig) % gsz); u.pn = (wgid % nig) / gsz; u.aux = 0; u.nt = nt; u.nt0 = nt0;
        const size_t arow = pad ? (size_t)((u.pm >> 5) * (SEQ + 1) + 1 + 256 * (u.pm & 31)) : (size_t)u.pm * 256;
        u.A0 = A + arow * (size_t)lda * 2; u.A1 = u.A0 + a1d; u.B0 = B + (size_t)u.pn * btile; u.B1 = u.B0 + b1d; return true;
    }
    __device__ __forceinline__ int row(int, int) const { return 0; }
};

struct MoeSched {
    LAS const int* ud; LAS const int* rowtab; int down; const char* A; const char* Wgu; const char* Wdn;
    __device__ __forceinline__ bool next(int i, pg8::Unit& u) const {
        if (i >= 4) return false;
        const int valid = __builtin_amdgcn_readfirstlane(ud[i * 16 + 0]); if (!valid) return false;
        const int st = __builtin_amdgcn_readfirstlane(ud[i * 16 + 1]), pn = __builtin_amdgcn_readfirstlane(ud[i * 16 + 2]);
        const int elo = __builtin_amdgcn_readfirstlane(ud[i * 16 + 3]), ehi = __builtin_amdgcn_readfirstlane(ud[i * 16 + 4]);
        u.pm = st; u.pn = pn; u.aux = i;
        if (!down) { u.nt = 16; u.nt0 = 16; u.A0 = A; u.A1 = A; const int e = (pn >> 1) ? ehi : elo;
            u.B0 = Wgu + ((size_t)e * 512 + (size_t)(pn & 1) * 256) * 1024 * 2; u.B1 = u.B0; }
        else { u.nt = 8; u.nt0 = 4; u.A0 = A + (size_t)st * 256 * 512 * 2; u.A1 = u.A0 + 4 * 128;
            u.B0 = Wdn + ((size_t)elo * 1024 + (size_t)pn * 256) * 256 * 2; u.B1 = Wdn + ((size_t)ehi * 1024 + (size_t)pn * 256) * 256 * 2; }
        return true;
    }
    __device__ __forceinline__ int row(int i, int r) const { const int t = rowtab[i * 256 + r]; return t < 0 ? 0 : t; }
};

typedef f32x4 AccT[2][2][4][2];
#define EPI_ARGS const AccT& acc, const pg8::Unit& u, int wr, int wc, int fr, int fq
__device__ __forceinline__ u32x4 pack8(f32x4 a, f32x4 b) { u32x4 w; w.x = cvtpk(a[0], a[1]); w.y = cvtpk(a[2], a[3]); w.z = cvtpk(b[0], b[1]); w.w = cvtpk(b[2], b[3]); return w; }
__device__ __forceinline__ u32x2 pack4(f32x4 a) { u32x2 w; w.x = cvtpk(a[0], a[1]); w.y = cvtpk(a[2], a[3]); return w; }

struct EpiBf16 {
    static constexpr bool PERM = true; bf16_t* O; int ldc;
    __device__ __forceinline__ void operator()(EPI_ARGS) const {
        const int row0 = u.pm * 256 + wr * 64 + fr, col0 = u.pn * 256 + wc * 32 + 8 * fq;
#pragma unroll
        for (int ai = 0; ai < 2; ++ai)
#pragma unroll
            for (int m = 0; m < 4; ++m) { bf16_t* rowp = O + (size_t)(row0 + ai * 128 + m * 16) * ldc + col0;
#pragma unroll
                for (int bj = 0; bj < 2; ++bj) *(u32x4*)(rowp + bj * 128) = pack8(acc[ai][bj][m][0], acc[ai][bj][m][1]); }
    }
};
struct EpiLoraDown {
    static constexpr bool PERM = true; bf16_t* O;
    __device__ __forceinline__ void operator()(EPI_ARGS) const {
        const int row0 = u.pm * 256 + wr * 64 + fr, col0 = wc * 32 + 8 * fq;
#pragma unroll
        for (int ai = 0; ai < 2; ++ai)
#pragma unroll
            for (int m = 0; m < 4; ++m) { bf16_t* rowp = O + (size_t)(row0 + ai * 128 + m * 16) * 256 + col0;
#pragma unroll
                for (int bj = 0; bj < 2; ++bj) { f32x4 v0 = acc[ai][bj][m][0], v1 = acc[ai][bj][m][1];
                    if (bj == 1) {
#pragma unroll
                        for (int i = 0; i < 4; ++i) { v0[i] = sigmoidf_(v0[i]); v1[i] = sigmoidf_(v1[i]); } }
                    else if (wc < 2) {
#pragma unroll
                        for (int i = 0; i < 4; ++i) { v0[i] = 1.0f - 2.0f * frcp(1.0f + fexp(2.0f * v0[i])); v1[i] = 1.0f - 2.0f * frcp(1.0f + fexp(2.0f * v1[i])); } }
                    *(u32x4*)(rowp + bj * 128) = pack8(v0, v1); } }
    }
};
struct EpiResid {
    static constexpr bool PERM = false; const float* xin; float* xout; const float* gate;
    __device__ __forceinline__ void operator()(EPI_ARGS) const {
        const int row0 = u.pm * 256 + wr * 64 + fr, col0 = u.pn * 256 + wc * 32 + 4 * fq; const int b = u.pm >> 5;
        f32x4 gv[2][2];
#pragma unroll
        for (int bj = 0; bj < 2; ++bj)
#pragma unroll
            for (int n = 0; n < 2; ++n) gv[bj][n] = *(const f32x4*)(gate + (size_t)b * MODW + col0 + bj * 128 + n * 16);
#pragma unroll
        for (int ai = 0; ai < 2; ++ai)
#pragma unroll
            for (int m = 0; m < 4; ++m) { const size_t off = (size_t)(row0 + ai * 128 + m * 16) * D + col0;
#pragma unroll
                for (int bj = 0; bj < 2; ++bj)
#pragma unroll
                    for (int n = 0; n < 2; ++n) { const f32x4 xv = *(const f32x4*)(xin + off + bj * 128 + n * 16);
                        *(f32x4*)(xout + off + bj * 128 + n * 16) = xv + gv[bj][n] * acc[ai][bj][m][n]; } }
    }
};
struct EpiMoeUp {
    static constexpr bool PERM = true; bf16_t* act; LAS const float* gatetab;
    __device__ __forceinline__ void operator()(EPI_ARGS) const {
        const int eidx = u.pn >> 1, half = u.pn & 1; const int rl0 = wr * 64 + fr, col0 = eidx * 256 + half * 128 + wc * 32 + 8 * fq;
#pragma unroll
        for (int ai = 0; ai < 2; ++ai)
#pragma unroll
            for (int m = 0; m < 4; ++m) { const int rl = rl0 + ai * 128 + m * 16; const float cb = gatetab[(u.aux * 256 + rl) * 2 + eidx];
                f32x4 o[2];
#pragma unroll
                for (int n = 0; n < 2; ++n)
#pragma unroll
                    for (int i = 0; i < 4; ++i) { const float g = acc[ai][0][m][n][i], up = acc[ai][1][m][n][i]; o[n][i] = g * sigmoidf_(g) * up * cb; }
                *(u32x4*)(act + (size_t)(u.pm * 256 + rl) * 512 + col0) = pack8(o[0], o[1]); }
    }
};
struct EpiMoeDown {
    static constexpr bool PERM = false; float* X; const float* gate; LAS const int* rowtab;
    __device__ __forceinline__ void operator()(EPI_ARGS) const {
        const int rl0 = wr * 64 + fr, col0 = u.pn * 256 + wc * 32 + 4 * fq;
#pragma unroll
        for (int ai = 0; ai < 2; ++ai)
#pragma unroll
            for (int m = 0; m < 4; ++m) { const int rl = rl0 + ai * 128 + m * 16; const int tok = rowtab[u.aux * 256 + rl];
                if (tok >= 0) { const float* gp = gate + (size_t)(tok >> 13) * MODW + col0; float* xp = X + (size_t)tok * D + col0;
#pragma unroll
                    for (int bj = 0; bj < 2; ++bj)
#pragma unroll
                        for (int n = 0; n < 2; ++n) { const f32x4 gv = *(const f32x4*)(gp + bj * 128 + n * 16); const f32x4 xv = *(const f32x4*)(xp + bj * 128 + n * 16);
                            *(f32x4*)(xp + bj * 128 + n * 16) = xv + gv * acc[ai][bj][m][n]; } } }
    }
};
struct EpiDown {
    static constexpr bool PERM = false; bf16_t* O; int ldc; int ncols1; float* ssq; int ssq_ld; bf16_t* Kr; const float* tab;
    __device__ __forceinline__ void operator()(EPI_ARGS) const {
        const int row0 = u.pm * 256 + wr * 64 + fr;
#pragma unroll
        for (int ai = 0; ai < 2; ++ai)
#pragma unroll
            for (int m = 0; m < 4; ++m) { const int row = row0 + ai * 128 + m * 16;
                if (u.pn == 0 || ncols1 > 0) { float ss = 0.f;
#pragma unroll
                    for (int bj = 0; bj < 2; ++bj) { if (u.pn == 0 || bj * 128 < ncols1) {
#pragma unroll
                        for (int n = 0; n < 2; ++n) { const f32x4 v = acc[ai][bj][m][n]; ss += (v[0] * v[0] + v[1] * v[1]) + (v[2] * v[2] + v[3] * v[3]);
                            *(u32x2*)(O + (size_t)row * ldc + u.pn * 256 + bj * 128 + wc * 32 + n * 16 + 4 * fq) = pack4(v); } } }
                    ss += __shfl_xor(ss, 16); ss += __shfl_xor(ss, 32);
                    if (fq == 0) ssq[(size_t)row * ssq_ld + u.pn * 4 + wc] = ss; }
                if (Kr != nullptr && u.pn == 1 && wc == 0) { const f32x4 x1 = acc[ai][0][m][0], x2 = acc[ai][0][m][1];
                    const f32x4 c4 = *(const f32x4*)(tab + (size_t)row * 32 + 4 * fq), s4 = *(const f32x4*)(tab + (size_t)row * 32 + 16 + 4 * fq);
                    *(u32x2*)(Kr + (size_t)row * 32 + 4 * fq) = pack4(x1 * c4 - x2 * s4); *(u32x2*)(Kr + (size_t)row * 32 + 16 + 4 * fq) = pack4(x2 * c4 + x1 * s4); } }
    }
};
struct EpiQ {
    static constexpr bool PERM = false; bf16_t* Q; const float* ssq; const float* tab;
    __device__ __forceinline__ void operator()(EPI_ARGS) const {
        const int row0 = u.pm * 256 + wr * 64 + fr;
#pragma unroll
        for (int ai = 0; ai < 2; ++ai)
#pragma unroll
            for (int m = 0; m < 4; ++m) { const int row = row0 + ai * 128 + m * 16;
                const f32x4 sa = *(const f32x4*)(ssq + (size_t)row * 8), sb = *(const f32x4*)(ssq + (size_t)row * 8 + 4);
                const float sc = rsqrtf(((sa[0] + sa[1]) + (sa[2] + sa[3]) + (sb[0] + sb[1]) + (sb[2] + sb[3])) * (1.0f / QLORA) + NORM_EPS) * QSCALE;
                bf16_t* qrow = Q + (size_t)row * (NHEAD * QKD);
                if (u.pn < 4) {
#pragma unroll
                    for (int bj = 0; bj < 2; ++bj)
#pragma unroll
                        for (int n = 0; n < 2; ++n) { const int col = u.pn * 256 + bj * 128 + wc * 32 + n * 16 + 4 * fq;
                            *(u32x2*)(qrow + (col >> 6) * QKD + (col & 63)) = pack4(acc[ai][bj][m][n] * sc); }
                } else { const f32x4 c4 = *(const f32x4*)(tab + (size_t)row * 32 + 4 * fq), s4 = *(const f32x4*)(tab + (size_t)row * 32 + 16 + 4 * fq);
#pragma unroll
                    for (int bj = 0; bj < 2; ++bj) { const int h = (u.pn - 4) * 8 + bj * 4 + wc; const f32x4 x1 = acc[ai][bj][m][0] * sc, x2 = acc[ai][bj][m][1] * sc;
                        *(u32x2*)(qrow + h * QKD + 64 + 4 * fq) = pack4(x1 * c4 - x2 * s4); *(u32x2*)(qrow + h * QKD + 80 + 4 * fq) = pack4(x2 * c4 + x1 * s4); } } }
    }
};
struct EpiKV {
    static constexpr bool PERM = true; bf16_t* Kn; bf16_t* V; const float* ssq;
    __device__ __forceinline__ void operator()(EPI_ARGS) const {
        const int row0 = u.pm * 256 + wr * 64 + fr; bf16_t* base = (u.pn < 4) ? Kn : V; const int col0 = (u.pn & 3) * 256 + wc * 32 + 8 * fq;
#pragma unroll
        for (int ai = 0; ai < 2; ++ai)
#pragma unroll
            for (int m = 0; m < 4; ++m) { const int row = row0 + ai * 128 + m * 16; const f32x4 sa = *(const f32x4*)(ssq + (size_t)row * 4);
                const float sc = rsqrtf(((sa[0] + sa[1]) + (sa[2] + sa[3])) * (1.0f / KVLORA) + NORM_EPS);
#pragma unroll
                for (int bj = 0; bj < 2; ++bj) *(u32x4*)(base + (size_t)row * D + col0 + bj * 128) = pack8(acc[ai][bj][m][0] * sc, acc[ai][bj][m][1] * sc); }
    }
};
__device__ __forceinline__ float srcval(const Params& p, int kind, int e, int k, int n) {
    switch (kind) {
    case 0: case 1: case 2: return p.in[I_WRKV][((size_t)kind * D + k) * D + n];
    case 3: { const int kk = k & 1023, hi = k >> 10; float w, mu;
        if (n < 64) { w = p.in[I_W1][kk * 64 + n]; mu = p.in[I_MU][1 * D + kk]; }
        else if (n < 128) { w = p.in[I_A1][kk * 64 + n - 64]; mu = p.in[I_MU][4 * D + kk]; }
        else { w = p.in[I_G1][kk * 128 + n - 128]; mu = p.in[I_MU][5 * D + kk]; }
        return w * (hi ? mu : 1.0f - mu); }
    case 4: return p.in[I_RWO][(size_t)k * D + n];
    case 5: return n < 256 ? p.in[I_WDKV][k * 256 + n] : (n < 288 ? p.in[I_WKR][k * 32 + n - 256] : 0.f);
    case 6: return n < 384 ? p.in[I_WDQ][k * 384 + n] : 0.f;
    case 7: return p.in[I_GQ][k] * (n < 1024 ? p.in[I_WUQ][(size_t)k * 1024 + n] : p.in[I_WQR][(size_t)k * 512 + n - 1024]);
    case 8: return p.in[I_GKV][k] * (n < 1024 ? p.in[I_WUK][(size_t)k * 1024 + n] : p.in[I_WUV][(size_t)k * 1024 + n - 1024]);
    case 9: return p.in[I_MWO][(size_t)k * D + n];
    case 10: { const int pp = n >> 8, w = n & 255; const int col = (w < 128) ? (128 * pp + w) : (256 + 128 * pp + (w - 128));
        return p.in[I_WGU][((size_t)e * D + k) * 512 + col]; }
    case 11: return p.in[I_WDOWN][((size_t)e * 256 + k) * D + n];
    case 12: return p.in[I_W2][(size_t)k * D + n];
    case 13: return p.in[I_A2][(size_t)k * D + n];
    default: return p.in[I_G2][(size_t)k * D + n];
    }
}
__device__ __forceinline__ void transpose_item(const Params& p, int kind, int e, bf16_t* dst, int ldd, LAS float* scr, int kb, int nb, int lane) {
    const int k0 = 64 * kb, n0 = 32 * nb;
#pragma unroll 4
    for (int i = 0; i < 32; ++i) { const int kk = 2 * i + (lane >> 5); scr[kk * 33 + (lane & 31)] = srcval(p, kind, e, k0 + kk, n0 + (lane & 31)); }
    asm volatile("s_waitcnt lgkmcnt(0)" ::: "memory");
    const int c = lane & 7;
#pragma unroll
    for (int j = 0; j < 4; ++j) { const int n = (lane >> 3) + 8 * j; const LAS float* s = scr + (8 * c) * 33 + n;
        u32x4 o; o.x = cvtpk(s[0 * 33], s[1 * 33]); o.y = cvtpk(s[2 * 33], s[3 * 33]); o.z = cvtpk(s[4 * 33], s[5 * 33]); o.w = cvtpk(s[6 * 33], s[7 * 33]);
        *(u32x4*)(dst + (size_t)(n0 + n) * ldd + k0 + 8 * c) = o; }
    asm volatile("s_waitcnt lgkmcnt(0)" ::: "memory");
}
__device__ __forceinline__ bool tjob(const Params& p, int& r, int kind, int e, size_t ws_off, int Kd, int Nd, LAS float* scr, int lane) {
    const int nkb = Kd / 64, nnb = Nd / 32, cnt = nkb * nnb;
    if (r < cnt) { transpose_item(p, kind, e, wsb(p, ws_off), Kd, scr, r / nnb, r % nnb, lane); return true; }
    r -= cnt; return false;
}
__device__ __forceinline__ void convert_moe_weights(const Params& p, const Ctx& c, int layer) {
    LAS float* scr = (LAS float*)(c.lds + RING_OFF + c.wave * 16384);
    const int gw = c.bid * NWAVES + c.wave, NGW = c.G * NWAVES;
    for (int it = gw; it < 16 * 384; it += NGW) { const int e = it / 384; int r = it % 384;
        if (r < 256) transpose_item(p, 10, layer * 16 + e, wsb(p, WS_WGU) + (size_t)e * 512 * 1024, 1024, scr, r / 16, r % 16, c.lane);
        else { r -= 256; transpose_item(p, 11, layer * 16 + e, wsb(p, WS_WDN) + (size_t)e * 1024 * 256, 256, scr, r / 32, r % 32, c.lane); } }
}
__device__ __forceinline__ void phase_prologue(const Params& p, const Ctx& c) {
    LAS float* sc = (LAS float*)(c.lds);
    LAS float* part = (LAS float*)(c.lds + 16384);
    for (int i = c.tid; i < NB * D; i += NTHREADS) { const float v = p.in[I_C][i]; sc[i] = v / (1.0f + __expf(-v)); }
    __syncthreads();
    const int prep = (p.pad == 100) ? 2 : 1;
    for (int it0 = c.bid; it0 < (MODW / 64) * prep; it0 += c.G) { const int it = it0 % (MODW / 64);
        const int col0 = it * 64, set = col0 < 12288 ? col0 / 3072 : 4, cin = col0 - (set < 4 ? set * 3072 : 12288);
        const float* W = set < 4 ? p.in[I_ADAW] + (size_t)set * D * 3072 : p.in[I_KVADAW]; const int ldw = set < 4 ? 3072 : 2048;
        const float* bias = set < 4 ? p.in[I_ADAB] + set * 3072 : p.in[I_KVADAB];
        float a0 = 0.f, a1 = 0.f, a2 = 0.f, a3 = 0.f;
#pragma unroll 8
        for (int kk = 0; kk < 128; ++kk) { const int k = c.wave * 128 + kk; const float w = W[(size_t)k * ldw + cin + c.lane];
            a0 += sc[k] * w; a1 += sc[D + k] * w; a2 += sc[2 * D + k] * w; a3 += sc[3 * D + k] * w; }
        part[(c.wave * 4 + 0) * 64 + c.lane] = a0; part[(c.wave * 4 + 1) * 64 + c.lane] = a1; part[(c.wave * 4 + 2) * 64 + c.lane] = a2; part[(c.wave * 4 + 3) * 64 + c.lane] = a3;
        __syncthreads();
        if (c.tid < 256) { const int b = c.tid >> 6, l = c.tid & 63; float s = bias[cin + l];
#pragma unroll
            for (int w = 0; w < 8; ++w) s += part[(w * 4 + b) * 64 + l];
            wsf(p, WS_MOD)[(size_t)b * MODW + col0 + l] = s; }
        __syncthreads();
    }
    __syncthreads();
    LAS float* scr = (LAS float*)(c.lds + RING_OFF + c.wave * 16384);
    const int gw = c.bid * NWAVES + c.wave, NGW = c.G * NWAVES;
    constexpr int NITEMS = 3 * 512 + 256 + 512 + 32 + 32 + 64;
    for (int it = gw; it < NITEMS * prep; it += NGW) { int r = it % NITEMS;
        if (tjob(p, r, 0, 0, WS_WR, 1024, 1024, scr, c.lane)) continue;
        if (tjob(p, r, 1, 0, WS_WK, 1024, 1024, scr, c.lane)) continue;
        if (tjob(p, r, 2, 0, WS_WV, 1024, 1024, scr, c.lane)) continue;
        if (tjob(p, r, 3, 0, WS_LD, 2048, 256, scr, c.lane)) continue;
        if (tjob(p, r, 4, 0, WS_WO, 1024, 1024, scr, c.lane)) continue;
        if (tjob(p, r, 12, 0, WS_W2T, 64, 1024, scr, c.lane)) continue;
        if (tjob(p, r, 13, 0, WS_A2T, 64, 1024, scr, c.lane)) continue;
        tjob(p, r, 14, 0, WS_G2T, 128, 1024, scr, c.lane);
    }
    for (int q = 0; q < prep; ++q) convert_moe_weights(p, c, 0);
    const int* pos = (const int*)p.in[I_POS]; float* tab = wsf(p, WS_TAB);
    for (int i0 = c.bid * NTHREADS + c.tid; i0 < T * 16 * prep; i0 += c.G * NTHREADS) { const int i = i0 % (T * 16); const int t = i >> 4, f = i & 15;
        const float inv = powf(10000.0f, -(float)(2 * f) / 32.0f); float s, co; sincosf((float)pos[t] * inv, &s, &co);
        tab[(size_t)t * 32 + f] = co; tab[(size_t)t * 32 + 16 + f] = s; }
}

__device__ __forceinline__ void load_row(const float* rowp, int lane, f32x4 (&v)[4]) {
#pragma unroll
    for (int j = 0; j < 4; ++j) v[j] = *(const f32x4*)(rowp + 4 * lane + 256 * j);
}
__device__ __forceinline__ float row_rstd(const f32x4 (&v)[4]) {
    float s = 0.f;
#pragma unroll
    for (int j = 0; j < 4; ++j) s += (v[j][0] * v[j][0] + v[j][1] * v[j][1]) + (v[j][2] * v[j][2] + v[j][3] * v[j][3]);
    return rsqrtf(wave_sum(s) * (1.0f / D) + NORM_EPS);
}
__device__ __forceinline__ void store_row_bf16(bf16_t* rowp, int lane, const f32x4 (&v)[4]) {
#pragma unroll
    for (int j = 0; j < 4; ++j) *(u32x2*)(rowp + 4 * lane + 256 * j) = pack4(v[j]);
}
__device__ __forceinline__ void load_mod(const Params& p, const float* g, int set, int b, int lane, f32x4 (&P)[4], f32x4 (&SH)[4]) {
    const float* m = wsf(p, WS_MOD) + (size_t)b * MODW + (set < 4 ? set * 3072 : 12288);
#pragma unroll
    for (int j = 0; j < 4; ++j) { const int o = 4 * lane + 256 * j; const f32x4 gg = *(const f32x4*)(g + o), sc = *(const f32x4*)(m + 1024 + o); SH[j] = *(const f32x4*)(m + o); P[j] = gg * (sc + 1.0f); }
}

__device__ __forceinline__ void phase_n0(const Params& p, const Ctx& c) {
    const int row0 = (c.bid * NWAVES + c.wave) * 16;
    if (row0 >= T) return;
    const int b = row0 >> 13, t0 = row0 & (SEQ - 1);
    f32x4 P[4], SH[4], mr[4], mk[4], mv[4];
    load_mod(p, p.in[I_NORMG] + 0 * D, 0, b, c.lane, P, SH);
#pragma unroll
    for (int j = 0; j < 4; ++j) { const int o = 4 * c.lane + 256 * j; mr[j] = *(const f32x4*)(p.in[I_MU] + 0 * D + o); mk[j] = *(const f32x4*)(p.in[I_MU] + 2 * D + o); mv[j] = *(const f32x4*)(p.in[I_MU] + 3 * D + o); }
    bf16_t* hpad = (bf16_t*)p.out; bf16_t* xr = wsb(p, WS_W0); bf16_t* xk = wsb(p, WS_W1); bf16_t* xv = wsb(p, WS_W2);
    f32x4 hp[4];
    if (t0 == 0) {
#pragma unroll
        for (int j = 0; j < 4; ++j) hp[j] = (f32x4){0.f, 0.f, 0.f, 0.f};
        store_row_bf16(hpad + (size_t)b * (SEQ + 1) * D, c.lane, hp);
    } else { f32x4 v[4]; load_row(p.in[I_X] + (size_t)(row0 - 1) * D, c.lane, v); const float rs = row_rstd(v);
#pragma unroll
        for (int j = 0; j < 4; ++j) hp[j] = v[j] * rs * P[j] + SH[j]; }
    for (int rr = 0, nr = (p.pad == 101) ? 32 : 16; rr < nr; ++rr) { const int r = rr & 15; const int row = row0 + r; f32x4 v[4], o[4]; load_row(p.in[I_X] + (size_t)row * D, c.lane, v); const float rs = row_rstd(v);
#pragma unroll
        for (int j = 0; j < 4; ++j) v[j] = v[j] * rs * P[j] + SH[j];
        store_row_bf16(hpad + ((size_t)b * (SEQ + 1) + 1 + t0 + r) * D, c.lane, v);
#pragma unroll
        for (int j = 0; j < 4; ++j) o[j] = v[j] + (hp[j] - v[j]) * mr[j];
        store_row_bf16(xr + (size_t)row * D, c.lane, o);
#pragma unroll
        for (int j = 0; j < 4; ++j) o[j] = v[j] + (hp[j] - v[j]) * mk[j];
        store_row_bf16(xk + (size_t)row * D, c.lane, o);
#pragma unroll
        for (int j = 0; j < 4; ++j) o[j] = v[j] + (hp[j] - v[j]) * mv[j];
        store_row_bf16(xv + (size_t)row * D, c.lane, o);
#pragma unroll
        for (int j = 0; j < 4; ++j) hp[j] = v[j]; }
}

__device__ __forceinline__ void phase_router(const Params& p, const Ctx& c, int layer) {
    LAS float* rwt = (LAS float*)(c.lds);
    LAS int* rcls = (LAS int*)(c.lds + 65536);
    LAS float* rgate = (LAS float*)(c.lds + 65536 + 512);
    LAS int* rpos = (LAS int*)(c.lds + 65536 + 2048);
    LAS int* hist = (LAS int*)(c.lds + 65536 + 4096);
    for (int i = c.tid; i < D * NEXP; i += NTHREADS) { const int k = i >> 4, e = i & 15; rwt[e * D + k] = p.in[I_RTW][i]; }
    if (c.tid < 64) hist[c.tid] = 0;
    __syncthreads();
    const int set = layer * 2 + 1; const int rowb = c.bid * 128; const int b = rowb >> 13;
    f32x4 P[4], SH[4]; load_mod(p, p.in[I_NORMG] + (size_t)set * D, set, b, c.lane, P, SH);
    float rb[16];
#pragma unroll
    for (int e = 0; e < 16; ++e) rb[e] = p.in[I_RTB][e];
    const float* X = p.out; bf16_t* h2 = wsb(p, WS_W1);
    for (int r = 0; r < 16; ++r) { const int rl = c.wave * 16 + r, row = rowb + rl; f32x4 v[4]; load_row(X + (size_t)row * D, c.lane, v); const float rs = row_rstd(v);
#pragma unroll
        for (int j = 0; j < 4; ++j) v[j] = v[j] * rs * P[j] + SH[j];
        store_row_bf16(h2 + (size_t)row * D, c.lane, v);
        float sel[16], aff[16];
#pragma unroll
        for (int e = 0; e < 16; ++e) { float s = 0.f;
#pragma unroll
            for (int j = 0; j < 4; ++j) { const f32x4 w = *(const LAS f32x4*)(rwt + e * D + 4 * c.lane + 256 * j); s += (v[j][0] * w[0] + v[j][1] * w[1]) + (v[j][2] * w[2] + v[j][3] * w[3]); }
            s = wave_sum(s); aff[e] = 1.0f / (1.0f + __expf(-s)); sel[e] = aff[e] + rb[e]; }
        int bg = 0; float bs = -INFINITY;
#pragma unroll
        for (int g = 0; g < 4; ++g) { const float a0 = sel[4 * g], a1 = sel[4 * g + 1], a2 = sel[4 * g + 2], a3 = sel[4 * g + 3];
            const float m01 = fmaxf(a0, a1), n01 = fminf(a0, a1), m23 = fmaxf(a2, a3), n23 = fminf(a2, a3);
            const float top = fmaxf(m01, m23), second = fmaxf(fminf(m01, m23), (m01 >= m23) ? n01 : n23); const float gs = top + second;
            if (gs > bs) { bs = gs; bg = g; } }
        float s4[4], a4[4];
#pragma unroll
        for (int g = 0; g < 4; ++g) if (g == bg) {
#pragma unroll
            for (int i = 0; i < 4; ++i) { s4[i] = sel[4 * g + i]; a4[i] = aff[4 * g + i]; } }
        int i0 = 0;
#pragma unroll
        for (int i = 1; i < 4; ++i) if (s4[i] > s4[i0]) i0 = i;
        int i1 = (i0 == 0) ? 1 : 0;
#pragma unroll
        for (int i = 0; i < 4; ++i) if (i != i0 && i != i1 && s4[i] > s4[i1]) i1 = i;
        float af0 = 0.f, af1 = 0.f;
#pragma unroll
        for (int i = 0; i < 4; ++i) { if (i == i0) af0 = a4[i]; if (i == i1) af1 = a4[i]; }
        const float inv = 1.0f / (af0 + af1);
        const int lo = i0 < i1 ? i0 : i1, hi = i0 < i1 ? i1 : i0; const float glo = (i0 < i1 ? af0 : af1) * inv, ghi = (i0 < i1 ? af1 : af0) * inv;
        const int pair = (lo == 0) ? (hi - 1) : (lo == 1 ? hi + 1 : 5);
        if (c.lane == 0) { rcls[rl] = bg * 6 + pair; rgate[rl * 2] = glo; rgate[rl * 2 + 1] = ghi; }
    }
    __syncthreads();
    if (c.tid < 128) rpos[c.tid] = atomicAdd((int*)(hist + rcls[c.tid]), 1);
    __syncthreads();
    unsigned* gcnt = (unsigned*)(p.ws + WS_CTL) + CW_CNT + 64 * layer;
    if (c.tid < NCLS) { const int n = hist[c.tid]; hist[32 + c.tid] = n ? (int)atomicAdd(gcnt + c.tid, (unsigned)n) : 0; }
    __syncthreads();
    if (c.tid < 128) { const int cl = rcls[c.tid], pos = hist[32 + cl] + rpos[c.tid], tok = rowb + c.tid;
        ((int*)(p.ws + WS_LIST))[(size_t)cl * T + pos] = tok;
        *(f32x2*)(wsf(p, WS_GATES) + (size_t)tok * 2) = (f32x2){rgate[c.tid * 2], rgate[c.tid * 2 + 1]}; }
}

__device__ __forceinline__ void moe_setup(const Params& p, const Ctx& c, int layer) {
    LAS int* ud = (LAS int*)(c.lds + UDESC_OFF); LAS int* ct = (LAS int*)(c.lds + CLSTAB_OFF);
    LAS int* rowtab = (LAS int*)(c.lds + ROWTAB_OFF); LAS float* gatetab = (LAS float*)(c.lds + GATETAB_OFF);
    const unsigned* gcnt = (const unsigned*)(p.ws + WS_CTL) + CW_CNT + 64 * layer;
    if (c.tid < NCLS) ct[c.tid] = (int)__hip_atomic_load(gcnt + c.tid, __ATOMIC_RELAXED, __HIP_MEMORY_SCOPE_AGENT);
    __syncthreads();
    if (c.tid == 0) { int acc = 0; for (int k = 0; k < NCLS; ++k) { ct[32 + k] = acc; acc += (ct[k] + 255) >> 8; } ct[32 + NCLS] = acc;
        const int total = acc * 4;
        for (int i = 0; i < 4; ++i) { const long L0 = (long)i * c.G + c.bid; int valid = 0, st = 0, pn = 0, elo = 0, ehi = 0, cls = 0, j = 0;
            if (L0 < total) { int L = (int)L0; { const int q = total / 8, r = total % 8, xcd = L % 8, off = L / 8; L = (xcd < r ? xcd * (q + 1) : r * (q + 1) + (xcd - r) * q) + off; }
                valid = 1; pn = L & 3; st = L >> 2; cls = 0; while (cls < NCLS - 1 && ct[32 + cls + 1] <= st) ++cls; j = st - ct[32 + cls];
                const int g = cls / 6, pr = cls % 6; const int lo = pr < 3 ? 0 : (pr < 5 ? 1 : 2), hi = pr < 3 ? pr + 1 : (pr < 5 ? pr - 1 : 3); elo = 4 * g + lo; ehi = 4 * g + hi; }
            ud[i * 16 + 0] = valid; ud[i * 16 + 1] = st; ud[i * 16 + 2] = pn; ud[i * 16 + 3] = elo; ud[i * 16 + 4] = ehi; ud[i * 16 + 5] = cls; ud[i * 16 + 6] = j; } }
    __syncthreads();
    const int* list = (const int*)(p.ws + WS_LIST); const float* gates = wsf(p, WS_GATES);
    for (int i = 0; i < 4; ++i) { if (!ud[i * 16]) continue; const int cls = ud[i * 16 + 5], j = ud[i * 16 + 6], n = ct[cls];
        if (c.tid < 256) { const int pos = j * 256 + c.tid; int tok = -1; f32x2 g = {0.f, 0.f};
            if (pos < n) { tok = list[(size_t)cls * T + pos]; g = *(const f32x2*)(gates + (size_t)tok * 2); }
            rowtab[i * 256 + c.tid] = tok; gatetab[(i * 256 + c.tid) * 2] = g.x; gatetab[(i * 256 + c.tid) * 2 + 1] = g.y; } }
    __syncthreads();
}

__device__ __forceinline__ void phase_n2(const Params& p, const Ctx& c) {
    const int row0 = (c.bid * NWAVES + c.wave) * 16; if (row0 >= T) return; const int b = row0 >> 13;
    f32x4 P1[4], S1[4], P2[4], S2[4];
    load_mod(p, p.in[I_NORMG] + 2 * D, 2, b, c.lane, P1, S1); load_mod(p, p.in[I_KVNG], 4, b, c.lane, P2, S2);
    const float* X = p.out; bf16_t* h1 = wsb(p, WS_W0); bf16_t* hkv = wsb(p, WS_W1);
    for (int rr = 0, nr = (p.pad == 110) ? 32 : 16; rr < nr; ++rr) { const int r = rr & 15; const int row = row0 + r; f32x4 v[4], o[4]; load_row(X + (size_t)row * D, c.lane, v); const float rs = row_rstd(v);
#pragma unroll
        for (int j = 0; j < 4; ++j) { v[j] = v[j] * rs; o[j] = v[j] * P1[j] + S1[j]; }
        store_row_bf16(h1 + (size_t)row * D, c.lane, o);
#pragma unroll
        for (int j = 0; j < 4; ++j) o[j] = v[j] * P2[j] + S2[j];
        store_row_bf16(hkv + (size_t)row * D, c.lane, o); }
}
__device__ __forceinline__ void phase_final(const Params& p, const Ctx& c) {
    const int row0 = (c.bid * NWAVES + c.wave) * 16; if (row0 >= T) return;
    f32x4 g[4];
#pragma unroll
    for (int j = 0; j < 4; ++j) g[j] = *(const f32x4*)(p.in[I_FG] + 4 * c.lane + 256 * j);
    for (int r = 0; r < 16; ++r) { float* rowp = p.out + (size_t)(row0 + r) * D; f32x4 v[4]; load_row(rowp, c.lane, v); const float rs = row_rstd(v);
#pragma unroll
        for (int j = 0; j < 4; ++j) *(f32x4*)(rowp + 4 * c.lane + 256 * j) = v[j] * rs * g[j]; }
}
constexpr int AT_KSTR = 208;
constexpr int AT_KBUF = 64 * AT_KSTR, AT_VBUF = 8192;
#define AT_BAR() do { asm volatile("s_waitcnt lgkmcnt(0)" ::: "memory"); __builtin_amdgcn_s_barrier(); asm volatile("" ::: "memory"); } while (0)
__device__ __forceinline__ s16x4 vtr(const LAS unsigned char* pp) { typedef short v4i16_t __attribute__((ext_vector_type(4)));
    return __builtin_bit_cast(s16x4, __builtin_amdgcn_ds_read_tr16_b64_v4i16((LAS v4i16_t*)pp)); }
__device__ __forceinline__ void attn_unit(const Params& p, const Ctx& c, int b, int h, int qb) {
    const int tid = c.tid, lane = c.lane, wid = c.wave, r32 = lane & 31, hi = lane >> 5, half = wid >> 2;
    const bf16_t* Q = wsb(p, WS_W2); const bf16_t* Kn = wsb(p, WS_W4); const bf16_t* V = wsb(p, WS_W5); const bf16_t* Kr = wsb(p, WS_KR); bf16_t* O = wsb(p, WS_W0);
    const size_t rowbase = (size_t)b * SEQ; const int q0 = qb * 256, qmin = q0 + 32 * wid, qmax = qmin + 31, qrow = qmin + r32;
    LAS unsigned char* Kb = c.lds; LAS unsigned char* Vb = c.lds + 2 * AT_KBUF;
    bf16x8 qr[6];
#pragma unroll
    for (int d0 = 0; d0 < 6; ++d0) qr[d0] = *(const bf16x8*)(Q + (rowbase + qrow) * (NHEAD * QKD) + h * QKD + 16 * d0 + 8 * hi);
    const int NT = (q0 + 256) / 64;
    const int lrow = tid >> 3, lch = tid & 7, lrow2 = (tid & 255) >> 2, lch2 = tid & 3;
    u32x4 kreg, vreg, rreg;
#define AT_LOAD(t) do { const size_t _r = rowbase + (size_t)(t) * 64; kreg = *(const u32x4*)(Kn + (_r + lrow) * D + h * HD + lch * 8); vreg = *(const u32x4*)(V + (_r + lrow) * D + h * HD + lch * 8); \
        if (tid < 256) rreg = *(const u32x4*)(Kr + (_r + lrow2) * ROPE + lch2 * 8); } while (0)
#define AT_STORE(buf) do { *(LAS u32x4*)(Kb + (buf) * AT_KBUF + lrow * AT_KSTR + lch * 16) = kreg; *(LAS u32x4*)(Vb + (buf) * AT_VBUF + (lch >> 2) * 4096 + lrow * 64 + (lch & 3) * 16) = vreg; \
        if (tid < 256) *(LAS u32x4*)(Kb + (buf) * AT_KBUF + lrow2 * AT_KSTR + 128 + lch2 * 16) = rreg; } while (0)
    AT_LOAD(0); AT_STORE(0); AT_LOAD(1); AT_STORE(1);
#pragma unroll
    for (int d0 = 0; d0 < 6; ++d0) asm volatile("" : "+v"(qr[d0]));
    AT_BAR();
    f32x16 o0 = {}, o1 = {}, s0 = {}, s1 = {}; float mrun = -1e30f, lrun = 0.f, mnew = 0.f;
    const int vlane = ((lane >> 4) & 1) * 32 + (lane & 3) * 8 + (4 * hi + ((lane & 15) >> 2)) * 64;
    if (half) AT_BAR();
    for (int t = 0; t < NT; ++t) {
        const int buf = t & 1; const bool need = (64 * t <= qmax);
        if (half) { if (t >= 1 && t + 1 < NT) AT_STORE((t + 1) & 1); if (t + 2 < NT) AT_LOAD(t + 2); }
        if (need) {
            const LAS unsigned char* kb = Kb + buf * AT_KBUF;
            s0 = (f32x16){}; s1 = (f32x16){};
#pragma unroll
            for (int d0 = 0; d0 < 6; ++d0) { const bf16x8 k0 = *(const LAS bf16x8*)(kb + r32 * AT_KSTR + d0 * 32 + hi * 16), k1 = *(const LAS bf16x8*)(kb + (32 + r32) * AT_KSTR + d0 * 32 + hi * 16);
                s0 = __builtin_amdgcn_mfma_f32_32x32x16_bf16(k0, qr[d0], s0, 0, 0, 0); s1 = __builtin_amdgcn_mfma_f32_32x32x16_bf16(k1, qr[d0], s1, 0, 0, 0); }
            if (64 * t + 63 > qmin) {
                const int kb0 = 64 * t + 4 * hi;
#pragma unroll
                for (int r = 0; r < 16; ++r) { const int kv = kb0 + (r & 3) + 8 * (r >> 2); if (kv > qrow) s0[r] = -INFINITY; if (kv + 32 > qrow) s1[r] = -INFINITY; } }
            float mx = fmaxf(s0[0], s1[0]);
#pragma unroll
            for (int r = 1; r < 16; ++r) mx = fmaxf(fmaxf(mx, s0[r]), s1[r]);
            mx = fmaxf(mx, __shfl_xor(mx, 32));
            mnew = fmaxf(mrun, mx); const float alpha = __builtin_amdgcn_exp2f(mrun - mnew); mrun = mnew; lrun *= alpha;
#pragma unroll
            for (int r = 0; r < 16; ++r) { o0[r] *= alpha; o1[r] *= alpha; }
        }
        AT_BAR();
        if (!half) { if (t >= 1 && t + 1 < NT) AT_STORE((t + 1) & 1); if (t + 2 < NT) AT_LOAD(t + 2); }
        if (need) {
            const LAS unsigned char* vb = Vb + buf * AT_VBUF;
            float rs = 0.f;
#pragma unroll
            for (int r = 0; r < 16; ++r) { s0[r] = __builtin_amdgcn_exp2f(s0[r] - mnew); s1[r] = __builtin_amdgcn_exp2f(s1[r] - mnew); rs += s0[r] + s1[r]; }
            lrun += rs;
#pragma unroll
            for (int s = 0; s < 4; ++s) { const f32x16& sv = (s >> 1) ? s1 : s0; const int r0 = 8 * (s & 1);
                const u32x4 pw = {cvtpk(sv[r0], sv[r0 + 1]), cvtpk(sv[r0 + 2], sv[r0 + 3]), cvtpk(sv[r0 + 4], sv[r0 + 5]), cvtpk(sv[r0 + 6], sv[r0 + 7])}; const bf16x8 pb = __builtin_bit_cast(bf16x8, pw);
                const s16x4 a0 = vtr(vb + vlane + s * 1024), a1 = vtr(vb + vlane + s * 1024 + 512), c0 = vtr(vb + 4096 + vlane + s * 1024), c1 = vtr(vb + 4096 + vlane + s * 1024 + 512);
                const bf16x8 va = {a0[0], a0[1], a0[2], a0[3], a1[0], a1[1], a1[2], a1[3]}, vc = {c0[0], c0[1], c0[2], c0[3], c1[0], c1[1], c1[2], c1[3]};
                o0 = __builtin_amdgcn_mfma_f32_32x32x16_bf16(va, pb, o0, 0, 0, 0); o1 = __builtin_amdgcn_mfma_f32_32x32x16_bf16(vc, pb, o1, 0, 0, 0); }
        }
        AT_BAR();
    }
    if (!half) AT_BAR();
    lrun += __shfl_xor(lrun, 32); const float inv = 1.0f / lrun;
    bf16_t* orow = O + (rowbase + qrow) * D + h * HD;
#pragma unroll
    for (int g = 0; g < 4; ++g) { const f32x4 x0 = {o0[4 * g] * inv, o0[4 * g + 1] * inv, o0[4 * g + 2] * inv, o0[4 * g + 3] * inv}, x1 = {o1[4 * g] * inv, o1[4 * g + 1] * inv, o1[4 * g + 2] * inv, o1[4 * g + 3] * inv};
        *(u32x2*)(orow + 8 * g + 4 * hi) = pack4(x0); *(u32x2*)(orow + 32 + 8 * g + 4 * hi) = pack4(x1); }
#undef AT_LOAD
#undef AT_STORE
}
__device__ __forceinline__ void phase_attention(const Params& p, const Ctx& c) {
    const int v = (c.G % 8 == 0) ? (c.bid % 8) * (c.G / 8) + c.bid / 8 : c.bid; const int bh = v >> 2, s = v & 3;
    if (bh >= NB * NHEAD) return;
    for (int ii = 0, ni = (p.pad == 113) ? 16 : 8; ii < ni; ++ii) { const int i = ii & 7; const int qb = 8 * (i >> 1) + ((i & 1) ? 7 - s : s); attn_unit(p, c, bh >> 4, bh & 15, qb); }
}
constexpr int WS_STR = 72, WBUF = 64 * WS_STR * 2;
constexpr int WK_NCH = SEQ / 64;
constexpr size_t WU = 64 * 64;
__device__ __forceinline__ bf16x8 ldsfrag(const LAS unsigned char* M, int row, int s, int hi) { return *(const LAS bf16x8*)(M + (row * WS_STR + 16 * s + 8 * hi) * 2); }
__device__ __forceinline__ bf16x8 glbfrag(const bf16_t* M, int ld, int row, int s, int hi) { return *(const bf16x8*)(M + (size_t)row * ld + 16 * s + 8 * hi); }
__device__ __forceinline__ f32x16 prod_ll(const LAS unsigned char* P1, const LAS unsigned char* P2, int xt, int yt, int r32, int hi, f32x16 acc) {
#pragma unroll
    for (int s = 0; s < 4; ++s) acc = __builtin_amdgcn_mfma_f32_32x32x16_bf16(ldsfrag(P2, 32 * yt + r32, s, hi), ldsfrag(P1, 32 * xt + r32, s, hi), acc, 0, 0, 0);
    return acc;
}
__device__ __forceinline__ void st_tile_lds(LAS unsigned char* dst, int xt, int yt, int r32, int hi, const f32x16& v) {
#pragma unroll
    for (int q = 0; q < 4; ++q) *(LAS u32x2*)(dst + ((32 * xt + r32) * WS_STR + 32 * yt + 8 * q + 4 * hi) * 2) = pack4((f32x4){v[4 * q], v[4 * q + 1], v[4 * q + 2], v[4 * q + 3]});
}
__device__ __forceinline__ void st_tile_glb(bf16_t* dst, int xt, int yt, int r32, int hi, const f32x16& v) {
#pragma unroll
    for (int q = 0; q < 4; ++q) *(u32x2*)(dst + (size_t)(32 * xt + r32) * 64 + 32 * yt + 8 * q + 4 * hi) = pack4((f32x4){v[4 * q], v[4 * q + 1], v[4 * q + 2], v[4 * q + 3]});
}
__device__ __forceinline__ f32x4 ld4_lds_bf16(const LAS unsigned char* M, int row, int col) { const u32x2 w = *(const LAS u32x2*)(M + (row * WS_STR + col) * 2); return (f32x4){bflo(w.x), bfhi(w.x), bflo(w.y), bfhi(w.y)}; }
__device__ __forceinline__ bf16x8 trifrag(int t, int s, int hi, int strict) {
    const int k0 = 16 * s + 8 * hi + strict; u32x4 w;
    w.x = (k0 + 0 <= t ? 0x3F80u : 0u) | (k0 + 1 <= t ? 0x3F800000u : 0u); w.y = (k0 + 2 <= t ? 0x3F80u : 0u) | (k0 + 3 <= t ? 0x3F800000u : 0u);
    w.z = (k0 + 4 <= t ? 0x3F80u : 0u) | (k0 + 5 <= t ? 0x3F800000u : 0u); w.w = (k0 + 6 <= t ? 0x3F80u : 0u) | (k0 + 7 <= t ? 0x3F800000u : 0u);
    return __builtin_bit_cast(bf16x8, w);
}
#define WK_Y(r) (32 * yt + ((r) & 3) + 8 * ((r) >> 2) + 4 * hi)

#define LDS_BARRIER() do { asm volatile("s_waitcnt lgkmcnt(0)" ::: "memory"); __builtin_amdgcn_s_barrier(); asm volatile("" ::: "memory"); } while (0)
__device__ __forceinline__ void phase_wkv_a(const Params& p, const Ctx& c) {
    const int tid = c.tid, lane = c.lane, w = c.wave, r32 = lane & 31, hi = lane >> 5, team = w >> 2, xt = (w >> 1) & 1, yt = w & 1;
    const int bh = c.bid >> 2, b = bh >> 4, h = bh & 15;
    LAS unsigned char* B0 = c.lds;
#define WB(i) (B0 + (i) * WBUF)
    LAS unsigned char *bR = WB(0), *bKraw = WB(1), *bVraw = WB(2), *bLDh = WB(3), *bLDl = WB(4), *bAt = WB(5), *bBt = WB(6), *bKt = WB(7), *bXA0 = WB(8), *bXA1 = WB(9), *bBtr = WB(10), *bVtr = WB(11), *bMNa = WB(12), *bMTa = WB(13), *bMbr = WB(14);
    LAS unsigned char *bXB0 = WB(1), *bXB1 = WB(2), *bMNb = WB(3), *bMTb = WB(4), *bGT = WB(5), *bHT = WB(6);
    LAS float* cst = (LAS float*)(B0 + 15 * WBUF);
    if (tid < 64) { cst[tid] = p.in[I_A0][h * 64 + tid]; cst[64 + tid] = p.in[I_KK][h * 64 + tid]; cst[128 + tid] = p.in[I_KA][h * 64 + tid]; cst[192 + tid] = p.in[I_RK][h * 64 + tid]; }
    const bf16_t* Rg = wsb(p, WS_W3); const bf16_t* Kg = wsb(p, WS_W4); const bf16_t* Vg = wsb(p, WS_W5); const bf16_t* L1 = wsb(p, WS_W6);
    const bf16_t* W2T = wsb(p, WS_W2T); const bf16_t* A2T = wsb(p, WS_A2T);
    bf16_t* PTg = wsb(p, WS_W0); bf16_t* Zg = wsb(p, WS_W1); bf16_t* QTg = wsb(p, WS_W2); bf16_t* YLg = (bf16_t*)p.out; float* bsg = wsf(p, WS_BSUM);
    const float w0c = p.in[I_W0][h * 64 + 32 * xt + r32];
    const int lrow = tid >> 3, lch = tid & 7;
    const int nrep = ((p.pad & 0xff) == 1) ? 2 : 1, skipm = p.pad >> 8;
    u32x4 pr_r, pr_k, pr_v;
#define WKA_PREFETCH(uu) do { const int _ch = (c.bid & 3) * 32 + (uu); const size_t _row0 = (size_t)b * SEQ + (size_t)_ch * 64; const size_t _g = (_row0 + lrow) * D + h * 64 + lch * 8; \
        pr_r = *(const u32x4*)(Rg + _g); pr_k = *(const u32x4*)(Kg + _g); pr_v = *(const u32x4*)(Vg + _g); } while (0)
    WKA_PREFETCH(0);
    for (int rep = 0; rep < nrep; ++rep)
    for (int u = 0; u < 32; ++u) {
        const int sk = (rep == nrep - 1) ? 0 : skipm;
        const int chunk = (c.bid & 3) * 32 + u; const size_t row0 = (size_t)b * SEQ + (size_t)chunk * 64; const size_t unit = (size_t)bh * WK_NCH + chunk;
        { const int o = (lrow * WS_STR + lch * 8) * 2; *(LAS u32x4*)(bR + o) = pr_r; *(LAS u32x4*)(bKraw + o) = pr_k; *(LAS u32x4*)(bVraw + o) = pr_v; }
        f32x16 aTL = {}, a = {};
#pragma unroll
        for (int s = 0; s < 4; ++s) { aTL = __builtin_amdgcn_mfma_f32_32x32x16_bf16(glbfrag(A2T, 64, h * 64 + 32 * yt + r32, s, hi), glbfrag(L1 + 64, 256, (int)row0 + 32 * xt + r32, s, hi), aTL, 0, 0, 0);
            a = __builtin_amdgcn_mfma_f32_32x32x16_bf16(glbfrag(L1, 256, (int)row0 + 32 * yt + r32, s, hi), glbfrag(W2T, 64, h * 64 + 32 * xt + r32, s, hi), a, 0, 0, 0); }
        {
#define WKA_LDEPI(q) do { f32x4 h4, l4; _Pragma("unroll") for (int i = 0; i < 4; ++i) { const float x = -(w0c + a[4 * (q) + i]); const float sp = fmaxf(x, 0.f) + __logf(1.0f + fexp(-fabsf(x))); const float ld = -fexp(-sp - 0.5f) * 1.4426950408889634f; \
                const float ldh = bf2f((unsigned short)(cvtpk(ld, 0.f) & 0xffffu)); h4[i] = ldh; l4[i] = ld - ldh; } \
            const int _o = ((32 * xt + r32) * WS_STR + 32 * yt + 8 * (q) + 4 * hi) * 2; *(LAS u32x2*)(bLDh + _o) = pack4(h4); *(LAS u32x2*)(bLDl + _o) = pack4(l4); } while (0)
            if (team == 0) { WKA_LDEPI(0); WKA_LDEPI(1); } else { WKA_LDEPI(2); WKA_LDEPI(3); }
#undef WKA_LDEPI
        }
        LDS_BARRIER();
        { f32x16 cl = {}, cle = {}; int tq = 32 * xt + r32; asm volatile("" : "+v"(tq));
#pragma unroll
          for (int s = 0; s < 4; ++s) { const bf16x8 fh = ldsfrag(bLDh, 32 * yt + r32, s, hi), fl = ldsfrag(bLDl, 32 * yt + r32, s, hi); const bf16x8 ti = trifrag(tq, s, hi, 0), ts = trifrag(tq, s, hi, 1);
              cl = __builtin_amdgcn_mfma_f32_32x32x16_bf16(fh, ti, cl, 0, 0, 0); cl = __builtin_amdgcn_mfma_f32_32x32x16_bf16(fl, ti, cl, 0, 0, 0);
              cle = __builtin_amdgcn_mfma_f32_32x32x16_bf16(fh, ts, cle, 0, 0, 0); cle = __builtin_amdgcn_mfma_f32_32x32x16_bf16(fl, ts, cle, 0, 0, 0); }
          const int t = 32 * xt + r32;
          float ss = 0.f;
#pragma unroll
          for (int q = 0; q < 8; ++q) { const f32x4 kv = ld4_lds_bf16(bKraw, t, 32 * hi + 4 * q); const f32x4 kc = *(const LAS f32x4*)(cst + 64 + 32 * hi + 4 * q); const f32x4 z = kv * kc; ss += (z[0] * z[0] + z[1] * z[1]) + (z[2] * z[2] + z[3] * z[3]); }
          ss += __shfl_xor(ss, 32); const float inrm = frcp(fmaxf(__builtin_amdgcn_sqrtf(ss), 1e-12f));
          float bs = 0.f; float aS[8], clS[8], cleS[8];
#pragma unroll
          for (int j = 0; j < 8; ++j) { aS[j] = team ? aTL[8 + j] : aTL[j]; clS[j] = team ? cl[8 + j] : cl[j]; cleS[j] = team ? cle[8 + j] : cle[j]; }
#pragma unroll
          for (int qq = 0; qq < 2; ++qq) { const int q = 2 * team + qq, c0 = 32 * yt + 8 * q + 4 * hi;
              const f32x4 kv = ld4_lds_bf16(bKraw, t, c0), rv = ld4_lds_bf16(bR, t, c0), vv = ld4_lds_bf16(bVraw, t, c0);
              const f32x4 a0 = *(const LAS f32x4*)(cst + c0), kkc = *(const LAS f32x4*)(cst + 64 + c0), kac = *(const LAS f32x4*)(cst + 128 + c0), rkc = *(const LAS f32x4*)(cst + 192 + c0);
              f32x4 at4, bt4, kt4, rt4;
#pragma unroll
              for (int i = 0; i < 4; ++i) { const int r = 4 * qq + i; const float a = sigmoidf_(a0[i] + aS[r]); const float kkv = kv[i] * kkc[i] * inrm, km = kv[i] * (1.0f + (a - 1.0f) * kac[i]);
                  const float cw = fexp2(clS[r]), cwm1 = fexp2(cleS[r]), icw = fexp2(-clS[r]);
                  at4[i] = -kkv * cwm1; bt4[i] = kkv * a * icw; kt4[i] = km * icw; rt4[i] = rv[i] * cw; bs += rv[i] * km * rkc[i];
                  if (t == 63) cst[256 + c0 + i] = cw; }
              const int o = (t * WS_STR + c0) * 2;
              *(LAS u32x2*)(bAt + o) = pack4(at4); *(LAS u32x2*)(bBt + o) = pack4(bt4); *(LAS u32x2*)(bKt + o) = pack4(kt4); *(LAS u32x2*)(bR + o) = pack4(rt4);
#pragma unroll
              for (int i = 0; i < 4; ++i) { const int ot = ((c0 + i) * WS_STR + t) * 2;
                  *(LAS unsigned short*)(bXA0 + ot) = (unsigned short)(cvtpk(at4[i], 0.f) & 0xffffu); *(LAS unsigned short*)(bBtr + ot) = (unsigned short)(cvtpk(bt4[i], 0.f) & 0xffffu); *(LAS unsigned short*)(bVtr + ot) = (unsigned short)(cvtpk(vv[i], 0.f) & 0xffffu); } }
          bs += __shfl_xor(bs, 32);
          if (hi == 0) bsg[((row0 + t) * NHEAD + h) * 4 + team * 2 + yt] = bs; }
        LDS_BARRIER();
        { const int x = 32 * xt + r32;
          f32x16 m1 = prod_ll(team ? bKt : bBt, bAt, xt, yt, r32, hi, (f32x16){});
          f32x16 m2 = prod_ll(team ? bR : bAt, bBt, xt, yt, r32, hi, (f32x16){});
#pragma unroll
          for (int r = 0; r < 16; ++r) { if (!(x < WK_Y(r))) m1[r] = 0.f; if (!(WK_Y(r) < x + team)) m2[r] = 0.f; }
          st_tile_lds(team ? bXA1 : bMNa, xt, yt, r32, hi, m1); st_tile_lds(team ? bMbr : bMTa, xt, yt, r32, hi, m2); }
        LDS_BARRIER();
        if (u + 1 < 32) WKA_PREFETCH(u + 1);
#pragma unroll
        for (int kq = 0; kq < 6; ++kq) { if (sk & 16) continue;
            LAS unsigned char* Xs = (kq & 1) ? (team ? bXB1 : bXB0) : (team ? bXA1 : bXA0); LAS unsigned char* Xd = (kq & 1) ? (team ? bXA1 : bXA0) : (team ? bXB1 : bXB0);
            LAS unsigned char* MNs = (kq & 1) ? bMNb : bMNa; LAS unsigned char* MTs = (kq & 1) ? bMTb : bMTa; LAS unsigned char* MNd = (kq & 1) ? bMNa : bMNb; LAS unsigned char* MTd = (kq & 1) ? bMTa : bMTb;
            f32x16 xa;
#pragma unroll
            for (int q = 0; q < 4; ++q) { const f32x4 o = ld4_lds_bf16(Xs, 32 * xt + r32, 32 * yt + 8 * q + 4 * hi); xa[4 * q] = o[0]; xa[4 * q + 1] = o[1]; xa[4 * q + 2] = o[2]; xa[4 * q + 3] = o[3]; }
            xa = prod_ll(Xs, MTs, xt, yt, r32, hi, xa);
            if (kq < 5) { const f32x16 mm = prod_ll(team ? MTs : MNs, team ? MNs : MTs, xt, yt, r32, hi, (f32x16){}); st_tile_lds(team ? MTd : MNd, xt, yt, r32, hi, mm); }
            st_tile_lds(Xd, xt, yt, r32, hi, xa);
            LDS_BARRIER();
        }
        { const int x = 32 * xt + r32; LAS unsigned char* W = team ? bXA1 : bXA0;
          f32x16 m = prod_ll(bBtr, W, xt, yt, r32, hi, (f32x16){});
          f32x16 qv;
          if (team == 0) {
#pragma unroll
              for (int q = 0; q < 4; ++q) { const f32x4 o = ld4_lds_bf16(bR, x, 32 * yt + 8 * q + 4 * hi); qv[4 * q] = o[0]; qv[4 * q + 1] = o[1]; qv[4 * q + 2] = o[2]; qv[4 * q + 3] = o[3]; } }
          else { qv = prod_ll(bR, bKt, xt, yt, r32, hi, (f32x16){});
#pragma unroll
              for (int r = 0; r < 16; ++r) if (!(WK_Y(r) <= x)) qv[r] = 0.f; }
          qv = prod_ll(bMbr, W, xt, yt, r32, hi, qv);
          const float cx = cst[256 + x];
          if (team == 0) {
#pragma unroll
              for (int r = 0; r < 16; ++r) m[r] = cx * (m[r] + (WK_Y(r) == x ? 1.0f : 0.0f));
              st_tile_glb(PTg + unit * WU, xt, yt, r32, hi, m); st_tile_glb(QTg + unit * WU, xt, yt, r32, hi, qv); }
          else {
#pragma unroll
              for (int r = 0; r < 16; ++r) m[r] = cx * (m[r] + bf2f(*(const LAS unsigned short*)(bKt + (WK_Y(r) * WS_STR + x) * 2)));
              st_tile_lds(bGT, xt, yt, r32, hi, m); st_tile_lds(bHT, xt, yt, r32, hi, qv); } }
        LDS_BARRIER();
        if (team == 0) st_tile_glb(Zg + unit * WU, xt, yt, r32, hi, prod_ll(bVtr, bGT, xt, yt, r32, hi, (f32x16){}));
        else st_tile_glb(YLg + unit * WU, xt, yt, r32, hi, prod_ll(bHT, bVtr, xt, yt, r32, hi, (f32x16){}));
        LDS_BARRIER();
    }
#undef WB
#undef WKA_PREFETCH
}

constexpr int WKB_RS = 136, WKB_MAT = 64 * WKB_RS, WKB_SLOT = 2 * WKB_MAT;
__device__ __forceinline__ void phase_wkv_b(const Params& p, const Ctx& c) {
    if (c.bid >= NB * NHEAD) {
        LAS float* scr = (LAS float*)(c.lds + RING_OFF + c.wave * 16384);
        const int gw = (c.bid - NB * NHEAD) * NWAVES + c.wave, NGW = (c.G - NB * NHEAD) * NWAVES;
        constexpr int NM = 256 + 256 + 288 + 256 + 512;
        for (int it = gw; it < NM + 16 * 384; it += NGW) { int r = it;
            if (r < NM) { if (tjob(p, r, 5, 0, WS_DKV, 1024, 512, scr, c.lane)) continue; if (tjob(p, r, 6, 0, WS_DQ, 1024, 512, scr, c.lane)) continue; if (tjob(p, r, 7, 0, WS_UQ, 384, 1536, scr, c.lane)) continue;
                if (tjob(p, r, 8, 0, WS_UKV, 256, 2048, scr, c.lane)) continue; tjob(p, r, 9, 0, WS_MWO, 1024, 1024, scr, c.lane); continue; }
            r -= NM; const int e = r / 384; r = r % 384;
            if (r < 256) transpose_item(p, 10, 16 + e, wsb(p, WS_WGU1) + (size_t)e * 512 * 1024, 1024, scr, r / 16, r % 16, c.lane);
            else { r -= 256; transpose_item(p, 11, 16 + e, wsb(p, WS_WDN1) + (size_t)e * 1024 * 256, 256, scr, r / 32, r % 32, c.lane); } }
        return; }
    const int lane = c.lane, r32 = lane & 31, hi = lane >> 5, bh = c.bid, xt = c.wave & 1; const bool comp = c.wave < 2;
    const bf16_t* PTg = wsb(p, WS_W0) + (size_t)bh * WK_NCH * WU; const bf16_t* Zg = wsb(p, WS_W1) + (size_t)bh * WK_NCH * WU; bf16_t* Sg = (bf16_t*)((unsigned char*)p.out + SLOT) + (size_t)bh * WK_NCH * WU;
    LAS unsigned char* ring = c.lds;
    const int ll = c.tid - 128;
    u32x4 ra[3], rb[3], rc[3], rd[3];
#define WKB_ISSUE(R, ch) do { if (!comp && (ch) < WK_NCH) { _Pragma("unroll") for (int k = 0; k < 3; ++k) { const int id = ll + 384 * k; if (id < 1024) { const int mat = id >> 9, e8 = (id & 511) * 8; \
        R[k] = *(const u32x4*)((mat ? Zg : PTg) + (size_t)(ch) * WU + e8); } } } } while (0)
#define WKB_PUT(R, ch) do { if (!comp && (ch) < WK_NCH) { _Pragma("unroll") for (int k = 0; k < 3; ++k) { const int id = ll + 384 * k; if (id < 1024) { const int mat = id >> 9, row = (id >> 3) & 63, cq = id & 7; \
        LAS unsigned char* d = ring + ((ch) & 1) * WKB_SLOT + mat * WKB_MAT + row * WKB_RS + cq * 16; *(LAS u32x2*)d = (u32x2){R[k].x, R[k].y}; *(LAS u32x2*)(d + 8) = (u32x2){R[k].z, R[k].w}; } } } } while (0)
    f32x16 S0 = {}, S1 = {};
#define WKB_STEP(ch) do { if (comp) { const LAS unsigned char* sl = ring + ((ch) & 1) * WKB_SLOT; bf16x8 bf[4]; bf16_t* sg = Sg + (size_t)(ch) * WU + (size_t)(32 * xt + r32) * 64; \
        _Pragma("unroll") for (int s = 0; s < 4; ++s) { const f32x16& St = (s >> 1) ? S1 : S0; const int r0 = 8 * (s & 1); \
            u32x4 wv; wv.x = cvtpk(St[r0], St[r0 + 1]); wv.y = cvtpk(St[r0 + 2], St[r0 + 3]); wv.z = cvtpk(St[r0 + 4], St[r0 + 5]); wv.w = cvtpk(St[r0 + 6], St[r0 + 7]); bf[s] = __builtin_bit_cast(bf16x8, wv); \
            *(u32x2*)(sg + 16 * s + 4 * hi) = (u32x2){wv.x, wv.y}; *(u32x2*)(sg + 16 * s + 8 + 4 * hi) = (u32x2){wv.z, wv.w}; } \
        f32x16 n0, n1; \
        _Pragma("unroll") for (int q = 0; q < 4; ++q) { const u32x2 z0 = *(const LAS u32x2*)(sl + WKB_MAT + (32 * xt + r32) * WKB_RS + (8 * q + 4 * hi) * 2), z1 = *(const LAS u32x2*)(sl + WKB_MAT + (32 * xt + r32) * WKB_RS + (32 + 8 * q + 4 * hi) * 2); \
            n0[4 * q] = bflo(z0.x); n0[4 * q + 1] = bfhi(z0.x); n0[4 * q + 2] = bflo(z0.y); n0[4 * q + 3] = bfhi(z0.y); n1[4 * q] = bflo(z1.x); n1[4 * q + 1] = bfhi(z1.x); n1[4 * q + 2] = bflo(z1.y); n1[4 * q + 3] = bfhi(z1.y); } \
        _Pragma("unroll") for (int s = 0; s < 4; ++s) { const u32x2 p00 = *(const LAS u32x2*)(sl + r32 * WKB_RS + (16 * s + 4 * hi) * 2), p01 = *(const LAS u32x2*)(sl + r32 * WKB_RS + (16 * s + 8 + 4 * hi) * 2); \
            const u32x2 p10 = *(const LAS u32x2*)(sl + (32 + r32) * WKB_RS + (16 * s + 4 * hi) * 2), p11 = *(const LAS u32x2*)(sl + (32 + r32) * WKB_RS + (16 * s + 8 + 4 * hi) * 2); \
            n0 = __builtin_amdgcn_mfma_f32_32x32x16_bf16(__builtin_bit_cast(bf16x8, (u32x4){p00.x, p00.y, p01.x, p01.y}), bf[s], n0, 0, 0, 0); \
            n1 = __builtin_amdgcn_mfma_f32_32x32x16_bf16(__builtin_bit_cast(bf16x8, (u32x4){p10.x, p10.y, p11.x, p11.y}), bf[s], n1, 0, 0, 0); } \
        S0 = n0; S1 = n1; } } while (0)
    WKB_ISSUE(ra, 0); WKB_ISSUE(rb, 1); WKB_ISSUE(rc, 2); WKB_ISSUE(rd, 3);
    WKB_PUT(ra, 0); WKB_ISSUE(ra, 4);
    LDS_BARRIER();
    for (int ch = 0; ch < WK_NCH; ch += 4) {
        WKB_PUT(rb, ch + 1); WKB_ISSUE(rb, ch + 5); WKB_STEP(ch);     LDS_BARRIER();
        WKB_PUT(rc, ch + 2); WKB_ISSUE(rc, ch + 6); WKB_STEP(ch + 1); LDS_BARRIER();
        WKB_PUT(rd, ch + 3); WKB_ISSUE(rd, ch + 7); WKB_STEP(ch + 2); LDS_BARRIER();
        WKB_PUT(ra, ch + 4); WKB_ISSUE(ra, ch + 8); WKB_STEP(ch + 3); LDS_BARRIER();
    }
#undef WKB_ISSUE
#undef WKB_PUT
#undef WKB_STEP
}

__device__ __forceinline__ void phase_wkv_c(const Params& p, const Ctx& c) {
    const int lane = c.lane, r32 = lane & 31, hi = lane >> 5;
    const bf16_t* QTg = wsb(p, WS_W2); const bf16_t* YLg = (const bf16_t*)p.out; const bf16_t* Sg = (const bf16_t*)((const unsigned char*)p.out + SLOT);
    const bf16_t* Vg = wsb(p, WS_W5); const bf16_t* L1 = wsb(p, WS_W6); const bf16_t* G2T = wsb(p, WS_G2T); const float* bsg = wsf(p, WS_BSUM); bf16_t* YG = wsb(p, WS_W0);
    for (int task = c.bid * NWAVES + c.wave; task < NB * NHEAD * WK_NCH * 2; task += c.G * NWAVES) {
        const int unit = task >> 1, xt = task & 1, bh = unit / WK_NCH, chunk = unit % WK_NCH, b = bh >> 4, h = bh & 15;
        const size_t row = (size_t)b * SEQ + (size_t)chunk * 64 + 32 * xt + r32;
        const bf16_t* qt = QTg + (size_t)unit * WU; const bf16_t* sc = Sg + (size_t)unit * WU; const bf16_t* yl = YLg + (size_t)unit * WU;
        f32x16 y[2], g[2];
#pragma unroll
        for (int yt = 0; yt < 2; ++yt) {
#pragma unroll
            for (int q = 0; q < 4; ++q) { const u32x2 wv = *(const u32x2*)(yl + (size_t)(32 * xt + r32) * 64 + 32 * yt + 8 * q + 4 * hi);
                y[yt][4 * q] = bflo(wv.x); y[yt][4 * q + 1] = bfhi(wv.x); y[yt][4 * q + 2] = bflo(wv.y); y[yt][4 * q + 3] = bfhi(wv.y); }
#pragma unroll
            for (int s = 0; s < 4; ++s) y[yt] = __builtin_amdgcn_mfma_f32_32x32x16_bf16(glbfrag(sc, 64, 32 * yt + r32, s, hi), glbfrag(qt, 64, 32 * xt + r32, s, hi), y[yt], 0, 0, 0);
            g[yt] = (f32x16){};
#pragma unroll
            for (int s = 0; s < 8; ++s) g[yt] = __builtin_amdgcn_mfma_f32_32x32x16_bf16(glbfrag(G2T, 128, h * 64 + 32 * yt + r32, s, hi), glbfrag(L1 + 128, 256, (int)row, s, hi), g[yt], 0, 0, 0);
        }
        float sm = 0.f;
#pragma unroll
        for (int r = 0; r < 16; ++r) sm += y[0][r] + y[1][r];
        sm += __shfl_xor(sm, 32); const float mean = sm * (1.0f / 64.0f);
        float q2 = 0.f;
#pragma unroll
        for (int r = 0; r < 16; ++r) { const float d0 = y[0][r] - mean, d1 = y[1][r] - mean; q2 += d0 * d0 + d1 * d1; }
        q2 += __shfl_xor(q2, 32); const float rstd = rsqrtf(q2 * (1.0f / 64.0f) + GN_EPS);
        const f32x4 b4 = *(const f32x4*)(bsg + (row * NHEAD + h) * 4); const float bsum = (b4[0] + b4[1]) + (b4[2] + b4[3]);
#pragma unroll
        for (int yt = 0; yt < 2; ++yt)
#pragma unroll
            for (int q = 0; q < 4; ++q) { const int ch = h * 64 + 32 * yt + 8 * q + 4 * hi; const f32x4 lw = *(const f32x4*)(p.in[I_LNW] + ch), lb = *(const f32x4*)(p.in[I_LNB] + ch);
                const u32x2 vw = *(const u32x2*)(Vg + row * D + ch); const f32x4 vv = {bflo(vw.x), bfhi(vw.x), bflo(vw.y), bfhi(vw.y)}; f32x4 o;
#pragma unroll
                for (int i = 0; i < 4; ++i) o[i] = ((y[yt][4 * q + i] - mean) * rstd * lw[i] + lb[i] + bsum * vv[i]) * g[yt][4 * q + i];
                *(u32x2*)(YG + row * D + ch) = pack4(o); }
    }
}
#undef WK_Y
#ifndef WKA_PROBE
#define WKA_PROBE 0
#endif
#ifndef MK_N_LAUNCHES
#define MK_N_LAUNCHES 1
#endif
constexpr int N_PHASES = 19;
constexpr int N_LAUNCHES = MK_N_LAUNCHES;


__global__ void __launch_bounds__(NTHREADS, 2) fwd_kernel(Params p) {
    extern __shared__ __attribute__((aligned(16))) unsigned char lds_raw[];
    Ctx c; c.lds = (LAS unsigned char*)lds_raw; c.tid = threadIdx.x; c.lane = c.tid & 63; c.wave = __builtin_amdgcn_readfirstlane(c.tid >> 6); c.G = gridDim.x; c.bid = blockIdx.x;
    volatile LAS unsigned* MISC = (volatile LAS unsigned*)(c.lds + MISC_OFF);
    if (c.tid < 64) ((LAS unsigned*)(c.lds + MISC_OFF))[c.tid] = 0u;
    __syncthreads();
    unsigned* ctl = (unsigned*)(p.ws + WS_CTL);
    XcdBarrier bar; bar.bar = ctl + CW_BAR; bar.x = 0; bar.st = nullptr;
    if (N_LAUNCHES == 1) bar = xcd_barrier_post(ctl + CW_BAR, MISC + 8);
    const int lo = p.ph_lo, hi = p.ph_hi;
#ifndef PH_MASK
#define PH_MASK 0x7ffff
#endif
#ifndef PROBE_DUP_EARLY
#define PROBE_DUP_EARLY -1
#endif
#define PHASE_ID 0
#define IN(k) ((((PH_MASK) >> (k)) & 1) && lo <= (k) && (k) < hi)
#define SEAM(k) do { if (IN(k) && IN((k) + 1)) xcd_barrier(bar); } while (0)
    LAS unsigned char* ring = c.lds + RING_OFF;

    if (IN(0)) { phase_prologue(p, c); } SEAM(0);
    if (IN(1)) { phase_n0(p, c); } SEAM(1);
    if (IN(2)) {
#undef PHASE_ID
#define PHASE_ID 2
        { DenseSched S; S.init((const bf16_t*)p.out, D, wsb(p, WS_LD), 2048, T, 256, 2048, c.G, c.bid); S.rep = (p.pad == 100 + PHASE_ID) ? 2 : 1; S.pad = 1; S.nt0 = 16; S.a1d = -(long)(D * 2); S.b1d = 1024 * 2;
          EpiLoraDown E{wsb(p, WS_W6)}; pg8::gemm_phase<EpiLoraDown, DenseSched, false>(ring, S, E, D, 2048); }
        { DenseSched S; S.init(wsb(p, WS_W0), D, wsb(p, WS_WR), D, T, D, D, c.G, c.bid); S.rep = (p.pad == 100 + PHASE_ID) ? 2 : 1; EpiBf16 E{wsb(p, WS_W3), D}; pg8::gemm_phase<EpiBf16, DenseSched, false>(ring, S, E, D, D); }
        { DenseSched S; S.init(wsb(p, WS_W1), D, wsb(p, WS_WK), D, T, D, D, c.G, c.bid); S.rep = (p.pad == 100 + PHASE_ID) ? 2 : 1; EpiBf16 E{wsb(p, WS_W4), D}; pg8::gemm_phase<EpiBf16, DenseSched, false>(ring, S, E, D, D); }
        { DenseSched S; S.init(wsb(p, WS_W2), D, wsb(p, WS_WV), D, T, D, D, c.G, c.bid); S.rep = (p.pad == 100 + PHASE_ID) ? 2 : 1; EpiBf16 E{wsb(p, WS_W5), D}; pg8::gemm_phase<EpiBf16, DenseSched, false>(ring, S, E, D, D); }
    } SEAM(2);
#ifndef PROBE_DUP
#define PROBE_DUP -1
#define DUP(k, call) do { if (PROBE_DUP == (k)) { call; xcd_barrier(bar); } } while (0)
    if (IN(3)) { phase_wkv_a(p, c); } SEAM(3);
    if (IN(4)) { phase_wkv_b(p, c); } SEAM(4);
    if (IN(5)) { phase_wkv_c(p, c); } SEAM(5);
#endif
    if (IN(6)) {
#undef PHASE_ID
#define PHASE_ID 6
        DenseSched S; S.init(wsb(p, WS_W0), D, wsb(p, WS_WO), D, T, D, D, c.G, c.bid); S.rep = (p.pad == 100 + PHASE_ID) ? 2 : 1; EpiResid E{p.in[I_X], p.out, wsf(p, WS_MOD) + 0 * 3072 + 2048};
        pg8::gemm_phase<EpiResid, DenseSched, false>(ring, S, E, D, D);
    } SEAM(6);
#define MOE_PHASES(layer, pb) do { \
        if (IN(pb)) { phase_router(p, c, layer); } SEAM(pb); \
        if (IN((pb) + 1)) { \
            moe_setup(p, c, layer); \
            MoeSched S{(LAS const int*)(c.lds + UDESC_OFF), (LAS const int*)(c.lds + ROWTAB_OFF), 0, (const char*)wsb(p, WS_W1), (const char*)wsb(p, (layer) ? WS_WGU1 : WS_WGU), (const char*)wsb(p, (layer) ? WS_WDN1 : WS_WDN)}; \
            EpiMoeUp E{wsb(p, WS_W2), (LAS const float*)(c.lds + GATETAB_OFF)}; \
            pg8::gemm_phase<EpiMoeUp, MoeSched, true>(ring, S, E, D, D); \
        } SEAM((pb) + 1); \
        if (IN((pb) + 2)) { \
            moe_setup(p, c, layer); \
            MoeSched S{(LAS const int*)(c.lds + UDESC_OFF), (LAS const int*)(c.lds + ROWTAB_OFF), 1, (const char*)wsb(p, WS_W2), (const char*)wsb(p, (layer) ? WS_WGU1 : WS_WGU), (const char*)wsb(p, (layer) ? WS_WDN1 : WS_WDN)}; \
            EpiMoeDown E{p.out, wsf(p, WS_MOD) + ((layer) * 2 + 1) * 3072 + 2048, (LAS const int*)(c.lds + ROWTAB_OFF)}; \
            pg8::gemm_phase<EpiMoeDown, MoeSched, false>(ring, S, E, 512, 256); \
        } SEAM((pb) + 2); } while (0)
    MOE_PHASES(0, 7);
            if (IN(10)) { phase_n2(p, c); } SEAM(10);
            if (IN(11)) {
#undef PHASE_ID
#define PHASE_ID 11
                { DenseSched S; S.init(wsb(p, WS_W1), D, wsb(p, WS_DKV), D, T, 512, D, c.G, c.bid); S.rep = (p.pad == 100 + PHASE_ID) ? 2 : 1; EpiDown E{wsb(p, WS_W6), KVLORA, 0, wsf(p, WS_SSQKV), 4, wsb(p, WS_KR), wsf(p, WS_TAB)};
                  pg8::gemm_phase<EpiDown, DenseSched, false>(ring, S, E, D, D); }
                { DenseSched S; S.init(wsb(p, WS_W0), D, wsb(p, WS_DQ), D, T, 512, D, c.G, c.bid); S.rep = (p.pad == 100 + PHASE_ID) ? 2 : 1; EpiDown E{wsb(p, WS_W6 + 16 * MiB), QLORA, 128, wsf(p, WS_SSQQ), 8, nullptr, nullptr};
                  pg8::gemm_phase<EpiDown, DenseSched, false>(ring, S, E, D, D); }
            } SEAM(11);
            if (IN(12)) {
#undef PHASE_ID
#define PHASE_ID 12
                { DenseSched S; S.init(wsb(p, WS_W6 + 16 * MiB), QLORA, wsb(p, WS_UQ), QLORA, T, 1536, QLORA, c.G, c.bid); S.rep = (p.pad == 100 + PHASE_ID) ? 2 : 1; EpiQ E{wsb(p, WS_W2), wsf(p, WS_SSQQ), wsf(p, WS_TAB)};
                  pg8::gemm_phase<EpiQ, DenseSched, false>(ring, S, E, QLORA, QLORA); }
                { DenseSched S; S.init(wsb(p, WS_W6), KVLORA, wsb(p, WS_UKV), KVLORA, T, 2048, KVLORA, c.G, c.bid); S.rep = (p.pad == 100 + PHASE_ID) ? 2 : 1; EpiKV E{wsb(p, WS_W4), wsb(p, WS_W5), wsf(p, WS_SSQKV)};
                  pg8::gemm_phase<EpiKV, DenseSched, false>(ring, S, E, KVLORA, KVLORA); }
            } SEAM(12);
            if (IN(13)) { phase_attention(p, c); } SEAM(13);
#if defined(PROBE_DUP) && PROBE_DUP == 13
            if (IN(13)) { phase_attention(p, c); } SEAM(13);
#endif
            if (IN(14)) {
#undef PHASE_ID
#define PHASE_ID 14
                DenseSched S; S.init(wsb(p, WS_W0), D, wsb(p, WS_MWO), D, T, D, D, c.G, c.bid); S.rep = (p.pad == 100 + PHASE_ID) ? 2 : 1; EpiResid E{p.out, p.out, wsf(p, WS_MOD) + 2 * 3072 + 2048};
                pg8::gemm_phase<EpiResid, DenseSched, false>(ring, S, E, D, D);
            } SEAM(14);
    MOE_PHASES(1, 15);
    if (IN(18)) { phase_final(p, c); }
#undef IN
#undef SEAM
}

extern "C" void kernel_launch(void* const* d_in, const int* in_sizes, int n_in, void* d_out, int out_size, void* d_ws, size_t ws_size, hipStream_t stream) {
    static int ready = 0;
    if (ready == 0) {
        ready = 1;
        if (n_in != N_IN || out_size != T * D || ws_size < WS_END) { fprintf(stderr, "kernel_launch: unexpected shapes (n_in %d, out %d, ws %zu)\n", n_in, out_size, ws_size); ready = -1; }
        else if (hipFuncSetAttribute((const void*)fwd_kernel, hipFuncAttributeMaxDynamicSharedMemorySize, LDS_BYTES) != hipSuccess) { fprintf(stderr, "kernel_launch: hipFuncSetAttribute failed\n"); ready = -1; }
        int per_cu = 0;
        if (ready > 0 && (hipOccupancyMaxActiveBlocksPerMultiprocessor(&per_cu, (const void*)fwd_kernel, NTHREADS, LDS_BYTES) != hipSuccess || per_cu < 1)) fprintf(stderr, "kernel_launch: occupancy query reports %d\n", per_cu);
        (void)hipGetLastError();
    }
    if (ready < 0) return;
    (void)hipMemsetAsync((char*)d_ws + WS_CTL, 0, CTL_ZERO_BYTES, stream);
    Params a{};
    for (int i = 0; i < N_IN; ++i) a.in[i] = (const float*)d_in[i];
    a.out = (float*)d_out; a.ws = (unsigned char*)d_ws; a.li = 0; a.pad = WKA_PROBE;
    const int grid = 256;
    if (N_LAUNCHES == 1) { a.ph_lo = 0; a.ph_hi = N_PHASES; hipLaunchKernelGGL(fwd_kernel, dim3(grid), dim3(NTHREADS), LDS_BYTES, stream, a); }
    else { for (int k = 0; k < N_PHASES; ++k) { a.ph_lo = k; a.ph_hi = k + 1; a.li = k; hipLaunchKernelGGL(fwd_kernel, dim3(grid), dim3(NTHREADS), LDS_BYTES, stream, a); } }
}
```

```cpp
#define WKA_PROBE 105
#include <hip/hip_runtime.h>
#include <cstdio>
#include <cstdint>

#define LAS __attribute__((address_space(3)))
#define GAS __attribute__((address_space(1)))
typedef unsigned short bf16_t;
typedef short bf16x8 __attribute__((ext_vector_type(8)));
typedef short s16x4 __attribute__((ext_vector_type(4)));
typedef float f32x2 __attribute__((ext_vector_type(2)));
typedef float f32x4 __attribute__((ext_vector_type(4)));
typedef float f32x16 __attribute__((ext_vector_type(16)));
typedef unsigned u32x2 __attribute__((ext_vector_type(2)));
typedef unsigned u32x4 __attribute__((ext_vector_type(4)));
typedef __bf16 bf16x2_t __attribute__((ext_vector_type(2)));

__device__ __forceinline__ unsigned cvtpk(float lo, float hi) { f32x2 v = {lo, hi}; bf16x2_t b = __builtin_convertvector(v, bf16x2_t); return __builtin_bit_cast(unsigned, b); }
__device__ __forceinline__ float bf2f(unsigned short b) { return __uint_as_float((unsigned)b << 16); }
__device__ __forceinline__ float bflo(unsigned w) { return __uint_as_float(w << 16); }
__device__ __forceinline__ float bfhi(unsigned w) { return __uint_as_float(w & 0xffff0000u); }
__device__ __forceinline__ float wave_sum(float v) {
#pragma unroll
    for (int o = 1; o < 64; o <<= 1) v += __shfl_xor(v, o);
    return v;
}
__device__ __forceinline__ float fexp2(float x) { return __builtin_amdgcn_exp2f(x); }
__device__ __forceinline__ float fexp(float x) { return __builtin_amdgcn_exp2f(x * 1.4426950408889634f); }
__device__ __forceinline__ float frcp(float x) { return __builtin_amdgcn_rcpf(x); }
__device__ __forceinline__ float sigmoidf_(float x) { return frcp(1.0f + fexp(-x)); }

namespace pg8 {
constexpr int BM = 256, BK = 64, HALF = 128, HTB = HALF * BK * 2  , STAGE_BYTES = 8 * HTB;
__host__ __device__ __forceinline__ int lds_byte(int r, int c) { const int st = (r >> 4) * 2 + (c >> 5), rr = r & 15, cc = c & 31, ob = rr * 64 + cc * 2; return st * 1024 + (ob ^ (((ob >> 9) & 1) << 5)); }
__host__ __device__ __forceinline__ void stage_rc(int b, int& R, int& C) { const int st = b / 1024, sb = b % 1024, swz = sb ^ (((sb >> 9) & 1) << 5); R = (st >> 1) * 16 + swz / 64; C = (st & 1) * 32 + (swz % 64) / 2; }
__host__ __device__ __forceinline__ int perm32(int rho) { const int n = rho >> 4, i = rho & 15; return 8 * (i >> 2) + 4 * n + (i & 3); }

struct Unit { int pm, pn, aux, nt, nt0; const char* A0; const char* A1; const char* B0; const char* B1; };
__device__ __forceinline__ const char* tile_ptr(const char* p0, const char* p1, int nt0, int t) { return t < nt0 ? p0 + (size_t)t * 128 : p1 + (size_t)(t - nt0) * 128; }

template <class Epi, class Sched, bool GA>
__device__ __forceinline__ void gemm_phase(LAS unsigned char* lds, const Sched& S, const Epi& E, const int lda, const int ldb) {
    const int tid = threadIdx.x, wid = __builtin_amdgcn_readfirstlane(tid >> 6), lane = tid & 63, wr = wid >> 2, wc = wid & 3, fr = lane & 15, fq = lane >> 4;
    unsigned voffB[2]; int RA[2], CA[2];
#pragma unroll
    for (int i = 0; i < 2; ++i) { int R, C; stage_rc(tid * 16 + i * 8192, R, C); const int Rb = Epi::PERM ? ((R & ~31) + perm32(R & 31)) : R;
        voffB[i] = (unsigned)(Rb * ldb + C) * 2u; RA[i] = R; CA[i] = C; }
    const size_t hstepB = (size_t)HALF * ldb * 2;
    unsigned voC[2][2], voN[2][2];
    const unsigned ldsw = (unsigned)wid * 1024u;
    const int aoff = lds_byte(wr * 64 + fr, fq * 8), boff = lds_byte(wc * 32 + fr, fq * 8);
#define PG8_SA(b, h) (((b) * 2 + (h)) * HTB)
#define PG8_SB(b, h) ((4 + (b) * 2 + (h)) * HTB)
#define PG8_STAGE_B(bufoff, gbase) do { _Pragma("unroll") for (int _i = 0; _i < 2; ++_i) \
        __builtin_amdgcn_global_load_lds((const unsigned*)((const char*)(gbase) + voffB[_i]), (LAS unsigned*)(lds + (bufoff) + ldsw + _i * 8192), 16, 0, 0); } while (0)
#define PG8_STAGE_A(bufoff, gbase, VO, hh) do { _Pragma("unroll") for (int _i = 0; _i < 2; ++_i) \
        __builtin_amdgcn_global_load_lds((const unsigned*)((const char*)(gbase) + VO[hh][_i]), (LAS unsigned*)(lds + (bufoff) + ldsw + _i * 8192), 16, 0, 0); } while (0)
#define PG8_LDA(dst, b, h) do { _Pragma("unroll") for (int m = 0; m < 4; ++m) _Pragma("unroll") for (int k = 0; k < 2; ++k) dst[m][k] = *(const LAS bf16x8*)(lds + PG8_SA(b, h) + aoff + m * 2048 + k * 1024); } while (0)
#define PG8_LDB(dst, b, h) do { _Pragma("unroll") for (int n = 0; n < 2; ++n) _Pragma("unroll") for (int k = 0; k < 2; ++k) dst[n][k] = *(const LAS bf16x8*)(lds + PG8_SB(b, h) + boff + n * 2048 + k * 1024); } while (0)
#define PG8_MMA(ai, bj, At, Bt) do { __builtin_amdgcn_s_setprio(1); _Pragma("unroll") for (int m = 0; m < 4; ++m) _Pragma("unroll") for (int n = 0; n < 2; ++n) _Pragma("unroll") for (int k = 0; k < 2; ++k) \
        acc[ai][bj][m][n] = __builtin_amdgcn_mfma_f32_16x16x32_bf16(Bt[n][k], At[m][k], acc[ai][bj][m][n], 0, 0, 0); __builtin_amdgcn_s_setprio(0); } while (0)
#define PG8_WAIT_V(n) asm volatile("s_waitcnt vmcnt(" #n ")" ::: "memory")
#define PG8_WAIT_L(n) asm volatile("s_waitcnt lgkmcnt(" #n ")" ::: "memory")
#define PG8_BAR __builtin_amdgcn_s_barrier()
#define PG8_SCHED __builtin_amdgcn_sched_barrier(0)
#define PG8_SETVO(VO, ui_) do { _Pragma("unroll") for (int _h = 0; _h < 2; ++_h) _Pragma("unroll") for (int _i = 0; _i < 2; ++_i) { \
        if constexpr (GA) VO[_h][_i] = (unsigned)(S.row((ui_), _h * HALF + RA[_i]) * lda + CA[_i]) * 2u; else VO[_h][_i] = (unsigned)((_h * HALF + RA[_i]) * lda + CA[_i]) * 2u; } } while (0)
    Unit cur, nxt; int ui = 0;
    if (!S.next(0, cur)) return;
    PG8_SETVO(voC, 0);
#pragma unroll
    for (int _h = 0; _h < 2; ++_h)
#pragma unroll
        for (int _i = 0; _i < 2; ++_i) voN[_h][_i] = 0u;
    f32x4 acc[2][2][4][2];
#pragma unroll
    for (int a = 0; a < 2; ++a)
#pragma unroll
        for (int b = 0; b < 2; ++b)
#pragma unroll
            for (int m = 0; m < 4; ++m)
#pragma unroll
                for (int n = 0; n < 2; ++n) acc[a][b][m][n] = (f32x4){0.f, 0.f, 0.f, 0.f};
    bf16x8 At[4][2], B0[2][2], B1[2][2];
    {
        const char* cA = cur.A0; const char* cB = cur.B0;
        PG8_STAGE_B(PG8_SB(0, 0), cB); PG8_STAGE_B(PG8_SB(0, 1), cB + hstepB); PG8_STAGE_A(PG8_SA(0, 0), cA, voC, 0); PG8_STAGE_A(PG8_SA(0, 1), cA, voC, 1);
        if (wr == 1) PG8_BAR;
        PG8_WAIT_V(2); PG8_BAR;
        PG8_STAGE_B(PG8_SB(1, 0), cB + 128); PG8_STAGE_A(PG8_SA(1, 0), cA + 128, voC, 0); PG8_STAGE_B(PG8_SB(1, 1), cB + hstepB + 128);
        PG8_WAIT_V(6); PG8_BAR;
    }
    for (;;) {
        const bool has_next = S.next(ui + 1, nxt);
        if (has_next) { if constexpr (GA) { PG8_SETVO(voN, ui + 1);
#pragma unroll
                for (int _h = 0; _h < 2; ++_h)
#pragma unroll
                    for (int _i = 0; _i < 2; ++_i) voN[_h][_i] -= voC[_h][_i]; } }
        else { nxt = cur;
#pragma unroll
            for (int _h = 0; _h < 2; ++_h)
#pragma unroll
                for (int _i = 0; _i < 2; ++_i) voN[_h][_i] = 0u; }
        const int nt = cur.nt;
        for (int t = 0; t < nt; t += 2) {
            const bool last = (t == nt - 2);
            const char* a1 = tile_ptr(cur.A0, cur.A1, cur.nt0, t + 1);
            const char* a2 = last ? nxt.A0 : tile_ptr(cur.A0, cur.A1, cur.nt0, t + 2);
            const char* b2 = last ? nxt.B0 : tile_ptr(cur.B0, cur.B1, cur.nt0, t + 2);
            const char* a3 = a2 + 128; const char* b3 = b2 + 128;
            unsigned vo2[2][2];
#pragma unroll
            for (int _h = 0; _h < 2; ++_h)
#pragma unroll
                for (int _i = 0; _i < 2; ++_i) vo2[_h][_i] = GA ? voC[_h][_i] + (last ? 1u : 0u) * voN[_h][_i] : voC[_h][_i];
            PG8_LDB(B0, 0, 0); PG8_LDB(B1, 0, 1); PG8_SCHED; PG8_LDA(At, 0, 0); PG8_STAGE_A(PG8_SA(1, 1), a1, voC, 1);
            PG8_WAIT_V(8); PG8_WAIT_L(0); PG8_BAR; PG8_MMA(0, 0, At, B0); PG8_MMA(0, 1, At, B1); PG8_BAR; PG8_SCHED;
            PG8_LDA(At, 0, 1); PG8_STAGE_B(PG8_SB(0, 0), b2); PG8_STAGE_B(PG8_SB(0, 1), b2 + hstepB); PG8_STAGE_A(PG8_SA(0, 0), a2, vo2, 0);
            PG8_WAIT_V(8); PG8_WAIT_L(0); PG8_BAR; PG8_MMA(1, 0, At, B0); PG8_MMA(1, 1, At, B1); PG8_BAR; PG8_SCHED;
            PG8_LDB(B0, 1, 0); PG8_LDB(B1, 1, 1); PG8_SCHED; PG8_LDA(At, 1, 0); PG8_STAGE_A(PG8_SA(0, 1), a2, vo2, 1);
            PG8_WAIT_V(8); PG8_WAIT_L(0); PG8_BAR; PG8_MMA(0, 0, At, B0); PG8_MMA(0, 1, At, B1); PG8_BAR; PG8_SCHED;
            PG8_LDA(At, 1, 1); PG8_STAGE_B(PG8_SB(1, 0), b3); PG8_STAGE_B(PG8_SB(1, 1), b3 + hstepB); PG8_STAGE_A(PG8_SA(1, 0), a3, vo2, 0);
            PG8_WAIT_V(8); PG8_WAIT_L(0); PG8_BAR; PG8_MMA(1, 0, At, B0); PG8_MMA(1, 1, At, B1); PG8_BAR; PG8_SCHED;
        }
        if (wr == 0) PG8_BAR;
        E(acc, cur, wr, wc, fr, fq);
        if (!has_next) break;
#pragma unroll
        for (int a = 0; a < 2; ++a)
#pragma unroll
            for (int b = 0; b < 2; ++b)
#pragma unroll
                for (int m = 0; m < 4; ++m)
#pragma unroll
                    for (int n = 0; n < 2; ++n) acc[a][b][m][n] = (f32x4){0.f, 0.f, 0.f, 0.f};
        cur = nxt; ++ui;
        if constexpr (GA) {
#pragma unroll
            for (int _h = 0; _h < 2; ++_h)
#pragma unroll
                for (int _i = 0; _i < 2; ++_i) voC[_h][_i] += voN[_h][_i];
        }
        if (wr == 1) PG8_BAR;
    }
    PG8_WAIT_V(0);
    PG8_BAR;
#undef PG8_SA
#undef PG8_SB
#undef PG8_STAGE_A
#undef PG8_STAGE_B
#undef PG8_LDA
#undef PG8_LDB
#undef PG8_MMA
#undef PG8_WAIT_V
#undef PG8_WAIT_L
#undef PG8_BAR
#undef PG8_SCHED
#undef PG8_SETVO
}
}
constexpr int NB = 4, SEQ = 8192, D = 1024, T = NB * SEQ;
constexpr int NHEAD = 16, HD = 64;
constexpr int QLORA = 384, KVLORA = 256, ROPE = 32, QKD = 96;
constexpr int NEXP = 16, NCLS = 24, DEXP = 256;
constexpr int MODW = 14336;
constexpr float NORM_EPS = 1e-6f, GN_EPS = 64e-5f;
constexpr float QSCALE = 0.10206207261596577f * 1.4426950408889634f;
constexpr int NWAVES = 8, NTHREADS = 512;

constexpr size_t MiB = 1u << 20;
constexpr size_t SLOT = 64 * MiB;
constexpr size_t WS_W0 = 0, WS_W1 = SLOT, WS_W2 = 2 * SLOT, WS_W3 = 3 * SLOT, WS_W4 = 4 * SLOT, WS_W5 = 5 * SLOT, WS_W6 = 6 * SLOT;
constexpr size_t WS_MISC = 7 * SLOT;
constexpr size_t WS_CTL = WS_MISC, CTL_ZERO_BYTES = 1 * MiB;
constexpr size_t WS_MOD = WS_MISC + 1 * MiB;
constexpr size_t WS_TAB = WS_MISC + 2 * MiB;
constexpr size_t WS_LIST = WS_MISC + 6 * MiB;
constexpr size_t WS_GATES = WS_MISC + 9 * MiB;
constexpr size_t WS_SSQKV = WS_MISC + 9 * MiB + 512 * 1024;
constexpr size_t WS_SSQQ = WS_MISC + 10 * MiB;
constexpr size_t WS_KR = WS_MISC + 11 * MiB;
constexpr size_t WS_WR = WS_MISC + 13 * MiB, WS_WK = WS_MISC + 15 * MiB, WS_WV = WS_MISC + 17 * MiB;
constexpr size_t WS_LD = WS_MISC + 19 * MiB;
constexpr size_t WS_WO = WS_MISC + 20 * MiB;
constexpr size_t WS_DKV = WS_MISC + 22 * MiB;
constexpr size_t WS_DQ = WS_MISC + 23 * MiB;
constexpr size_t WS_UQ = WS_MISC + 24 * MiB;
constexpr size_t WS_UKV = WS_MISC + 26 * MiB;
constexpr size_t WS_MWO = WS_MISC + 27 * MiB;
constexpr size_t WS_WGU = WS_MISC + 29 * MiB;
constexpr size_t WS_WDN = WS_MISC + 45 * MiB;
constexpr size_t WS_W2T = WS_MISC + 53 * MiB;
constexpr size_t WS_A2T = WS_MISC + 53 * MiB + 256 * 1024;
constexpr size_t WS_G2T = WS_MISC + 53 * MiB + 512 * 1024;
constexpr size_t WS_BSUM = WS_MISC + 54 * MiB;
constexpr size_t WS_END = WS_MISC + 62 * MiB;
constexpr size_t WS_WGU1 = WS_W6 + 40 * MiB, WS_WDN1 = WS_W6 + 56 * MiB;
static_assert(WS_END <= 512 * MiB, "d_ws map");
constexpr int CW_BAR = 4096;
constexpr int CW_CNT = 16384;

constexpr int RING_OFF = 0, RING_BYTES = 131072;
constexpr int TAB_OFF = 131072;
constexpr int ROWTAB_OFF = TAB_OFF, GATETAB_OFF = TAB_OFF + 4096, UDESC_OFF = TAB_OFF + 12288, CLSTAB_OFF = UDESC_OFF + 256;
constexpr int MISC_OFF = 151552;
constexpr int LDS_BYTES = 155648;

#define XB_TMO      128
#define XB_XCNT(j)  (256  + 64 * (j))
#define XB_XSUB(j)  (1280 + 64 * (j))
#define XB_XGEN(j)  (2304 + 64 * (j))
#define XB_TOP      3328
#define XB_TOPGEN   3392
#define XCD_BAR_WORDS 3456
#define XB_SPIN_CAP (1u << 18)

__device__ __forceinline__ unsigned xb_ld(unsigned* p)              { return __hip_atomic_load(p, __ATOMIC_RELAXED, __HIP_MEMORY_SCOPE_AGENT); }
__device__ __forceinline__ unsigned xb_add(unsigned* p, unsigned v) { return __hip_atomic_fetch_add(p, v, __ATOMIC_RELAXED, __HIP_MEMORY_SCOPE_AGENT); }
__device__ __forceinline__ unsigned xb_xcc_id() { return (unsigned)__builtin_amdgcn_s_getreg((3 << 11) | 20) & 0xFu; }
#define XB_SPIN(cond, bar) do { unsigned _sp = 0; while (cond) { __builtin_amdgcn_s_sleep(1); \
    if ((++_sp & 255u) == 0u) { if (xb_ld(&(bar)[XB_TMO])) break; if (_sp > XB_SPIN_CAP) { atomicAdd(&(bar)[XB_TMO], 1u); break; } } } } while (0)

struct XcdBarrier { unsigned* bar; unsigned x; volatile LAS unsigned* st; };

__device__ __forceinline__ XcdBarrier xcd_barrier_post(unsigned* bar, volatile LAS unsigned* st) {
    XcdBarrier b; b.bar = bar; b.x = xb_xcc_id(); b.st = st;
    if (threadIdx.x == 0) (void)xb_add(&bar[XB_XCNT(b.x)], 1u);
    return b;
}
__device__ __forceinline__ void xcd_barrier_complete(unsigned* bar, unsigned x, unsigned& nloc, unsigned& nx) {
    const unsigned G = gridDim.x * gridDim.y * gridDim.z;
    unsigned sum, cnt, mine, sp = 0u;
    for (;;) {
        sum = 0u; cnt = 0u; mine = 0u;
#pragma unroll
        for (unsigned j = 0; j < 16; ++j) { const unsigned c = xb_ld(&bar[XB_XCNT(j)]); sum += c; cnt += (c > 0u) ? 1u : 0u; mine = (j == x) ? c : mine; }
        if (sum == G) break;
        __builtin_amdgcn_s_sleep(1);
        if ((++sp & 255u) == 0u) { if (xb_ld(&bar[XB_TMO])) break; if (sp > XB_SPIN_CAP) { atomicAdd(&bar[XB_TMO], 1u); break; } }
    }
    nloc = mine > 0u ? mine : 1u; nx = cnt > 0u ? cnt : 1u;
}
__device__ __forceinline__ void xcd_barrier(const XcdBarrier& b) {
    asm volatile("s_waitcnt vmcnt(0)" ::: "memory");
    __syncthreads();
    if (threadIdx.x == 0) {
        unsigned* bar = b.bar;
        __builtin_amdgcn_s_waitcnt(0);
        unsigned nloc = b.st[0], nx = b.st[1];
        if (nloc == 0u) { xcd_barrier_complete(bar, b.x, nloc, nx); b.st[0] = nloc; b.st[1] = nx; }
        const unsigned old = xb_add(&bar[XB_XSUB(b.x)], 1u);
        const unsigned gen = old / nloc;
        if (old + 1u == (gen + 1u) * nloc) {
            __builtin_amdgcn_fence(__ATOMIC_RELEASE, "agent");
            asm volatile("s_waitcnt vmcnt(0)" ::: "memory");
            const unsigned og = xb_add(&bar[XB_TOP], 1u);
            const unsigned tg = og / nx;
            if (og + 1u == (tg + 1u) * nx) xb_add(&bar[XB_TOPGEN], 1u);
            else XB_SPIN(xb_ld(&bar[XB_TOPGEN]) == tg, bar);
            __builtin_amdgcn_fence(__ATOMIC_ACQUIRE, "agent");
            xb_add(&bar[XB_XGEN(b.x)], 1u);
            asm volatile("s_waitcnt vmcnt(0)" ::: "memory");
        } else {
            XB_SPIN(xb_ld(&bar[XB_XGEN(b.x)]) == gen, bar);
            __builtin_amdgcn_fence(__ATOMIC_ACQUIRE, "agent");
            asm volatile("s_waitcnt vmcnt(0)" ::: "memory");
        }
    }
    __syncthreads();
}

enum { I_X = 0, I_C, I_POS, I_ADAW, I_ADAB, I_NORMG, I_MU, I_WRKV, I_W0, I_W1, I_W2, I_A0, I_A1, I_A2, I_G1, I_G2, I_KK, I_KA, I_RK, I_LNW, I_LNB, I_RWO,
       I_KVADAW, I_KVADAB, I_KVNG, I_WDKV, I_GKV, I_WUK, I_WUV, I_WKR, I_WDQ, I_GQ, I_WUQ, I_WQR, I_MWO, I_RTW, I_RTB, I_WGU, I_WDOWN, I_FG, N_IN };
struct Params { const float* in[N_IN]; float* out; unsigned char* ws; int ph_lo, ph_hi, li, pad; };

struct Ctx {
    LAS unsigned char* lds;
    int tid, lane, wave, G, bid;
};
__device__ __forceinline__ bf16_t* wsb(const Params& p, size_t off) { return (bf16_t*)(p.ws + off); }
__device__ __forceinline__ float* wsf(const Params& p, size_t off) { return (float*)(p.ws + off); }
struct DenseSched {
    int nM, nN, nwg, G, c, nt, nt0, lda, pad, rep; const char* A; const char* B; size_t btile; long a1d, b1d;
    __device__ __forceinline__ void init(const void* A_, int lda_, const void* B_, int ldb_, int M, int N, int K, int G_, int c_) {
        nM = M / 256; nN = N / 256; nwg = nM * nN; G = G_; c = c_; nt = K / 64; nt0 = nt; lda = lda_; pad = 0; rep = 1; A = (const char*)A_; B = (const char*)B_;
        btile = (size_t)256 * ldb_ * 2; a1d = 0; b1d = 0; }
    __device__ __forceinline__ bool next(int i, pg8::Unit& u) const {
        const long L0 = (long)i * G + c; if (L0 >= (long)nwg * rep) return false; const long L = L0 >= nwg ? L0 - nwg : L0;
        int wgid = (int)L; { const int q = nwg / 8, r = nwg % 8, xcd = wgid % 8, off = wgid / 8; wgid = (xcd < r ? xcd * (q + 1) : r * (q + 1) + (xcd - r) * q) + off; }
        const int nig = 8 * nN, gid = wgid / nig, fm = gid * 8, gsz = (nM - fm) < 8 ? (nM - fm) : 8;
        u.pm = fm + ((wgid % nig) % gsz); u.pn = (wgid % nig) / gsz; u.aux = 0; u.nt = nt; u.nt0 = nt0;
        const size_t arow = pad ? (size_t)((u.pm >> 5) * (SEQ + 1) + 1 + 256 * (u.pm & 31)) : (size_t)u.pm * 256;
        u.A0 = A + arow * (size_t)lda * 2; u.A1 = u.A0 + a1d; u.B0 = B + (size_t)u.pn * btile; u.B1 = u.B0 + b1d; return true;
    }
    __device__ __forceinline__ int row(int, int) const { return 0; }
};

struct MoeSched {
    LAS const int* ud; LAS const int* rowtab; int down; const char* A; const char* Wgu; const char* Wdn;
    __device__ __forceinline__ bool next(int i, pg8::Unit& u) const {
        if (i >= 4) return false;
        const int valid = __builtin_amdgcn_readfirstlane(ud[i * 16 + 0]); if (!valid) return false;
        const int st = __builtin_amdgcn_readfirstlane(ud[i * 16 + 1]), pn = __builtin_amdgcn_readfirstlane(ud[i * 16 + 2]);
        const int elo = __builtin_amdgcn_readfirstlane(ud[i * 16 + 3]), ehi = __builtin_amdgcn_readfirstlane(ud[i * 16 + 4]);
        u.pm = st; u.pn = pn; u.aux = i;
        if (!down) { u.nt = 16; u.nt0 = 16; u.A0 = A; u.A1 = A; const int e = (pn >> 1) ? ehi : elo;
            u.B0 = Wgu + ((size_t)e * 512 + (size_t)(pn & 1) * 256) * 1024 * 2; u.B1 = u.B0; }
        else { u.nt = 8; u.nt0 = 4; u.A0 = A + (size_t)st * 256 * 512 * 2; u.A1 = u.A0 + 4 * 128;
            u.B0 = Wdn + ((size_t)elo * 1024 + (size_t)pn * 256) * 256 * 2; u.B1 = Wdn + ((size_t)ehi * 1024 + (size_t)pn * 256) * 256 * 2; }
        return true;
    }
    __device__ __forceinline__ int row(int i, int r) const { const int t = rowtab[i * 256 + r]; return t < 0 ? 0 : t; }
};

typedef f32x4 AccT[2][2][4][2];
#define EPI_ARGS const AccT& acc, const pg8::Unit& u, int wr, int wc, int fr, int fq
__device__ __forceinline__ u32x4 pack8(f32x4 a, f32x4 b) { u32x4 w; w.x = cvtpk(a[0], a[1]); w.y = cvtpk(a[2], a[3]); w.z = cvtpk(b[0], b[1]); w.w = cvtpk(b[2], b[3]); return w; }
__device__ __forceinline__ u32x2 pack4(f32x4 a) { u32x2 w; w.x = cvtpk(a[0], a[1]); w.y = cvtpk(a[2], a[3]); return w; }

struct EpiBf16 {
    static constexpr bool PERM = true; bf16_t* O; int ldc;
    __device__ __forceinline__ void operator()(EPI_ARGS) const {
        const int row0 = u.pm * 256 + wr * 64 + fr, col0 = u.pn * 256 + wc * 32 + 8 * fq;
#pragma unroll
        for (int ai = 0; ai < 2; ++ai)
#pragma unroll
            for (int m = 0; m < 4; ++m) { bf16_t* rowp = O + (size_t)(row0 + ai * 128 + m * 16) * ldc + col0;
#pragma unroll
                for (int bj = 0; bj < 2; ++bj) *(u32x4*)(rowp + bj * 128) = pack8(acc[ai][bj][m][0], acc[ai][bj][m][1]); }
    }
};
struct EpiLoraDown {
    static constexpr bool PERM = true; bf16_t* O;
    __device__ __forceinline__ void operator()(EPI_ARGS) const {
        const int row0 = u.pm * 256 + wr * 64 + fr, col0 = wc * 32 + 8 * fq;
#pragma unroll
        for (int ai = 0; ai < 2; ++ai)
#pragma unroll
            for (int m = 0; m < 4; ++m) { bf16_t* rowp = O + (size_t)(row0 + ai * 128 + m * 16) * 256 + col0;
#pragma unroll
                for (int bj = 0; bj < 2; ++bj) { f32x4 v0 = acc[ai][bj][m][0], v1 = acc[ai][bj][m][1];
                    if (bj == 1) {
#pragma unroll
                        for (int i = 0; i < 4; ++i) { v0[i] = sigmoidf_(v0[i]); v1[i] = sigmoidf_(v1[i]); } }
                    else if (wc < 2) {
#pragma unroll
                        for (int i = 0; i < 4; ++i) { v0[i] = 1.0f - 2.0f * frcp(1.0f + fexp(2.0f * v0[i])); v1[i] = 1.0f - 2.0f * frcp(1.0f + fexp(2.0f * v1[i])); } }
                    *(u32x4*)(rowp + bj * 128) = pack8(v0, v1); } }
    }
};
struct EpiResid {
    static constexpr bool PERM = false; const float* xin; float* xout; const float* gate;
    __device__ __forceinline__ void operator()(EPI_ARGS) const {
        const int row0 = u.pm * 256 + wr * 64 + fr, col0 = u.pn * 256 + wc * 32 + 4 * fq; const int b = u.pm >> 5;
        f32x4 gv[2][2];
#pragma unroll
        for (int bj = 0; bj < 2; ++bj)
#pragma unroll
            for (int n = 0; n < 2; ++n) gv[bj][n] = *(const f32x4*)(gate + (size_t)b * MODW + col0 + bj * 128 + n * 16);
#pragma unroll
        for (int ai = 0; ai < 2; ++ai)
#pragma unroll
            for (int m = 0; m < 4; ++m) { const size_t off = (size_t)(row0 + ai * 128 + m * 16) * D + col0;
#pragma unroll
                for (int bj = 0; bj < 2; ++bj)
#pragma unroll
                    for (int n = 0; n < 2; ++n) { const f32x4 xv = *(const f32x4*)(xin + off + bj * 128 + n * 16);
                        *(f32x4*)(xout + off + bj * 128 + n * 16) = xv + gv[bj][n] * acc[ai][bj][m][n]; } }
    }
};
struct EpiMoeUp {
    static constexpr bool PERM = true; bf16_t* act; LAS const float* gatetab;
    __device__ __forceinline__ void operator()(EPI_ARGS) const {
        const int eidx = u.pn >> 1, half = u.pn & 1; const int rl0 = wr * 64 + fr, col0 = eidx * 256 + half * 128 + wc * 32 + 8 * fq;
#pragma unroll
        for (int ai = 0; ai < 2; ++ai)
#pragma unroll
            for (int m = 0; m < 4; ++m) { const int rl = rl0 + ai * 128 + m * 16; const float cb = gatetab[(u.aux * 256 + rl) * 2 + eidx];
                f32x4 o[2];
#pragma unroll
                for (int n = 0; n < 2; ++n)
#pragma unroll
                    for (int i = 0; i < 4; ++i) { const float g = acc[ai][0][m][n][i], up = acc[ai][1][m][n][i]; o[n][i] = g * sigmoidf_(g) * up * cb; }
                *(u32x4*)(act + (size_t)(u.pm * 256 + rl) * 512 + col0) = pack8(o[0], o[1]); }
    }
};
struct EpiMoeDown {
    static constexpr bool PERM = false; float* X; const float* gate; LAS const int* rowtab;
    __device__ __forceinline__ void operator()(EPI_ARGS) const {
        const int rl0 = wr * 64 + fr, col0 = u.pn * 256 + wc * 32 + 4 * fq;
#pragma unroll
        for (int ai = 0; ai < 2; ++ai)
#pragma unroll
            for (int m = 0; m < 4; ++m) { const int rl = rl0 + ai * 128 + m * 16; const int tok = rowtab[u.aux * 256 + rl];
                if (tok >= 0) { const float* gp = gate + (size_t)(tok >> 13) * MODW + col0; float* xp = X + (size_t)tok * D + col0;
#pragma unroll
                    for (int bj = 0; bj < 2; ++bj)
#pragma unroll
                        for (int n = 0; n < 2; ++n) { const f32x4 gv = *(const f32x4*)(gp + bj * 128 + n * 16); const f32x4 xv = *(const f32x4*)(xp + bj * 128 + n * 16);
                            *(f32x4*)(xp + bj * 128 + n * 16) = xv + gv * acc[ai][bj][m][n]; } } }
    }
};
struct EpiDown {
    static constexpr bool PERM = false; bf16_t* O; int ldc; int ncols1; float* ssq; int ssq_ld; bf16_t* Kr; const float* tab;
    __device__ __forceinline__ void operator()(EPI_ARGS) const {
        const int row0 = u.pm * 256 + wr * 64 + fr;
#pragma unroll
        for (int ai = 0; ai < 2; ++ai)
#pragma unroll
            for (int m = 0; m < 4; ++m) { const int row = row0 + ai * 128 + m * 16;
                if (u.pn == 0 || ncols1 > 0) { float ss = 0.f;
#pragma unroll
                    for (int bj = 0; bj < 2; ++bj) { if (u.pn == 0 || bj * 128 < ncols1) {
#pragma unroll
                        for (int n = 0; n < 2; ++n) { const f32x4 v = acc[ai][bj][m][n]; ss += (v[0] * v[0] + v[1] * v[1]) + (v[2] * v[2] + v[3] * v[3]);
                            *(u32x2*)(O + (size_t)row * ldc + u.pn * 256 + bj * 128 + wc * 32 + n * 16 + 4 * fq) = pack4(v); } } }
                    ss += __shfl_xor(ss, 16); ss += __shfl_xor(ss, 32);
                    if (fq == 0) ssq[(size_t)row * ssq_ld + u.pn * 4 + wc] = ss; }
                if (Kr != nullptr && u.pn == 1 && wc == 0) { const f32x4 x1 = acc[ai][0][m][0], x2 = acc[ai][0][m][1];
                    const f32x4 c4 = *(const f32x4*)(tab + (size_t)row * 32 + 4 * fq), s4 = *(const f32x4*)(tab + (size_t)row * 32 + 16 + 4 * fq);
                    *(u32x2*)(Kr + (size_t)row * 32 + 4 * fq) = pack4(x1 * c4 - x2 * s4); *(u32x2*)(Kr + (size_t)row * 32 + 16 + 4 * fq) = pack4(x2 * c4 + x1 * s4); } }
    }
};
struct EpiQ {
    static constexpr bool PERM = false; bf16_t* Q; const float* ssq; const float* tab;
    __device__ __forceinline__ void operator()(EPI_ARGS) const {
        const int row0 = u.pm * 256 + wr * 64 + fr;
#pragma unroll
        for (int ai = 0; ai < 2; ++ai)
#pragma unroll
            for (int m = 0; m < 4; ++m) { const int row = row0 + ai * 128 + m * 16;
                const f32x4 sa = *(const f32x4*)(ssq + (size_t)row * 8), sb = *(const f32x4*)(ssq + (size_t)row * 8 + 4);
                const float sc = rsqrtf(((sa[0] + sa[1]) + (sa[2] + sa[3]) + (sb[0] + sb[1]) + (sb[2] + sb[3])) * (1.0f / QLORA) + NORM_EPS) * QSCALE;
                bf16_t* qrow = Q + (size_t)row * (NHEAD * QKD);
                if (u.pn < 4) {
#pragma unroll
                    for (int bj = 0; bj < 2; ++bj)
#pragma unroll
                        for (int n = 0; n < 2; ++n) { const int col = u.pn * 256 + bj * 128 + wc * 32 + n * 16 + 4 * fq;
                            *(u32x2*)(qrow + (col >> 6) * QKD + (col & 63)) = pack4(acc[ai][bj][m][n] * sc); }
                } else { const f32x4 c4 = *(const f32x4*)(tab + (size_t)row * 32 + 4 * fq), s4 = *(const f32x4*)(tab + (size_t)row * 32 + 16 + 4 * fq);
#pragma unroll
                    for (int bj = 0; bj < 2; ++bj) { const int h = (u.pn - 4) * 8 + bj * 4 + wc; const f32x4 x1 = acc[ai][bj][m][0] * sc, x2 = acc[ai][bj][m][1] * sc;
                        *(u32x2*)(qrow + h * QKD + 64 + 4 * fq) = pack4(x1 * c4 - x2 * s4); *(u32x2*)(qrow + h * QKD + 80 + 4 * fq) = pack4(x2 * c4 + x1 * s4); } } }
    }
};
struct EpiKV {
    static constexpr bool PERM = true; bf16_t* Kn; bf16_t* V; const float* ssq;
    __device__ __forceinline__ void operator()(EPI_ARGS) const {
        const int row0 = u.pm * 256 + wr * 64 + fr; bf16_t* base = (u.pn < 4) ? Kn : V; const int col0 = (u.pn & 3) * 256 + wc * 32 + 8 * fq;
#pragma unroll
        for (int ai = 0; ai < 2; ++ai)
#pragma unroll
            for (int m = 0; m < 4; ++m) { const int row = row0 + ai * 128 + m * 16; const f32x4 sa = *(const f32x4*)(ssq + (size_t)row * 4);
                const float sc = rsqrtf(((sa[0] + sa[1]) + (sa[2] + sa[3])) * (1.0f / KVLORA) + NORM_EPS);
#pragma unroll
                for (int bj = 0; bj < 2; ++bj) *(u32x4*)(base + (size_t)row * D + col0 + bj * 128) = pack8(acc[ai][bj][m][0] * sc, acc[ai][bj][m][1] * sc); }
    }
};
__device__ __forceinline__ float srcval(const Params& p, int kind, int e, int k, int n) {
    switch (kind) {
    case 0: case 1: case 2: return p.in[I_WRKV][((size_t)kind * D + k) * D + n];
    case 3: { const int kk = k & 1023, hi = k >> 10; float w, mu;
        if (n < 64) { w = p.in[I_W1][kk * 64 + n]; mu = p.in[I_MU][1 * D + kk]; }
        else if (n < 128) { w = p.in[I_A1][kk * 64 + n - 64]; mu = p.in[I_MU][4 * D + kk]; }
        else { w = p.in[I_G1][kk * 128 + n - 128]; mu = p.in[I_MU][5 * D + kk]; }
        return w * (hi ? mu : 1.0f - mu); }
    case 4: return p.in[I_RWO][(size_t)k * D + n];
    case 5: return n < 256 ? p.in[I_WDKV][k * 256 + n] : (n < 288 ? p.in[I_WKR][k * 32 + n - 256] : 0.f);
    case 6: return n < 384 ? p.in[I_WDQ][k * 384 + n] : 0.f;
    case 7: return p.in[I_GQ][k] * (n < 1024 ? p.in[I_WUQ][(size_t)k * 1024 + n] : p.in[I_WQR][(size_t)k * 512 + n - 1024]);
    case 8: return p.in[I_GKV][k] * (n < 1024 ? p.in[I_WUK][(size_t)k * 1024 + n] : p.in[I_WUV][(size_t)k * 1024 + n - 1024]);
    case 9: return p.in[I_MWO][(size_t)k * D + n];
    case 10: { const int pp = n >> 8, w = n & 255; const int col = (w < 128) ? (128 * pp + w) : (256 + 128 * pp + (w - 128));
        return p.in[I_WGU][((size_t)e * D + k) * 512 + col]; }
    case 11: return p.in[I_WDOWN][((size_t)e * 256 + k) * D + n];
    case 12: return p.in[I_W2][(size_t)k * D + n];
    case 13: return p.in[I_A2][(size_t)k * D + n];
    default: return p.in[I_G2][(size_t)k * D + n];
    }
}
__device__ __forceinline__ void transpose_item(const Params& p, int kind, int e, bf16_t* dst, int ldd, LAS float* scr, int kb, int nb, int lane) {
    const int k0 = 64 * kb, n0 = 32 * nb;
#pragma unroll 4
    for (int i = 0; i < 32; ++i) { const int kk = 2 * i + (lane >> 5); scr[kk * 33 + (lane & 31)] = srcval(p, kind, e, k0 + kk, n0 + (lane & 31)); }
    asm volatile("s_waitcnt lgkmcnt(0)" ::: "memory");
    const int c = lane & 7;
#pragma unroll
    for (int j = 0; j < 4; ++j) { const int n = (lane >> 3) + 8 * j; const LAS float* s = scr + (8 * c) * 33 + n;
        u32x4 o; o.x = cvtpk(s[0 * 33], s[1 * 33]); o.y = cvtpk(s[2 * 33], s[3 * 33]); o.z = cvtpk(s[4 * 33], s[5 * 33]); o.w = cvtpk(s[6 * 33], s[7 * 33]);
        *(u32x4*)(dst + (size_t)(n0 + n) * ldd + k0 + 8 * c) = o; }
    asm volatile("s_waitcnt lgkmcnt(0)" ::: "memory");
}
__device__ __forceinline__ bool tjob(const Params& p, int& r, int kind, int e, size_t ws_off, int Kd, int Nd, LAS float* scr, int lane) {
    const int nkb = Kd / 64, nnb = Nd / 32, cnt = nkb * nnb;
    if (r < cnt) { transpose_item(p, kind, e, wsb(p, ws_off), Kd, scr, r / nnb, r % nnb, lane); return true; }
    r -= cnt; return false;
}
__device__ __forceinline__ void convert_moe_weights(const Params& p, const Ctx& c, int layer) {
    LAS float* scr = (LAS float*)(c.lds + RING_OFF + c.wave * 16384);
    const int gw = c.bid * NWAVES + c.wave, NGW = c.G * NWAVES;
    for (int it = gw; it < 16 * 384; it += NGW) { const int e = it / 384; int r = it % 384;
        if (r < 256) transpose_item(p, 10, layer * 16 + e, wsb(p, WS_WGU) + (size_t)e * 512 * 1024, 1024, scr, r / 16, r % 16, c.lane);
        else { r -= 256; transpose_item(p, 11, layer * 16 + e, wsb(p, WS_WDN) + (size_t)e * 1024 * 256, 256, scr, r / 32, r % 32, c.lane); } }
}
__device__ __forceinline__ void phase_prologue(const Params& p, const Ctx& c) {
    LAS float* sc = (LAS float*)(c.lds);
    LAS float* part = (LAS float*)(c.lds + 16384);
    for (int i = c.tid; i < NB * D; i += NTHREADS) { const float v = p.in[I_C][i]; sc[i] = v / (1.0f + __expf(-v)); }
    __syncthreads();
    const int prep = (p.pad == 100) ? 2 : 1;
    for (int it0 = c.bid; it0 < (MODW / 64) * prep; it0 += c.G) { const int it = it0 % (MODW / 64);
        const int col0 = it * 64, set = col0 < 12288 ? col0 / 3072 : 4, cin = col0 - (set < 4 ? set * 3072 : 12288);
        const float* W = set < 4 ? p.in[I_ADAW] + (size_t)set * D * 3072 : p.in[I_KVADAW]; const int ldw = set < 4 ? 3072 : 2048;
        const float* bias = set < 4 ? p.in[I_ADAB] + set * 3072 : p.in[I_KVADAB];
        float a0 = 0.f, a1 = 0.f, a2 = 0.f, a3 = 0.f;
#pragma unroll 8
        for (int kk = 0; kk < 128; ++kk) { const int k = c.wave * 128 + kk; const float w = W[(size_t)k * ldw + cin + c.lane];
            a0 += sc[k] * w; a1 += sc[D + k] * w; a2 += sc[2 * D + k] * w; a3 += sc[3 * D + k] * w; }
        part[(c.wave * 4 + 0) * 64 + c.lane] = a0; part[(c.wave * 4 + 1) * 64 + c.lane] = a1; part[(c.wave * 4 + 2) * 64 + c.lane] = a2; part[(c.wave * 4 + 3) * 64 + c.lane] = a3;
        __syncthreads();
        if (c.tid < 256) { const int b = c.tid >> 6, l = c.tid & 63; float s = bias[cin + l];
#pragma unroll
            for (int w = 0; w < 8; ++w) s += part[(w * 4 + b) * 64 + l];
            wsf(p, WS_MOD)[(size_t)b * MODW + col0 + l] = s; }
        __syncthreads();
    }
    __syncthreads();
    LAS float* scr = (LAS float*)(c.lds + RING_OFF + c.wave * 16384);
    const int gw = c.bid * NWAVES + c.wave, NGW = c.G * NWAVES;
    constexpr int NITEMS = 3 * 512 + 256 + 512 + 32 + 32 + 64;
    for (int it = gw; it < NITEMS * prep; it += NGW) { int r = it % NITEMS;
        if (tjob(p, r, 0, 0, WS_WR, 1024, 1024, scr, c.lane)) continue;
        if (tjob(p, r, 1, 0, WS_WK, 1024, 1024, scr, c.lane)) continue;
        if (tjob(p, r, 2, 0, WS_WV, 1024, 1024, scr, c.lane)) continue;
        if (tjob(p, r, 3, 0, WS_LD, 2048, 256, scr, c.lane)) continue;
        if (tjob(p, r, 4, 0, WS_WO, 1024, 1024, scr, c.lane)) continue;
        if (tjob(p, r, 12, 0, WS_W2T, 64, 1024, scr, c.lane)) continue;
        if (tjob(p, r, 13, 0, WS_A2T, 64, 1024, scr, c.lane)) continue;
        tjob(p, r, 14, 0, WS_G2T, 128, 1024, scr, c.lane);
    }
    for (int q = 0; q < prep; ++q) convert_moe_weights(p, c, 0);
    const int* pos = (const int*)p.in[I_POS]; float* tab = wsf(p, WS_TAB);
    for (int i0 = c.bid * NTHREADS + c.tid; i0 < T * 16 * prep; i0 += c.G * NTHREADS) { const int i = i0 % (T * 16); const int t = i >> 4, f = i & 15;
        const float inv = powf(10000.0f, -(float)(2 * f) / 32.0f); float s, co; sincosf((float)pos[t] * inv, &s, &co);
        tab[(size_t)t * 32 + f] = co; tab[(size_t)t * 32 + 16 + f] = s; }
}

__device__ __forceinline__ void load_row(const float* rowp, int lane, f32x4 (&v)[4]) {
#pragma unroll
    for (int j = 0; j < 4; ++j) v[j] = *(const f32x4*)(rowp + 4 * lane + 256 * j);
}
__device__ __forceinline__ float row_rstd(const f32x4 (&v)[4]) {
    float s = 0.f;
#pragma unroll
    for (int j = 0; j < 4; ++j) s += (v[j][0] * v[j][0] + v[j][1] * v[j][1]) + (v[j][2] * v[j][2] + v[j][3] * v[j][3]);
    return rsqrtf(wave_sum(s) * (1.0f / D) + NORM_EPS);
}
__device__ __forceinline__ void store_row_bf16(bf16_t* rowp, int lane, const f32x4 (&v)[4]) {
#pragma unroll
    for (int j = 0; j < 4; ++j) *(u32x2*)(rowp + 4 * lane + 256 * j) = pack4(v[j]);
}
__device__ __forceinline__ void load_mod(const Params& p, const float* g, int set, int b, int lane, f32x4 (&P)[4], f32x4 (&SH)[4]) {
    const float* m = wsf(p, WS_MOD) + (size_t)b * MODW + (set < 4 ? set * 3072 : 12288);
#pragma unroll
    for (int j = 0; j < 4; ++j) { const int o = 4 * lane + 256 * j; const f32x4 gg = *(const f32x4*)(g + o), sc = *(const f32x4*)(m + 1024 + o); SH[j] = *(const f32x4*)(m + o); P[j] = gg * (sc + 1.0f); }
}

__device__ __forceinline__ void phase_n0(const Params& p, const Ctx& c) {
    const int row0 = (c.bid * NWAVES + c.wave) * 16;
    if (row0 >= T) return;
    const int b = row0 >> 13, t0 = row0 & (SEQ - 1);
    f32x4 P[4], SH[4], mr[4], mk[4], mv[4];
    load_mod(p, p.in[I_NORMG] + 0 * D, 0, b, c.lane, P, SH);
#pragma unroll
    for (int j = 0; j < 4; ++j) { const int o = 4 * c.lane + 256 * j; mr[j] = *(const f32x4*)(p.in[I_MU] + 0 * D + o); mk[j] = *(const f32x4*)(p.in[I_MU] + 2 * D + o); mv[j] = *(const f32x4*)(p.in[I_MU] + 3 * D + o); }
    bf16_t* hpad = (bf16_t*)p.out; bf16_t* xr = wsb(p, WS_W0); bf16_t* xk = wsb(p, WS_W1); bf16_t* xv = wsb(p, WS_W2);
    f32x4 hp[4];
    if (t0 == 0) {
#pragma unroll
        for (int j = 0; j < 4; ++j) hp[j] = (f32x4){0.f, 0.f, 0.f, 0.f};
        store_row_bf16(hpad + (size_t)b * (SEQ + 1) * D, c.lane, hp);
    } else { f32x4 v[4]; load_row(p.in[I_X] + (size_t)(row0 - 1) * D, c.lane, v); const float rs = row_rstd(v);
#pragma unroll
        for (int j = 0; j < 4; ++j) hp[j] = v[j] * rs * P[j] + SH[j]; }
    for (int rr = 0, nr = (p.pad == 101) ? 32 : 16; rr < nr; ++rr) { const int r = rr & 15; const int row = row0 + r; f32x4 v[4], o[4]; load_row(p.in[I_X] + (size_t)row * D, c.lane, v); const float rs = row_rstd(v);
#pragma unroll
        for (int j = 0; j < 4; ++j) v[j] = v[j] * rs * P[j] + SH[j];
        store_row_bf16(hpad + ((size_t)b * (SEQ + 1) + 1 + t0 + r) * D, c.lane, v);
#pragma unroll
        for (int j = 0; j < 4; ++j) o[j] = v[j] + (hp[j] - v[j]) * mr[j];
        store_row_bf16(xr + (size_t)row * D, c.lane, o);
#pragma unroll
        for (int j = 0; j < 4; ++j) o[j] = v[j] + (hp[j] - v[j]) * mk[j];
        store_row_bf16(xk + (size_t)row * D, c.lane, o);
#pragma unroll
        for (int j = 0; j < 4; ++j) o[j] = v[j] + (hp[j] - v[j]) * mv[j];
        store_row_bf16(xv + (size_t)row * D, c.lane, o);
#pragma unroll
        for (int j = 0; j < 4; ++j) hp[j] = v[j]; }
}

__device__ __forceinline__ void phase_router(const Params& p, const Ctx& c, int layer) {
    LAS float* rwt = (LAS float*)(c.lds);
    LAS int* rcls = (LAS int*)(c.lds + 65536);
    LAS float* rgate = (LAS float*)(c.lds + 65536 + 512);
    LAS int* rpos = (LAS int*)(c.lds + 65536 + 2048);
    LAS int* hist = (LAS int*)(c.lds + 65536 + 4096);
    for (int i = c.tid; i < D * NEXP; i += NTHREADS) { const int k = i >> 4, e = i & 15; rwt[e * D + k] = p.in[I_RTW][i]; }
    if (c.tid < 64) hist[c.tid] = 0;
    __syncthreads();
    const int set = layer * 2 + 1; const int rowb = c.bid * 128; const int b = rowb >> 13;
    f32x4 P[4], SH[4]; load_mod(p, p.in[I_NORMG] + (size_t)set * D, set, b, c.lane, P, SH);
    float rb[16];
#pragma unroll
    for (int e = 0; e < 16; ++e) rb[e] = p.in[I_RTB][e];
    const float* X = p.out; bf16_t* h2 = wsb(p, WS_W1);
    for (int r = 0; r < 16; ++r) { const int rl = c.wave * 16 + r, row = rowb + rl; f32x4 v[4]; load_row(X + (size_t)row * D, c.lane, v); const float rs = row_rstd(v);
#pragma unroll
        for (int j = 0; j < 4; ++j) v[j] = v[j] * rs * P[j] + SH[j];
        store_row_bf16(h2 + (size_t)row * D, c.lane, v);
        float sel[16], aff[16];
#pragma unroll
        for (int e = 0; e < 16; ++e) { float s = 0.f;
#pragma unroll
            for (int j = 0; j < 4; ++j) { const f32x4 w = *(const LAS f32x4*)(rwt + e * D + 4 * c.lane + 256 * j); s += (v[j][0] * w[0] + v[j][1] * w[1]) + (v[j][2] * w[2] + v[j][3] * w[3]); }
            s = wave_sum(s); aff[e] = 1.0f / (1.0f + __expf(-s)); sel[e] = aff[e] + rb[e]; }
        int bg = 0; float bs = -INFINITY;
#pragma unroll
        for (int g = 0; g < 4; ++g) { const float a0 = sel[4 * g], a1 = sel[4 * g + 1], a2 = sel[4 * g + 2], a3 = sel[4 * g + 3];
            const float m01 = fmaxf(a0, a1), n01 = fminf(a0, a1), m23 = fmaxf(a2, a3), n23 = fminf(a2, a3);
            const float top = fmaxf(m01, m23), second = fmaxf(fminf(m01, m23), (m01 >= m23) ? n01 : n23); const float gs = top + second;
            if (gs > bs) { bs = gs; bg = g; } }
        float s4[4], a4[4];
#pragma unroll
        for (int g = 0; g < 4; ++g) if (g == bg) {
#pragma unroll
            for (int i = 0; i < 4; ++i) { s4[i] = sel[4 * g + i]; a4[i] = aff[4 * g + i]; } }
        int i0 = 0;
#pragma unroll
        for (int i = 1; i < 4; ++i) if (s4[i] > s4[i0]) i0 = i;
        int i1 = (i0 == 0) ? 1 : 0;
#pragma unroll
        for (int i = 0; i < 4; ++i) if (i != i0 && i != i1 && s4[i] > s4[i1]) i1 = i;
        float af0 = 0.f, af1 = 0.f;
#pragma unroll
        for (int i = 0; i < 4; ++i) { if (i == i0) af0 = a4[i]; if (i == i1) af1 = a4[i]; }
        const float inv = 1.0f / (af0 + af1);
        const int lo = i0 < i1 ? i0 : i1, hi = i0 < i1 ? i1 : i0; const float glo = (i0 < i1 ? af0 : af1) * inv, ghi = (i0 < i1 ? af1 : af0) * inv;
        const int pair = (lo == 0) ? (hi - 1) : (lo == 1 ? hi + 1 : 5);
        if (c.lane == 0) { rcls[rl] = bg * 6 + pair; rgate[rl * 2] = glo; rgate[rl * 2 + 1] = ghi; }
    }
    __syncthreads();
    if (c.tid < 128) rpos[c.tid] = atomicAdd((int*)(hist + rcls[c.tid]), 1);
    __syncthreads();
    unsigned* gcnt = (unsigned*)(p.ws + WS_CTL) + CW_CNT + 64 * layer;
    if (c.tid < NCLS) { const int n = hist[c.tid]; hist[32 + c.tid] = n ? (int)atomicAdd(gcnt + c.tid, (unsigned)n) : 0; }
    __syncthreads();
    if (c.tid < 128) { const int cl = rcls[c.tid], pos = hist[32 + cl] + rpos[c.tid], tok = rowb + c.tid;
        ((int*)(p.ws + WS_LIST))[(size_t)cl * T + pos] = tok;
        *(f32x2*)(wsf(p, WS_GATES) + (size_t)tok * 2) = (f32x2){rgate[c.tid * 2], rgate[c.tid * 2 + 1]}; }
}

__device__ __forceinline__ void moe_setup(const Params& p, const Ctx& c, int layer) {
    LAS int* ud = (LAS int*)(c.lds + UDESC_OFF); LAS int* ct = (LAS int*)(c.lds + CLSTAB_OFF);
    LAS int* rowtab = (LAS int*)(c.lds + ROWTAB_OFF); LAS float* gatetab = (LAS float*)(c.lds + GATETAB_OFF);
    const unsigned* gcnt = (const unsigned*)(p.ws + WS_CTL) + CW_CNT + 64 * layer;
    if (c.tid < NCLS) ct[c.tid] = (int)__hip_atomic_load(gcnt + c.tid, __ATOMIC_RELAXED, __HIP_MEMORY_SCOPE_AGENT);
    __syncthreads();
    if (c.tid == 0) { int acc = 0; for (int k = 0; k < NCLS; ++k) { ct[32 + k] = acc; acc += (ct[k] + 255) >> 8; } ct[32 + NCLS] = acc;
        const int total = acc * 4;
        for (int i = 0; i < 4; ++i) { const long L0 = (long)i * c.G + c.bid; int valid = 0, st = 0, pn = 0, elo = 0, ehi = 0, cls = 0, j = 0;
            if (L0 < total) { int L = (int)L0; { const int q = total / 8, r = total % 8, xcd = L % 8, off = L / 8; L = (xcd < r ? xcd * (q + 1) : r * (q + 1) + (xcd - r) * q) + off; }
                valid = 1; pn = L & 3; st = L >> 2; cls = 0; while (cls < NCLS - 1 && ct[32 + cls + 1] <= st) ++cls; j = st - ct[32 + cls];
                const int g = cls / 6, pr = cls % 6; const int lo = pr < 3 ? 0 : (pr < 5 ? 1 : 2), hi = pr < 3 ? pr + 1 : (pr < 5 ? pr - 1 : 3); elo = 4 * g + lo; ehi = 4 * g + hi; }
            ud[i * 16 + 0] = valid; ud[i * 16 + 1] = st; ud[i * 16 + 2] = pn; ud[i * 16 + 3] = elo; ud[i * 16 + 4] = ehi; ud[i * 16 + 5] = cls; ud[i * 16 + 6] = j; } }
    __syncthreads();
    const int* list = (const int*)(p.ws + WS_LIST); const float* gates = wsf(p, WS_GATES);
    for (int i = 0; i < 4; ++i) { if (!ud[i * 16]) continue; const int cls = ud[i * 16 + 5], j = ud[i * 16 + 6], n = ct[cls];
        if (c.tid < 256) { const int pos = j * 256 + c.tid; int tok = -1; f32x2 g = {0.f, 0.f};
            if (pos < n) { tok = list[(size_t)cls * T + pos]; g = *(const f32x2*)(gates + (size_t)tok * 2); }
            rowtab[i * 256 + c.tid] = tok; gatetab[(i * 256 + c.tid) * 2] = g.x; gatetab[(i * 256 + c.tid) * 2 + 1] = g.y; } }
    __syncthreads();
}

__device__ __forceinline__ void phase_n2(const Params& p, const Ctx& c) {
    const int row0 = (c.bid * NWAVES + c.wave) * 16; if (row0 >= T) return; const int b = row0 >> 13;
    f32x4 P1[4], S1[4], P2[4], S2[4];
    load_mod(p, p.in[I_NORMG] + 2 * D, 2, b, c.lane, P1, S1); load_mod(p, p.in[I_KVNG], 4, b, c.lane, P2, S2);
    const float* X = p.out; bf16_t* h1 = wsb(p, WS_W0); bf16_t* hkv = wsb(p, WS_W1);
    for (int rr = 0, nr = (p.pad == 110) ? 32 : 16; rr < nr; ++rr) { const int r = rr & 15; const int row = row0 + r; f32x4 v[4], o[4]; load_row(X + (size_t)row * D, c.lane, v); const float rs = row_rstd(v);
#pragma unroll
        for (int j = 0; j < 4; ++j) { v[j] = v[j] * rs; o[j] = v[j] * P1[j] + S1[j]; }
        store_row_bf16(h1 + (size_t)row * D, c.lane, o);
#pragma unroll
        for (int j = 0; j < 4; ++j) o[j] = v[j] * P2[j] + S2[j];
        store_row_bf16(hkv + (size_t)row * D, c.lane, o); }
}
__device__ __forceinline__ void phase_final(const Params& p, const Ctx& c) {
    const int row0 = (c.bid * NWAVES + c.wave) * 16; if (row0 >= T) return;
    f32x4 g[4];
#pragma unroll
    for (int j = 0; j < 4; ++j) g[j] = *(const f32x4*)(p.in[I_FG] + 4 * c.lane + 256 * j);
    for (int r = 0; r < 16; ++r) { float* rowp = p.out + (size_t)(row0 + r) * D; f32x4 v[4]; load_row(rowp, c.lane, v); const float rs = row_rstd(v);
#pragma unroll
        for (int j = 0; j < 4; ++j) *(f32x4*)(rowp + 4 * c.lane + 256 * j) = v[j] * rs * g[j]; }
}
constexpr int AT_KSTR = 208;
constexpr int AT_KBUF = 64 * AT_KSTR, AT_VBUF = 8192;
constexpr float AT_THR = 6.0f;
__device__ __forceinline__ s16x4 vtr(const LAS unsigned char* pp) { typedef short v4i16_t __attribute__((ext_vector_type(4)));
    return __builtin_bit_cast(s16x4, __builtin_amdgcn_ds_read_tr16_b64_v4i16((LAS v4i16_t*)pp)); }
__device__ __forceinline__ void attn_unit(const Params& p, const Ctx& c, int b, int h, int qb) {
    const int tid = c.tid, lane = c.lane, wid = c.wave, r32 = lane & 31, hi = lane >> 5;
    const bf16_t* Q = wsb(p, WS_W2); const bf16_t* Kn = wsb(p, WS_W4); const bf16_t* V = wsb(p, WS_W5); const bf16_t* Kr = wsb(p, WS_KR); bf16_t* O = wsb(p, WS_W0);
    const size_t rowbase = (size_t)b * SEQ; const int q0 = qb * 256, qrow = q0 + 32 * wid + r32;
    LAS unsigned char* Kb = c.lds; LAS unsigned char* Vb = c.lds + 2 * AT_KBUF;
    bf16x8 qr[6];
#pragma unroll
    for (int d0 = 0; d0 < 6; ++d0) qr[d0] = *(const bf16x8*)(Q + (rowbase + qrow) * (NHEAD * QKD) + h * QKD + 16 * d0 + 8 * hi);
    const int NTL = (q0 + 256) / 64;
    const int lrow = tid >> 3, lch = tid & 7, lrow2 = (tid & 255) >> 2, lch2 = tid & 3;
    u32x4 kreg, vreg, rreg;
#define AT_LOAD(t) do { const size_t _r = rowbase + (size_t)(t) * 64; kreg = *(const u32x4*)(Kn + (_r + lrow) * D + h * HD + lch * 8); vreg = *(const u32x4*)(V + (_r + lrow) * D + h * HD + lch * 8); \
        if (tid < 256) rreg = *(const u32x4*)(Kr + (_r + lrow2) * ROPE + lch2 * 8); } while (0)
#define AT_STORE(buf) do { *(LAS u32x4*)(Kb + (buf) * AT_KBUF + lrow * AT_KSTR + lch * 16) = kreg; *(LAS u32x4*)(Vb + (buf) * AT_VBUF + (lch >> 2) * 4096 + lrow * 64 + (lch & 3) * 16) = vreg; \
        if (tid < 256) *(LAS u32x4*)(Kb + (buf) * AT_KBUF + lrow2 * AT_KSTR + 128 + lch2 * 16) = rreg; } while (0)
    AT_LOAD(0); AT_STORE(0);
#pragma unroll
    for (int d0 = 0; d0 < 6; ++d0) asm volatile("" : "+v"(qr[d0]));
    __syncthreads();
    f32x16 o0 = {}, o1 = {}; float mref = 0.f, lrun = 0.f;
    bf16x8 qx = {}; const bf16x8 kx = __builtin_bit_cast(bf16x8, (u32x4){hi ? 0u : 0x3F80u, 0u, 0u, 0u});
    const int vlane = ((lane >> 4) & 1) * 32 + (lane & 3) * 8 + (4 * hi + ((lane & 15) >> 2)) * 64;
    for (int t = 0; t < NTL; ++t) {
        const int buf = t & 1;
        if (t + 1 < NTL) AT_LOAD(t + 1);
        if (64 * t <= q0 + 32 * wid + 31) {
            const LAS unsigned char* kb = Kb + buf * AT_KBUF; const LAS unsigned char* vb = Vb + buf * AT_VBUF;
            bf16x8 kf0[6], kf1[6];
#pragma unroll
            for (int d0 = 0; d0 < 6; ++d0) { kf0[d0] = *(const LAS bf16x8*)(kb + r32 * AT_KSTR + d0 * 32 + hi * 16); kf1[d0] = *(const LAS bf16x8*)(kb + (32 + r32) * AT_KSTR + d0 * 32 + hi * 16); }
            __builtin_amdgcn_sched_barrier(0);
            f32x16 s0 = __builtin_amdgcn_mfma_f32_32x32x16_bf16(kx, qx, (f32x16){}, 0, 0, 0), s1 = s0;
#pragma unroll
            for (int d0 = 0; d0 < 6; ++d0) { s0 = __builtin_amdgcn_mfma_f32_32x32x16_bf16(kf0[d0], qr[d0], s0, 0, 0, 0); s1 = __builtin_amdgcn_mfma_f32_32x32x16_bf16(kf1[d0], qr[d0], s1, 0, 0, 0); }
            if (64 * t + 63 > q0 + 32 * wid) {
                const int kb0 = 64 * t + 4 * hi;
#pragma unroll
                for (int r = 0; r < 16; ++r) { const int kv = kb0 + (r & 3) + 8 * (r >> 2); if (kv > qrow) s0[r] = -INFINITY; if (kv + 32 > qrow) s1[r] = -INFINITY; } }
            float mx = fmaxf(s0[0], s1[0]);
#pragma unroll
            for (int r = 1; r < 16; ++r) mx = fmaxf(fmaxf(mx, s0[r]), s1[r]);
            mx = fmaxf(mx, __shfl_xor(mx, 32));
            if (t == 0 || __any(mx > AT_THR)) {
                const float want = mref + ((t == 0) ? mx : fmaxf(mx, 0.f)); const float mnew = bf2f((unsigned short)(cvtpk(want, 0.f) & 0xffffu)); const float dl = mnew - mref; mref = mnew;
                qx = __builtin_bit_cast(bf16x8, (u32x4){hi ? 0u : (cvtpk(-mnew, 0.f) & 0xffffu), 0u, 0u, 0u});
#pragma unroll
                for (int r = 0; r < 16; ++r) { s0[r] -= dl; s1[r] -= dl; }
                if (t != 0) { const float alpha = __builtin_amdgcn_exp2f(-dl); lrun *= alpha;
#pragma unroll
                    for (int r = 0; r < 16; ++r) { o0[r] *= alpha; o1[r] *= alpha; } } }
            float rs = 0.f;
#pragma unroll
            for (int r = 0; r < 16; ++r) { s0[r] = __builtin_amdgcn_exp2f(s0[r]); s1[r] = __builtin_amdgcn_exp2f(s1[r]); rs += s0[r] + s1[r]; }
            lrun += rs;
            u32x4 pw[4];
#pragma unroll
            for (int s = 0; s < 2; ++s) { pw[s] = (u32x4){cvtpk(s0[8 * s], s0[8 * s + 1]), cvtpk(s0[8 * s + 2], s0[8 * s + 3]), cvtpk(s0[8 * s + 4], s0[8 * s + 5]), cvtpk(s0[8 * s + 6], s0[8 * s + 7])};
                pw[2 + s] = (u32x4){cvtpk(s1[8 * s], s1[8 * s + 1]), cvtpk(s1[8 * s + 2], s1[8 * s + 3]), cvtpk(s1[8 * s + 4], s1[8 * s + 5]), cvtpk(s1[8 * s + 6], s1[8 * s + 7])}; }
            s16x4 va0[4], va1[4], vc0[4], vc1[4];
#pragma unroll
            for (int s = 0; s < 4; ++s) { va0[s] = vtr(vb + vlane + s * 1024); va1[s] = vtr(vb + vlane + s * 1024 + 512); vc0[s] = vtr(vb + 4096 + vlane + s * 1024); vc1[s] = vtr(vb + 4096 + vlane + s * 1024 + 512); }
            __builtin_amdgcn_sched_barrier(0);
#pragma unroll
            for (int s = 0; s < 4; ++s) { const bf16x8 pb = __builtin_bit_cast(bf16x8, pw[s]);
                const bf16x8 va = {va0[s][0], va0[s][1], va0[s][2], va0[s][3], va1[s][0], va1[s][1], va1[s][2], va1[s][3]}, vc = {vc0[s][0], vc0[s][1], vc0[s][2], vc0[s][3], vc1[s][0], vc1[s][1], vc1[s][2], vc1[s][3]};
                o0 = __builtin_amdgcn_mfma_f32_32x32x16_bf16(va, pb, o0, 0, 0, 0); o1 = __builtin_amdgcn_mfma_f32_32x32x16_bf16(vc, pb, o1, 0, 0, 0); }
        }
        if (t + 1 < NTL) AT_STORE(buf ^ 1);
        __syncthreads();
    }
    lrun += __shfl_xor(lrun, 32); const float inv = 1.0f / lrun;
    bf16_t* orow = O + (rowbase + qrow) * D + h * HD;
#pragma unroll
    for (int g = 0; g < 4; ++g) { const f32x4 x0 = {o0[4 * g] * inv, o0[4 * g + 1] * inv, o0[4 * g + 2] * inv, o0[4 * g + 3] * inv}, x1 = {o1[4 * g] * inv, o1[4 * g + 1] * inv, o1[4 * g + 2] * inv, o1[4 * g + 3] * inv};
        *(u32x2*)(orow + 8 * g + 4 * hi) = pack4(x0); *(u32x2*)(orow + 32 + 8 * g + 4 * hi) = pack4(x1); }
#undef AT_LOAD
#undef AT_STORE
}
__device__ __forceinline__ void phase_attention(const Params& p, const Ctx& c) {
    const int v = (c.G % 8 == 0) ? (c.bid % 8) * (c.G / 8) + c.bid / 8 : c.bid; const int bh = v >> 2, s = v & 3;
    if (bh >= NB * NHEAD) return;
    for (int ii = 0, ni = (p.pad == 113) ? 16 : 8; ii < ni; ++ii) { const int i = ii & 7; const int qb = 8 * (i >> 1) + ((i & 1) ? 7 - s : s); attn_unit(p, c, bh >> 4, bh & 15, qb); }
}
constexpr int W32_NCH = SEQ / 32;
struct Pk { u32x4 f[2]; };
__device__ __forceinline__ Pk pk_tile(const f32x16& t) { Pk p;
#pragma unroll
    for (int s = 0; s < 2; ++s) p.f[s] = (u32x4){cvtpk(t[8 * s], t[8 * s + 1]), cvtpk(t[8 * s + 2], t[8 * s + 3]), cvtpk(t[8 * s + 4], t[8 * s + 5]), cvtpk(t[8 * s + 6], t[8 * s + 7])};
    return p; }
__device__ __forceinline__ f32x16 unpk_tile(const Pk& p) { f32x16 t;
#pragma unroll
    for (int s = 0; s < 2; ++s) { t[8 * s] = bflo(p.f[s].x); t[8 * s + 1] = bfhi(p.f[s].x); t[8 * s + 2] = bflo(p.f[s].y); t[8 * s + 3] = bfhi(p.f[s].y); t[8 * s + 4] = bflo(p.f[s].z); t[8 * s + 5] = bfhi(p.f[s].z); t[8 * s + 6] = bflo(p.f[s].w); t[8 * s + 7] = bfhi(p.f[s].w); }
    return t; }
__device__ __forceinline__ f32x16 mma2(f32x16 acc, const Pk& p2, const Pk& p1) {
#pragma unroll
    for (int s = 0; s < 2; ++s) acc = __builtin_amdgcn_mfma_f32_32x32x16_bf16(__builtin_bit_cast(bf16x8, p2.f[s]), __builtin_bit_cast(bf16x8, p1.f[s]), acc, 0, 0, 0);
    return acc; }
__device__ __forceinline__ Pk tri_pk(int t, int hi, int strict) { Pk p;
#pragma unroll
    for (int s = 0; s < 2; ++s) { unsigned w[4];
#pragma unroll
        for (int d = 0; d < 4; ++d) { const int k0 = 16 * s + 8 * (d >> 1) + 4 * hi + 2 * (d & 1) + strict; w[d] = (k0 <= t ? 0x3F80u : 0u) | (k0 + 1 <= t ? 0x3F800000u : 0u); }
        p.f[s] = (u32x4){w[0], w[1], w[2], w[3]}; }
    return p; }
__device__ __forceinline__ Pk ident_pk(int x, int hi) { Pk p;
#pragma unroll
    for (int s = 0; s < 2; ++s) { unsigned w[4];
#pragma unroll
        for (int d = 0; d < 4; ++d) { const int k0 = 16 * s + 8 * (d >> 1) + 4 * hi + 2 * (d & 1); w[d] = (k0 == x ? 0x3F80u : 0u) | (k0 + 1 == x ? 0x3F800000u : 0u); }
        p.f[s] = (u32x4){w[0], w[1], w[2], w[3]}; }
    return p; }
__device__ __forceinline__ bf16x8 glbfrag(const bf16_t* M, int ld, int row, int s, int hi) { return *(const bf16x8*)(M + (size_t)row * ld + 16 * s + 8 * hi); }
#define LDS_BARRIER() do { asm volatile("s_waitcnt lgkmcnt(0)" ::: "memory"); __builtin_amdgcn_s_barrier(); asm volatile("" ::: "memory"); } while (0)
#define W32_Y(r) (((r) & 3) + 8 * ((r) >> 2) + 4 * hi)
constexpr size_t WU = 64 * 64;

#define W32_YQ(r) (((r) & 3) + 8 * ((r) >> 2) + 4 * hq)
__device__ __forceinline__ void phase_wkv_a(const Params& p, const Ctx& c) {
    const int lane = c.lane, r32 = lane & 31, hi = lane >> 5;
    LAS float* cst = (LAS float*)c.lds;
    for (int i = c.tid; i < D; i += NTHREADS) { cst[i] = p.in[I_A0][i]; cst[D + i] = p.in[I_KK][i]; cst[2 * D + i] = p.in[I_KA][i]; cst[3 * D + i] = p.in[I_RK][i]; cst[4 * D + i] = p.in[I_W0][i]; }
    __syncthreads();
    bf16_t* Rg = wsb(p, WS_W3); bf16_t* Kg = wsb(p, WS_W4); const bf16_t* Vg = wsb(p, WS_W5); const bf16_t* L1 = wsb(p, WS_W6);
    const bf16_t* W2T = wsb(p, WS_W2T); const bf16_t* A2T = wsb(p, WS_A2T);
    bf16_t* PTg = wsb(p, WS_W0); bf16_t* Zg = (bf16_t*)p.out; bf16_t* QTg = wsb(p, WS_W2); float* bsg = wsf(p, WS_BSUM);
    const int gw = c.bid * NWAVES + c.wave;
    for (int uu2 = (p.pad == 1) ? -8 : 0; uu2 < 8; ++uu2) { const int uu = uu2 & 7; const bool dry = uu2 < 0;
        int unit_ = gw * 8 + uu; asm volatile("" : "+s"(unit_));
        const int unit = unit_, bh = unit >> 8, chunk = unit & 255, b = bh >> 4, h = bh & 15;
        int hq = hi; asm volatile("" : "+v"(hq));
        const size_t row0 = (size_t)b * SEQ + (size_t)chunk * 32, tok = row0 + r32;
        const size_t tokoff = tok * D + h * 64 + 4 * hi; bf16_t* rp = Rg + tokoff; bf16_t* kp = Kg + tokoff; const bf16_t* vp = Vg + tokoff;
        const LAS float* cp = cst + h * 64 + 4 * hi;
        const bf16_t* l1p = L1 + tok * 256 + 8 * hi;
        float ss = 0.f;
#pragma unroll
        for (int yt = 0; yt < 2; ++yt)
#pragma unroll
            for (int q = 0; q < 4; ++q) { const u32x2 kw = *(const u32x2*)(kp + 32 * yt + 8 * q); const f32x4 kc = *(const LAS f32x4*)(cp + D + 32 * yt + 8 * q);
                const float k0 = bflo(kw.x) * kc[0], k1 = bfhi(kw.x) * kc[1], k2 = bflo(kw.y) * kc[2], k3 = bfhi(kw.y) * kc[3]; ss += (k0 * k0 + k1 * k1) + (k2 * k2 + k3 * k3); }
        ss += __shfl_xor(ss, 32); const float inrm = frcp(fmaxf(__builtin_amdgcn_sqrtf(ss), 1e-12f));
        float bs = 0.f, cwC[2];
        LAS unsigned char* park = c.lds + 5 * D * 4 + c.wave * 16384 + lane * 16;
#define PARK_ST(mat, yt_, fr, v) (*(LAS u32x4*)(park + (((mat) * 2 + (yt_)) * 2 + (fr)) * 1024) = (v))
#define PARK_LD(mat, yt_) Pk{{*(const LAS u32x4*)(park + (((mat) * 2 + (yt_)) * 2) * 1024), *(const LAS u32x4*)(park + (((mat) * 2 + (yt_)) * 2 + 1) * 1024)}}
#pragma unroll
        for (int yt = 0; yt < 2; ++yt) {
            Pk ldh, ldl;
            { const bf16_t* w2p = W2T + (size_t)(h * 64 + 32 * yt + r32) * 64 + 8 * hi; bf16x8 w2[4], fw[4];
#pragma unroll
              for (int s = 0; s < 4; ++s) { w2[s] = *(const bf16x8*)(w2p + 16 * s); fw[s] = *(const bf16x8*)(l1p + 16 * s); }
              f32x16 ldt = {};
#pragma unroll
              for (int s = 0; s < 4; ++s) ldt = __builtin_amdgcn_mfma_f32_32x32x16_bf16(fw[s], w2[s], ldt, 0, 0, 0);
              const float w0c = cst[4 * D + h * 64 + 32 * yt + r32]; f32x16 vh, vl; float sum = 0.f;
#pragma unroll
              for (int r = 0; r < 16; ++r) { const float x = -(w0c + ldt[r]); const float sp = fmaxf(x, 0.f) + __logf(1.0f + fexp(-fabsf(x))); const float ld = -fexp(-sp - 0.5f) * 1.4426950408889634f;
                  const float lh = bf2f((unsigned short)(cvtpk(ld, 0.f) & 0xffffu)); vh[r] = lh; vl[r] = ld - lh; sum += ld; }
              sum += __shfl_xor(sum, 32); cwC[yt] = fexp2(sum); ldh = pk_tile(vh); ldl = pk_tile(vl); }
            __builtin_amdgcn_sched_barrier(0);
            int tq = r32; asm volatile("" : "+v"(tq));
            const Pk tri = tri_pk(tq, hq, 0), tris = tri_pk(tq, hq, 1);
            const f32x16 cl = mma2(mma2((f32x16){}, ldh, tri), ldl, tri), cle = mma2(mma2((f32x16){}, ldh, tris), ldl, tris);
            __builtin_amdgcn_sched_barrier(0);
            f32x16 aTL = {};
            { const bf16_t* a2p = A2T + (size_t)(h * 64 + 32 * yt + r32) * 64 + 8 * hi; bf16x8 a2[4], fa[4];
#pragma unroll
              for (int s = 0; s < 4; ++s) { a2[s] = *(const bf16x8*)(a2p + 16 * s); fa[s] = *(const bf16x8*)(l1p + 64 + 16 * s); }
#pragma unroll
              for (int s = 0; s < 4; ++s) aTL = __builtin_amdgcn_mfma_f32_32x32x16_bf16(a2[s], fa[s], aTL, 0, 0, 0); }
            u32x2 rr[4], kk[4];
#pragma unroll
            for (int q = 0; q < 4; ++q) { rr[q] = *(const u32x2*)(rp + 32 * yt + 8 * q); kk[q] = *(const u32x2*)(kp + 32 * yt + 8 * q); }
            __builtin_amdgcn_sched_barrier(0);
            u32x4 fA, fB, fK, fR;
#pragma unroll
            for (int q = 0; q < 4; ++q) { const int c0 = 32 * yt + 8 * q;
                const f32x4 a0 = *(const LAS f32x4*)(cp + c0), kkc = *(const LAS f32x4*)(cp + D + c0), kac = *(const LAS f32x4*)(cp + 2 * D + c0), rkc = *(const LAS f32x4*)(cp + 3 * D + c0);
                const float kv[4] = {bflo(kk[q].x), bfhi(kk[q].x), bflo(kk[q].y), bfhi(kk[q].y)}, rv[4] = {bflo(rr[q].x), bfhi(rr[q].x), bflo(rr[q].y), bfhi(rr[q].y)};
                float at[4], bt[4], kt[4], rt[4];
#pragma unroll
                for (int i = 0; i < 4; ++i) { const int r = 4 * q + i; const float a = sigmoidf_(a0[i] + aTL[r]); const float kkv = kv[i] * kkc[i] * inrm, km = kv[i] * (1.0f + (a - 1.0f) * kac[i]);
                    const float cw = fexp2(cl[r]), cwm1 = fexp2(cle[r]), icw = fexp2(-cl[r]);
                    at[i] = -kkv * cwm1; bt[i] = kkv * a * icw; kt[i] = km * icw; rt[i] = rv[i] * cw; bs += rv[i] * km * rkc[i]; }
                if (q & 1) { fA.z = cvtpk(at[0], at[1]); fA.w = cvtpk(at[2], at[3]); fB.z = cvtpk(bt[0], bt[1]); fB.w = cvtpk(bt[2], bt[3]); fK.z = cvtpk(kt[0], kt[1]); fK.w = cvtpk(kt[2], kt[3]); fR.z = cvtpk(rt[0], rt[1]); fR.w = cvtpk(rt[2], rt[3]);
                             PARK_ST(0, yt, q >> 1, fA); PARK_ST(1, yt, q >> 1, fB); PARK_ST(2, yt, q >> 1, fK); PARK_ST(3, yt, q >> 1, fR); }
                else       { fA.x = cvtpk(at[0], at[1]); fA.y = cvtpk(at[2], at[3]); fB.x = cvtpk(bt[0], bt[1]); fB.y = cvtpk(bt[2], bt[3]); fK.x = cvtpk(kt[0], kt[1]); fK.y = cvtpk(kt[2], kt[3]); fR.x = cvtpk(rt[0], rt[1]); fR.y = cvtpk(rt[2], rt[3]); } }
            __builtin_amdgcn_sched_barrier(0); }
        bs += __shfl_xor(bs, 32);
        if (hi == 0 && !dry) bsg[tok * NHEAD + h] = bs;
        __builtin_amdgcn_sched_barrier(0);
#define W32_SB() __builtin_amdgcn_sched_barrier(0)
        int rq = r32; asm volatile("" : "+v"(rq));
        f32x16 MN = {}, MT = {}, X2 = {}; Pk pMbr, pMkr;
        asm volatile("s_waitcnt lgkmcnt(0)" ::: "memory");
        { const Pk a0_ = PARK_LD(0, 0), a1_ = PARK_LD(0, 1), b0_ = PARK_LD(1, 0), b1_ = PARK_LD(1, 1);
        MN = mma2(mma2(MN, a0_, b0_), a1_, b1_);
#pragma unroll
        for (int r = 0; r < 16; ++r) if (!(rq < W32_YQ(r))) MN[r] = 0.f;
        W32_SB();
        MT = mma2(mma2(MT, b0_, a0_), b1_, a1_); }
#pragma unroll
        for (int r = 0; r < 16; ++r) if (!(W32_YQ(r) < rq)) MT[r] = 0.f;
        W32_SB();
        { const Pk a0_ = PARK_LD(0, 0), a1_ = PARK_LD(0, 1), k0_ = PARK_LD(2, 0), k1_ = PARK_LD(2, 1);
        X2 = mma2(mma2(X2, a0_, k0_), a1_, k1_); }
#pragma unroll
        for (int r = 0; r < 16; ++r) if (!(rq < W32_YQ(r))) X2[r] = 0.f;
        W32_SB();
        { const Pk b0_ = PARK_LD(1, 0), b1_ = PARK_LD(1, 1), r0_ = PARK_LD(3, 0), r1_ = PARK_LD(3, 1);
          f32x16 m = mma2(mma2((f32x16){}, b0_, r0_), b1_, r1_);
#pragma unroll
          for (int r = 0; r < 16; ++r) if (!(W32_YQ(r) <= rq)) m[r] = 0.f;
          pMbr = pk_tile(m); }
        W32_SB();
        { const Pk k0_ = PARK_LD(2, 0), k1_ = PARK_LD(2, 1), r0_ = PARK_LD(3, 0), r1_ = PARK_LD(3, 1);
          f32x16 m = mma2(mma2((f32x16){}, k0_, r0_), k1_, r1_);
#pragma unroll
          for (int r = 0; r < 16; ++r) if (!(W32_YQ(r) <= rq)) m[r] = 0.f;
          pMkr = pk_tile(m); }
        W32_SB();
        const Pk idn = ident_pk(rq, hq);
        f32x16 X0 = mma2((f32x16){}, PARK_LD(0, 0), idn), X1 = mma2((f32x16){}, PARK_LD(0, 1), idn);
        W32_SB();
#define PARK_PK(mat, yt_, pk) do { const Pk _p = (pk); PARK_ST(mat, yt_, 0, _p.f[0]); PARK_ST(mat, yt_, 1, _p.f[1]); } while (0)
#pragma unroll
        for (int xt = 0; xt < 2; ++xt) {
            { const Pk t = pk_tile(mma2((f32x16){}, PARK_LD(1, xt), idn)); PARK_PK(1, xt, t); } W32_SB();
            { const Pk t = pk_tile(mma2((f32x16){}, PARK_LD(2, xt), idn)); PARK_PK(2, xt, t); } W32_SB();
            { u32x2 vv[4];
#pragma unroll
              for (int q = 0; q < 4; ++q) vv[q] = *(const u32x2*)(vp + 32 * xt + 8 * q);
              Pk pV; pV.f[0] = (u32x4){vv[0].x, vv[0].y, vv[1].x, vv[1].y}; pV.f[1] = (u32x4){vv[2].x, vv[2].y, vv[3].x, vv[3].y};
              const Pk t = pk_tile(mma2((f32x16){}, pV, idn)); PARK_PK(0, xt, t); } W32_SB(); }
        __builtin_amdgcn_sched_barrier(0);
#pragma unroll
        for (int kq = 0; kq < 5; ++kq) { const Pk pMN = pk_tile(MN), pMT = pk_tile(MT);
            X0 = mma2(X0, pMT, pk_tile(X0)); X1 = mma2(X1, pMT, pk_tile(X1)); X2 = mma2(X2, pMT, pk_tile(X2));
            if (kq < 4) { MN = mma2((f32x16){}, pMT, pMN); MT = mma2((f32x16){}, pMN, pMT); } }
        const Pk pW1[2] = {pk_tile(X0), pk_tile(X1)}, pW2 = pk_tile(X2);
        __builtin_amdgcn_sched_barrier(0);
        bf16_t* ptp = PTg + (size_t)unit * WU + lane * 4; bf16_t* zp = Zg + (size_t)unit * WU + lane * 4; bf16_t* qtp = QTg + (size_t)unit * 2048 + lane * 4;
        Pk pGT[2];
#pragma unroll
        for (int xt = 0; xt < 2; ++xt) {
#pragma unroll
            for (int yt = 0; yt < 2; ++yt) { f32x16 m = mma2((f32x16){}, pW1[yt], PARK_LD(1, xt));
#pragma unroll
                for (int r = 0; r < 16; ++r) m[r] = cwC[xt] * (m[r] + ((xt == yt && W32_YQ(r) == rq) ? 1.0f : 0.0f));
#pragma unroll
                for (int q = 0; q < 4; ++q) if (!dry) *(u32x2*)(ptp + ((xt * 2 + yt) * 4 + q) * 256) = pack4((f32x4){m[4 * q], m[4 * q + 1], m[4 * q + 2], m[4 * q + 3]}); }
            f32x16 g = mma2(unpk_tile(PARK_LD(2, xt)), pW2, PARK_LD(1, xt));
#pragma unroll
            for (int r = 0; r < 16; ++r) g[r] *= cwC[xt];
            pGT[xt] = pk_tile(g); }
        const Pk pHT = pk_tile(mma2(unpk_tile(pMkr), pW2, pMbr));
#pragma unroll
        for (int yt = 0; yt < 2; ++yt) {
            const f32x16 qv = mma2(unpk_tile(PARK_LD(3, yt)), pW1[yt], pMbr);
            const f32x16 yl = mma2((f32x16){}, PARK_LD(0, yt), pHT);
#pragma unroll
            for (int q = 0; q < 4; ++q) { if (dry) continue;
                *(u32x2*)(qtp + (yt * 4 + q) * 256) = pack4((f32x4){qv[4 * q], qv[4 * q + 1], qv[4 * q + 2], qv[4 * q + 3]}); *(u32x2*)(rp + 32 * yt + 8 * q) = pack4((f32x4){yl[4 * q], yl[4 * q + 1], yl[4 * q + 2], yl[4 * q + 3]}); } }
#pragma unroll
        for (int xt = 0; xt < 2; ++xt)
#pragma unroll
            for (int yt = 0; yt < 2; ++yt) { const f32x16 z = mma2((f32x16){}, pGT[yt], PARK_LD(0, xt));
#pragma unroll
                for (int q = 0; q < 4; ++q) if (!dry) *(u32x2*)(zp + ((xt * 2 + yt) * 4 + q) * 256) = pack4((f32x4){z[4 * q], z[4 * q + 1], z[4 * q + 2], z[4 * q + 3]}); }
    }
}

constexpr int WKB_MAT = 8192, WKB_SLOT = 2 * WKB_MAT;
__device__ __forceinline__ void phase_wkv_b(const Params& p, const Ctx& c) {
    if (c.bid >= NB * NHEAD) {
        LAS float* scr = (LAS float*)(c.lds + RING_OFF + c.wave * 16384);
        const int gw = (c.bid - NB * NHEAD) * NWAVES + c.wave, NGW = (c.G - NB * NHEAD) * NWAVES;
        constexpr int NM = 256 + 256 + 288 + 256 + 512;
        for (int it = gw; it < NM + 16 * 384; it += NGW) { int r = it;
            if (r < NM) { if (tjob(p, r, 5, 0, WS_DKV, 1024, 512, scr, c.lane)) continue; if (tjob(p, r, 6, 0, WS_DQ, 1024, 512, scr, c.lane)) continue; if (tjob(p, r, 7, 0, WS_UQ, 384, 1536, scr, c.lane)) continue;
                if (tjob(p, r, 8, 0, WS_UKV, 256, 2048, scr, c.lane)) continue; tjob(p, r, 9, 0, WS_MWO, 1024, 1024, scr, c.lane); continue; }
            r -= NM; const int e = r / 384; r = r % 384;
            if (r < 256) transpose_item(p, 10, 16 + e, wsb(p, WS_WGU1) + (size_t)e * 512 * 1024, 1024, scr, r / 16, r % 16, c.lane);
            else { r -= 256; transpose_item(p, 11, 16 + e, wsb(p, WS_WDN1) + (size_t)e * 1024 * 256, 256, scr, r / 32, r % 32, c.lane); } }
        return; }
    const int lane = c.lane, r32 = lane & 31, hi = lane >> 5, bh = c.bid, xt = c.wave & 1; const bool comp = c.wave < 2;
    bf16_t* PTg = wsb(p, WS_W0) + (size_t)bh * W32_NCH * WU; const bf16_t* Zg = (const bf16_t*)p.out + (size_t)bh * W32_NCH * WU;
    LAS unsigned char* ring = c.lds;
    const int ll = c.tid - 128;
    u32x4 ra[3], rb[3], rc[3], rd[3];
#define WKB_ISSUE(R, ch) do { if (!comp && (ch) < W32_NCH) { _Pragma("unroll") for (int k = 0; k < 3; ++k) { const int id = ll + 384 * k; if (id < 1024) { const int mat = id >> 9, e8 = (id & 511) * 8; \
        R[k] = *(const u32x4*)((mat ? Zg : (const bf16_t*)PTg) + (size_t)(ch) * WU + e8); } } } } while (0)
#define WKB_PUT(R, ch) do { if (!comp && (ch) < W32_NCH) { _Pragma("unroll") for (int k = 0; k < 3; ++k) { const int id = ll + 384 * k; if (id < 1024) { *(LAS u32x4*)(ring + ((ch) & 1) * WKB_SLOT + id * 16) = R[k]; } } } } while (0)
    f32x16 S0 = {}, S1 = {};
    bool dryb = false;
#define WKB_STEP(ch) do { if (comp) { const LAS unsigned char* sl = ring + ((ch) & 1) * WKB_SLOT + lane * 8; bf16x8 bf[4]; bf16_t* sg = PTg + (size_t)(ch) * WU + lane * 4; \
        _Pragma("unroll") for (int s = 0; s < 4; ++s) { const f32x16& St = (s >> 1) ? S1 : S0; const int r0 = 8 * (s & 1); \
            u32x4 wv; wv.x = cvtpk(St[r0], St[r0 + 1]); wv.y = cvtpk(St[r0 + 2], St[r0 + 3]); wv.z = cvtpk(St[r0 + 4], St[r0 + 5]); wv.w = cvtpk(St[r0 + 6], St[r0 + 7]); bf[s] = __builtin_bit_cast(bf16x8, wv); \
            if (!dryb) { *(u32x2*)(sg + ((xt * 2 + (s >> 1)) * 4 + 2 * (s & 1)) * 256) = (u32x2){wv.x, wv.y}; *(u32x2*)(sg + ((xt * 2 + (s >> 1)) * 4 + 2 * (s & 1) + 1) * 256) = (u32x2){wv.z, wv.w}; } } \
        f32x16 n0, n1; \
        _Pragma("unroll") for (int q = 0; q < 4; ++q) { const u32x2 z0 = *(const LAS u32x2*)(sl + WKB_MAT + ((xt * 2 + 0) * 4 + q) * 512), z1 = *(const LAS u32x2*)(sl + WKB_MAT + ((xt * 2 + 1) * 4 + q) * 512); \
            n0[4 * q] = bflo(z0.x); n0[4 * q + 1] = bfhi(z0.x); n0[4 * q + 2] = bflo(z0.y); n0[4 * q + 3] = bfhi(z0.y); n1[4 * q] = bflo(z1.x); n1[4 * q + 1] = bfhi(z1.x); n1[4 * q + 2] = bflo(z1.y); n1[4 * q + 3] = bfhi(z1.y); } \
        _Pragma("unroll") for (int s = 0; s < 4; ++s) { const int pq = ((s >> 1) * 4 + 2 * (s & 1)) * 512; \
            const u32x2 p00 = *(const LAS u32x2*)(sl + pq), p01 = *(const LAS u32x2*)(sl + pq + 512), p10 = *(const LAS u32x2*)(sl + 8 * 512 + pq), p11 = *(const LAS u32x2*)(sl + 8 * 512 + pq + 512); \
            n0 = __builtin_amdgcn_mfma_f32_32x32x16_bf16(__builtin_bit_cast(bf16x8, (u32x4){p00.x, p00.y, p01.x, p01.y}), bf[s], n0, 0, 0, 0); \
            n1 = __builtin_amdgcn_mfma_f32_32x32x16_bf16(__builtin_bit_cast(bf16x8, (u32x4){p10.x, p10.y, p11.x, p11.y}), bf[s], n1, 0, 0, 0); } \
        S0 = n0; S1 = n1; } } while (0)
    for (int repb = (p.pad == 104) ? -1 : 0; repb < 1; ++repb) { dryb = repb < 0; S0 = (f32x16){}; S1 = (f32x16){};
    WKB_ISSUE(ra, 0); WKB_ISSUE(rb, 1); WKB_ISSUE(rc, 2); WKB_ISSUE(rd, 3);
    WKB_PUT(ra, 0); WKB_ISSUE(ra, 4);
    LDS_BARRIER();
    for (int ch = 0; ch < W32_NCH; ch += 4) {
        WKB_PUT(rb, ch + 1); WKB_ISSUE(rb, ch + 5); WKB_STEP(ch);     LDS_BARRIER();
        WKB_PUT(rc, ch + 2); WKB_ISSUE(rc, ch + 6); WKB_STEP(ch + 1); LDS_BARRIER();
        WKB_PUT(rd, ch + 3); WKB_ISSUE(rd, ch + 7); WKB_STEP(ch + 2); LDS_BARRIER();
        WKB_PUT(ra, ch + 4); WKB_ISSUE(ra, ch + 8); WKB_STEP(ch + 3); LDS_BARRIER();
    } }
#undef WKB_ISSUE
#undef WKB_PUT
#undef WKB_STEP
}

__device__ __forceinline__ void phase_wkv_c(const Params& p, const Ctx& c) {
    const int lane = c.lane, r32 = lane & 31, hi = lane >> 5;
    const bf16_t* QTg = wsb(p, WS_W2); bf16_t* YLg = wsb(p, WS_W3); const bf16_t* Sg = wsb(p, WS_W0);
    const bf16_t* Vg = wsb(p, WS_W5); const bf16_t* L1 = wsb(p, WS_W6); const bf16_t* G2T = wsb(p, WS_G2T); const float* bsg = wsf(p, WS_BSUM); bf16_t* YG = YLg;
    for (int unit0 = c.bid * NWAVES + c.wave, nun = NB * NHEAD * W32_NCH * ((p.pad == 105) ? 2 : 1); unit0 < nun; unit0 += c.G * NWAVES) { const int unit = unit0 & (NB * NHEAD * W32_NCH - 1); const bool dryc = (p.pad == 105) && unit0 < NB * NHEAD * W32_NCH;
        const int bh = unit >> 8, chunk = unit & 255, b = bh >> 4, h = bh & 15;
        const size_t row = (size_t)b * SEQ + (size_t)chunk * 32 + r32;
        const bf16_t* sc = Sg + (size_t)unit * WU + lane * 4; const bf16_t* qtp = QTg + (size_t)unit * 2048 + lane * 4;
        f32x16 y[2], g[2];
#pragma unroll
        for (int yt = 0; yt < 2; ++yt) {
#pragma unroll
            for (int q = 0; q < 4; ++q) { const u32x2 wv = *(const u32x2*)(YLg + row * D + h * 64 + 32 * yt + 8 * q + 4 * hi);
                y[yt][4 * q] = bflo(wv.x); y[yt][4 * q + 1] = bfhi(wv.x); y[yt][4 * q + 2] = bflo(wv.y); y[yt][4 * q + 3] = bfhi(wv.y); }
#pragma unroll
            for (int s = 0; s < 4; ++s) { const int pq = ((s >> 1) * 4 + 2 * (s & 1)) * 256; const u32x2 a0 = *(const u32x2*)(sc + yt * 2048 + pq), a1 = *(const u32x2*)(sc + yt * 2048 + pq + 256), b0 = *(const u32x2*)(qtp + pq), b1 = *(const u32x2*)(qtp + pq + 256);
                y[yt] = __builtin_amdgcn_mfma_f32_32x32x16_bf16(__builtin_bit_cast(bf16x8, (u32x4){a0.x, a0.y, a1.x, a1.y}), __builtin_bit_cast(bf16x8, (u32x4){b0.x, b0.y, b1.x, b1.y}), y[yt], 0, 0, 0); }
            g[yt] = (f32x16){};
#pragma unroll
            for (int s = 0; s < 8; ++s) g[yt] = __builtin_amdgcn_mfma_f32_32x32x16_bf16(glbfrag(G2T, 128, h * 64 + 32 * yt + r32, s, hi), glbfrag(L1 + 128, 256, (int)row, s, hi), g[yt], 0, 0, 0);
        }
        float sm = 0.f;
#pragma unroll
        for (int r = 0; r < 16; ++r) sm += y[0][r] + y[1][r];
        sm += __shfl_xor(sm, 32); const float mean = sm * (1.0f / 64.0f);
        float q2 = 0.f;
#pragma unroll
        for (int r = 0; r < 16; ++r) { const float d0 = y[0][r] - mean, d1 = y[1][r] - mean; q2 += d0 * d0 + d1 * d1; }
        q2 += __shfl_xor(q2, 32); const float rstd = rsqrtf(q2 * (1.0f / 64.0f) + GN_EPS);
        const float bsum = bsg[row * NHEAD + h];
#pragma unroll
        for (int yt = 0; yt < 2; ++yt)
#pragma unroll
            for (int q = 0; q < 4; ++q) { const int ch = h * 64 + 32 * yt + 8 * q + 4 * hi; const f32x4 lw = *(const f32x4*)(p.in[I_LNW] + ch), lb = *(const f32x4*)(p.in[I_LNB] + ch);
                const u32x2 vw = *(const u32x2*)(Vg + row * D + ch); const f32x4 vv = {bflo(vw.x), bfhi(vw.x), bflo(vw.y), bfhi(vw.y)}; f32x4 o;
#pragma unroll
                for (int i = 0; i < 4; ++i) o[i] = ((y[yt][4 * q + i] - mean) * rstd * lw[i] + lb[i] + bsum * vv[i]) * g[yt][4 * q + i];
                if (!dryc) *(u32x2*)(YG + row * D + ch) = pack4(o); }
    }
}
#undef W32_Y
#ifndef WKA_PROBE
#define WKA_PROBE 0
#endif
#ifndef MK_N_LAUNCHES
#define MK_N_LAUNCHES 1
#endif
constexpr int N_PHASES = 19;
constexpr int N_LAUNCHES = MK_N_LAUNCHES;


__global__ void __launch_bounds__(NTHREADS, 2) fwd_kernel(Params p) {
    extern __shared__ __attribute__((aligned(16))) unsigned char lds_raw[];
    Ctx c; c.lds = (LAS unsigned char*)lds_raw; c.tid = threadIdx.x; c.lane = c.tid & 63; c.wave = __builtin_amdgcn_readfirstlane(c.tid >> 6); c.G = gridDim.x; c.bid = blockIdx.x;
    volatile LAS unsigned* MISC = (volatile LAS unsigned*)(c.lds + MISC_OFF);
    if (c.tid < 64) ((LAS unsigned*)(c.lds + MISC_OFF))[c.tid] = 0u;
    __syncthreads();
    unsigned* ctl = (unsigned*)(p.ws + WS_CTL);
    XcdBarrier bar; bar.bar = ctl + CW_BAR; bar.x = 0; bar.st = nullptr;
    if (N_LAUNCHES == 1) bar = xcd_barrier_post(ctl + CW_BAR, MISC + 8);
    const int lo = p.ph_lo, hi = p.ph_hi;
#ifndef PH_MASK
#define PH_MASK 0x7ffff
#endif
#ifndef PROBE_DUP_EARLY
#define PROBE_DUP_EARLY -1
#endif
#define PHASE_ID 0
#define IN(k) ((((PH_MASK) >> (k)) & 1) && lo <= (k) && (k) < hi)
#define SEAM(k) do { if (IN(k) && IN((k) + 1)) xcd_barrier(bar); } while (0)
    LAS unsigned char* ring = c.lds + RING_OFF;

    if (IN(0)) { phase_prologue(p, c); } SEAM(0);
    if (IN(1)) { phase_n0(p, c); } SEAM(1);
    if (IN(2)) {
#undef PHASE_ID
#define PHASE_ID 2
        { DenseSched S; S.init((const bf16_t*)p.out, D, wsb(p, WS_LD), 2048, T, 256, 2048, c.G, c.bid); S.rep = (p.pad == 100 + PHASE_ID) ? 2 : 1; S.pad = 1; S.nt0 = 16; S.a1d = -(long)(D * 2); S.b1d = 1024 * 2;
          EpiLoraDown E{wsb(p, WS_W6)}; pg8::gemm_phase<EpiLoraDown, DenseSched, false>(ring, S, E, D, 2048); }
        { DenseSched S; S.init(wsb(p, WS_W0), D, wsb(p, WS_WR), D, T, D, D, c.G, c.bid); S.rep = (p.pad == 100 + PHASE_ID) ? 2 : 1; EpiBf16 E{wsb(p, WS_W3), D}; pg8::gemm_phase<EpiBf16, DenseSched, false>(ring, S, E, D, D); }
        { DenseSched S; S.init(wsb(p, WS_W1), D, wsb(p, WS_WK), D, T, D, D, c.G, c.bid); S.rep = (p.pad == 100 + PHASE_ID) ? 2 : 1; EpiBf16 E{wsb(p, WS_W4), D}; pg8::gemm_phase<EpiBf16, DenseSched, false>(ring, S, E, D, D); }
        { DenseSched S; S.init(wsb(p, WS_W2), D, wsb(p, WS_WV), D, T, D, D, c.G, c.bid); S.rep = (p.pad == 100 + PHASE_ID) ? 2 : 1; EpiBf16 E{wsb(p, WS_W5), D}; pg8::gemm_phase<EpiBf16, DenseSched, false>(ring, S, E, D, D); }
    } SEAM(2);
#ifndef PROBE_DUP
#define PROBE_DUP -1
#define DUP(k, call) do { if (PROBE_DUP == (k)) { call; xcd_barrier(bar); } } while (0)
    if (IN(3)) { phase_wkv_a(p, c); } SEAM(3);
    if (IN(4)) { phase_wkv_b(p, c); } SEAM(4);
    if (IN(5)) { phase_wkv_c(p, c); } SEAM(5);
#endif
    if (IN(6)) {
#undef PHASE_ID
#define PHASE_ID 6
        DenseSched S; S.init(wsb(p, WS_W3), D, wsb(p, WS_WO), D, T, D, D, c.G, c.bid); S.rep = (p.pad == 100 + PHASE_ID) ? 2 : 1; EpiResid E{p.in[I_X], p.out, wsf(p, WS_MOD) + 0 * 3072 + 2048};
        pg8::gemm_phase<EpiResid, DenseSched, false>(ring, S, E, D, D);
    } SEAM(6);
#define MOE_PHASES(layer, pb) do { \
        if (IN(pb)) { phase_router(p, c, layer); } SEAM(pb); \
        if (IN((pb) + 1)) { \
            moe_setup(p, c, layer); \
            MoeSched S{(LAS const int*)(c.lds + UDESC_OFF), (LAS const int*)(c.lds + ROWTAB_OFF), 0, (const char*)wsb(p, WS_W1), (const char*)wsb(p, (layer) ? WS_WGU1 : WS_WGU), (const char*)wsb(p, (layer) ? WS_WDN1 : WS_WDN)}; \
            EpiMoeUp E{wsb(p, WS_W2), (LAS const float*)(c.lds + GATETAB_OFF)}; \
            pg8::gemm_phase<EpiMoeUp, MoeSched, true>(ring, S, E, D, D); \
        } SEAM((pb) + 1); \
        if (IN((pb) + 2)) { \
            moe_setup(p, c, layer); \
            MoeSched S{(LAS const int*)(c.lds + UDESC_OFF), (LAS const int*)(c.lds + ROWTAB_OFF), 1, (const char*)wsb(p, WS_W2), (const char*)wsb(p, (layer) ? WS_WGU1 : WS_WGU), (const char*)wsb(p, (layer) ? WS_WDN1 : WS_WDN)}; \
            EpiMoeDown E{p.out, wsf(p, WS_MOD) + ((layer) * 2 + 1) * 3072 + 2048, (LAS const int*)(c.lds + ROWTAB_OFF)}; \
            pg8::gemm_phase<EpiMoeDown, MoeSched, false>(ring, S, E, 512, 256); \
        } SEAM((pb) + 2); } while (0)
    MOE_PHASES(0, 7);
            if (IN(10)) { phase_n2(p, c); } SEAM(10);
            if (IN(11)) {
#undef PHASE_ID
#define PHASE_ID 11
                { DenseSched S; S.init(wsb(p, WS_W1), D, wsb(p, WS_DKV), D, T, 512, D, c.G, c.bid); S.rep = (p.pad == 100 + PHASE_ID) ? 2 : 1; EpiDown E{wsb(p, WS_W6), KVLORA, 0, wsf(p, WS_SSQKV), 4, wsb(p, WS_KR), wsf(p, WS_TAB)};
                  pg8::gemm_phase<EpiDown, DenseSched, false>(ring, S, E, D, D); }
                { DenseSched S; S.init(wsb(p, WS_W0), D, wsb(p, WS_DQ), D, T, 512, D, c.G, c.bid); S.rep = (p.pad == 100 + PHASE_ID) ? 2 : 1; EpiDown E{wsb(p, WS_W6 + 16 * MiB), QLORA, 128, wsf(p, WS_SSQQ), 8, nullptr, nullptr};
                  pg8::gemm_phase<EpiDown, DenseSched, false>(ring, S, E, D, D); }
            } SEAM(11);
            if (IN(12)) {
#undef PHASE_ID
#define PHASE_ID 12
                { DenseSched S; S.init(wsb(p, WS_W6 + 16 * MiB), QLORA, wsb(p, WS_UQ), QLORA, T, 1536, QLORA, c.G, c.bid); S.rep = (p.pad == 100 + PHASE_ID) ? 2 : 1; EpiQ E{wsb(p, WS_W2), wsf(p, WS_SSQQ), wsf(p, WS_TAB)};
                  pg8::gemm_phase<EpiQ, DenseSched, false>(ring, S, E, QLORA, QLORA); }
                { DenseSched S; S.init(wsb(p, WS_W6), KVLORA, wsb(p, WS_UKV), KVLORA, T, 2048, KVLORA, c.G, c.bid); S.rep = (p.pad == 100 + PHASE_ID) ? 2 : 1; EpiKV E{wsb(p, WS_W4), wsb(p, WS_W5), wsf(p, WS_SSQKV)};
                  pg8::gemm_phase<EpiKV, DenseSched, false>(ring, S, E, KVLORA, KVLORA); }
            } SEAM(12);
            if (IN(13)) { phase_attention(p, c); } SEAM(13);
#if defined(PROBE_DUP) && PROBE_DUP == 13
            if (IN(13)) { phase_attention(p, c); } SEAM(13);
#endif
            if (IN(14)) {
#undef PHASE_ID
#define PHASE_ID 14
                DenseSched S; S.init(wsb(p, WS_W0), D, wsb(p, WS_MWO), D, T, D, D, c.G, c.bid); S.rep = (p.pad == 100 + PHASE_ID) ? 2 : 1; EpiResid E{p.out, p.out, wsf(p, WS_MOD) + 2 * 3072 + 2048};
                pg8::gemm_phase<EpiResid, DenseSched, false>(ring, S, E, D, D);
            } SEAM(14);
    MOE_PHASES(1, 15);
    if (IN(18)) { phase_final(p, c); }
#undef IN
#undef SEAM
}

extern "C" void kernel_launch(void* const* d_in, const int* in_sizes, int n_in, void* d_out, int out_size, void* d_ws, size_t ws_size, hipStream_t stream) {
    static int ready = 0;
    if (ready == 0) {
        ready = 1;
        if (n_in != N_IN || out_size != T * D || ws_size < WS_END) { fprintf(stderr, "kernel_launch: unexpected shapes (n_in %d, out %d, ws %zu)\n", n_in, out_size, ws_size); ready = -1; }
        else if (hipFuncSetAttribute((const void*)fwd_kernel, hipFuncAttributeMaxDynamicSharedMemorySize, LDS_BYTES) != hipSuccess) { fprintf(stderr, "kernel_launch: hipFuncSetAttribute failed\n"); ready = -1; }
        int per_cu = 0;
        if (ready > 0 && (hipOccupancyMaxActiveBlocksPerMultiprocessor(&per_cu, (const void*)fwd_kernel, NTHREADS, LDS_BYTES) != hipSuccess || per_cu < 1)) fprintf(stderr, "kernel_launch: occupancy query reports %d\n", per_cu);
        (void)hipGetLastError();
    }
    if (ready < 0) return;
    (void)hipMemsetAsync((char*)d_ws + WS_CTL, 0, CTL_ZERO_BYTES, stream);
    Params a{};
    for (int i = 0; i < N_IN; ++i) a.in[i] = (const float*)d_in[i];
    a.out = (float*)d_out; a.ws = (unsigned char*)d_ws; a.li = 0; a.pad = WKA_PROBE;
    const int grid = 256;
    if (N_LAUNCHES == 1) { a.ph_lo = 0; a.ph_hi = N_PHASES; hipLaunchKernelGGL(fwd_kernel, dim3(grid), dim3(NTHREADS), LDS_BYTES, stream, a); }
    else { for (int k = 0; k < N_PHASES; ++k) { a.ph_lo = k; a.ph_hi = k + 1; a.li = k; hipLaunchKernelGGL(fwd_kernel, dim3(grid), dim3(NTHREADS), LDS_BYTES, stream, a); } }
}
```

```cpp
#include <hip/hip_runtime.h>
#include <cstdio>
#include <cstdint>

#define LAS __attribute__((address_space(3)))
#define GAS __attribute__((address_space(1)))
typedef unsigned short bf16_t;
typedef short bf16x8 __attribute__((ext_vector_type(8)));
typedef short s16x4 __attribute__((ext_vector_type(4)));
typedef float f32x2 __attribute__((ext_vector_type(2)));
typedef float f32x4 __attribute__((ext_vector_type(4)));
typedef float f32x16 __attribute__((ext_vector_type(16)));
typedef unsigned u32x2 __attribute__((ext_vector_type(2)));
typedef unsigned u32x4 __attribute__((ext_vector_type(4)));
typedef __bf16 bf16x2_t __attribute__((ext_vector_type(2)));

__device__ __forceinline__ unsigned cvtpk(float lo, float hi) { f32x2 v = {lo, hi}; bf16x2_t b = __builtin_convertvector(v, bf16x2_t); return __builtin_bit_cast(unsigned, b); }
__device__ __forceinline__ float bf2f(unsigned short b) { return __uint_as_float((unsigned)b << 16); }
__device__ __forceinline__ float bflo(unsigned w) { return __uint_as_float(w << 16); }
__device__ __forceinline__ float bfhi(unsigned w) { return __uint_as_float(w & 0xffff0000u); }
__device__ __forceinline__ float wave_sum(float v) {
#pragma unroll
    for (int o = 1; o < 64; o <<= 1) v += __shfl_xor(v, o);
    return v;
}
__device__ __forceinline__ float fexp2(float x) { return __builtin_amdgcn_exp2f(x); }
__device__ __forceinline__ float fexp(float x) { return __builtin_amdgcn_exp2f(x * 1.4426950408889634f); }
__device__ __forceinline__ float frcp(float x) { return __builtin_amdgcn_rcpf(x); }
__device__ __forceinline__ float sigmoidf_(float x) { return frcp(1.0f + fexp(-x)); }

namespace pg8 {
constexpr int BM = 256, BK = 64, HALF = 128, HTB = HALF * BK * 2  , STAGE_BYTES = 8 * HTB;
__host__ __device__ __forceinline__ int lds_byte(int r, int c) { const int st = (r >> 4) * 2 + (c >> 5), rr = r & 15, cc = c & 31, ob = rr * 64 + cc * 2; return st * 1024 + (ob ^ (((ob >> 9) & 1) << 5)); }
__host__ __device__ __forceinline__ void stage_rc(int b, int& R, int& C) { const int st = b / 1024, sb = b % 1024, swz = sb ^ (((sb >> 9) & 1) << 5); R = (st >> 1) * 16 + swz / 64; C = (st & 1) * 32 + (swz % 64) / 2; }
__host__ __device__ __forceinline__ int perm32(int rho) { const int n = rho >> 4, i = rho & 15; return 8 * (i >> 2) + 4 * n + (i & 3); }

struct Unit { int pm, pn, aux, nt, nt0; const char* A0; const char* A1; const char* B0; const char* B1; };
__device__ __forceinline__ const char* tile_ptr(const char* p0, const char* p1, int nt0, int t) { return t < nt0 ? p0 + (size_t)t * 128 : p1 + (size_t)(t - nt0) * 128; }

template <class Epi, class Sched, bool GA>
__device__ __forceinline__ void gemm_phase(LAS unsigned char* lds, const Sched& S, const Epi& E, const int lda, const int ldb) {
    const int tid = threadIdx.x, wid = __builtin_amdgcn_readfirstlane(tid >> 6), lane = tid & 63, wr = wid >> 2, wc = wid & 3, fr = lane & 15, fq = lane >> 4;
    unsigned voffB[2]; int RA[2], CA[2];
#pragma unroll
    for (int i = 0; i < 2; ++i) { int R, C; stage_rc(tid * 16 + i * 8192, R, C); const int Rb = Epi::PERM ? ((R & ~31) + perm32(R & 31)) : R;
        voffB[i] = (unsigned)(Rb * ldb + C) * 2u; RA[i] = R; CA[i] = C; }
    const size_t hstepB = (size_t)HALF * ldb * 2;
    unsigned voC[2][2], voN[2][2];
    const unsigned ldsw = (unsigned)wid * 1024u;
    const int aoff = lds_byte(wr * 64 + fr, fq * 8), boff = lds_byte(wc * 32 + fr, fq * 8);
#define PG8_SA(b, h) (((b) * 2 + (h)) * HTB)
#define PG8_SB(b, h) ((4 + (b) * 2 + (h)) * HTB)
#define PG8_STAGE_B(bufoff, gbase) do { _Pragma("unroll") for (int _i = 0; _i < 2; ++_i) \
        __builtin_amdgcn_global_load_lds((const unsigned*)((const char*)(gbase) + voffB[_i]), (LAS unsigned*)(lds + (bufoff) + ldsw + _i * 8192), 16, 0, 0); } while (0)
#define PG8_STAGE_A(bufoff, gbase, VO, hh) do { _Pragma("unroll") for (int _i = 0; _i < 2; ++_i) \
        __builtin_amdgcn_global_load_lds((const unsigned*)((const char*)(gbase) + VO[hh][_i]), (LAS unsigned*)(lds + (bufoff) + ldsw + _i * 8192), 16, 0, 0); } while (0)
#define PG8_LDA(dst, b, h) do { _Pragma("unroll") for (int m = 0; m < 4; ++m) _Pragma("unroll") for (int k = 0; k < 2; ++k) dst[m][k] = *(const LAS bf16x8*)(lds + PG8_SA(b, h) + aoff + m * 2048 + k * 1024); } while (0)
#define PG8_LDB(dst, b, h) do { _Pragma("unroll") for (int n = 0; n < 2; ++n) _Pragma("unroll") for (int k = 0; k < 2; ++k) dst[n][k] = *(const LAS bf16x8*)(lds + PG8_SB(b, h) + boff + n * 2048 + k * 1024); } while (0)
#define PG8_MMA(ai, bj, At, Bt) do { __builtin_amdgcn_s_setprio(1); _Pragma("unroll") for (int m = 0; m < 4; ++m) _Pragma("unroll") for (int n = 0; n < 2; ++n) _Pragma("unroll") for (int k = 0; k < 2; ++k) \
        acc[ai][bj][m][n] = __builtin_amdgcn_mfma_f32_16x16x32_bf16(Bt[n][k], At[m][k], acc[ai][bj][m][n], 0, 0, 0); __builtin_amdgcn_s_setprio(0); } while (0)
#define PG8_WAIT_V(n) asm volatile("s_waitcnt vmcnt(" #n ")" ::: "memory")
#define PG8_WAIT_L(n) asm volatile("s_waitcnt lgkmcnt(" #n ")" ::: "memory")
#define PG8_BAR __builtin_amdgcn_s_barrier()
#define PG8_SCHED __builtin_amdgcn_sched_barrier(0)
#define PG8_SETVO(VO, ui_) do { _Pragma("unroll") for (int _h = 0; _h < 2; ++_h) _Pragma("unroll") for (int _i = 0; _i < 2; ++_i) { \
        if constexpr (GA) VO[_h][_i] = (unsigned)(S.row((ui_), _h * HALF + RA[_i]) * lda + CA[_i]) * 2u; else VO[_h][_i] = (unsigned)((_h * HALF + RA[_i]) * lda + CA[_i]) * 2u; } } while (0)
    Unit cur, nxt; int ui = 0;
    if (!S.next(0, cur)) return;
    PG8_SETVO(voC, 0);
#pragma unroll
    for (int _h = 0; _h < 2; ++_h)
#pragma unroll
        for (int _i = 0; _i < 2; ++_i) voN[_h][_i] = 0u;
    f32x4 acc[2][2][4][2];
#pragma unroll
    for (int a = 0; a < 2; ++a)
#pragma unroll
        for (int b = 0; b < 2; ++b)
#pragma unroll
            for (int m = 0; m < 4; ++m)
#pragma unroll
                for (int n = 0; n < 2; ++n) acc[a][b][m][n] = (f32x4){0.f, 0.f, 0.f, 0.f};
    bf16x8 At[4][2], B0[2][2], B1[2][2];
    {
        const char* cA = cur.A0; const char* cB = cur.B0;
        PG8_STAGE_B(PG8_SB(0, 0), cB); PG8_STAGE_B(PG8_SB(0, 1), cB + hstepB); PG8_STAGE_A(PG8_SA(0, 0), cA, voC, 0); PG8_STAGE_A(PG8_SA(0, 1), cA, voC, 1);
        if (wr == 1) PG8_BAR;
        PG8_WAIT_V(2); PG8_BAR;
        PG8_STAGE_B(PG8_SB(1, 0), cB + 128); PG8_STAGE_A(PG8_SA(1, 0), cA + 128, voC, 0); PG8_STAGE_B(PG8_SB(1, 1), cB + hstepB + 128);
        PG8_WAIT_V(6); PG8_BAR;
    }
    for (;;) {
        const bool has_next = S.next(ui + 1, nxt);
        if (has_next) { if constexpr (GA) { PG8_SETVO(voN, ui + 1);
#pragma unroll
                for (int _h = 0; _h < 2; ++_h)
#pragma unroll
                    for (int _i = 0; _i < 2; ++_i) voN[_h][_i] -= voC[_h][_i]; } }
        else { nxt = cur;
#pragma unroll
            for (int _h = 0; _h < 2; ++_h)
#pragma unroll
                for (int _i = 0; _i < 2; ++_i) voN[_h][_i] = 0u; }
        const int nt = cur.nt;
        for (int t = 0; t < nt; t += 2) {
            const bool last = (t == nt - 2);
            const char* a1 = tile_ptr(cur.A0, cur.A1, cur.nt0, t + 1);
            const char* a2 = last ? nxt.A0 : tile_ptr(cur.A0, cur.A1, cur.nt0, t + 2);
            const char* b2 = last ? nxt.B0 : tile_ptr(cur.B0, cur.B1, cur.nt0, t + 2);
            const char* a3 = a2 + 128; const char* b3 = b2 + 128;
            unsigned vo2[2][2];
#pragma unroll
            for (int _h = 0; _h < 2; ++_h)
#pragma unroll
                for (int _i = 0; _i < 2; ++_i) vo2[_h][_i] = GA ? voC[_h][_i] + (last ? 1u : 0u) * voN[_h][_i] : voC[_h][_i];
            PG8_LDB(B0, 0, 0); PG8_LDB(B1, 0, 1); PG8_SCHED; PG8_LDA(At, 0, 0); PG8_STAGE_A(PG8_SA(1, 1), a1, voC, 1);
            PG8_WAIT_V(8); PG8_WAIT_L(0); PG8_BAR; PG8_MMA(0, 0, At, B0); PG8_MMA(0, 1, At, B1); PG8_BAR; PG8_SCHED;
            PG8_LDA(At, 0, 1); PG8_STAGE_B(PG8_SB(0, 0), b2); PG8_STAGE_B(PG8_SB(0, 1), b2 + hstepB); PG8_STAGE_A(PG8_SA(0, 0), a2, vo2, 0);
            PG8_WAIT_V(8); PG8_WAIT_L(0); PG8_BAR; PG8_MMA(1, 0, At, B0); PG8_MMA(1, 1, At, B1); PG8_BAR; PG8_SCHED;
            PG8_LDB(B0, 1, 0); PG8_LDB(B1, 1, 1); PG8_SCHED; PG8_LDA(At, 1, 0); PG8_STAGE_A(PG8_SA(0, 1), a2, vo2, 1);
            PG8_WAIT_V(8); PG8_WAIT_L(0); PG8_BAR; PG8_MMA(0, 0, At, B0); PG8_MMA(0, 1, At, B1); PG8_BAR; PG8_SCHED;
            PG8_LDA(At, 1, 1); PG8_STAGE_B(PG8_SB(1, 0), b3); PG8_STAGE_B(PG8_SB(1, 1), b3 + hstepB); PG8_STAGE_A(PG8_SA(1, 0), a3, vo2, 0);
            PG8_WAIT_V(8); PG8_WAIT_L(0); PG8_BAR; PG8_MMA(1, 0, At, B0); PG8_MMA(1, 1, At, B1); PG8_BAR; PG8_SCHED;
        }
        if (wr == 0) PG8_BAR;
        E(acc, cur, wr, wc, fr, fq);
        if (!has_next) break;
#pragma unroll
        for (int a = 0; a < 2; ++a)
#pragma unroll
            for (int b = 0; b < 2; ++b)
#pragma unroll
                for (int m = 0; m < 4; ++m)
#pragma unroll
                    for (int n = 0; n < 2; ++n) acc[a][b][m][n] = (f32x4){0.f, 0.f, 0.f, 0.f};
        cur = nxt; ++ui;
        if constexpr (GA) {
#pragma unroll
            for (int _h = 0; _h < 2; ++_h)
#pragma unroll
                for (int _i = 0; _i < 2; ++_i) voC[_h][_i] += voN[_h][_i];
        }
        if (wr == 1) PG8_BAR;
    }
    PG8_WAIT_V(0);
    PG8_BAR;
#undef PG8_SA
#undef PG8_SB
#undef PG8_STAGE_A
#undef PG8_STAGE_B
#undef PG8_LDA
#undef PG8_LDB
#undef PG8_MMA
#undef PG8_WAIT_V
#undef PG8_WAIT_L
#undef PG8_BAR
#undef PG8_SCHED
#undef PG8_SETVO
}
}
constexpr int NB = 4, SEQ = 8192, D = 1024, T = NB * SEQ;
constexpr int NHEAD = 16, HD = 64;
constexpr int QLORA = 384, KVLORA = 256, ROPE = 32, QKD = 96;
constexpr int NEXP = 16, NCLS = 24, DEXP = 256;
constexpr int MODW = 14336;
constexpr float NORM_EPS = 1e-6f, GN_EPS = 64e-5f;
constexpr float QSCALE = 0.10206207261596577f * 1.4426950408889634f;
constexpr int NWAVES = 8, NTHREADS = 512;

constexpr size_t MiB = 1u << 20;
constexpr size_t SLOT = 64 * MiB;
constexpr size_t WS_W0 = 0, WS_W1 = SLOT, WS_W2 = 2 * SLOT, WS_W3 = 3 * SLOT, WS_W4 = 4 * SLOT, WS_W5 = 5 * SLOT, WS_W6 = 6 * SLOT;
constexpr size_t WS_MISC = 7 * SLOT;
constexpr size_t WS_CTL = WS_MISC, CTL_ZERO_BYTES = 1 * MiB;
constexpr size_t WS_MOD = WS_MISC + 1 * MiB;
constexpr size_t WS_TAB = WS_MISC + 2 * MiB;
constexpr size_t WS_LIST = WS_MISC + 6 * MiB;
constexpr size_t WS_GATES = WS_MISC + 9 * MiB;
constexpr size_t WS_SSQKV = WS_MISC + 9 * MiB + 512 * 1024;
constexpr size_t WS_SSQQ = WS_MISC + 10 * MiB;
constexpr size_t WS_KR = WS_MISC + 11 * MiB;
constexpr size_t WS_WR = WS_MISC + 13 * MiB, WS_WK = WS_MISC + 15 * MiB, WS_WV = WS_MISC + 17 * MiB;
constexpr size_t WS_LD = WS_MISC + 19 * MiB;
constexpr size_t WS_WO = WS_MISC + 20 * MiB;
constexpr size_t WS_DKV = WS_MISC + 22 * MiB;
constexpr size_t WS_DQ = WS_MISC + 23 * MiB;
constexpr size_t WS_UQ = WS_MISC + 24 * MiB;
constexpr size_t WS_UKV = WS_MISC + 26 * MiB;
constexpr size_t WS_MWO = WS_MISC + 27 * MiB;
constexpr size_t WS_WGU = WS_MISC + 29 * MiB;
constexpr size_t WS_WDN = WS_MISC + 45 * MiB;
constexpr size_t WS_W2T = WS_MISC + 53 * MiB;
constexpr size_t WS_A2T = WS_MISC + 53 * MiB + 256 * 1024;
constexpr size_t WS_G2T = WS_MISC + 53 * MiB + 512 * 1024;
constexpr size_t WS_BSUM = WS_MISC + 54 * MiB;
constexpr size_t WS_END = WS_MISC + 62 * MiB;
constexpr size_t WS_WGU1 = WS_W6 + 40 * MiB, WS_WDN1 = WS_W6 + 56 * MiB;
static_assert(WS_END <= 512 * MiB, "d_ws map");
constexpr int CW_BAR = 4096;
constexpr int CW_CNT = 16384;

constexpr int RING_OFF = 0, RING_BYTES = 131072;
constexpr int TAB_OFF = 131072;
constexpr int ROWTAB_OFF = TAB_OFF, GATETAB_OFF = TAB_OFF + 4096, UDESC_OFF = TAB_OFF + 12288, CLSTAB_OFF = UDESC_OFF + 256;
constexpr int MISC_OFF = 151552;
constexpr int LDS_BYTES = 155648;

#define XB_TMO      128
#define XB_XCNT(j)  (256  + 64 * (j))
#define XB_XSUB(j)  (1280 + 64 * (j))
#define XB_XGEN(j)  (2304 + 64 * (j))
#define XB_TOP      3328
#define XB_TOPGEN   3392
#define XCD_BAR_WORDS 3456
#define XB_SPIN_CAP (1u << 18)

__device__ __forceinline__ unsigned xb_ld(unsigned* p)              { return __hip_atomic_load(p, __ATOMIC_RELAXED, __HIP_MEMORY_SCOPE_AGENT); }
__device__ __forceinline__ unsigned xb_add(unsigned* p, unsigned v) { return __hip_atomic_fetch_add(p, v, __ATOMIC_RELAXED, __HIP_MEMORY_SCOPE_AGENT); }
__device__ __forceinline__ unsigned xb_xcc_id() { return (unsigned)__builtin_amdgcn_s_getreg((3 << 11) | 20) & 0xFu; }
#define XB_SPIN(cond, bar) do { unsigned _sp = 0; while (cond) { __builtin_amdgcn_s_sleep(1); \
    if ((++_sp & 255u) == 0u) { if (xb_ld(&(bar)[XB_TMO])) break; if (_sp > XB_SPIN_CAP) { atomicAdd(&(bar)[XB_TMO], 1u); break; } } } } while (0)

struct XcdBarrier { unsigned* bar; unsigned x; volatile LAS unsigned* st; };

__device__ __forceinline__ XcdBarrier xcd_barrier_post(unsigned* bar, volatile LAS unsigned* st) {
    XcdBarrier b; b.bar = bar; b.x = xb_xcc_id(); b.st = st;
    if (threadIdx.x == 0) (void)xb_add(&bar[XB_XCNT(b.x)], 1u);
    return b;
}
__device__ __forceinline__ void xcd_barrier_complete(unsigned* bar, unsigned x, unsigned& nloc, unsigned& nx) {
    const unsigned G = gridDim.x * gridDim.y * gridDim.z;
    unsigned sum, cnt, mine, sp = 0u;
    for (;;) {
        sum = 0u; cnt = 0u; mine = 0u;
#pragma unroll
        for (unsigned j = 0; j < 16; ++j) { const unsigned c = xb_ld(&bar[XB_XCNT(j)]); sum += c; cnt += (c > 0u) ? 1u : 0u; mine = (j == x) ? c : mine; }
        if (sum == G) break;
        __builtin_amdgcn_s_sleep(1);
        if ((++sp & 255u) == 0u) { if (xb_ld(&bar[XB_TMO])) break; if (sp > XB_SPIN_CAP) { atomicAdd(&bar[XB_TMO], 1u); break; } }
    }
    nloc = mine > 0u ? mine : 1u; nx = cnt > 0u ? cnt : 1u;
}
__device__ __forceinline__ void xcd_barrier(const XcdBarrier& b) {
    asm volatile("s_waitcnt vmcnt(0)" ::: "memory");
    __syncthreads();
    if (threadIdx.x == 0) {
        unsigned* bar = b.bar;
        __builtin_amdgcn_s_waitcnt(0);
        unsigned nloc = b.st[0], nx = b.st[1];
        if (nloc == 0u) { xcd_barrier_complete(bar, b.x, nloc, nx); b.st[0] = nloc; b.st[1] = nx; }
        const unsigned old = xb_add(&bar[XB_XSUB(b.x)], 1u);
        const unsigned gen = old / nloc;
        if (old + 1u == (gen + 1u) * nloc) {
            __builtin_amdgcn_fence(__ATOMIC_RELEASE, "agent");
            asm volatile("s_waitcnt vmcnt(0)" ::: "memory");
            const unsigned og = xb_add(&bar[XB_TOP], 1u);
            const unsigned tg = og / nx;
            if (og + 1u == (tg + 1u) * nx) xb_add(&bar[XB_TOPGEN], 1u);
            else XB_SPIN(xb_ld(&bar[XB_TOPGEN]) == tg, bar);
            __builtin_amdgcn_fence(__ATOMIC_ACQUIRE, "agent");
            xb_add(&bar[XB_XGEN(b.x)], 1u);
            asm volatile("s_waitcnt vmcnt(0)" ::: "memory");
        } else {
            XB_SPIN(xb_ld(&bar[XB_XGEN(b.x)]) == gen, bar);
            __builtin_amdgcn_fence(__ATOMIC_ACQUIRE, "agent");
            asm volatile("s_waitcnt vmcnt(0)" ::: "memory");
        }
    }
    __syncthreads();
}

enum { I_X = 0, I_C, I_POS, I_ADAW, I_ADAB, I_NORMG, I_MU, I_WRKV, I_W0, I_W1, I_W2, I_A0, I_A1, I_A2, I_G1, I_G2, I_KK, I_KA, I_RK, I_LNW, I_LNB, I_RWO,
       I_KVADAW, I_KVADAB, I_KVNG, I_WDKV, I_GKV, I_WUK, I_WUV, I_WKR, I_WDQ, I_GQ, I_WUQ, I_WQR, I_MWO, I_RTW, I_RTB, I_WGU, I_WDOWN, I_FG, N_IN };
struct Params { const float* in[N_IN]; float* out; unsigned char* ws; int ph_lo, ph_hi, li, pad; };

struct Ctx {
    LAS unsigned char* lds;
    int tid, lane, wave, G, bid;
};
__device__ __forceinline__ bf16_t* wsb(const Params& p, size_t off) { return (bf16_t*)(p.ws + off); }
__device__ __forceinline__ float* wsf(const Params& p, size_t off) { return (float*)(p.ws + off); }
struct DenseSched {
    int nM, nN, nwg, G, c, nt, nt0, lda, pad, rep; const char* A; const char* B; size_t btile; long a1d, b1d;
    __device__ __forceinline__ void init(const void* A_, int lda_, const void* B_, int ldb_, int M, int N, int K, int G_, int c_) {
        nM = M / 256; nN = N / 256; nwg = nM * nN; G = G_; c = c_; nt = K / 64; nt0 = nt; lda = lda_; pad = 0; rep = 1; A = (const char*)A_; B = (const char*)B_;
        btile = (size_t)256 * ldb_ * 2; a1d = 0; b1d = 0; }
    __device__ __forceinline__ bool next(int i, pg8::Unit& u) const {
        const long L0 = (long)i * G + c; if (L0 >= (long)nwg * rep) return false; const long L = L0 >= nwg ? L0 - nwg : L0;
        int wgid = (int)L; { const int q = nwg / 8, r = nwg % 8, xcd = wgid % 8, off = wgid / 8; wgid = (xcd < r ? xcd * (q + 1) : r * (q + 1) + (xcd - r) * q) + off; }
        const int nig = 8 * nN, gid = wgid / nig, fm = gid * 8, gsz = (nM - fm) < 8 ? (nM - fm) : 8;
        u.pm = fm + ((wgid % nig) % gsz); u.pn = (wgid % nig) / gsz; u.aux = 0; u.nt = nt; u.nt0 = nt0;
        const size_t arow = pad ? (size_t)((u.pm >> 5) * (SEQ + 1) + 1 + 256 * (u.pm & 31)) : (size_t)u.pm * 256;
        u.A0 = A + arow * (size_t)lda * 2; u.A1 = u.A0 + a1d; u.B0 = B + (size_t)u.pn * btile; u.B1 = u.B0 + b1d; return true;
    }
    __device__ __forceinline__ int row(int, int) const { return 0; }
};

struct MoeSched {
    LAS const int* ud; LAS const int* rowtab; int down; const char* A; const char* Wgu; const char* Wdn;
    __device__ __forceinline__ bool next(int i, pg8::Unit& u) const {
        if (i >= 4) return false;
        const int valid = __builtin_amdgcn_readfirstlane(ud[i * 16 + 0]); if (!valid) return false;
        const int st = __builtin_amdgcn_readfirstlane(ud[i * 16 + 1]), pn = __builtin_amdgcn_readfirstlane(ud[i * 16 + 2]);
        const int elo = __builtin_amdgcn_readfirstlane(ud[i * 16 + 3]), ehi = __builtin_amdgcn_readfirstlane(ud[i * 16 + 4]);
        u.pm = st; u.pn = pn; u.aux = i;
        if (!down) { u.nt = 16; u.nt0 = 16; u.A0 = A; u.A1 = A; const int e = (pn >> 1) ? ehi : elo;
            u.B0 = Wgu + ((size_t)e * 512 + (size_t)(pn & 1) * 256) * 1024 * 2; u.B1 = u.B0; }
        else { u.nt = 8; u.nt0 = 4; u.A0 = A + (size_t)st * 256 * 512 * 2; u.A1 = u.A0 + 4 * 128;
            u.B0 = Wdn + ((size_t)elo * 1024 + (size_t)pn * 256) * 256 * 2; u.B1 = Wdn + ((size_t)ehi * 1024 + (size_t)pn * 256) * 256 * 2; }
        return true;
    }
    __device__ __forceinline__ int row(int i, int r) const { const int t = rowtab[i * 256 + r]; return t < 0 ? 0 : t; }
};

typedef f32x4 AccT[2][2][4][2];
#define EPI_ARGS const AccT& acc, const pg8::Unit& u, int wr, int wc, int fr, int fq
__device__ __forceinline__ u32x4 pack8(f32x4 a, f32x4 b) { u32x4 w; w.x = cvtpk(a[0], a[1]); w.y = cvtpk(a[2], a[3]); w.z = cvtpk(b[0], b[1]); w.w = cvtpk(b[2], b[3]); return w; }
__device__ __forceinline__ u32x2 pack4(f32x4 a) { u32x2 w; w.x = cvtpk(a[0], a[1]); w.y = cvtpk(a[2], a[3]); return w; }

struct EpiBf16 {
    static constexpr bool PERM = true; bf16_t* O; int ldc;
    __device__ __forceinline__ void operator()(EPI_ARGS) const {
        const int row0 = u.pm * 256 + wr * 64 + fr, col0 = u.pn * 256 + wc * 32 + 8 * fq;
#pragma unroll
        for (int ai = 0; ai < 2; ++ai)
#pragma unroll
            for (int m = 0; m < 4; ++m) { bf16_t* rowp = O + (size_t)(row0 + ai * 128 + m * 16) * ldc + col0;
#pragma unroll
                for (int bj = 0; bj < 2; ++bj) *(u32x4*)(rowp + bj * 128) = pack8(acc[ai][bj][m][0], acc[ai][bj][m][1]); }
    }
};
struct EpiLoraDown {
    static constexpr bool PERM = true; bf16_t* O;
    __device__ __forceinline__ void operator()(EPI_ARGS) const {
        const int row0 = u.pm * 256 + wr * 64 + fr, col0 = wc * 32 + 8 * fq;
#pragma unroll
        for (int ai = 0; ai < 2; ++ai)
#pragma unroll
            for (int m = 0; m < 4; ++m) { bf16_t* rowp = O + (size_t)(row0 + ai * 128 + m * 16) * 256 + col0;
#pragma unroll
                for (int bj = 0; bj < 2; ++bj) { f32x4 v0 = acc[ai][bj][m][0], v1 = acc[ai][bj][m][1];
                    if (bj == 1) {
#pragma unroll
                        for (int i = 0; i < 4; ++i) { v0[i] = sigmoidf_(v0[i]); v1[i] = sigmoidf_(v1[i]); } }
                    else if (wc < 2) {
#pragma unroll
                        for (int i = 0; i < 4; ++i) { v0[i] = 1.0f - 2.0f * frcp(1.0f + fexp(2.0f * v0[i])); v1[i] = 1.0f - 2.0f * frcp(1.0f + fexp(2.0f * v1[i])); } }
                    *(u32x4*)(rowp + bj * 128) = pack8(v0, v1); } }
    }
};
__device__ __forceinline__ void unpack8(u32x4 w, f32x4& a, f32x4& b) { a = (f32x4){bflo(w.x), bfhi(w.x), bflo(w.y), bfhi(w.y)}; b = (f32x4){bflo(w.z), bfhi(w.z), bflo(w.w), bfhi(w.w)}; }
template <bool XF32>
struct EpiResidT {
    static constexpr bool PERM = true; const void* xin; bf16_t* xout; const float* gate;
    __device__ __forceinline__ void operator()(EPI_ARGS) const {
        const int row0 = u.pm * 256 + wr * 64 + fr, col0 = u.pn * 256 + wc * 32 + 8 * fq; const int b = u.pm >> 5;
        f32x4 gv[2][2];
#pragma unroll
        for (int bj = 0; bj < 2; ++bj)
#pragma unroll
            for (int n = 0; n < 2; ++n) gv[bj][n] = *(const f32x4*)(gate + (size_t)b * MODW + col0 + bj * 128 + n * 4);
#pragma unroll
        for (int ai = 0; ai < 2; ++ai)
#pragma unroll
            for (int m = 0; m < 4; ++m) { const size_t off = (size_t)(row0 + ai * 128 + m * 16) * D + col0;
#pragma unroll
                for (int bj = 0; bj < 2; ++bj) { f32x4 x0, x1;
                    if constexpr (XF32) { x0 = *(const f32x4*)((const float*)xin + off + bj * 128); x1 = *(const f32x4*)((const float*)xin + off + bj * 128 + 4); }
                    else unpack8(*(const u32x4*)((const bf16_t*)xin + off + bj * 128), x0, x1);
                    *(u32x4*)(xout + off + bj * 128) = pack8(x0 + gv[bj][0] * acc[ai][bj][m][0], x1 + gv[bj][1] * acc[ai][bj][m][1]); } }
    }
};
struct EpiMoeUp {
    static constexpr bool PERM = true; bf16_t* act; LAS const float* gatetab;
    __device__ __forceinline__ void operator()(EPI_ARGS) const {
        const int eidx = u.pn >> 1, half = u.pn & 1; const int rl0 = wr * 64 + fr, col0 = eidx * 256 + half * 128 + wc * 32 + 8 * fq;
#pragma unroll
        for (int ai = 0; ai < 2; ++ai)
#pragma unroll
            for (int m = 0; m < 4; ++m) { const int rl = rl0 + ai * 128 + m * 16; const float cb = gatetab[(u.aux * 256 + rl) * 2 + eidx];
                f32x4 o[2];
#pragma unroll
                for (int n = 0; n < 2; ++n)
#pragma unroll
                    for (int i = 0; i < 4; ++i) { const float g = acc[ai][0][m][n][i], up = acc[ai][1][m][n][i]; o[n][i] = g * sigmoidf_(g) * up * cb; }
                *(u32x4*)(act + (size_t)(u.pm * 256 + rl) * 512 + col0) = pack8(o[0], o[1]); }
    }
};
struct EpiMoeDown {
    static constexpr bool PERM = true; const bf16_t* Xin; bf16_t* Xout; const float* gate; LAS const int* rowtab;
    __device__ __forceinline__ void operator()(EPI_ARGS) const {
        const int rl0 = wr * 64 + fr, col0 = u.pn * 256 + wc * 32 + 8 * fq;
#pragma unroll
        for (int ai = 0; ai < 2; ++ai)
#pragma unroll
            for (int m = 0; m < 4; ++m) { const int rl = rl0 + ai * 128 + m * 16; const int tok = rowtab[u.aux * 256 + rl];
                if (tok >= 0) { const float* gp = gate + (size_t)(tok >> 13) * MODW + col0; const size_t off = (size_t)tok * D + col0;
#pragma unroll
                    for (int bj = 0; bj < 2; ++bj) { const f32x4 g0 = *(const f32x4*)(gp + bj * 128), g1 = *(const f32x4*)(gp + bj * 128 + 4); f32x4 x0, x1;
                        unpack8(*(const u32x4*)(Xin + off + bj * 128), x0, x1);
                        *(u32x4*)(Xout + off + bj * 128) = pack8(x0 + g0 * acc[ai][bj][m][0], x1 + g1 * acc[ai][bj][m][1]); } } }
    }
};
struct EpiDown {
    static constexpr bool PERM = false; bf16_t* O; int ldc; int ncols1; float* ssq; int ssq_ld; bf16_t* Kr; const float* tab;
    __device__ __forceinline__ void operator()(EPI_ARGS) const {
        const int row0 = u.pm * 256 + wr * 64 + fr;
#pragma unroll
        for (int ai = 0; ai < 2; ++ai)
#pragma unroll
            for (int m = 0; m < 4; ++m) { const int row = row0 + ai * 128 + m * 16;
                if (u.pn == 0 || ncols1 > 0) { float ss = 0.f;
#pragma unroll
                    for (int bj = 0; bj < 2; ++bj) { if (u.pn == 0 || bj * 128 < ncols1) {
#pragma unroll
                        for (int n = 0; n < 2; ++n) { const f32x4 v = acc[ai][bj][m][n]; ss += (v[0] * v[0] + v[1] * v[1]) + (v[2] * v[2] + v[3] * v[3]);
                            *(u32x2*)(O + (size_t)row * ldc + u.pn * 256 + bj * 128 + wc * 32 + n * 16 + 4 * fq) = pack4(v); } } }
                    ss += __shfl_xor(ss, 16); ss += __shfl_xor(ss, 32);
                    if (fq == 0) ssq[(size_t)row * ssq_ld + u.pn * 4 + wc] = ss; }
                if (Kr != nullptr && u.pn == 1 && wc == 0) { const f32x4 x1 = acc[ai][0][m][0], x2 = acc[ai][0][m][1];
                    const f32x4 c4 = *(const f32x4*)(tab + (size_t)row * 32 + 4 * fq), s4 = *(const f32x4*)(tab + (size_t)row * 32 + 16 + 4 * fq);
                    *(u32x2*)(Kr + (size_t)row * 32 + 4 * fq) = pack4(x1 * c4 - x2 * s4); *(u32x2*)(Kr + (size_t)row * 32 + 16 + 4 * fq) = pack4(x2 * c4 + x1 * s4); } }
    }
};
struct EpiQ {
    static constexpr bool PERM = false; bf16_t* Q; const float* ssq; const float* tab;
    __device__ __forceinline__ void operator()(EPI_ARGS) const {
        const int row0 = u.pm * 256 + wr * 64 + fr;
#pragma unroll
        for (int ai = 0; ai < 2; ++ai)
#pragma unroll
            for (int m = 0; m < 4; ++m) { const int row = row0 + ai * 128 + m * 16;
                const f32x4 sa = *(const f32x4*)(ssq + (size_t)row * 8), sb = *(const f32x4*)(ssq + (size_t)row * 8 + 4);
                const float sc = rsqrtf(((sa[0] + sa[1]) + (sa[2] + sa[3]) + (sb[0] + sb[1]) + (sb[2] + sb[3])) * (1.0f / QLORA) + NORM_EPS) * QSCALE;
                bf16_t* qrow = Q + (size_t)row * (NHEAD * QKD);
                if (u.pn < 4) {
#pragma unroll
                    for (int bj = 0; bj < 2; ++bj)
#pragma unroll
                        for (int n = 0; n < 2; ++n) { const int col = u.pn * 256 + bj * 128 + wc * 32 + n * 16 + 4 * fq;
                            *(u32x2*)(qrow + (col >> 6) * QKD + (col & 63)) = pack4(acc[ai][bj][m][n] * sc); }
                } else { const f32x4 c4 = *(const f32x4*)(tab + (size_t)row * 32 + 4 * fq), s4 = *(const f32x4*)(tab + (size_t)row * 32 + 16 + 4 * fq);
#pragma unroll
                    for (int bj = 0; bj < 2; ++bj) { const int h = (u.pn - 4) * 8 + bj * 4 + wc; const f32x4 x1 = acc[ai][bj][m][0] * sc, x2 = acc[ai][bj][m][1] * sc;
                        *(u32x2*)(qrow + h * QKD + 64 + 4 * fq) = pack4(x1 * c4 - x2 * s4); *(u32x2*)(qrow + h * QKD + 80 + 4 * fq) = pack4(x2 * c4 + x1 * s4); } } }
    }
};
struct EpiKV {
    static constexpr bool PERM = true; bf16_t* Kn; bf16_t* V; const float* ssq;
    __device__ __forceinline__ void operator()(EPI_ARGS) const {
        const int row0 = u.pm * 256 + wr * 64 + fr; bf16_t* base = (u.pn < 4) ? Kn : V; const int col0 = (u.pn & 3) * 256 + wc * 32 + 8 * fq;
#pragma unroll
        for (int ai = 0; ai < 2; ++ai)
#pragma unroll
            for (int m = 0; m < 4; ++m) { const int row = row0 + ai * 128 + m * 16; const f32x4 sa = *(const f32x4*)(ssq + (size_t)row * 4);
                const float sc = rsqrtf(((sa[0] + sa[1]) + (sa[2] + sa[3])) * (1.0f / KVLORA) + NORM_EPS);
#pragma unroll
                for (int bj = 0; bj < 2; ++bj) *(u32x4*)(base + (size_t)row * D + col0 + bj * 128) = pack8(acc[ai][bj][m][0] * sc, acc[ai][bj][m][1] * sc); }
    }
};
__device__ __forceinline__ float srcval(const Params& p, int kind, int e, int k, int n) {
    switch (kind) {
    case 0: case 1: case 2: return p.in[I_WRKV][((size_t)kind * D + k) * D + n];
    case 3: { const int kk = k & 1023, hi = k >> 10; float w, mu;
        if (n < 64) { w = p.in[I_W1][kk * 64 + n]; mu = p.in[I_MU][1 * D + kk]; }
        else if (n < 128) { w = p.in[I_A1][kk * 64 + n - 64]; mu = p.in[I_MU][4 * D + kk]; }
        else { w = p.in[I_G1][kk * 128 + n - 128]; mu = p.in[I_MU][5 * D + kk]; }
        return w * (hi ? mu : 1.0f - mu); }
    case 4: return p.in[I_RWO][(size_t)k * D + n];
    case 5: return n < 256 ? p.in[I_WDKV][k * 256 + n] : (n < 288 ? p.in[I_WKR][k * 32 + n - 256] : 0.f);
    case 6: return n < 384 ? p.in[I_WDQ][k * 384 + n] : 0.f;
    case 7: return p.in[I_GQ][k] * (n < 1024 ? p.in[I_WUQ][(size_t)k * 1024 + n] : p.in[I_WQR][(size_t)k * 512 + n - 1024]);
    case 8: return p.in[I_GKV][k] * (n < 1024 ? p.in[I_WUK][(size_t)k * 1024 + n] : p.in[I_WUV][(size_t)k * 1024 + n - 1024]);
    case 9: return p.in[I_MWO][(size_t)k * D + n];
    case 10: { const int pp = n >> 8, w = n & 255; const int col = (w < 128) ? (128 * pp + w) : (256 + 128 * pp + (w - 128));
        return p.in[I_WGU][((size_t)e * D + k) * 512 + col]; }
    case 11: return p.in[I_WDOWN][((size_t)e * 256 + k) * D + n];
    case 12: return p.in[I_W2][(size_t)k * D + n];
    case 13: return p.in[I_A2][(size_t)k * D + n];
    default: return p.in[I_G2][(size_t)k * D + n];
    }
}
__device__ __forceinline__ void transpose_item(const Params& p, int kind, int e, bf16_t* dst, int ldd, LAS float* scr, int kb, int nb, int lane) {
    const int k0 = 64 * kb, n0 = 32 * nb;
#pragma unroll 4
    for (int i = 0; i < 32; ++i) { const int kk = 2 * i + (lane >> 5); scr[kk * 33 + (lane & 31)] = srcval(p, kind, e, k0 + kk, n0 + (lane & 31)); }
    asm volatile("s_waitcnt lgkmcnt(0)" ::: "memory");
    const int c = lane & 7;
#pragma unroll
    for (int j = 0; j < 4; ++j) { const int n = (lane >> 3) + 8 * j; const LAS float* s = scr + (8 * c) * 33 + n;
        u32x4 o; o.x = cvtpk(s[0 * 33], s[1 * 33]); o.y = cvtpk(s[2 * 33], s[3 * 33]); o.z = cvtpk(s[4 * 33], s[5 * 33]); o.w = cvtpk(s[6 * 33], s[7 * 33]);
        *(u32x4*)(dst + (size_t)(n0 + n) * ldd + k0 + 8 * c) = o; }
    asm volatile("s_waitcnt lgkmcnt(0)" ::: "memory");
}
__device__ __forceinline__ bool tjob(const Params& p, int& r, int kind, int e, size_t ws_off, int Kd, int Nd, LAS float* scr, int lane) {
    const int nkb = Kd / 64, nnb = Nd / 32, cnt = nkb * nnb;
    if (r < cnt) { transpose_item(p, kind, e, wsb(p, ws_off), Kd, scr, r / nnb, r % nnb, lane); return true; }
    r -= cnt; return false;
}
__device__ __forceinline__ void convert_moe_weights(const Params& p, const Ctx& c, int layer) {
    LAS float* scr = (LAS float*)(c.lds + RING_OFF + c.wave * 16384);
    const int gw = c.bid * NWAVES + c.wave, NGW = c.G * NWAVES;
    for (int it = gw; it < 16 * 384; it += NGW) { const int e = it / 384; int r = it % 384;
        if (r < 256) transpose_item(p, 10, layer * 16 + e, wsb(p, WS_WGU) + (size_t)e * 512 * 1024, 1024, scr, r / 16, r % 16, c.lane);
        else { r -= 256; transpose_item(p, 11, layer * 16 + e, wsb(p, WS_WDN) + (size_t)e * 1024 * 256, 256, scr, r / 32, r % 32, c.lane); } }
}
__device__ __forceinline__ void phase_prologue(const Params& p, const Ctx& c) {
    LAS float* sc = (LAS float*)(c.lds);
    LAS float* part = (LAS float*)(c.lds + 16384);
    for (int i = c.tid; i < NB * D; i += NTHREADS) { const float v = p.in[I_C][i]; sc[i] = v / (1.0f + __expf(-v)); }
    __syncthreads();
    const int prep = (p.pad == 100) ? 2 : 1;
    for (int it0 = c.bid; it0 < (MODW / 64) * prep; it0 += c.G) { const int it = it0 % (MODW / 64);
        const int col0 = it * 64, set = col0 < 12288 ? col0 / 3072 : 4, cin = col0 - (set < 4 ? set * 3072 : 12288);
        const float* W = set < 4 ? p.in[I_ADAW] + (size_t)set * D * 3072 : p.in[I_KVADAW]; const int ldw = set < 4 ? 3072 : 2048;
        const float* bias = set < 4 ? p.in[I_ADAB] + set * 3072 : p.in[I_KVADAB];
        float a0 = 0.f, a1 = 0.f, a2 = 0.f, a3 = 0.f;
#pragma unroll 8
        for (int kk = 0; kk < 128; ++kk) { const int k = c.wave * 128 + kk; const float w = W[(size_t)k * ldw + cin + c.lane];
            a0 += sc[k] * w; a1 += sc[D + k] * w; a2 += sc[2 * D + k] * w; a3 += sc[3 * D + k] * w; }
        part[(c.wave * 4 + 0) * 64 + c.lane] = a0; part[(c.wave * 4 + 1) * 64 + c.lane] = a1; part[(c.wave * 4 + 2) * 64 + c.lane] = a2; part[(c.wave * 4 + 3) * 64 + c.lane] = a3;
        __syncthreads();
        if (c.tid < 256) { const int b = c.tid >> 6, l = c.tid & 63; float s = bias[cin + l];
#pragma unroll
            for (int w = 0; w < 8; ++w) s += part[(w * 4 + b) * 64 + l];
            wsf(p, WS_MOD)[(size_t)b * MODW + col0 + l] = s; }
        __syncthreads();
    }
    __syncthreads();
    LAS float* scr = (LAS float*)(c.lds + RING_OFF + c.wave * 16384);
    const int gw = c.bid * NWAVES + c.wave, NGW = c.G * NWAVES;
    constexpr int NITEMS = 3 * 512 + 256 + 512 + 32 + 32 + 64;
    for (int it = gw; it < NITEMS * prep; it += NGW) { int r = it % NITEMS;
        if (tjob(p, r, 0, 0, WS_WR, 1024, 1024, scr, c.lane)) continue;
        if (tjob(p, r, 1, 0, WS_WK, 1024, 1024, scr, c.lane)) continue;
        if (tjob(p, r, 2, 0, WS_WV, 1024, 1024, scr, c.lane)) continue;
        if (tjob(p, r, 3, 0, WS_LD, 2048, 256, scr, c.lane)) continue;
        if (tjob(p, r, 4, 0, WS_WO, 1024, 1024, scr, c.lane)) continue;
        if (tjob(p, r, 12, 0, WS_W2T, 64, 1024, scr, c.lane)) continue;
        if (tjob(p, r, 13, 0, WS_A2T, 64, 1024, scr, c.lane)) continue;
        tjob(p, r, 14, 0, WS_G2T, 128, 1024, scr, c.lane);
    }
    for (int q = 0; q < prep; ++q) convert_moe_weights(p, c, 0);
    const int* pos = (const int*)p.in[I_POS]; float* tab = wsf(p, WS_TAB);
    for (int i0 = c.bid * NTHREADS + c.tid; i0 < T * 16 * prep; i0 += c.G * NTHREADS) { const int i = i0 % (T * 16); const int t = i >> 4, f = i & 15;
        const float inv = powf(10000.0f, -(float)(2 * f) / 32.0f); float s, co; sincosf((float)pos[t] * inv, &s, &co);
        tab[(size_t)t * 32 + f] = co; tab[(size_t)t * 32 + 16 + f] = s; }
}

__device__ __forceinline__ void load_row(const float* rowp, int lane, f32x4 (&v)[4]) {
#pragma unroll
    for (int j = 0; j < 4; ++j) v[j] = *(const f32x4*)(rowp + 4 * lane + 256 * j);
}
__device__ __forceinline__ void load_row_b(const bf16_t* rowp, int lane, f32x4 (&v)[4]) {
#pragma unroll
    for (int j = 0; j < 4; ++j) { const u32x2 w = *(const u32x2*)(rowp + 4 * lane + 256 * j); v[j] = (f32x4){bflo(w.x), bfhi(w.x), bflo(w.y), bfhi(w.y)}; }
}
__device__ __forceinline__ float row_rstd(const f32x4 (&v)[4]) {
    float s = 0.f;
#pragma unroll
    for (int j = 0; j < 4; ++j) s += (v[j][0] * v[j][0] + v[j][1] * v[j][1]) + (v[j][2] * v[j][2] + v[j][3] * v[j][3]);
    return rsqrtf(wave_sum(s) * (1.0f / D) + NORM_EPS);
}
__device__ __forceinline__ void store_row_bf16(bf16_t* rowp, int lane, const f32x4 (&v)[4]) {
#pragma unroll
    for (int j = 0; j < 4; ++j) *(u32x2*)(rowp + 4 * lane + 256 * j) = pack4(v[j]);
}
__device__ __forceinline__ void load_mod(const Params& p, const float* g, int set, int b, int lane, f32x4 (&P)[4], f32x4 (&SH)[4]) {
    const float* m = wsf(p, WS_MOD) + (size_t)b * MODW + (set < 4 ? set * 3072 : 12288);
#pragma unroll
    for (int j = 0; j < 4; ++j) { const int o = 4 * lane + 256 * j; const f32x4 gg = *(const f32x4*)(g + o), sc = *(const f32x4*)(m + 1024 + o); SH[j] = *(const f32x4*)(m + o); P[j] = gg * (sc + 1.0f); }
}

__device__ __forceinline__ void phase_n0(const Params& p, const Ctx& c) {
    const int row0 = (c.bid * NWAVES + c.wave) * 16;
    if (row0 >= T) return;
    const int b = row0 >> 13, t0 = row0 & (SEQ - 1);
    f32x4 P[4], SH[4], mr[4], mk[4], mv[4];
    load_mod(p, p.in[I_NORMG] + 0 * D, 0, b, c.lane, P, SH);
#pragma unroll
    for (int j = 0; j < 4; ++j) { const int o = 4 * c.lane + 256 * j; mr[j] = *(const f32x4*)(p.in[I_MU] + 0 * D + o); mk[j] = *(const f32x4*)(p.in[I_MU] + 2 * D + o); mv[j] = *(const f32x4*)(p.in[I_MU] + 3 * D + o); }
    bf16_t* hpad = (bf16_t*)p.out; bf16_t* xr = wsb(p, WS_W0); bf16_t* xk = wsb(p, WS_W1); bf16_t* xv = wsb(p, WS_W2);
    f32x4 hp[4];
    if (t0 == 0) {
#pragma unroll
        for (int j = 0; j < 4; ++j) hp[j] = (f32x4){0.f, 0.f, 0.f, 0.f};
        store_row_bf16(hpad + (size_t)b * (SEQ + 1) * D, c.lane, hp);
    } else { f32x4 v[4]; load_row(p.in[I_X] + (size_t)(row0 - 1) * D, c.lane, v); const float rs = row_rstd(v);
#pragma unroll
        for (int j = 0; j < 4; ++j) hp[j] = v[j] * rs * P[j] + SH[j]; }
    for (int rr = 0, nr = (p.pad == 101) ? 32 : 16; rr < nr; ++rr) { const int r = rr & 15; const int row = row0 + r; f32x4 v[4], o[4]; load_row(p.in[I_X] + (size_t)row * D, c.lane, v); const float rs = row_rstd(v);
#pragma unroll
        for (int j = 0; j < 4; ++j) v[j] = v[j] * rs * P[j] + SH[j];
        store_row_bf16(hpad + ((size_t)b * (SEQ + 1) + 1 + t0 + r) * D, c.lane, v);
#pragma unroll
        for (int j = 0; j < 4; ++j) o[j] = v[j] + (hp[j] - v[j]) * mr[j];
        store_row_bf16(xr + (size_t)row * D, c.lane, o);
#pragma unroll
        for (int j = 0; j < 4; ++j) o[j] = v[j] + (hp[j] - v[j]) * mk[j];
        store_row_bf16(xk + (size_t)row * D, c.lane, o);
#pragma unroll
        for (int j = 0; j < 4; ++j) o[j] = v[j] + (hp[j] - v[j]) * mv[j];
        store_row_bf16(xv + (size_t)row * D, c.lane, o);
#pragma unroll
        for (int j = 0; j < 4; ++j) hp[j] = v[j]; }
}

__device__ __forceinline__ void phase_router(const Params& p, const Ctx& c, int layer) {
    LAS float* rwt = (LAS float*)(c.lds);
    LAS int* rcls = (LAS int*)(c.lds + 65536);
    LAS float* rgate = (LAS float*)(c.lds + 65536 + 512);
    LAS int* rpos = (LAS int*)(c.lds + 65536 + 2048);
    LAS int* hist = (LAS int*)(c.lds + 65536 + 4096);
    for (int i = c.tid; i < D * NEXP; i += NTHREADS) { const int k = i >> 4, e = i & 15; rwt[e * D + k] = p.in[I_RTW][i]; }
    if (c.tid < 64) hist[c.tid] = 0;
    __syncthreads();
    const int set = layer * 2 + 1; const int rowb = c.bid * 128; const int b = rowb >> 13;
    f32x4 P[4], SH[4]; load_mod(p, p.in[I_NORMG] + (size_t)set * D, set, b, c.lane, P, SH);
    const bf16_t* X = (const bf16_t*)p.out; bf16_t* h2 = wsb(p, WS_W1);
    LAS float* sa = (LAS float*)(c.lds + 65536 + 8192) + c.wave * 512;
    const float rbl = p.in[I_RTB][c.lane & 15];
    for (int rq = 0; rq < 4; ++rq) {
        f32x4 v[4][4];
#pragma unroll
        for (int q = 0; q < 4; ++q) load_row_b(X + (size_t)(rowb + c.wave * 16 + rq * 4 + q) * D, c.lane, v[q]);
#pragma unroll
        for (int q = 0; q < 4; ++q) { const float rs = row_rstd(v[q]);
#pragma unroll
            for (int j = 0; j < 4; ++j) v[q][j] = v[q][j] * rs * P[j] + SH[j];
            store_row_bf16(h2 + (size_t)(rowb + c.wave * 16 + rq * 4 + q) * D, c.lane, v[q]); }
        float s[64];
#pragma unroll
        for (int i = 0; i < 64; ++i) s[i] = 0.f;
#pragma unroll
        for (int j = 0; j < 4; ++j)
#pragma unroll
            for (int e = 0; e < 16; ++e) { const f32x4 w = *(const LAS f32x4*)(rwt + e * D + 4 * c.lane + 256 * j);
#pragma unroll
                for (int q = 0; q < 4; ++q) s[q * 16 + e] += (v[q][j][0] * w[0] + v[q][j][1] * w[1]) + (v[q][j][2] * w[2] + v[q][j][3] * w[3]); }
#pragma unroll
        for (int i = 0; i < 32; ++i) { auto rr = __builtin_amdgcn_permlane32_swap(__float_as_uint(s[i]), __float_as_uint(s[i + 32]), false, false); s[i] = __uint_as_float(rr[0]) + __uint_as_float(rr[1]); }
#pragma unroll
        for (int st = 16; st >= 1; st >>= 1) { const bool up = (c.lane & st) != 0;
#pragma unroll
            for (int i = 0; i < st; ++i) { const float keep = up ? s[i + st] : s[i], send = up ? s[i] : s[i + st]; s[i] = keep + __shfl_xor(send, st); } }
        const float aff = 1.0f / (1.0f + __expf(-s[0]));
        sa[rq * 64 + c.lane] = aff + rbl; sa[256 + rq * 64 + c.lane] = aff;
    }
    {
        const int r = c.lane & 15; float sel[16], aff[16];
#pragma unroll
        for (int k = 0; k < 4; ++k) { const f32x4 a = *(const LAS f32x4*)(sa + r * 16 + 4 * k), b = *(const LAS f32x4*)(sa + 256 + r * 16 + 4 * k);
#pragma unroll
            for (int i = 0; i < 4; ++i) { sel[4 * k + i] = a[i]; aff[4 * k + i] = b[i]; } }
        int bg = 0; float bs = -INFINITY;
#pragma unroll
        for (int g = 0; g < 4; ++g) { const float a0 = sel[4 * g], a1 = sel[4 * g + 1], a2 = sel[4 * g + 2], a3 = sel[4 * g + 3];
            const float m01 = fmaxf(a0, a1), n01 = fminf(a0, a1), m23 = fmaxf(a2, a3), n23 = fminf(a2, a3);
            const float top = fmaxf(m01, m23), second = fmaxf(fminf(m01, m23), (m01 >= m23) ? n01 : n23); const float gs = top + second;
            if (gs > bs) { bs = gs; bg = g; } }
        float s4[4], a4[4];
#pragma unroll
        for (int i = 0; i < 4; ++i) { s4[i] = sel[i]; a4[i] = aff[i]; }
#pragma unroll
        for (int g = 1; g < 4; ++g) if (g == bg) {
#pragma unroll
            for (int i = 0; i < 4; ++i) { s4[i] = sel[4 * g + i]; a4[i] = aff[4 * g + i]; } }
        int i0 = 0;
#pragma unroll
        for (int i = 1; i < 4; ++i) if (s4[i] > s4[i0]) i0 = i;
        int i1 = (i0 == 0) ? 1 : 0;
#pragma unroll
        for (int i = 0; i < 4; ++i) if (i != i0 && i != i1 && s4[i] > s4[i1]) i1 = i;
        float af0 = 0.f, af1 = 0.f;
#pragma unroll
        for (int i = 0; i < 4; ++i) { if (i == i0) af0 = a4[i]; if (i == i1) af1 = a4[i]; }
        const float inv = 1.0f / (af0 + af1);
        const int lo = i0 < i1 ? i0 : i1, hi = i0 < i1 ? i1 : i0; const float glo = (i0 < i1 ? af0 : af1) * inv, ghi = (i0 < i1 ? af1 : af0) * inv;
        const int pair = (lo == 0) ? (hi - 1) : (lo == 1 ? hi + 1 : 5);
        if (c.lane < 16) { const int rl = c.wave * 16 + r; rcls[rl] = bg * 6 + pair; rgate[rl * 2] = glo; rgate[rl * 2 + 1] = ghi; }
    }
    __syncthreads();
    if (c.tid < 128) rpos[c.tid] = atomicAdd((int*)(hist + rcls[c.tid]), 1);
    __syncthreads();
    unsigned* gcnt = (unsigned*)(p.ws + WS_CTL) + CW_CNT + 64 * layer;
    if (c.tid < NCLS) { const int n = hist[c.tid]; hist[32 + c.tid] = n ? (int)atomicAdd(gcnt + c.tid, (unsigned)n) : 0; }
    __syncthreads();
    if (c.tid < 128) { const int cl = rcls[c.tid], pos = hist[32 + cl] + rpos[c.tid], tok = rowb + c.tid;
        ((int*)(p.ws + WS_LIST))[(size_t)cl * T + pos] = tok;
        *(f32x2*)(wsf(p, WS_GATES) + (size_t)tok * 2) = (f32x2){rgate[c.tid * 2], rgate[c.tid * 2 + 1]}; }
}

__device__ __forceinline__ void moe_setup(const Params& p, const Ctx& c, int layer) {
    LAS int* ud = (LAS int*)(c.lds + UDESC_OFF); LAS int* ct = (LAS int*)(c.lds + CLSTAB_OFF);
    LAS int* rowtab = (LAS int*)(c.lds + ROWTAB_OFF); LAS float* gatetab = (LAS float*)(c.lds + GATETAB_OFF);
    const unsigned* gcnt = (const unsigned*)(p.ws + WS_CTL) + CW_CNT + 64 * layer;
    if (c.tid < NCLS) ct[c.tid] = (int)__hip_atomic_load(gcnt + c.tid, __ATOMIC_RELAXED, __HIP_MEMORY_SCOPE_AGENT);
    __syncthreads();
    if (c.tid == 0) { int acc = 0; for (int k = 0; k < NCLS; ++k) { ct[32 + k] = acc; acc += (ct[k] + 255) >> 8; } ct[32 + NCLS] = acc;
        const int total = acc * 4;
        for (int i = 0; i < 4; ++i) { const long L0 = (long)i * c.G + c.bid; int valid = 0, st = 0, pn = 0, elo = 0, ehi = 0, cls = 0, j = 0;
            if (L0 < total) { int L = (int)L0; { const int q = total / 8, r = total % 8, xcd = L % 8, off = L / 8; L = (xcd < r ? xcd * (q + 1) : r * (q + 1) + (xcd - r) * q) + off; }
                valid = 1; pn = L & 3; st = L >> 2; cls = 0; while (cls < NCLS - 1 && ct[32 + cls + 1] <= st) ++cls; j = st - ct[32 + cls];
                const int g = cls / 6, pr = cls % 6; const int lo = pr < 3 ? 0 : (pr < 5 ? 1 : 2), hi = pr < 3 ? pr + 1 : (pr < 5 ? pr - 1 : 3); elo = 4 * g + lo; ehi = 4 * g + hi; }
            ud[i * 16 + 0] = valid; ud[i * 16 + 1] = st; ud[i * 16 + 2] = pn; ud[i * 16 + 3] = elo; ud[i * 16 + 4] = ehi; ud[i * 16 + 5] = cls; ud[i * 16 + 6] = j; } }
    __syncthreads();
    const int* list = (const int*)(p.ws + WS_LIST); const float* gates = wsf(p, WS_GATES);
    for (int i = 0; i < 4; ++i) { if (!ud[i * 16]) continue; const int cls = ud[i * 16 + 5], j = ud[i * 16 + 6], n = ct[cls];
        if (c.tid < 256) { const int pos = j * 256 + c.tid; int tok = -1; f32x2 g = {0.f, 0.f};
            if (pos < n) { tok = list[(size_t)cls * T + pos]; g = *(const f32x2*)(gates + (size_t)tok * 2); }
            rowtab[i * 256 + c.tid] = tok; gatetab[(i * 256 + c.tid) * 2] = g.x; gatetab[(i * 256 + c.tid) * 2 + 1] = g.y; } }
    __syncthreads();
}

__device__ __forceinline__ void phase_n2(const Params& p, const Ctx& c) {
    const int row0 = (c.bid * NWAVES + c.wave) * 16; if (row0 >= T) return; const int b = row0 >> 13;
    f32x4 P1[4], S1[4], P2[4], S2[4];
    load_mod(p, p.in[I_NORMG] + 2 * D, 2, b, c.lane, P1, S1); load_mod(p, p.in[I_KVNG], 4, b, c.lane, P2, S2);
    const bf16_t* X = (const bf16_t*)p.out; bf16_t* h1 = wsb(p, WS_W0); bf16_t* hkv = wsb(p, WS_W1);
    for (int rr = 0, nr = (p.pad == 110) ? 32 : 16; rr < nr; ++rr) { const int r = rr & 15; const int row = row0 + r; f32x4 v[4], o[4]; load_row_b(X + (size_t)row * D, c.lane, v); const float rs = row_rstd(v);
#pragma unroll
        for (int j = 0; j < 4; ++j) { v[j] = v[j] * rs; o[j] = v[j] * P1[j] + S1[j]; }
        store_row_bf16(h1 + (size_t)row * D, c.lane, o);
#pragma unroll
        for (int j = 0; j < 4; ++j) o[j] = v[j] * P2[j] + S2[j];
        store_row_bf16(hkv + (size_t)row * D, c.lane, o); }
}
__device__ __forceinline__ void phase_final(const Params& p, const Ctx& c) {
    const int row0 = (c.bid * NWAVES + c.wave) * 16; if (row0 >= T) return;
    f32x4 g[4];
#pragma unroll
    for (int j = 0; j < 4; ++j) g[j] = *(const f32x4*)(p.in[I_FG] + 4 * c.lane + 256 * j);
    const bf16_t* X = wsb(p, WS_W1);
    for (int r = 0; r < 16; ++r) { float* rowp = p.out + (size_t)(row0 + r) * D; f32x4 v[4]; load_row_b(X + (size_t)(row0 + r) * D, c.lane, v); const float rs = row_rstd(v);
#pragma unroll
        for (int j = 0; j < 4; ++j) *(f32x4*)(rowp + 4 * c.lane + 256 * j) = v[j] * rs * g[j]; }
}
constexpr int AT_KSTR = 208;
constexpr int AT_KBUF = 64 * AT_KSTR, AT_VBUF = 8192;
__device__ __forceinline__ s16x4 vtr(const LAS unsigned char* pp) { typedef short v4i16_t __attribute__((ext_vector_type(4)));
    return __builtin_bit_cast(s16x4, __builtin_amdgcn_ds_read_tr16_b64_v4i16((LAS v4i16_t*)pp)); }
__device__ __forceinline__ void attn_unit(const Params& p, const Ctx& c, int b, int h, int qb) {
    const int tid = c.tid, lane = c.lane, wid = c.wave, r32 = lane & 31, hi = lane >> 5;
    const bf16_t* Q = wsb(p, WS_W2); const bf16_t* Kn = wsb(p, WS_W4); const bf16_t* V = wsb(p, WS_W5); const bf16_t* Kr = wsb(p, WS_KR); bf16_t* O = wsb(p, WS_W0);
    const size_t rowbase = (size_t)b * SEQ; const int q0 = qb * 256, qrow = q0 + 32 * wid + r32;
    LAS unsigned char* Kb = c.lds; LAS unsigned char* Vb = c.lds + 2 * AT_KBUF;
    bf16x8 qr[6];
#pragma unroll
    for (int d0 = 0; d0 < 6; ++d0) qr[d0] = *(const bf16x8*)(Q + (rowbase + qrow) * (NHEAD * QKD) + h * QKD + 16 * d0 + 8 * hi);
    const int NTL = (q0 + 256) / 64;
    const int lrow = tid >> 3, lch = tid & 7, lrow2 = (tid & 255) >> 2, lch2 = tid & 3;
    u32x4 kreg, vreg, rreg;
#define AT_LOAD(t) do { const size_t _r = rowbase + (size_t)(t) * 64; kreg = *(const u32x4*)(Kn + (_r + lrow) * D + h * HD + lch * 8); vreg = *(const u32x4*)(V + (_r + lrow) * D + h * HD + lch * 8); \
        if (tid < 256) rreg = *(const u32x4*)(Kr + (_r + lrow2) * ROPE + lch2 * 8); } while (0)
#define AT_STORE(buf) do { *(LAS u32x4*)(Kb + (buf) * AT_KBUF + lrow * AT_KSTR + lch * 16) = kreg; *(LAS u32x4*)(Vb + (buf) * AT_VBUF + (lch >> 2) * 4096 + lrow * 64 + (lch & 3) * 16) = vreg; \
        if (tid < 256) *(LAS u32x4*)(Kb + (buf) * AT_KBUF + lrow2 * AT_KSTR + 128 + lch2 * 16) = rreg; } while (0)
    AT_LOAD(0); AT_STORE(0);
#pragma unroll
    for (int d0 = 0; d0 < 6; ++d0) asm volatile("" : "+v"(qr[d0]));
    __syncthreads();
    f32x16 o0 = {}, o1 = {}, lacc = {}; float mref = 0.f;
    const bf16x8 onesrow = __builtin_bit_cast(bf16x8, (u32x4){r32 ? 0u : 0x3F803F80u, r32 ? 0u : 0x3F803F80u, r32 ? 0u : 0x3F803F80u, r32 ? 0u : 0x3F803F80u});
    bf16x8 qx = {}; const bf16x8 kx = __builtin_bit_cast(bf16x8, (u32x4){hi ? 0u : 0x3F80u, 0u, 0u, 0u});
    const int vlane = ((lane >> 4) & 1) * 32 + (lane & 3) * 8 + (4 * hi + ((lane & 15) >> 2)) * 64;
    for (int t = 0; t < NTL; ++t) {
        const int buf = t & 1;
        if (t + 1 < NTL) AT_LOAD(t + 1);
        if (64 * t <= q0 + 32 * wid + 31) {
            const LAS unsigned char* kb = Kb + buf * AT_KBUF; const LAS unsigned char* vb = Vb + buf * AT_VBUF;
            bf16x8 kf0[6], kf1[6];
#pragma unroll
            for (int d0 = 0; d0 < 6; ++d0) { kf0[d0] = *(const LAS bf16x8*)(kb + r32 * AT_KSTR + d0 * 32 + hi * 16); kf1[d0] = *(const LAS bf16x8*)(kb + (32 + r32) * AT_KSTR + d0 * 32 + hi * 16); }
            __builtin_amdgcn_sched_barrier(0);
            f32x16 s0 = __builtin_amdgcn_mfma_f32_32x32x16_bf16(kx, qx, (f32x16){}, 0, 0, 0), s1 = s0;
#pragma unroll
            for (int d0 = 0; d0 < 6; ++d0) { s0 = __builtin_amdgcn_mfma_f32_32x32x16_bf16(kf0[d0], qr[d0], s0, 0, 0, 0); s1 = __builtin_amdgcn_mfma_f32_32x32x16_bf16(kf1[d0], qr[d0], s1, 0, 0, 0); }
            if (64 * t + 63 > q0 + 32 * wid) {
                const int kb0 = 64 * t + 4 * hi;
#pragma unroll
                for (int r = 0; r < 16; ++r) { const int kv = kb0 + (r & 3) + 8 * (r >> 2); if (kv > qrow) s0[r] = -INFINITY; if (kv + 32 > qrow) s1[r] = -INFINITY; } }
            if (t == 0) {
                float mx = fmaxf(s0[0], s1[0]);
#pragma unroll
                for (int r = 1; r < 16; ++r) mx = fmaxf(fmaxf(mx, s0[r]), s1[r]);
                mx = fmaxf(mx, __shfl_xor(mx, 32));
                mref = bf2f((unsigned short)(cvtpk(mx, 0.f) & 0xffffu));
                qx = __builtin_bit_cast(bf16x8, (u32x4){hi ? 0u : (cvtpk(-mref, 0.f) & 0xffffu), 0u, 0u, 0u});
#pragma unroll
                for (int r = 0; r < 16; ++r) { s0[r] -= mref; s1[r] -= mref; } }
#pragma unroll
            for (int r = 0; r < 16; ++r) { s0[r] = __builtin_amdgcn_exp2f(s0[r]); s1[r] = __builtin_amdgcn_exp2f(s1[r]); }
            u32x4 pw[4];
#pragma unroll
            for (int s = 0; s < 2; ++s) { pw[s] = (u32x4){cvtpk(s0[8 * s], s0[8 * s + 1]), cvtpk(s0[8 * s + 2], s0[8 * s + 3]), cvtpk(s0[8 * s + 4], s0[8 * s + 5]), cvtpk(s0[8 * s + 6], s0[8 * s + 7])};
                pw[2 + s] = (u32x4){cvtpk(s1[8 * s], s1[8 * s + 1]), cvtpk(s1[8 * s + 2], s1[8 * s + 3]), cvtpk(s1[8 * s + 4], s1[8 * s + 5]), cvtpk(s1[8 * s + 6], s1[8 * s + 7])}; }
            s16x4 va0[4], va1[4], vc0[4], vc1[4];
#pragma unroll
            for (int s = 0; s < 4; ++s) { va0[s] = vtr(vb + vlane + s * 1024); va1[s] = vtr(vb + vlane + s * 1024 + 512); vc0[s] = vtr(vb + 4096 + vlane + s * 1024); vc1[s] = vtr(vb + 4096 + vlane + s * 1024 + 512); }
            __builtin_amdgcn_sched_barrier(0);
#pragma unroll
            for (int s = 0; s < 4; ++s) { const bf16x8 pb = __builtin_bit_cast(bf16x8, pw[s]);
                const bf16x8 va = {va0[s][0], va0[s][1], va0[s][2], va0[s][3], va1[s][0], va1[s][1], va1[s][2], va1[s][3]}, vc = {vc0[s][0], vc0[s][1], vc0[s][2], vc0[s][3], vc1[s][0], vc1[s][1], vc1[s][2], vc1[s][3]};
                o0 = __builtin_amdgcn_mfma_f32_32x32x16_bf16(va, pb, o0, 0, 0, 0); o1 = __builtin_amdgcn_mfma_f32_32x32x16_bf16(vc, pb, o1, 0, 0, 0);
                lacc = __builtin_amdgcn_mfma_f32_32x32x16_bf16(onesrow, pb, lacc, 0, 0, 0); }
            { const float lq = __shfl(lacc[0], r32);
              if (__builtin_expect(__any(lq > 0x1p40f), 0)) { asm volatile("; rare rescale path" ::: "memory"); const float dl = (lq > 0x1p40f) ? bf2f((unsigned short)(cvtpk(__log2f(lq), 0.f) & 0xffffu)) : 0.f;
                  const float mnew = bf2f((unsigned short)(cvtpk(mref + dl, 0.f) & 0xffffu)); const float de = mnew - mref; mref = mnew; const float alpha = __builtin_amdgcn_exp2f(-de);
                  qx = __builtin_bit_cast(bf16x8, (u32x4){hi ? 0u : (cvtpk(-mnew, 0.f) & 0xffffu), 0u, 0u, 0u});
#pragma unroll
                  for (int r = 0; r < 16; ++r) { o0[r] *= alpha; o1[r] *= alpha; lacc[r] *= alpha; } } }
        }
        if (t + 1 < NTL) AT_STORE(buf ^ 1);
        __syncthreads();
    }
    const float inv = 1.0f / __shfl(lacc[0], r32);
    bf16_t* orow = O + (rowbase + qrow) * D + h * HD;
#pragma unroll
    for (int g = 0; g < 4; ++g) { const f32x4 x0 = {o0[4 * g] * inv, o0[4 * g + 1] * inv, o0[4 * g + 2] * inv, o0[4 * g + 3] * inv}, x1 = {o1[4 * g] * inv, o1[4 * g + 1] * inv, o1[4 * g + 2] * inv, o1[4 * g + 3] * inv};
        *(u32x2*)(orow + 8 * g + 4 * hi) = pack4(x0); *(u32x2*)(orow + 32 + 8 * g + 4 * hi) = pack4(x1); }
#undef AT_LOAD
#undef AT_STORE
}
__device__ __forceinline__ void phase_attention(const Params& p, const Ctx& c) {
    const int v = (c.G % 8 == 0) ? (c.bid % 8) * (c.G / 8) + c.bid / 8 : c.bid; const int bh = v >> 2, s = v & 3;
    if (bh >= NB * NHEAD) return;
    for (int ii = 0, ni = (p.pad == 113) ? 16 : 8; ii < ni; ++ii) { const int i = ii & 7; const int qb = 8 * (i >> 1) + ((i & 1) ? 7 - s : s); attn_unit(p, c, bh >> 4, bh & 15, qb); }
}
constexpr int W32_NCH = SEQ / 32;
struct Pk { u32x4 f[2]; };
__device__ __forceinline__ Pk pk_tile(const f32x16& t) { Pk p;
#pragma unroll
    for (int s = 0; s < 2; ++s) p.f[s] = (u32x4){cvtpk(t[8 * s], t[8 * s + 1]), cvtpk(t[8 * s + 2], t[8 * s + 3]), cvtpk(t[8 * s + 4], t[8 * s + 5]), cvtpk(t[8 * s + 6], t[8 * s + 7])};
    return p; }
__device__ __forceinline__ f32x16 unpk_tile(const Pk& p) { f32x16 t;
#pragma unroll
    for (int s = 0; s < 2; ++s) { t[8 * s] = bflo(p.f[s].x); t[8 * s + 1] = bfhi(p.f[s].x); t[8 * s + 2] = bflo(p.f[s].y); t[8 * s + 3] = bfhi(p.f[s].y); t[8 * s + 4] = bflo(p.f[s].z); t[8 * s + 5] = bfhi(p.f[s].z); t[8 * s + 6] = bflo(p.f[s].w); t[8 * s + 7] = bfhi(p.f[s].w); }
    return t; }
__device__ __forceinline__ f32x16 mma2(f32x16 acc, const Pk& p2, const Pk& p1) {
#pragma unroll
    for (int s = 0; s < 2; ++s) acc = __builtin_amdgcn_mfma_f32_32x32x16_bf16(__builtin_bit_cast(bf16x8, p2.f[s]), __builtin_bit_cast(bf16x8, p1.f[s]), acc, 0, 0, 0);
    return acc; }
__device__ __forceinline__ Pk tri_pk(int t, int hi, int strict) { Pk p;
#pragma unroll
    for (int s = 0; s < 2; ++s) { unsigned w[4];
#pragma unroll
        for (int d = 0; d < 4; ++d) { const int k0 = 16 * s + 8 * (d >> 1) + 4 * hi + 2 * (d & 1) + strict; w[d] = (k0 <= t ? 0x3F80u : 0u) | (k0 + 1 <= t ? 0x3F800000u : 0u); }
        p.f[s] = (u32x4){w[0], w[1], w[2], w[3]}; }
    return p; }
__device__ __forceinline__ Pk ident_pk(int x, int hi) { Pk p;
#pragma unroll
    for (int s = 0; s < 2; ++s) { unsigned w[4];
#pragma unroll
        for (int d = 0; d < 4; ++d) { const int k0 = 16 * s + 8 * (d >> 1) + 4 * hi + 2 * (d & 1); w[d] = (k0 == x ? 0x3F80u : 0u) | (k0 + 1 == x ? 0x3F800000u : 0u); }
        p.f[s] = (u32x4){w[0], w[1], w[2], w[3]}; }
    return p; }
__device__ __forceinline__ bf16x8 glbfrag(const bf16_t* M, int ld, int row, int s, int hi) { return *(const bf16x8*)(M + (size_t)row * ld + 16 * s + 8 * hi); }
#define LDS_BARRIER() do { asm volatile("s_waitcnt lgkmcnt(0)" ::: "memory"); __builtin_amdgcn_s_barrier(); asm volatile("" ::: "memory"); } while (0)
#define W32_Y(r) (((r) & 3) + 8 * ((r) >> 2) + 4 * hi)
constexpr size_t WU = 64 * 64;

#define W32_YQ(r) (((r) & 3) + 8 * ((r) >> 2) + 4 * hq)
__device__ __forceinline__ void phase_wkv_a(const Params& p, const Ctx& c) {
    const int lane = c.lane, r32 = lane & 31, hi = lane >> 5;
    LAS float* cst = (LAS float*)c.lds;
    for (int i = c.tid; i < D; i += NTHREADS) { cst[i] = p.in[I_A0][i]; cst[D + i] = p.in[I_KK][i]; cst[2 * D + i] = p.in[I_KA][i]; cst[3 * D + i] = p.in[I_RK][i]; cst[4 * D + i] = p.in[I_W0][i]; }
    __syncthreads();
    bf16_t* Rg = wsb(p, WS_W3); bf16_t* Kg = wsb(p, WS_W4); const bf16_t* Vg = wsb(p, WS_W5); const bf16_t* L1 = wsb(p, WS_W6);
    const bf16_t* W2T = wsb(p, WS_W2T); const bf16_t* A2T = wsb(p, WS_A2T);
    bf16_t* PTg = wsb(p, WS_W0); bf16_t* Zg = (bf16_t*)p.out; bf16_t* QTg = wsb(p, WS_W2); float* bsg = wsf(p, WS_BSUM);
    const int gw = c.bid * NWAVES + c.wave;
    for (int uu2 = (p.pad == 1) ? -8 : 0; uu2 < 8; ++uu2) { const int uu = uu2 & 7; const bool dry = uu2 < 0;
        int unit_ = gw * 8 + uu; asm volatile("" : "+s"(unit_));
        const int unit = unit_, bh = unit >> 8, chunk = unit & 255, b = bh >> 4, h = bh & 15;
        int hq = hi; asm volatile("" : "+v"(hq));
        const size_t row0 = (size_t)b * SEQ + (size_t)chunk * 32, tok = row0 + r32;
        const size_t tokoff = tok * D + h * 64 + 4 * hi; bf16_t* rp = Rg + tokoff; bf16_t* kp = Kg + tokoff; const bf16_t* vp = Vg + tokoff;
        const LAS float* cp = cst + h * 64 + 4 * hi;
        const bf16_t* l1p = L1 + tok * 256 + 8 * hi;
        float ss = 0.f;
#pragma unroll
        for (int yt = 0; yt < 2; ++yt)
#pragma unroll
            for (int q = 0; q < 4; ++q) { const u32x2 kw = *(const u32x2*)(kp + 32 * yt + 8 * q); const f32x4 kc = *(const LAS f32x4*)(cp + D + 32 * yt + 8 * q);
                const float k0 = bflo(kw.x) * kc[0], k1 = bfhi(kw.x) * kc[1], k2 = bflo(kw.y) * kc[2], k3 = bfhi(kw.y) * kc[3]; ss += (k0 * k0 + k1 * k1) + (k2 * k2 + k3 * k3); }
        ss += __shfl_xor(ss, 32); const float inrm = frcp(fmaxf(__builtin_amdgcn_sqrtf(ss), 1e-12f));
        float bs = 0.f, cwC[2];
        LAS unsigned char* park = c.lds + 5 * D * 4 + c.wave * 16384 + lane * 16;
#define PARK_ST(mat, yt_, fr, v) (*(LAS u32x4*)(park + (((mat) * 2 + (yt_)) * 2 + (fr)) * 1024) = (v))
#define PARK_LD(mat, yt_) Pk{{*(const LAS u32x4*)(park + (((mat) * 2 + (yt_)) * 2) * 1024), *(const LAS u32x4*)(park + (((mat) * 2 + (yt_)) * 2 + 1) * 1024)}}
#pragma unroll
        for (int yt = 0; yt < 2; ++yt) {
            Pk ldh, ldl;
            { const bf16_t* w2p = W2T + (size_t)(h * 64 + 32 * yt + r32) * 64 + 8 * hi; bf16x8 w2[4], fw[4];
#pragma unroll
              for (int s = 0; s < 4; ++s) { w2[s] = *(const bf16x8*)(w2p + 16 * s); fw[s] = *(const bf16x8*)(l1p + 16 * s); }
              f32x16 ldt = {};
#pragma unroll
              for (int s = 0; s < 4; ++s) ldt = __builtin_amdgcn_mfma_f32_32x32x16_bf16(fw[s], w2[s], ldt, 0, 0, 0);
              const float w0c = cst[4 * D + h * 64 + 32 * yt + r32]; f32x16 vh, vl; float sum = 0.f;
#pragma unroll
              for (int r = 0; r < 16; ++r) { const float x = -(w0c + ldt[r]); const float sp = fmaxf(x, 0.f) + __logf(1.0f + fexp(-fabsf(x))); const float ld = -fexp(-sp - 0.5f) * 1.4426950408889634f;
                  const float lh = bf2f((unsigned short)(cvtpk(ld, 0.f) & 0xffffu)); vh[r] = lh; vl[r] = ld - lh; sum += ld; }
              sum += __shfl_xor(sum, 32); cwC[yt] = fexp2(sum); ldh = pk_tile(vh); ldl = pk_tile(vl); }
            __builtin_amdgcn_sched_barrier(0);
            int tq = r32; asm volatile("" : "+v"(tq));
            const Pk tri = tri_pk(tq, hq, 0), tris = tri_pk(tq, hq, 1);
            const f32x16 cl = mma2(mma2((f32x16){}, ldh, tri), ldl, tri), cle = mma2(mma2((f32x16){}, ldh, tris), ldl, tris);
            __builtin_amdgcn_sched_barrier(0);
            f32x16 aTL = {};
            { const bf16_t* a2p = A2T + (size_t)(h * 64 + 32 * yt + r32) * 64 + 8 * hi; bf16x8 a2[4], fa[4];
#pragma unroll
              for (int s = 0; s < 4; ++s) { a2[s] = *(const bf16x8*)(a2p + 16 * s); fa[s] = *(const bf16x8*)(l1p + 64 + 16 * s); }
#pragma unroll
              for (int s = 0; s < 4; ++s) aTL = __builtin_amdgcn_mfma_f32_32x32x16_bf16(a2[s], fa[s], aTL, 0, 0, 0); }
            u32x2 rr[4], kk[4];
#pragma unroll
            for (int q = 0; q < 4; ++q) { rr[q] = *(const u32x2*)(rp + 32 * yt + 8 * q); kk[q] = *(const u32x2*)(kp + 32 * yt + 8 * q); }
            __builtin_amdgcn_sched_barrier(0);
            u32x4 fA, fB, fK, fR;
#pragma unroll
            for (int q = 0; q < 4; ++q) { const int c0 = 32 * yt + 8 * q;
                const f32x4 a0 = *(const LAS f32x4*)(cp + c0), kkc = *(const LAS f32x4*)(cp + D + c0), kac = *(const LAS f32x4*)(cp + 2 * D + c0), rkc = *(const LAS f32x4*)(cp + 3 * D + c0);
                const float kv[4] = {bflo(kk[q].x), bfhi(kk[q].x), bflo(kk[q].y), bfhi(kk[q].y)}, rv[4] = {bflo(rr[q].x), bfhi(rr[q].x), bflo(rr[q].y), bfhi(rr[q].y)};
                float at[4], bt[4], kt[4], rt[4];
#pragma unroll
                for (int i = 0; i < 4; ++i) { const int r = 4 * q + i; const float a = sigmoidf_(a0[i] + aTL[r]); const float kkv = kv[i] * kkc[i] * inrm, km = kv[i] * (1.0f + (a - 1.0f) * kac[i]);
                    const float cw = fexp2(cl[r]), cwm1 = fexp2(cle[r]), icw = fexp2(-cl[r]);
                    at[i] = -kkv * cwm1; bt[i] = kkv * a * icw; kt[i] = km * icw; rt[i] = rv[i] * cw; bs += rv[i] * km * rkc[i]; }
                if (q & 1) { fA.z = cvtpk(at[0], at[1]); fA.w = cvtpk(at[2], at[3]); fB.z = cvtpk(bt[0], bt[1]); fB.w = cvtpk(bt[2], bt[3]); fK.z = cvtpk(kt[0], kt[1]); fK.w = cvtpk(kt[2], kt[3]); fR.z = cvtpk(rt[0], rt[1]); fR.w = cvtpk(rt[2], rt[3]);
                             PARK_ST(0, yt, q >> 1, fA); PARK_ST(1, yt, q >> 1, fB); PARK_ST(2, yt, q >> 1, fK); PARK_ST(3, yt, q >> 1, fR); }
                else       { fA.x = cvtpk(at[0], at[1]); fA.y = cvtpk(at[2], at[3]); fB.x = cvtpk(bt[0], bt[1]); fB.y = cvtpk(bt[2], bt[3]); fK.x = cvtpk(kt[0], kt[1]); fK.y = cvtpk(kt[2], kt[3]); fR.x = cvtpk(rt[0], rt[1]); fR.y = cvtpk(rt[2], rt[3]); } }
            __builtin_amdgcn_sched_barrier(0); }
        bs += __shfl_xor(bs, 32);
        if (hi == 0 && !dry) bsg[tok * NHEAD + h] = bs;
        __builtin_amdgcn_sched_barrier(0);
#define W32_SB() __builtin_amdgcn_sched_barrier(0)
        int rq = r32; asm volatile("" : "+v"(rq));
        f32x16 MN = {}, MT = {}, X2 = {}; Pk pMbr, pMkr;
        asm volatile("s_waitcnt lgkmcnt(0)" ::: "memory");
        { const Pk a0_ = PARK_LD(0, 0), a1_ = PARK_LD(0, 1), b0_ = PARK_LD(1, 0), b1_ = PARK_LD(1, 1);
        MN = mma2(mma2(MN, a0_, b0_), a1_, b1_);
#pragma unroll
        for (int r = 0; r < 16; ++r) if (!(rq < W32_YQ(r))) MN[r] = 0.f;
        W32_SB();
        MT = mma2(mma2(MT, b0_, a0_), b1_, a1_); }
#pragma unroll
        for (int r = 0; r < 16; ++r) if (!(W32_YQ(r) < rq)) MT[r] = 0.f;
        W32_SB();
        { const Pk a0_ = PARK_LD(0, 0), a1_ = PARK_LD(0, 1), k0_ = PARK_LD(2, 0), k1_ = PARK_LD(2, 1);
        X2 = mma2(mma2(X2, a0_, k0_), a1_, k1_); }
#pragma unroll
        for (int r = 0; r < 16; ++r) if (!(rq < W32_YQ(r))) X2[r] = 0.f;
        W32_SB();
        { const Pk b0_ = PARK_LD(1, 0), b1_ = PARK_LD(1, 1), r0_ = PARK_LD(3, 0), r1_ = PARK_LD(3, 1);
          f32x16 m = mma2(mma2((f32x16){}, b0_, r0_), b1_, r1_);
#pragma unroll
          for (int r = 0; r < 16; ++r) if (!(W32_YQ(r) <= rq)) m[r] = 0.f;
          pMbr = pk_tile(m); }
        W32_SB();
        { const Pk k0_ = PARK_LD(2, 0), k1_ = PARK_LD(2, 1), r0_ = PARK_LD(3, 0), r1_ = PARK_LD(3, 1);
          f32x16 m = mma2(mma2((f32x16){}, k0_, r0_), k1_, r1_);
#pragma unroll
          for (int r = 0; r < 16; ++r) if (!(W32_YQ(r) <= rq)) m[r] = 0.f;
          pMkr = pk_tile(m); }
        W32_SB();
        const Pk idn = ident_pk(rq, hq);
        f32x16 X0 = mma2((f32x16){}, PARK_LD(0, 0), idn), X1 = mma2((f32x16){}, PARK_LD(0, 1), idn);
        W32_SB();
#define PARK_PK(mat, yt_, pk) do { const Pk _p = (pk); PARK_ST(mat, yt_, 0, _p.f[0]); PARK_ST(mat, yt_, 1, _p.f[1]); } while (0)
#pragma unroll
        for (int xt = 0; xt < 2; ++xt) {
            { const Pk t = pk_tile(mma2((f32x16){}, PARK_LD(1, xt), idn)); PARK_PK(1, xt, t); } W32_SB();
            { const Pk t = pk_tile(mma2((f32x16){}, PARK_LD(2, xt), idn)); PARK_PK(2, xt, t); } W32_SB();
            { u32x2 vv[4];
#pragma unroll
              for (int q = 0; q < 4; ++q) vv[q] = *(const u32x2*)(vp + 32 * xt + 8 * q);
              Pk pV; pV.f[0] = (u32x4){vv[0].x, vv[0].y, vv[1].x, vv[1].y}; pV.f[1] = (u32x4){vv[2].x, vv[2].y, vv[3].x, vv[3].y};
              const Pk t = pk_tile(mma2((f32x16){}, pV, idn)); PARK_PK(0, xt, t); } W32_SB(); }
        __builtin_amdgcn_sched_barrier(0);
#pragma unroll
        for (int kq = 0; kq < 5; ++kq) { const Pk pMN = pk_tile(MN), pMT = pk_tile(MT);
            X0 = mma2(X0, pMT, pk_tile(X0)); X1 = mma2(X1, pMT, pk_tile(X1)); X2 = mma2(X2, pMT, pk_tile(X2));
            if (kq < 4) { MN = mma2((f32x16){}, pMT, pMN); MT = mma2((f32x16){}, pMN, pMT); } }
        const Pk pW1[2] = {pk_tile(X0), pk_tile(X1)}, pW2 = pk_tile(X2);
        __builtin_amdgcn_sched_barrier(0);
        bf16_t* ptp = PTg + (size_t)unit * WU + lane * 4; bf16_t* zp = Zg + (size_t)unit * WU + lane * 4; bf16_t* qtp = QTg + (size_t)unit * 2048 + lane * 4;
        Pk pGT[2];
#pragma unroll
        for (int xt = 0; xt < 2; ++xt) {
#pragma unroll
            for (int yt = 0; yt < 2; ++yt) { f32x16 m = mma2((f32x16){}, pW1[yt], PARK_LD(1, xt));
#pragma unroll
                for (int r = 0; r < 16; ++r) m[r] = cwC[xt] * (m[r] + ((xt == yt && W32_YQ(r) == rq) ? 1.0f : 0.0f));
#pragma unroll
                for (int q = 0; q < 4; ++q) if (!dry) *(u32x2*)(ptp + ((xt * 2 + yt) * 4 + q) * 256) = pack4((f32x4){m[4 * q], m[4 * q + 1], m[4 * q + 2], m[4 * q + 3]}); }
            f32x16 g = mma2(unpk_tile(PARK_LD(2, xt)), pW2, PARK_LD(1, xt));
#pragma unroll
            for (int r = 0; r < 16; ++r) g[r] *= cwC[xt];
            pGT[xt] = pk_tile(g); }
        const Pk pHT = pk_tile(mma2(unpk_tile(pMkr), pW2, pMbr));
#pragma unroll
        for (int yt = 0; yt < 2; ++yt) {
            const f32x16 qv = mma2(unpk_tile(PARK_LD(3, yt)), pW1[yt], pMbr);
            const f32x16 yl = mma2((f32x16){}, PARK_LD(0, yt), pHT);
#pragma unroll
            for (int q = 0; q < 4; ++q) { if (dry) continue;
                *(u32x2*)(qtp + (yt * 4 + q) * 256) = pack4((f32x4){qv[4 * q], qv[4 * q + 1], qv[4 * q + 2], qv[4 * q + 3]}); *(u32x2*)(rp + 32 * yt + 8 * q) = pack4((f32x4){yl[4 * q], yl[4 * q + 1], yl[4 * q + 2], yl[4 * q + 3]}); } }
#pragma unroll
        for (int xt = 0; xt < 2; ++xt)
#pragma unroll
            for (int yt = 0; yt < 2; ++yt) { const f32x16 z = mma2((f32x16){}, pGT[yt], PARK_LD(0, xt));
#pragma unroll
                for (int q = 0; q < 4; ++q) if (!dry) *(u32x2*)(zp + ((xt * 2 + yt) * 4 + q) * 256) = pack4((f32x4){z[4 * q], z[4 * q + 1], z[4 * q + 2], z[4 * q + 3]}); }
    }
}

constexpr int WKB_MAT = 8192, WKB_SLOT = 2 * WKB_MAT;
__device__ __forceinline__ void phase_wkv_b(const Params& p, const Ctx& c) {
    if (c.bid >= NB * NHEAD) {
        LAS float* scr = (LAS float*)(c.lds + RING_OFF + c.wave * 16384);
        const int gw = (c.bid - NB * NHEAD) * NWAVES + c.wave, NGW = (c.G - NB * NHEAD) * NWAVES;
        constexpr int NM = 256 + 256 + 288 + 256 + 512;
        for (int it = gw; it < NM + 16 * 384; it += NGW) { int r = it;
            if (r < NM) { if (tjob(p, r, 5, 0, WS_DKV, 1024, 512, scr, c.lane)) continue; if (tjob(p, r, 6, 0, WS_DQ, 1024, 512, scr, c.lane)) continue; if (tjob(p, r, 7, 0, WS_UQ, 384, 1536, scr, c.lane)) continue;
                if (tjob(p, r, 8, 0, WS_UKV, 256, 2048, scr, c.lane)) continue; tjob(p, r, 9, 0, WS_MWO, 1024, 1024, scr, c.lane); continue; }
            r -= NM; const int e = r / 384; r = r % 384;
            if (r < 256) transpose_item(p, 10, 16 + e, wsb(p, WS_WGU1) + (size_t)e * 512 * 1024, 1024, scr, r / 16, r % 16, c.lane);
            else { r -= 256; transpose_item(p, 11, 16 + e, wsb(p, WS_WDN1) + (size_t)e * 1024 * 256, 256, scr, r / 32, r % 32, c.lane); } }
        return; }
    const int lane = c.lane, r32 = lane & 31, hi = lane >> 5, bh = c.bid, xt = c.wave & 1; const bool comp = c.wave < 2;
    bf16_t* PTg = wsb(p, WS_W0) + (size_t)bh * W32_NCH * WU; const bf16_t* Zg = (const bf16_t*)p.out + (size_t)bh * W32_NCH * WU;
    LAS unsigned char* ring = c.lds;
    const int ll = c.tid - 128;
    u32x4 ra[3], rb[3], rc[3], rd[3];
#define WKB_ISSUE(R, ch) do { if (!comp && (ch) < W32_NCH) { _Pragma("unroll") for (int k = 0; k < 3; ++k) { const int id = ll + 384 * k; if (id < 1024) { const int mat = id >> 9, e8 = (id & 511) * 8; \
        R[k] = *(const u32x4*)((mat ? Zg : (const bf16_t*)PTg) + (size_t)(ch) * WU + e8); } } } } while (0)
#define WKB_PUT(R, ch) do { if (!comp && (ch) < W32_NCH) { _Pragma("unroll") for (int k = 0; k < 3; ++k) { const int id = ll + 384 * k; if (id < 1024) { *(LAS u32x4*)(ring + ((ch) & 1) * WKB_SLOT + id * 16) = R[k]; } } } } while (0)
    f32x16 S0 = {}, S1 = {};
    bool dryb = false;
#define WKB_STEP(ch) do { if (comp) { const LAS unsigned char* sl = ring + ((ch) & 1) * WKB_SLOT + lane * 8; bf16x8 bf[4]; bf16_t* sg = PTg + (size_t)(ch) * WU + lane * 4; \
        _Pragma("unroll") for (int s = 0; s < 4; ++s) { const f32x16& St = (s >> 1) ? S1 : S0; const int r0 = 8 * (s & 1); \
            u32x4 wv; wv.x = cvtpk(St[r0], St[r0 + 1]); wv.y = cvtpk(St[r0 + 2], St[r0 + 3]); wv.z = cvtpk(St[r0 + 4], St[r0 + 5]); wv.w = cvtpk(St[r0 + 6], St[r0 + 7]); bf[s] = __builtin_bit_cast(bf16x8, wv); \
            if (!dryb) { *(u32x2*)(sg + ((xt * 2 + (s >> 1)) * 4 + 2 * (s & 1)) * 256) = (u32x2){wv.x, wv.y}; *(u32x2*)(sg + ((xt * 2 + (s >> 1)) * 4 + 2 * (s & 1) + 1) * 256) = (u32x2){wv.z, wv.w}; } } \
        f32x16 n0, n1; \
        _Pragma("unroll") for (int q = 0; q < 4; ++q) { const u32x2 z0 = *(const LAS u32x2*)(sl + WKB_MAT + ((xt * 2 + 0) * 4 + q) * 512), z1 = *(const LAS u32x2*)(sl + WKB_MAT + ((xt * 2 + 1) * 4 + q) * 512); \
            n0[4 * q] = bflo(z0.x); n0[4 * q + 1] = bfhi(z0.x); n0[4 * q + 2] = bflo(z0.y); n0[4 * q + 3] = bfhi(z0.y); n1[4 * q] = bflo(z1.x); n1[4 * q + 1] = bfhi(z1.x); n1[4 * q + 2] = bflo(z1.y); n1[4 * q + 3] = bfhi(z1.y); } \
        _Pragma("unroll") for (int s = 0; s < 4; ++s) { const int pq = ((s >> 1) * 4 + 2 * (s & 1)) * 512; \
            const u32x2 p00 = *(const LAS u32x2*)(sl + pq), p01 = *(const LAS u32x2*)(sl + pq + 512), p10 = *(const LAS u32x2*)(sl + 8 * 512 + pq), p11 = *(const LAS u32x2*)(sl + 8 * 512 + pq + 512); \
            n0 = __builtin_amdgcn_mfma_f32_32x32x16_bf16(__builtin_bit_cast(bf16x8, (u32x4){p00.x, p00.y, p01.x, p01.y}), bf[s], n0, 0, 0, 0); \
            n1 = __builtin_amdgcn_mfma_f32_32x32x16_bf16(__builtin_bit_cast(bf16x8, (u32x4){p10.x, p10.y, p11.x, p11.y}), bf[s], n1, 0, 0, 0); } \
        S0 = n0; S1 = n1; } } while (0)
    for (int repb = (p.pad == 104) ? -1 : 0; repb < 1; ++repb) { dryb = repb < 0; S0 = (f32x16){}; S1 = (f32x16){};
    WKB_ISSUE(ra, 0); WKB_ISSUE(rb, 1); WKB_ISSUE(rc, 2); WKB_ISSUE(rd, 3);
    WKB_PUT(ra, 0); WKB_ISSUE(ra, 4);
    LDS_BARRIER();
    for (int ch = 0; ch < W32_NCH; ch += 4) {
        WKB_PUT(rb, ch + 1); WKB_ISSUE(rb, ch + 5); WKB_STEP(ch);     LDS_BARRIER();
        WKB_PUT(rc, ch + 2); WKB_ISSUE(rc, ch + 6); WKB_STEP(ch + 1); LDS_BARRIER();
        WKB_PUT(rd, ch + 3); WKB_ISSUE(rd, ch + 7); WKB_STEP(ch + 2); LDS_BARRIER();
        WKB_PUT(ra, ch + 4); WKB_ISSUE(ra, ch + 8); WKB_STEP(ch + 3); LDS_BARRIER();
    } }
#undef WKB_ISSUE
#undef WKB_PUT
#undef WKB_STEP
}

__device__ __forceinline__ void phase_wkv_c(const Params& p, const Ctx& c) {
    const int lane = c.lane, r32 = lane & 31, hi = lane >> 5;
    const bf16_t* QTg = wsb(p, WS_W2); bf16_t* YLg = wsb(p, WS_W3); const bf16_t* Sg = wsb(p, WS_W0);
    const bf16_t* Vg = wsb(p, WS_W5); const bf16_t* L1 = wsb(p, WS_W6); const bf16_t* G2T = wsb(p, WS_G2T); const float* bsg = wsf(p, WS_BSUM); bf16_t* YG = YLg;
    for (int unit0 = c.bid * NWAVES + c.wave, nun = NB * NHEAD * W32_NCH * ((p.pad == 105) ? 2 : 1); unit0 < nun; unit0 += c.G * NWAVES) { const int unit = unit0 & (NB * NHEAD * W32_NCH - 1); const bool dryc = (p.pad == 105) && unit0 < NB * NHEAD * W32_NCH;
        const int bh = unit >> 8, chunk = unit & 255, b = bh >> 4, h = bh & 15;
        const size_t row = (size_t)b * SEQ + (size_t)chunk * 32 + r32;
        const bf16_t* sc = Sg + (size_t)unit * WU + lane * 4; const bf16_t* qtp = QTg + (size_t)unit * 2048 + lane * 4;
        f32x16 y[2], g[2];
#pragma unroll
        for (int yt = 0; yt < 2; ++yt) {
#pragma unroll
            for (int q = 0; q < 4; ++q) { const u32x2 wv = *(const u32x2*)(YLg + row * D + h * 64 + 32 * yt + 8 * q + 4 * hi);
                y[yt][4 * q] = bflo(wv.x); y[yt][4 * q + 1] = bfhi(wv.x); y[yt][4 * q + 2] = bflo(wv.y); y[yt][4 * q + 3] = bfhi(wv.y); }
#pragma unroll
            for (int s = 0; s < 4; ++s) { const int pq = ((s >> 1) * 4 + 2 * (s & 1)) * 256; const u32x2 a0 = *(const u32x2*)(sc + yt * 2048 + pq), a1 = *(const u32x2*)(sc + yt * 2048 + pq + 256), b0 = *(const u32x2*)(qtp + pq), b1 = *(const u32x2*)(qtp + pq + 256);
                y[yt] = __builtin_amdgcn_mfma_f32_32x32x16_bf16(__builtin_bit_cast(bf16x8, (u32x4){a0.x, a0.y, a1.x, a1.y}), __builtin_bit_cast(bf16x8, (u32x4){b0.x, b0.y, b1.x, b1.y}), y[yt], 0, 0, 0); }
            g[yt] = (f32x16){};
#pragma unroll
            for (int s = 0; s < 8; ++s) g[yt] = __builtin_amdgcn_mfma_f32_32x32x16_bf16(glbfrag(G2T, 128, h * 64 + 32 * yt + r32, s, hi), glbfrag(L1 + 128, 256, (int)row, s, hi), g[yt], 0, 0, 0);
        }
        float sm = 0.f;
#pragma unroll
        for (int r = 0; r < 16; ++r) sm += y[0][r] + y[1][r];
        sm += __shfl_xor(sm, 32); const float mean = sm * (1.0f / 64.0f);
        float q2 = 0.f;
#pragma unroll
        for (int r = 0; r < 16; ++r) { const float d0 = y[0][r] - mean, d1 = y[1][r] - mean; q2 += d0 * d0 + d1 * d1; }
        q2 += __shfl_xor(q2, 32); const float rstd = rsqrtf(q2 * (1.0f / 64.0f) + GN_EPS);
        const float bsum = bsg[row * NHEAD + h];
#pragma unroll
        for (int yt = 0; yt < 2; ++yt)
#pragma unroll
            for (int q = 0; q < 4; ++q) { const int ch = h * 64 + 32 * yt + 8 * q + 4 * hi; const f32x4 lw = *(const f32x4*)(p.in[I_LNW] + ch), lb = *(const f32x4*)(p.in[I_LNB] + ch);
                const u32x2 vw = *(const u32x2*)(Vg + row * D + ch); const f32x4 vv = {bflo(vw.x), bfhi(vw.x), bflo(vw.y), bfhi(vw.y)}; f32x4 o;
#pragma unroll
                for (int i = 0; i < 4; ++i) o[i] = ((y[yt][4 * q + i] - mean) * rstd * lw[i] + lb[i] + bsum * vv[i]) * g[yt][4 * q + i];
                if (!dryc) *(u32x2*)(YG + row * D + ch) = pack4(o); }
    }
}
#undef W32_Y
#ifndef WKA_PROBE
#define WKA_PROBE 0
#endif
#ifndef MK_N_LAUNCHES
#define MK_N_LAUNCHES 1
#endif
constexpr int N_PHASES = 19;
constexpr int N_LAUNCHES = MK_N_LAUNCHES;


__global__ void __launch_bounds__(NTHREADS, 2) fwd_kernel(Params p) {
    extern __shared__ __attribute__((aligned(16))) unsigned char lds_raw[];
    Ctx c; c.lds = (LAS unsigned char*)lds_raw; c.tid = threadIdx.x; c.lane = c.tid & 63; c.wave = __builtin_amdgcn_readfirstlane(c.tid >> 6); c.G = gridDim.x; c.bid = blockIdx.x;
    volatile LAS unsigned* MISC = (volatile LAS unsigned*)(c.lds + MISC_OFF);
    if (c.tid < 64) ((LAS unsigned*)(c.lds + MISC_OFF))[c.tid] = 0u;
    __syncthreads();
    unsigned* ctl = (unsigned*)(p.ws + WS_CTL);
    XcdBarrier bar; bar.bar = ctl + CW_BAR; bar.x = 0; bar.st = nullptr;
    if (N_LAUNCHES == 1) bar = xcd_barrier_post(ctl + CW_BAR, MISC + 8);
    const int lo = p.ph_lo, hi = p.ph_hi;
#ifndef PH_MASK
#define PH_MASK 0x7ffff
#endif
#ifndef PROBE_DUP_EARLY
#define PROBE_DUP_EARLY -1
#endif
#define PHASE_ID 0
#define IN(k) ((((PH_MASK) >> (k)) & 1) && lo <= (k) && (k) < hi)
#define SEAM(k) do { if (IN(k) && IN((k) + 1)) xcd_barrier(bar); } while (0)
    LAS unsigned char* ring = c.lds + RING_OFF;

    if (IN(0)) { phase_prologue(p, c); } SEAM(0);
    if (IN(1)) { phase_n0(p, c); } SEAM(1);
    if (IN(2)) {
#undef PHASE_ID
#define PHASE_ID 2
        { DenseSched S; S.init((const bf16_t*)p.out, D, wsb(p, WS_LD), 2048, T, 256, 2048, c.G, c.bid); S.rep = (p.pad == 100 + PHASE_ID) ? 2 : 1; S.pad = 1; S.nt0 = 16; S.a1d = -(long)(D * 2); S.b1d = 1024 * 2;
          EpiLoraDown E{wsb(p, WS_W6)}; pg8::gemm_phase<EpiLoraDown, DenseSched, false>(ring, S, E, D, 2048); }
        { DenseSched S; S.init(wsb(p, WS_W0), D, wsb(p, WS_WR), D, T, D, D, c.G, c.bid); S.rep = (p.pad == 100 + PHASE_ID) ? 2 : 1; EpiBf16 E{wsb(p, WS_W3), D}; pg8::gemm_phase<EpiBf16, DenseSched, false>(ring, S, E, D, D); }
        { DenseSched S; S.init(wsb(p, WS_W1), D, wsb(p, WS_WK), D, T, D, D, c.G, c.bid); S.rep = (p.pad == 100 + PHASE_ID) ? 2 : 1; EpiBf16 E{wsb(p, WS_W4), D}; pg8::gemm_phase<EpiBf16, DenseSched, false>(ring, S, E, D, D); }
        { DenseSched S; S.init(wsb(p, WS_W2), D, wsb(p, WS_WV), D, T, D, D, c.G, c.bid); S.rep = (p.pad == 100 + PHASE_ID) ? 2 : 1; EpiBf16 E{wsb(p, WS_W5), D}; pg8::gemm_phase<EpiBf16, DenseSched, false>(ring, S, E, D, D); }
    } SEAM(2);
#ifndef PROBE_DUP
#define PROBE_DUP -1
#define DUP(k, call) do { if (PROBE_DUP == (k)) { call; xcd_barrier(bar); } } while (0)
    if (IN(3)) { phase_wkv_a(p, c); } SEAM(3);
    if (IN(4)) { phase_wkv_b(p, c); } SEAM(4);
    if (IN(5)) { phase_wkv_c(p, c); } SEAM(5);
#endif
    if (IN(6)) {
#undef PHASE_ID
#define PHASE_ID 6
        DenseSched S; S.init(wsb(p, WS_W3), D, wsb(p, WS_WO), D, T, D, D, c.G, c.bid); S.rep = (p.pad == 100 + PHASE_ID) ? 2 : 1; EpiResidT<true> E{p.in[I_X], (bf16_t*)p.out, wsf(p, WS_MOD) + 0 * 3072 + 2048};
        pg8::gemm_phase<EpiResidT<true>, DenseSched, false>(ring, S, E, D, D);
    } SEAM(6);
#define MOE_PHASES(layer, pb) do { \
        if (IN(pb)) { phase_router(p, c, layer); } SEAM(pb); \
        if (IN((pb) + 1)) { \
            moe_setup(p, c, layer); \
            MoeSched S{(LAS const int*)(c.lds + UDESC_OFF), (LAS const int*)(c.lds + ROWTAB_OFF), 0, (const char*)wsb(p, WS_W1), (const char*)wsb(p, (layer) ? WS_WGU1 : WS_WGU), (const char*)wsb(p, (layer) ? WS_WDN1 : WS_WDN)}; \
            EpiMoeUp E{wsb(p, WS_W2), (LAS const float*)(c.lds + GATETAB_OFF)}; \
            pg8::gemm_phase<EpiMoeUp, MoeSched, true>(ring, S, E, D, D); \
        } SEAM((pb) + 1); \
        if (IN((pb) + 2)) { \
            moe_setup(p, c, layer); \
            MoeSched S{(LAS const int*)(c.lds + UDESC_OFF), (LAS const int*)(c.lds + ROWTAB_OFF), 1, (const char*)wsb(p, WS_W2), (const char*)wsb(p, (layer) ? WS_WGU1 : WS_WGU), (const char*)wsb(p, (layer) ? WS_WDN1 : WS_WDN)}; \
            EpiMoeDown E{(const bf16_t*)p.out, (layer) ? wsb(p, WS_W1) : (bf16_t*)p.out, wsf(p, WS_MOD) + ((layer) * 2 + 1) * 3072 + 2048, (LAS const int*)(c.lds + ROWTAB_OFF)}; \
            pg8::gemm_phase<EpiMoeDown, MoeSched, false>(ring, S, E, 512, 256); \
        } SEAM((pb) + 2); } while (0)
    MOE_PHASES(0, 7);
            if (IN(10)) { phase_n2(p, c); } SEAM(10);
            if (IN(11)) {
#undef PHASE_ID
#define PHASE_ID 11
                { DenseSched S; S.init(wsb(p, WS_W1), D, wsb(p, WS_DKV), D, T, 512, D, c.G, c.bid); S.rep = (p.pad == 100 + PHASE_ID) ? 2 : 1; EpiDown E{wsb(p, WS_W6), KVLORA, 0, wsf(p, WS_SSQKV), 4, wsb(p, WS_KR), wsf(p, WS_TAB)};
                  pg8::gemm_phase<EpiDown, DenseSched, false>(ring, S, E, D, D); }
                { DenseSched S; S.init(wsb(p, WS_W0), D, wsb(p, WS_DQ), D, T, 512, D, c.G, c.bid); S.rep = (p.pad == 100 + PHASE_ID) ? 2 : 1; EpiDown E{wsb(p, WS_W6 + 16 * MiB), QLORA, 128, wsf(p, WS_SSQQ), 8, nullptr, nullptr};
                  pg8::gemm_phase<EpiDown, DenseSched, false>(ring, S, E, D, D); }
            } SEAM(11);
            if (IN(12)) {
#undef PHASE_ID
#define PHASE_ID 12
                { DenseSched S; S.init(wsb(p, WS_W6 + 16 * MiB), QLORA, wsb(p, WS_UQ), QLORA, T, 1536, QLORA, c.G, c.bid); S.rep = (p.pad == 100 + PHASE_ID) ? 2 : 1; EpiQ E{wsb(p, WS_W2), wsf(p, WS_SSQQ), wsf(p, WS_TAB)};
                  pg8::gemm_phase<EpiQ, DenseSched, false>(ring, S, E, QLORA, QLORA); }
                { DenseSched S; S.init(wsb(p, WS_W6), KVLORA, wsb(p, WS_UKV), KVLORA, T, 2048, KVLORA, c.G, c.bid); S.rep = (p.pad == 100 + PHASE_ID) ? 2 : 1; EpiKV E{wsb(p, WS_W4), wsb(p, WS_W5), wsf(p, WS_SSQKV)};
                  pg8::gemm_phase<EpiKV, DenseSched, false>(ring, S, E, KVLORA, KVLORA); }
            } SEAM(12);
            if (IN(13)) { phase_attention(p, c); } SEAM(13);
#if defined(PROBE_DUP) && PROBE_DUP == 13
            if (IN(13)) { phase_attention(p, c); } SEAM(13);
#endif
            if (IN(14)) {
#undef PHASE_ID
#define PHASE_ID 14
                DenseSched S; S.init(wsb(p, WS_W0), D, wsb(p, WS_MWO), D, T, D, D, c.G, c.bid); S.rep = (p.pad == 100 + PHASE_ID) ? 2 : 1; EpiResidT<false> E{p.out, (bf16_t*)p.out, wsf(p, WS_MOD) + 2 * 3072 + 2048};
                pg8::gemm_phase<EpiResidT<false>, DenseSched, false>(ring, S, E, D, D);
            } SEAM(14);
    MOE_PHASES(1, 15);
    if (IN(18)) { phase_final(p, c); }
#undef IN
#undef SEAM
}

extern "C" void kernel_launch(void* const* d_in, const int* in_sizes, int n_in, void* d_out, int out_size, void* d_ws, size_t ws_size, hipStream_t stream) {
    static int ready = 0;
    if (ready == 0) {
        ready = 1;
        if (n_in != N_IN || out_size != T * D || ws_size < WS_END) { fprintf(stderr, "kernel_launch: unexpected shapes (n_in %d, out %d, ws %zu)\n", n_in, out_size, ws_size); ready = -1; }
        else if (hipFuncSetAttribute((const void*)fwd_kernel, hipFuncAttributeMaxDynamicSharedMemorySize, LDS_BYTES) != hipSuccess) { fprintf(stderr, "kernel_launch: hipFuncSetAttribute failed\n"); ready = -1; }
        int per_cu = 0;
        if (ready > 0 && (hipOccupancyMaxActiveBlocksPerMultiprocessor(&per_cu, (const void*)fwd_kernel, NTHREADS, LDS_BYTES) != hipSuccess || per_cu < 1)) fprintf(stderr, "kernel_launch: occupancy query reports %d\n", per_cu);
        (void)hipGetLastError();
    }
    if (ready < 0) return;
    (void)hipMemsetAsync((char*)d_ws + WS_CTL, 0, CTL_ZERO_BYTES, stream);
    Params a{};
    for (int i = 0; i < N_IN; ++i) a.in[i] = (const float*)d_in[i];
    a.out = (float*)d_out; a.ws = (unsigned char*)d_ws; a.li = 0; a.pad = WKA_PROBE;
    const int grid = 256;
    if (N_LAUNCHES == 1) { a.ph_lo = 0; a.ph_hi = N_PHASES; hipLaunchKernelGGL(fwd_kernel, dim3(grid), dim3(NTHREADS), LDS_BYTES, stream, a); }
    else { for (int k = 0; k < N_PHASES; ++k) { a.ph_lo = k; a.ph_hi = k + 1; a.li = k; hipLaunchKernelGGL(fwd_kernel, dim3(grid), dim3(NTHREADS), LDS_BYTES, stream, a); } }
}
```

```cpp
#include <hip/hip_runtime.h>
#include <cstdio>
#include <cstdint>

#define LAS __attribute__((address_space(3)))
#define GAS __attribute__((address_space(1)))
typedef unsigned short bf16_t;
typedef short bf16x8 __attribute__((ext_vector_type(8)));
typedef short s16x4 __attribute__((ext_vector_type(4)));
typedef float f32x2 __attribute__((ext_vector_type(2)));
typedef float f32x4 __attribute__((ext_vector_type(4)));
typedef float f32x16 __attribute__((ext_vector_type(16)));
typedef unsigned u32x2 __attribute__((ext_vector_type(2)));
typedef unsigned u32x4 __attribute__((ext_vector_type(4)));
typedef __bf16 bf16x2_t __attribute__((ext_vector_type(2)));

__device__ __forceinline__ unsigned cvtpk(float lo, float hi) { f32x2 v = {lo, hi}; bf16x2_t b = __builtin_convertvector(v, bf16x2_t); return __builtin_bit_cast(unsigned, b); }
__device__ __forceinline__ float bf2f(unsigned short b) { return __uint_as_float((unsigned)b << 16); }
__device__ __forceinline__ float bflo(unsigned w) { return __uint_as_float(w << 16); }
__device__ __forceinline__ float bfhi(unsigned w) { return __uint_as_float(w & 0xffff0000u); }
__device__ __forceinline__ float wave_sum(float v) {
#pragma unroll
    for (int o = 1; o < 64; o <<= 1) v += __shfl_xor(v, o);
    return v;
}
__device__ __forceinline__ float fexp2(float x) { return __builtin_amdgcn_exp2f(x); }
__device__ __forceinline__ float fexp(float x) { return __builtin_amdgcn_exp2f(x * 1.4426950408889634f); }
__device__ __forceinline__ float frcp(float x) { return __builtin_amdgcn_rcpf(x); }
__device__ __forceinline__ float sigmoidf_(float x) { return frcp(1.0f + fexp(-x)); }

namespace pg8 {
constexpr int BM = 256, BK = 64, HALF = 128, HTB = HALF * BK * 2  , STAGE_BYTES = 8 * HTB;
__host__ __device__ __forceinline__ int lds_byte(int r, int c) { const int st = (r >> 4) * 2 + (c >> 5), rr = r & 15, cc = c & 31, ob = rr * 64 + cc * 2; return st * 1024 + (ob ^ (((ob >> 9) & 1) << 5)); }
__host__ __device__ __forceinline__ void stage_rc(int b, int& R, int& C) { const int st = b / 1024, sb = b % 1024, swz = sb ^ (((sb >> 9) & 1) << 5); R = (st >> 1) * 16 + swz / 64; C = (st & 1) * 32 + (swz % 64) / 2; }
__host__ __device__ __forceinline__ int perm32(int rho) { const int n = rho >> 4, i = rho & 15; return 8 * (i >> 2) + 4 * n + (i & 3); }

struct Unit { int pm, pn, aux, nt, nt0; const char* A0; const char* A1; const char* B0; const char* B1; };
__device__ __forceinline__ const char* tile_ptr(const char* p0, const char* p1, int nt0, int t) { return t < nt0 ? p0 + (size_t)t * 128 : p1 + (size_t)(t - nt0) * 128; }

template <class Epi, class Sched, bool GA>
__device__ __forceinline__ void gemm_phase(LAS unsigned char* lds, const Sched& S, const Epi& E, const int lda, const int ldb) {
    const int tid = threadIdx.x, wid = __builtin_amdgcn_readfirstlane(tid >> 6), lane = tid & 63, wr = wid >> 2, wc = wid & 3, fr = lane & 15, fq = lane >> 4;
    unsigned voffB[2]; int RA[2], CA[2];
#pragma unroll
    for (int i = 0; i < 2; ++i) { int R, C; stage_rc(tid * 16 + i * 8192, R, C); const int Rb = Epi::PERM ? ((R & ~31) + perm32(R & 31)) : R;
        voffB[i] = (unsigned)(Rb * ldb + C) * 2u; RA[i] = R; CA[i] = C; }
    const size_t hstepB = (size_t)HALF * ldb * 2;
    unsigned voC[2][2], voN[2][2];
    const unsigned ldsw = (unsigned)wid * 1024u;
    const int aoff = lds_byte(wr * 64 + fr, fq * 8), boff = lds_byte(wc * 32 + fr, fq * 8);
#define PG8_SA(b, h) (((b) * 2 + (h)) * HTB)
#define PG8_SB(b, h) ((4 + (b) * 2 + (h)) * HTB)
#define PG8_STAGE_B(bufoff, gbase) do { _Pragma("unroll") for (int _i = 0; _i < 2; ++_i) \
        __builtin_amdgcn_global_load_lds((const unsigned*)((const char*)(gbase) + voffB[_i]), (LAS unsigned*)(lds + (bufoff) + ldsw + _i * 8192), 16, 0, 0); } while (0)
#define PG8_STAGE_A(bufoff, gbase, VO, hh) do { _Pragma("unroll") for (int _i = 0; _i < 2; ++_i) \
        __builtin_amdgcn_global_load_lds((const unsigned*)((const char*)(gbase) + VO[hh][_i]), (LAS unsigned*)(lds + (bufoff) + ldsw + _i * 8192), 16, 0, 0); } while (0)
#define PG8_LDA(dst, b, h) do { _Pragma("unroll") for (int m = 0; m < 4; ++m) _Pragma("unroll") for (int k = 0; k < 2; ++k) dst[m][k] = *(const LAS bf16x8*)(lds + PG8_SA(b, h) + aoff + m * 2048 + k * 1024); } while (0)
#define PG8_LDB(dst, b, h) do { _Pragma("unroll") for (int n = 0; n < 2; ++n) _Pragma("unroll") for (int k = 0; k < 2; ++k) dst[n][k] = *(const LAS bf16x8*)(lds + PG8_SB(b, h) + boff + n * 2048 + k * 1024); } while (0)
#define PG8_MMA(ai, bj, At, Bt) do { __builtin_amdgcn_s_setprio(1); _Pragma("unroll") for (int m = 0; m < 4; ++m) _Pragma("unroll") for (int n = 0; n < 2; ++n) _Pragma("unroll") for (int k = 0; k < 2; ++k) \
        acc[ai][bj][m][n] = __builtin_amdgcn_mfma_f32_16x16x32_bf16(Bt[n][k], At[m][k], acc[ai][bj][m][n], 0, 0, 0); __builtin_amdgcn_s_setprio(0); } while (0)
#define PG8_WAIT_V(n) asm volatile("s_waitcnt vmcnt(" #n ")" ::: "memory")
#define PG8_WAIT_L(n) asm volatile("s_waitcnt lgkmcnt(" #n ")" ::: "memory")
#define PG8_BAR __builtin_amdgcn_s_barrier()
#define PG8_SCHED __builtin_amdgcn_sched_barrier(0)
#define PG8_SETVO(VO, ui_) do { _Pragma("unroll") for (int _h = 0; _h < 2; ++_h) _Pragma("unroll") for (int _i = 0; _i < 2; ++_i) { \
        if constexpr (GA) VO[_h][_i] = (unsigned)(S.row((ui_), _h * HALF + RA[_i]) * lda + CA[_i]) * 2u; else VO[_h][_i] = (unsigned)((_h * HALF + RA[_i]) * lda + CA[_i]) * 2u; } } while (0)
    Unit cur, nxt; int ui = 0;
    if (!S.next(0, cur)) return;
    PG8_SETVO(voC, 0);
#pragma unroll
    for (int _h = 0; _h < 2; ++_h)
#pragma unroll
        for (int _i = 0; _i < 2; ++_i) voN[_h][_i] = 0u;
    f32x4 acc[2][2][4][2];
#pragma unroll
    for (int a = 0; a < 2; ++a)
#pragma unroll
        for (int b = 0; b < 2; ++b)
#pragma unroll
            for (int m = 0; m < 4; ++m)
#pragma unroll
                for (int n = 0; n < 2; ++n) acc[a][b][m][n] = (f32x4){0.f, 0.f, 0.f, 0.f};
    bf16x8 At[4][2], B0[2][2], B1[2][2];
    {
        const char* cA = cur.A0; const char* cB = cur.B0;
        PG8_STAGE_B(PG8_SB(0, 0), cB); PG8_STAGE_B(PG8_SB(0, 1), cB + hstepB); PG8_STAGE_A(PG8_SA(0, 0), cA, voC, 0); PG8_STAGE_A(PG8_SA(0, 1), cA, voC, 1);
        if (wr == 1) PG8_BAR;
        PG8_WAIT_V(2); PG8_BAR;
        PG8_STAGE_B(PG8_SB(1, 0), cB + 128); PG8_STAGE_A(PG8_SA(1, 0), cA + 128, voC, 0); PG8_STAGE_B(PG8_SB(1, 1), cB + hstepB + 128);
        PG8_WAIT_V(6); PG8_BAR;
    }
    for (;;) {
        const bool has_next = S.next(ui + 1, nxt);
        if (has_next) { if constexpr (GA) { PG8_SETVO(voN, ui + 1);
#pragma unroll
                for (int _h = 0; _h < 2; ++_h)
#pragma unroll
                    for (int _i = 0; _i < 2; ++_i) voN[_h][_i] -= voC[_h][_i]; } }
        else { nxt = cur;
#pragma unroll
            for (int _h = 0; _h < 2; ++_h)
#pragma unroll
                for (int _i = 0; _i < 2; ++_i) voN[_h][_i] = 0u; }
        const int nt = cur.nt;
        for (int t = 0; t < nt; t += 2) {
            const bool last = (t == nt - 2);
            const char* a1 = tile_ptr(cur.A0, cur.A1, cur.nt0, t + 1);
            const char* a2 = last ? nxt.A0 : tile_ptr(cur.A0, cur.A1, cur.nt0, t + 2);
            const char* b2 = last ? nxt.B0 : tile_ptr(cur.B0, cur.B1, cur.nt0, t + 2);
            const char* a3 = a2 + 128; const char* b3 = b2 + 128;
            unsigned vo2[2][2];
#pragma unroll
            for (int _h = 0; _h < 2; ++_h)
#pragma unroll
                for (int _i = 0; _i < 2; ++_i) vo2[_h][_i] = GA ? voC[_h][_i] + (last ? 1u : 0u) * voN[_h][_i] : voC[_h][_i];
            PG8_LDB(B0, 0, 0); PG8_LDB(B1, 0, 1); PG8_SCHED; PG8_LDA(At, 0, 0); PG8_STAGE_A(PG8_SA(1, 1), a1, voC, 1);
            PG8_WAIT_V(8); PG8_WAIT_L(0); PG8_BAR; PG8_MMA(0, 0, At, B0); PG8_MMA(0, 1, At, B1); PG8_BAR; PG8_SCHED;
            PG8_LDA(At, 0, 1); PG8_STAGE_B(PG8_SB(0, 0), b2); PG8_STAGE_B(PG8_SB(0, 1), b2 + hstepB); PG8_STAGE_A(PG8_SA(0, 0), a2, vo2, 0);
            PG8_WAIT_V(8); PG8_WAIT_L(0); PG8_BAR; PG8_MMA(1, 0, At, B0); PG8_MMA(1, 1, At, B1); PG8_BAR; PG8_SCHED;
            PG8_LDB(B0, 1, 0); PG8_LDB(B1, 1, 1); PG8_SCHED; PG8_LDA(At, 1, 0); PG8_STAGE_A(PG8_SA(0, 1), a2, vo2, 1);
            PG8_WAIT_V(8); PG8_WAIT_L(0); PG8_BAR; PG8_MMA(0, 0, At, B0); PG8_MMA(0, 1, At, B1); PG8_BAR; PG8_SCHED;
            PG8_LDA(At, 1, 1); PG8_STAGE_B(PG8_SB(1, 0), b3); PG8_STAGE_B(PG8_SB(1, 1), b3 + hstepB); PG8_STAGE_A(PG8_SA(1, 0), a3, vo2, 0);
            PG8_WAIT_V(8); PG8_WAIT_L(0); PG8_BAR; PG8_MMA(1, 0, At, B0); PG8_MMA(1, 1, At, B1); PG8_BAR; PG8_SCHED;
        }
        if (wr == 0) PG8_BAR;
        E(acc, cur, wr, wc, fr, fq);
        if (!has_next) break;
#pragma unroll
        for (int a = 0; a < 2; ++a)
#pragma unroll
            for (int b = 0; b < 2; ++b)
#pragma unroll
                for (int m = 0; m < 4; ++m)
#pragma unroll
                    for (int n = 0; n < 2; ++n) acc[a][b][m][n] = (f32x4){0.f, 0.f, 0.f, 0.f};
        cur = nxt; ++ui;
        if constexpr (GA) {
#pragma unroll
            for (int _h = 0; _h < 2; ++_h)
#pragma unroll
                for (int _i = 0; _i < 2; ++_i) voC[_h][_i] += voN[_h][_i];
        }
        if (wr == 1) PG8_BAR;
    }
    PG8_WAIT_V(0);
    PG8_BAR;
#undef PG8_SA
#undef PG8_SB
#undef PG8_STAGE_A
#undef PG8_STAGE_B
#undef PG8_LDA
#undef PG8_LDB
#undef PG8_MMA
#undef PG8_WAIT_V
#undef PG8_WAIT_L
#undef PG8_BAR
#undef PG8_SCHED
#undef PG8_SETVO
}
}
constexpr int NB = 4, SEQ = 8192, D = 1024, T = NB * SEQ;
constexpr int NHEAD = 16, HD = 64;
constexpr int QLORA = 384, KVLORA = 256, ROPE = 32, QKD = 96;
constexpr int NEXP = 16, NCLS = 24, DEXP = 256;
constexpr int MODW = 14336;
constexpr float NORM_EPS = 1e-6f, GN_EPS = 64e-5f;
constexpr float QSCALE = 0.10206207261596577f * 1.4426950408889634f;
constexpr int NWAVES = 8, NTHREADS = 512;

constexpr size_t MiB = 1u << 20;
constexpr size_t SLOT = 64 * MiB;
constexpr size_t WS_W0 = 0, WS_W1 = SLOT, WS_W2 = 2 * SLOT, WS_W3 = 3 * SLOT, WS_W4 = 4 * SLOT, WS_W5 = 5 * SLOT, WS_W6 = 6 * SLOT;
constexpr size_t WS_MISC = 7 * SLOT;
constexpr size_t WS_CTL = WS_MISC, CTL_ZERO_BYTES = 1 * MiB;
constexpr size_t WS_MOD = WS_MISC + 1 * MiB;
constexpr size_t WS_TAB = WS_MISC + 2 * MiB;
constexpr size_t WS_LIST = WS_MISC + 6 * MiB;
constexpr size_t WS_GATES = WS_MISC + 9 * MiB;
constexpr size_t WS_SSQKV = WS_MISC + 9 * MiB + 512 * 1024;
constexpr size_t WS_SSQQ = WS_MISC + 10 * MiB;
constexpr size_t WS_KR = WS_MISC + 11 * MiB;
constexpr size_t WS_WR = WS_MISC + 13 * MiB, WS_WK = WS_MISC + 15 * MiB, WS_WV = WS_MISC + 17 * MiB;
constexpr size_t WS_LD = WS_MISC + 19 * MiB;
constexpr size_t WS_WO = WS_MISC + 20 * MiB;
constexpr size_t WS_DKV = WS_MISC + 22 * MiB;
constexpr size_t WS_DQ = WS_MISC + 23 * MiB;
constexpr size_t WS_UQ = WS_MISC + 24 * MiB;
constexpr size_t WS_UKV = WS_MISC + 26 * MiB;
constexpr size_t WS_MWO = WS_MISC + 27 * MiB;
constexpr size_t WS_WGU = WS_MISC + 29 * MiB;
constexpr size_t WS_WDN = WS_MISC + 45 * MiB;
constexpr size_t WS_W2T = WS_MISC + 53 * MiB;
constexpr size_t WS_A2T = WS_MISC + 53 * MiB + 256 * 1024;
constexpr size_t WS_G2T = WS_MISC + 53 * MiB + 512 * 1024;
constexpr size_t WS_BSUM = WS_MISC + 54 * MiB;
constexpr size_t WS_END = WS_MISC + 62 * MiB;
constexpr size_t WS_WGU1 = WS_W6 + 40 * MiB, WS_WDN1 = WS_W6 + 56 * MiB;
static_assert(WS_END <= 512 * MiB, "d_ws map");
constexpr int CW_BAR = 4096;
constexpr int CW_XSLOT = 20480;
constexpr int CW_CNT = 16384;

constexpr int RING_OFF = 0, RING_BYTES = 131072;
constexpr int TAB_OFF = 131072;
constexpr int ROWTAB_OFF = TAB_OFF, GATETAB_OFF = TAB_OFF + 4096, UDESC_OFF = TAB_OFF + 12288, CLSTAB_OFF = UDESC_OFF + 256;
constexpr int MISC_OFF = 151552;
constexpr int LDS_BYTES = 155648;

#define XB_TMO      128
#define XB_XCNT(j)  (256  + 64 * (j))
#define XB_XSUB(j)  (1280 + 64 * (j))
#define XB_XGEN(j)  (2304 + 64 * (j))
#define XB_TOP      3328
#define XB_TOPGEN   3392
#define XCD_BAR_WORDS 3456
#define XB_SPIN_CAP (1u << 18)

__device__ __forceinline__ unsigned xb_ld(unsigned* p)              { return __hip_atomic_load(p, __ATOMIC_RELAXED, __HIP_MEMORY_SCOPE_AGENT); }
__device__ __forceinline__ unsigned xb_add(unsigned* p, unsigned v) { return __hip_atomic_fetch_add(p, v, __ATOMIC_RELAXED, __HIP_MEMORY_SCOPE_AGENT); }
__device__ __forceinline__ unsigned xb_xcc_id() { return (unsigned)__builtin_amdgcn_s_getreg((3 << 11) | 20) & 0xFu; }
#define XB_SPIN(cond, bar) do { unsigned _sp = 0; while (cond) { __builtin_amdgcn_s_sleep(1); \
    if ((++_sp & 255u) == 0u) { if (xb_ld(&(bar)[XB_TMO])) break; if (_sp > XB_SPIN_CAP) { atomicAdd(&(bar)[XB_TMO], 1u); break; } } } } while (0)

struct XcdBarrier { unsigned* bar; unsigned x; volatile LAS unsigned* st; };

__device__ __forceinline__ XcdBarrier xcd_barrier_post(unsigned* bar, volatile LAS unsigned* st) {
    XcdBarrier b; b.bar = bar; b.x = xb_xcc_id(); b.st = st;
    if (threadIdx.x == 0) (void)xb_add(&bar[XB_XCNT(b.x)], 1u);
    return b;
}
__device__ __forceinline__ void xcd_barrier_complete(unsigned* bar, unsigned x, unsigned& nloc, unsigned& nx) {
    const unsigned G = gridDim.x * gridDim.y * gridDim.z;
    unsigned sum, cnt, mine, sp = 0u;
    for (;;) {
        sum = 0u; cnt = 0u; mine = 0u;
#pragma unroll
        for (unsigned j = 0; j < 16; ++j) { const unsigned c = xb_ld(&bar[XB_XCNT(j)]); sum += c; cnt += (c > 0u) ? 1u : 0u; mine = (j == x) ? c : mine; }
        if (sum == G) break;
        __builtin_amdgcn_s_sleep(1);
        if ((++sp & 255u) == 0u) { if (xb_ld(&bar[XB_TMO])) break; if (sp > XB_SPIN_CAP) { atomicAdd(&bar[XB_TMO], 1u); break; } }
    }
    nloc = mine > 0u ? mine : 1u; nx = cnt > 0u ? cnt : 1u;
}
__device__ __forceinline__ void xcd_barrier(const XcdBarrier& b) {
    asm volatile("s_waitcnt vmcnt(0)" ::: "memory");
    __syncthreads();
    if (threadIdx.x == 0) {
        unsigned* bar = b.bar;
        __builtin_amdgcn_s_waitcnt(0);
        unsigned nloc = b.st[0], nx = b.st[1];
        if (nloc == 0u) { xcd_barrier_complete(bar, b.x, nloc, nx); b.st[0] = nloc; b.st[1] = nx; }
        const unsigned old = xb_add(&bar[XB_XSUB(b.x)], 1u);
        const unsigned gen = old / nloc;
        if (old + 1u == (gen + 1u) * nloc) {
            __builtin_amdgcn_fence(__ATOMIC_RELEASE, "agent");
            asm volatile("s_waitcnt vmcnt(0)" ::: "memory");
            const unsigned og = xb_add(&bar[XB_TOP], 1u);
            const unsigned tg = og / nx;
            if (og + 1u == (tg + 1u) * nx) xb_add(&bar[XB_TOPGEN], 1u);
            else XB_SPIN(xb_ld(&bar[XB_TOPGEN]) == tg, bar);
            __builtin_amdgcn_fence(__ATOMIC_ACQUIRE, "agent");
            xb_add(&bar[XB_XGEN(b.x)], 1u);
            asm volatile("s_waitcnt vmcnt(0)" ::: "memory");
        } else {
            XB_SPIN(xb_ld(&bar[XB_XGEN(b.x)]) == gen, bar);
            __builtin_amdgcn_fence(__ATOMIC_ACQUIRE, "agent");
            asm volatile("s_waitcnt vmcnt(0)" ::: "memory");
        }
    }
    __syncthreads();
}

#ifdef PT_CUSTOM
#define PT_M0(c, id) do { if ((id) == PT_SEL && (c).tid == 0) *(volatile LAS unsigned long long*)((c).lds + MISC_OFF + 512) = wall_clock64(); } while (0)
#define PT_M1(c, id) do { if ((id) == PT_SEL && (c).tid == 0) *(volatile LAS unsigned long long*)((c).lds + MISC_OFF + 520) = wall_clock64(); } while (0)
#else
#define PT_M0(c, id) do { } while (0)
#define PT_M1(c, id) do { } while (0)
#endif
enum { I_X = 0, I_C, I_POS, I_ADAW, I_ADAB, I_NORMG, I_MU, I_WRKV, I_W0, I_W1, I_W2, I_A0, I_A1, I_A2, I_G1, I_G2, I_KK, I_KA, I_RK, I_LNW, I_LNB, I_RWO,
       I_KVADAW, I_KVADAB, I_KVNG, I_WDKV, I_GKV, I_WUK, I_WUV, I_WKR, I_WDQ, I_GQ, I_WUQ, I_WQR, I_MWO, I_RTW, I_RTB, I_WGU, I_WDOWN, I_FG, N_IN };
struct Params { const float* in[N_IN]; float* out; unsigned char* ws; int ph_lo, ph_hi, li, pad; };

struct Ctx {
    LAS unsigned char* lds;
    int tid, lane, wave, G, bid;
};
__device__ __forceinline__ bf16_t* wsb(const Params& p, size_t off) { return (bf16_t*)(p.ws + off); }
__device__ __forceinline__ float* wsf(const Params& p, size_t off) { return (float*)(p.ws + off); }
struct DenseSched {
    int nM, nN, nwg, G, c, nt, nt0, lda, pad, rep; const char* A; const char* B; size_t btile; long a1d, b1d;
    __device__ __forceinline__ void init(const void* A_, int lda_, const void* B_, int ldb_, int M, int N, int K, int G_, int c_) {
        nM = M / 256; nN = N / 256; nwg = nM * nN; G = G_; c = c_; nt = K / 64; nt0 = nt; lda = lda_; pad = 0; rep = 1; A = (const char*)A_; B = (const char*)B_;
        btile = (size_t)256 * ldb_ * 2; a1d = 0; b1d = 0; }
    __device__ __forceinline__ bool next(int i, pg8::Unit& u) const {
        const long L0 = (long)i * G + c; if (L0 >= (long)nwg * rep) return false; const long L = L0 >= nwg ? L0 - nwg : L0;
        int wgid = (int)L; { const int q = nwg / 8, r = nwg % 8, xcd = wgid % 8, off = wgid / 8; wgid = (xcd < r ? xcd * (q + 1) : r * (q + 1) + (xcd - r) * q) + off; }
        const int nig = 8 * nN, gid = wgid / nig, fm = gid * 8, gsz = (nM - fm) < 8 ? (nM - fm) : 8;
        u.pm = fm + ((wgid % nig) % gsz); u.pn = (wgid % nig) / gsz; u.aux = 0; u.nt = nt; u.nt0 = nt0;
        const size_t arow = pad ? (size_t)((u.pm >> 5) * (SEQ + 1) + 1 + 256 * (u.pm & 31)) : (size_t)u.pm * 256;
        u.A0 = A + arow * (size_t)lda * 2; u.A1 = u.A0 + a1d; u.B0 = B + (size_t)u.pn * btile; u.B1 = u.B0 + b1d; return true;
    }
    __device__ __forceinline__ int row(int, int) const { return 0; }
};

struct MoeSched {
    LAS const int* ud; LAS const int* rowtab; int down; const char* A; const char* Wgu; const char* Wdn;
    __device__ __forceinline__ bool next(int i, pg8::Unit& u) const {
        if (i >= 4) return false;
        const int valid = __builtin_amdgcn_readfirstlane(ud[i * 16 + 0]); if (!valid) return false;
        const int st = __builtin_amdgcn_readfirstlane(ud[i * 16 + 1]), pn = __builtin_amdgcn_readfirstlane(ud[i * 16 + 2]);
        const int elo = __builtin_amdgcn_readfirstlane(ud[i * 16 + 3]), ehi = __builtin_amdgcn_readfirstlane(ud[i * 16 + 4]);
        u.pm = st; u.pn = pn; u.aux = i;
        if (!down) { u.nt = 16; u.nt0 = 16; u.A0 = A; u.A1 = A; const int e = (pn >> 1) ? ehi : elo;
            u.B0 = Wgu + ((size_t)e * 512 + (size_t)(pn & 1) * 256) * 1024 * 2; u.B1 = u.B0; }
        else { u.nt = 8; u.nt0 = 4; u.A0 = A + (size_t)st * 256 * 512 * 2; u.A1 = u.A0 + 4 * 128;
            u.B0 = Wdn + ((size_t)elo * 1024 + (size_t)pn * 256) * 256 * 2; u.B1 = Wdn + ((size_t)ehi * 1024 + (size_t)pn * 256) * 256 * 2; }
        return true;
    }
    __device__ __forceinline__ int row(int i, int r) const { const int t = rowtab[i * 256 + r]; return t < 0 ? 0 : t; }
};

typedef f32x4 AccT[2][2][4][2];
#define EPI_ARGS const AccT& acc, const pg8::Unit& u, int wr, int wc, int fr, int fq
__device__ __forceinline__ u32x4 pack8(f32x4 a, f32x4 b) { u32x4 w; w.x = cvtpk(a[0], a[1]); w.y = cvtpk(a[2], a[3]); w.z = cvtpk(b[0], b[1]); w.w = cvtpk(b[2], b[3]); return w; }
__device__ __forceinline__ u32x2 pack4(f32x4 a) { u32x2 w; w.x = cvtpk(a[0], a[1]); w.y = cvtpk(a[2], a[3]); return w; }

struct EpiBf16 {
    static constexpr bool PERM = true; bf16_t* O; int ldc;
    __device__ __forceinline__ void operator()(EPI_ARGS) const {
        const int row0 = u.pm * 256 + wr * 64 + fr, col0 = u.pn * 256 + wc * 32 + 8 * fq;
#pragma unroll
        for (int ai = 0; ai < 2; ++ai)
#pragma unroll
            for (int m = 0; m < 4; ++m) { bf16_t* rowp = O + (size_t)(row0 + ai * 128 + m * 16) * ldc + col0;
#pragma unroll
                for (int bj = 0; bj < 2; ++bj) *(u32x4*)(rowp + bj * 128) = pack8(acc[ai][bj][m][0], acc[ai][bj][m][1]); }
    }
};
struct EpiLoraDown {
    static constexpr bool PERM = true; bf16_t* O;
    __device__ __forceinline__ void operator()(EPI_ARGS) const {
        const int row0 = u.pm * 256 + wr * 64 + fr, col0 = wc * 32 + 8 * fq;
#pragma unroll
        for (int ai = 0; ai < 2; ++ai)
#pragma unroll
            for (int m = 0; m < 4; ++m) { bf16_t* rowp = O + (size_t)(row0 + ai * 128 + m * 16) * 256 + col0;
#pragma unroll
                for (int bj = 0; bj < 2; ++bj) { f32x4 v0 = acc[ai][bj][m][0], v1 = acc[ai][bj][m][1];
                    if (bj == 1) {
#pragma unroll
                        for (int i = 0; i < 4; ++i) { v0[i] = sigmoidf_(v0[i]); v1[i] = sigmoidf_(v1[i]); } }
                    else if (wc < 2) {
#pragma unroll
                        for (int i = 0; i < 4; ++i) { v0[i] = 1.0f - 2.0f * frcp(1.0f + fexp(2.0f * v0[i])); v1[i] = 1.0f - 2.0f * frcp(1.0f + fexp(2.0f * v1[i])); } }
                    *(u32x4*)(rowp + bj * 128) = pack8(v0, v1); } }
    }
};
__device__ __forceinline__ void unpack8(u32x4 w, f32x4& a, f32x4& b) { a = (f32x4){bflo(w.x), bfhi(w.x), bflo(w.y), bfhi(w.y)}; b = (f32x4){bflo(w.z), bfhi(w.z), bflo(w.w), bfhi(w.w)}; }
template <bool XF32>
struct EpiResidT {
    static constexpr bool PERM = true; const void* xin; bf16_t* xout; const float* gate;
    __device__ __forceinline__ void operator()(EPI_ARGS) const {
        const int row0 = u.pm * 256 + wr * 64 + fr, col0 = u.pn * 256 + wc * 32 + 8 * fq; const int b = u.pm >> 5;
        f32x4 gv[2][2];
#pragma unroll
        for (int bj = 0; bj < 2; ++bj)
#pragma unroll
            for (int n = 0; n < 2; ++n) gv[bj][n] = *(const f32x4*)(gate + (size_t)b * MODW + col0 + bj * 128 + n * 4);
#pragma unroll
        for (int ai = 0; ai < 2; ++ai)
#pragma unroll
            for (int m = 0; m < 4; ++m) { const size_t off = (size_t)(row0 + ai * 128 + m * 16) * D + col0;
#pragma unroll
                for (int bj = 0; bj < 2; ++bj) { f32x4 x0, x1;
                    if constexpr (XF32) { x0 = *(const f32x4*)((const float*)xin + off + bj * 128); x1 = *(const f32x4*)((const float*)xin + off + bj * 128 + 4); }
                    else unpack8(*(const u32x4*)((const bf16_t*)xin + off + bj * 128), x0, x1);
                    *(u32x4*)(xout + off + bj * 128) = pack8(x0 + gv[bj][0] * acc[ai][bj][m][0], x1 + gv[bj][1] * acc[ai][bj][m][1]); } }
    }
};
struct EpiMoeUp {
    static constexpr bool PERM = true; bf16_t* act; LAS const float* gatetab;
    __device__ __forceinline__ void operator()(EPI_ARGS) const {
        const int eidx = u.pn >> 1, half = u.pn & 1; const int rl0 = wr * 64 + fr, col0 = eidx * 256 + half * 128 + wc * 32 + 8 * fq;
#pragma unroll
        for (int ai = 0; ai < 2; ++ai)
#pragma unroll
            for (int m = 0; m < 4; ++m) { const int rl = rl0 + ai * 128 + m * 16; const float cb = gatetab[(u.aux * 256 + rl) * 2 + eidx];
                f32x4 o[2];
#pragma unroll
                for (int n = 0; n < 2; ++n)
#pragma unroll
                    for (int i = 0; i < 4; ++i) { const float g = acc[ai][0][m][n][i], up = acc[ai][1][m][n][i]; o[n][i] = g * sigmoidf_(g) * up * cb; }
                *(u32x4*)(act + (size_t)(u.pm * 256 + rl) * 512 + col0) = pack8(o[0], o[1]); }
    }
};
struct EpiMoeDown {
    static constexpr bool PERM = true; const bf16_t* Xin; bf16_t* Xout; const float* gate; LAS const int* rowtab;
    __device__ __forceinline__ void operator()(EPI_ARGS) const {
        const int rl0 = wr * 64 + fr, col0 = u.pn * 256 + wc * 32 + 8 * fq;
#pragma unroll
        for (int ai = 0; ai < 2; ++ai)
#pragma unroll
            for (int m = 0; m < 4; ++m) { const int rl = rl0 + ai * 128 + m * 16; const int tok = rowtab[u.aux * 256 + rl];
                if (tok >= 0) { const float* gp = gate + (size_t)(tok >> 13) * MODW + col0; const size_t off = (size_t)tok * D + col0;
#pragma unroll
                    for (int bj = 0; bj < 2; ++bj) { const f32x4 g0 = *(const f32x4*)(gp + bj * 128), g1 = *(const f32x4*)(gp + bj * 128 + 4); f32x4 x0, x1;
                        unpack8(*(const u32x4*)(Xin + off + bj * 128), x0, x1);
                        *(u32x4*)(Xout + off + bj * 128) = pack8(x0 + g0 * acc[ai][bj][m][0], x1 + g1 * acc[ai][bj][m][1]); } } }
    }
};
struct EpiDown {
    static constexpr bool PERM = false; bf16_t* O; int ldc; int ncols1; float* ssq; int ssq_ld; bf16_t* Kr; const float* tab;
    __device__ __forceinline__ void operator()(EPI_ARGS) const {
        const int row0 = u.pm * 256 + wr * 64 + fr;
#pragma unroll
        for (int ai = 0; ai < 2; ++ai)
#pragma unroll
            for (int m = 0; m < 4; ++m) { const int row = row0 + ai * 128 + m * 16;
                if (u.pn == 0 || ncols1 > 0) { float ss = 0.f;
#pragma unroll
                    for (int bj = 0; bj < 2; ++bj) { if (u.pn == 0 || bj * 128 < ncols1) {
#pragma unroll
                        for (int n = 0; n < 2; ++n) { const f32x4 v = acc[ai][bj][m][n]; ss += (v[0] * v[0] + v[1] * v[1]) + (v[2] * v[2] + v[3] * v[3]);
                            *(u32x2*)(O + (size_t)row * ldc + u.pn * 256 + bj * 128 + wc * 32 + n * 16 + 4 * fq) = pack4(v); } } }
                    ss += __shfl_xor(ss, 16); ss += __shfl_xor(ss, 32);
                    if (fq == 0) ssq[(size_t)row * ssq_ld + u.pn * 4 + wc] = ss; }
                if (Kr != nullptr && u.pn == 1 && wc == 0) { const f32x4 x1 = acc[ai][0][m][0], x2 = acc[ai][0][m][1];
                    const f32x4 c4 = *(const f32x4*)(tab + (size_t)row * 32 + 4 * fq), s4 = *(const f32x4*)(tab + (size_t)row * 32 + 16 + 4 * fq);
                    *(u32x2*)(Kr + (size_t)row * 32 + 4 * fq) = pack4(x1 * c4 - x2 * s4); *(u32x2*)(Kr + (size_t)row * 32 + 16 + 4 * fq) = pack4(x2 * c4 + x1 * s4); } }
    }
};
struct EpiQ {
    static constexpr bool PERM = false; bf16_t* Q; const float* ssq; const float* tab;
    __device__ __forceinline__ void operator()(EPI_ARGS) const {
        const int row0 = u.pm * 256 + wr * 64 + fr;
#pragma unroll
        for (int ai = 0; ai < 2; ++ai)
#pragma unroll
            for (int m = 0; m < 4; ++m) { const int row = row0 + ai * 128 + m * 16;
                const f32x4 sa = *(const f32x4*)(ssq + (size_t)row * 8), sb = *(const f32x4*)(ssq + (size_t)row * 8 + 4);
                const float sc = rsqrtf(((sa[0] + sa[1]) + (sa[2] + sa[3]) + (sb[0] + sb[1]) + (sb[2] + sb[3])) * (1.0f / QLORA) + NORM_EPS) * QSCALE;
                bf16_t* qrow = Q + (size_t)row * (NHEAD * QKD);
                if (u.pn < 4) {
#pragma unroll
                    for (int bj = 0; bj < 2; ++bj)
#pragma unroll
                        for (int n = 0; n < 2; ++n) { const int col = u.pn * 256 + bj * 128 + wc * 32 + n * 16 + 4 * fq;
                            *(u32x2*)(qrow + (col >> 6) * QKD + (col & 63)) = pack4(acc[ai][bj][m][n] * sc); }
                } else { const f32x4 c4 = *(const f32x4*)(tab + (size_t)row * 32 + 4 * fq), s4 = *(const f32x4*)(tab + (size_t)row * 32 + 16 + 4 * fq);
#pragma unroll
                    for (int bj = 0; bj < 2; ++bj) { const int h = (u.pn - 4) * 8 + bj * 4 + wc; const f32x4 x1 = acc[ai][bj][m][0] * sc, x2 = acc[ai][bj][m][1] * sc;
                        *(u32x2*)(qrow + h * QKD + 64 + 4 * fq) = pack4(x1 * c4 - x2 * s4); *(u32x2*)(qrow + h * QKD + 80 + 4 * fq) = pack4(x2 * c4 + x1 * s4); } } }
    }
};
struct EpiKV {
    static constexpr bool PERM = true; bf16_t* Kn; bf16_t* V; const float* ssq;
    __device__ __forceinline__ void operator()(EPI_ARGS) const {
        const int row0 = u.pm * 256 + wr * 64 + fr; bf16_t* base = (u.pn < 4) ? Kn : V; const int col0 = (u.pn & 3) * 256 + wc * 32 + 8 * fq;
#pragma unroll
        for (int ai = 0; ai < 2; ++ai)
#pragma unroll
            for (int m = 0; m < 4; ++m) { const int row = row0 + ai * 128 + m * 16; const f32x4 sa = *(const f32x4*)(ssq + (size_t)row * 4);
                const float sc = rsqrtf(((sa[0] + sa[1]) + (sa[2] + sa[3])) * (1.0f / KVLORA) + NORM_EPS);
#pragma unroll
                for (int bj = 0; bj < 2; ++bj) *(u32x4*)(base + (size_t)row * D + col0 + bj * 128) = pack8(acc[ai][bj][m][0] * sc, acc[ai][bj][m][1] * sc); }
    }
};
__device__ __forceinline__ float srcval(const Params& p, int kind, int e, int k, int n) {
    switch (kind) {
    case 0: case 1: case 2: return p.in[I_WRKV][((size_t)kind * D + k) * D + n];
    case 3: { const int kk = k & 1023, hi = k >> 10; float w, mu;
        if (n < 64) { w = p.in[I_W1][kk * 64 + n]; mu = p.in[I_MU][1 * D + kk]; }
        else if (n < 128) { w = p.in[I_A1][kk * 64 + n - 64]; mu = p.in[I_MU][4 * D + kk]; }
        else { w = p.in[I_G1][kk * 128 + n - 128]; mu = p.in[I_MU][5 * D + kk]; }
        return w * (hi ? mu : 1.0f - mu); }
    case 4: return p.in[I_RWO][(size_t)k * D + n];
    case 5: return n < 256 ? p.in[I_WDKV][k * 256 + n] : (n < 288 ? p.in[I_WKR][k * 32 + n - 256] : 0.f);
    case 6: return n < 384 ? p.in[I_WDQ][k * 384 + n] : 0.f;
    case 7: return p.in[I_GQ][k] * (n < 1024 ? p.in[I_WUQ][(size_t)k * 1024 + n] : p.in[I_WQR][(size_t)k * 512 + n - 1024]);
    case 8: return p.in[I_GKV][k] * (n < 1024 ? p.in[I_WUK][(size_t)k * 1024 + n] : p.in[I_WUV][(size_t)k * 1024 + n - 1024]);
    case 9: return p.in[I_MWO][(size_t)k * D + n];
    case 10: { const int pp = n >> 8, w = n & 255; const int col = (w < 128) ? (128 * pp + w) : (256 + 128 * pp + (w - 128));
        return p.in[I_WGU][((size_t)e * D + k) * 512 + col]; }
    case 11: return p.in[I_WDOWN][((size_t)e * 256 + k) * D + n];
    case 12: return p.in[I_W2][(size_t)k * D + n];
    case 13: return p.in[I_A2][(size_t)k * D + n];
    default: return p.in[I_G2][(size_t)k * D + n];
    }
}
__device__ __forceinline__ void transpose_item(const Params& p, int kind, int e, bf16_t* dst, int ldd, LAS float* scr, int kb, int nb, int lane) {
    const int k0 = 64 * kb, n0 = 32 * nb;
#pragma unroll 4
    for (int i = 0; i < 32; ++i) { const int kk = 2 * i + (lane >> 5); scr[kk * 33 + (lane & 31)] = srcval(p, kind, e, k0 + kk, n0 + (lane & 31)); }
    asm volatile("s_waitcnt lgkmcnt(0)" ::: "memory");
    const int c = lane & 7;
#pragma unroll
    for (int j = 0; j < 4; ++j) { const int n = (lane >> 3) + 8 * j; const LAS float* s = scr + (8 * c) * 33 + n;
        u32x4 o; o.x = cvtpk(s[0 * 33], s[1 * 33]); o.y = cvtpk(s[2 * 33], s[3 * 33]); o.z = cvtpk(s[4 * 33], s[5 * 33]); o.w = cvtpk(s[6 * 33], s[7 * 33]);
        *(u32x4*)(dst + (size_t)(n0 + n) * ldd + k0 + 8 * c) = o; }
    asm volatile("s_waitcnt lgkmcnt(0)" ::: "memory");
}
__device__ __forceinline__ bool tjob(const Params& p, int& r, int kind, int e, size_t ws_off, int Kd, int Nd, LAS float* scr, int lane) {
    const int nkb = Kd / 64, nnb = Nd / 32, cnt = nkb * nnb;
    if (r < cnt) { transpose_item(p, kind, e, wsb(p, ws_off), Kd, scr, r / nnb, r % nnb, lane); return true; }
    r -= cnt; return false;
}
__device__ __forceinline__ void convert_moe_weights(const Params& p, const Ctx& c, int layer) {
    LAS float* scr = (LAS float*)(c.lds + RING_OFF + c.wave * 16384);
    const int gw = c.bid * NWAVES + c.wave, NGW = c.G * NWAVES;
    for (int it = gw; it < 16 * 384; it += NGW) { const int e = it / 384; int r = it % 384;
        if (r < 256) transpose_item(p, 10, layer * 16 + e, wsb(p, WS_WGU) + (size_t)e * 512 * 1024, 1024, scr, r / 16, r % 16, c.lane);
        else { r -= 256; transpose_item(p, 11, layer * 16 + e, wsb(p, WS_WDN) + (size_t)e * 1024 * 256, 256, scr, r / 32, r % 32, c.lane); } }
}
__device__ __forceinline__ void phase_prologue(const Params& p, const Ctx& c) {
    LAS float* sc = (LAS float*)(c.lds);
    LAS float* part = (LAS float*)(c.lds + 16384);
    for (int i = c.tid; i < NB * D; i += NTHREADS) { const float v = p.in[I_C][i]; sc[i] = v / (1.0f + __expf(-v)); }
    __syncthreads();
    const int prep = (p.pad == 100) ? 2 : 1;
    for (int it0 = c.bid; it0 < (MODW / 64) * prep; it0 += c.G) { const int it = it0 % (MODW / 64);
        const int col0 = it * 64, set = col0 < 12288 ? col0 / 3072 : 4, cin = col0 - (set < 4 ? set * 3072 : 12288);
        const float* W = set < 4 ? p.in[I_ADAW] + (size_t)set * D * 3072 : p.in[I_KVADAW]; const int ldw = set < 4 ? 3072 : 2048;
        const float* bias = set < 4 ? p.in[I_ADAB] + set * 3072 : p.in[I_KVADAB];
        float a0 = 0.f, a1 = 0.f, a2 = 0.f, a3 = 0.f;
#pragma unroll 8
        for (int kk = 0; kk < 128; ++kk) { const int k = c.wave * 128 + kk; const float w = W[(size_t)k * ldw + cin + c.lane];
            a0 += sc[k] * w; a1 += sc[D + k] * w; a2 += sc[2 * D + k] * w; a3 += sc[3 * D + k] * w; }
        part[(c.wave * 4 + 0) * 64 + c.lane] = a0; part[(c.wave * 4 + 1) * 64 + c.lane] = a1; part[(c.wave * 4 + 2) * 64 + c.lane] = a2; part[(c.wave * 4 + 3) * 64 + c.lane] = a3;
        __syncthreads();
        if (c.tid < 256) { const int b = c.tid >> 6, l = c.tid & 63; float s = bias[cin + l];
#pragma unroll
            for (int w = 0; w < 8; ++w) s += part[(w * 4 + b) * 64 + l];
            wsf(p, WS_MOD)[(size_t)b * MODW + col0 + l] = s; }
        __syncthreads();
    }
    __syncthreads();
    LAS float* scr = (LAS float*)(c.lds + RING_OFF + c.wave * 16384);
    const int gw = c.bid * NWAVES + c.wave, NGW = c.G * NWAVES;
    constexpr int NITEMS = 3 * 512 + 256 + 512 + 32 + 32 + 64;
    for (int it = gw; it < NITEMS * prep; it += NGW) { int r = it % NITEMS;
        if (tjob(p, r, 0, 0, WS_WR, 1024, 1024, scr, c.lane)) continue;
        if (tjob(p, r, 1, 0, WS_WK, 1024, 1024, scr, c.lane)) continue;
        if (tjob(p, r, 2, 0, WS_WV, 1024, 1024, scr, c.lane)) continue;
        if (tjob(p, r, 3, 0, WS_LD, 2048, 256, scr, c.lane)) continue;
        if (tjob(p, r, 4, 0, WS_WO, 1024, 1024, scr, c.lane)) continue;
        if (tjob(p, r, 12, 0, WS_W2T, 64, 1024, scr, c.lane)) continue;
        if (tjob(p, r, 13, 0, WS_A2T, 64, 1024, scr, c.lane)) continue;
        tjob(p, r, 14, 0, WS_G2T, 128, 1024, scr, c.lane);
    }
    for (int q = 0; q < prep; ++q) convert_moe_weights(p, c, 0);
    const int* pos = (const int*)p.in[I_POS]; float* tab = wsf(p, WS_TAB);
    for (int i0 = c.bid * NTHREADS + c.tid; i0 < T * 16 * prep; i0 += c.G * NTHREADS) { const int i = i0 % (T * 16); const int t = i >> 4, f = i & 15;
        const float inv = powf(10000.0f, -(float)(2 * f) / 32.0f); float s, co; sincosf((float)pos[t] * inv, &s, &co);
        tab[(size_t)t * 32 + f] = co; tab[(size_t)t * 32 + 16 + f] = s; }
}

__device__ __forceinline__ void load_row(const float* rowp, int lane, f32x4 (&v)[4]) {
#pragma unroll
    for (int j = 0; j < 4; ++j) v[j] = *(const f32x4*)(rowp + 4 * lane + 256 * j);
}
__device__ __forceinline__ void load_row_b(const bf16_t* rowp, int lane, f32x4 (&v)[4]) {
#pragma unroll
    for (int j = 0; j < 4; ++j) { const u32x2 w = *(const u32x2*)(rowp + 4 * lane + 256 * j); v[j] = (f32x4){bflo(w.x), bfhi(w.x), bflo(w.y), bfhi(w.y)}; }
}
__device__ __forceinline__ float row_rstd(const f32x4 (&v)[4]) {
    float s = 0.f;
#pragma unroll
    for (int j = 0; j < 4; ++j) s += (v[j][0] * v[j][0] + v[j][1] * v[j][1]) + (v[j][2] * v[j][2] + v[j][3] * v[j][3]);
    return rsqrtf(wave_sum(s) * (1.0f / D) + NORM_EPS);
}
__device__ __forceinline__ void store_row_bf16(bf16_t* rowp, int lane, const f32x4 (&v)[4]) {
#pragma unroll
    for (int j = 0; j < 4; ++j) *(u32x2*)(rowp + 4 * lane + 256 * j) = pack4(v[j]);
}
__device__ __forceinline__ void load_mod(const Params& p, const float* g, int set, int b, int lane, f32x4 (&P)[4], f32x4 (&SH)[4]) {
    const float* m = wsf(p, WS_MOD) + (size_t)b * MODW + (set < 4 ? set * 3072 : 12288);
#pragma unroll
    for (int j = 0; j < 4; ++j) { const int o = 4 * lane + 256 * j; const f32x4 gg = *(const f32x4*)(g + o), sc = *(const f32x4*)(m + 1024 + o); SH[j] = *(const f32x4*)(m + o); P[j] = gg * (sc + 1.0f); }
}

__device__ __forceinline__ void phase_n0(const Params& p, const Ctx& c) {
    const int row0 = (c.bid * NWAVES + c.wave) * 16;
    if (row0 >= T) return;
    const int b = row0 >> 13, t0 = row0 & (SEQ - 1);
    f32x4 P[4], SH[4], mr[4], mk[4], mv[4];
    load_mod(p, p.in[I_NORMG] + 0 * D, 0, b, c.lane, P, SH);
#pragma unroll
    for (int j = 0; j < 4; ++j) { const int o = 4 * c.lane + 256 * j; mr[j] = *(const f32x4*)(p.in[I_MU] + 0 * D + o); mk[j] = *(const f32x4*)(p.in[I_MU] + 2 * D + o); mv[j] = *(const f32x4*)(p.in[I_MU] + 3 * D + o); }
    bf16_t* hpad = (bf16_t*)p.out; bf16_t* xr = wsb(p, WS_W0); bf16_t* xk = wsb(p, WS_W1); bf16_t* xv = wsb(p, WS_W2);
    f32x4 hp[4];
    if (t0 == 0) {
#pragma unroll
        for (int j = 0; j < 4; ++j) hp[j] = (f32x4){0.f, 0.f, 0.f, 0.f};
        store_row_bf16(hpad + (size_t)b * (SEQ + 1) * D, c.lane, hp);
    } else { f32x4 v[4]; load_row(p.in[I_X] + (size_t)(row0 - 1) * D, c.lane, v); const float rs = row_rstd(v);
#pragma unroll
        for (int j = 0; j < 4; ++j) hp[j] = v[j] * rs * P[j] + SH[j]; }
    for (int rr = 0, nr = (p.pad == 101) ? 32 : 16; rr < nr; ++rr) { const int r = rr & 15; const int row = row0 + r; f32x4 v[4], o[4]; load_row(p.in[I_X] + (size_t)row * D, c.lane, v); const float rs = row_rstd(v);
#pragma unroll
        for (int j = 0; j < 4; ++j) v[j] = v[j] * rs * P[j] + SH[j];
        store_row_bf16(hpad + ((size_t)b * (SEQ + 1) + 1 + t0 + r) * D, c.lane, v);
#pragma unroll
        for (int j = 0; j < 4; ++j) o[j] = v[j] + (hp[j] - v[j]) * mr[j];
        store_row_bf16(xr + (size_t)row * D, c.lane, o);
#pragma unroll
        for (int j = 0; j < 4; ++j) o[j] = v[j] + (hp[j] - v[j]) * mk[j];
        store_row_bf16(xk + (size_t)row * D, c.lane, o);
#pragma unroll
        for (int j = 0; j < 4; ++j) o[j] = v[j] + (hp[j] - v[j]) * mv[j];
        store_row_bf16(xv + (size_t)row * D, c.lane, o);
#pragma unroll
        for (int j = 0; j < 4; ++j) hp[j] = v[j]; }
}

__device__ __forceinline__ void phase_router(const Params& p, const Ctx& c, int layer) {
    LAS float* rwt = (LAS float*)(c.lds);
    LAS int* rcls = (LAS int*)(c.lds + 65536);
    LAS float* rgate = (LAS float*)(c.lds + 65536 + 512);
    LAS int* rpos = (LAS int*)(c.lds + 65536 + 2048);
    LAS int* hist = (LAS int*)(c.lds + 65536 + 4096);
    for (int i = c.tid; i < D * NEXP; i += NTHREADS) { const int k = i >> 4, e = i & 15; rwt[e * D + k] = p.in[I_RTW][i]; }
    if (c.tid < 64) hist[c.tid] = 0;
    __syncthreads();
    const int set = layer * 2 + 1; const int rowb = c.bid * 128; const int b = rowb >> 13;
    f32x4 P[4], SH[4]; load_mod(p, p.in[I_NORMG] + (size_t)set * D, set, b, c.lane, P, SH);
    const bf16_t* X = (const bf16_t*)p.out; bf16_t* h2 = wsb(p, WS_W1);
    LAS float* sa = (LAS float*)(c.lds + 65536 + 8192) + c.wave * 512;
    const float rbl = p.in[I_RTB][c.lane & 15];
    for (int rq = 0; rq < 4; ++rq) {
        f32x4 v[4][4];
#pragma unroll
        for (int q = 0; q < 4; ++q) load_row_b(X + (size_t)(rowb + c.wave * 16 + rq * 4 + q) * D, c.lane, v[q]);
#pragma unroll
        for (int q = 0; q < 4; ++q) { const float rs = row_rstd(v[q]);
#pragma unroll
            for (int j = 0; j < 4; ++j) v[q][j] = v[q][j] * rs * P[j] + SH[j];
            store_row_bf16(h2 + (size_t)(rowb + c.wave * 16 + rq * 4 + q) * D, c.lane, v[q]); }
        float s[64];
#pragma unroll
        for (int i = 0; i < 64; ++i) s[i] = 0.f;
#pragma unroll
        for (int j = 0; j < 4; ++j)
#pragma unroll
            for (int e = 0; e < 16; ++e) { const f32x4 w = *(const LAS f32x4*)(rwt + e * D + 4 * c.lane + 256 * j);
#pragma unroll
                for (int q = 0; q < 4; ++q) s[q * 16 + e] += (v[q][j][0] * w[0] + v[q][j][1] * w[1]) + (v[q][j][2] * w[2] + v[q][j][3] * w[3]); }
#pragma unroll
        for (int i = 0; i < 32; ++i) { auto rr = __builtin_amdgcn_permlane32_swap(__float_as_uint(s[i]), __float_as_uint(s[i + 32]), false, false); s[i] = __uint_as_float(rr[0]) + __uint_as_float(rr[1]); }
#pragma unroll
        for (int st = 16; st >= 1; st >>= 1) { const bool up = (c.lane & st) != 0;
#pragma unroll
            for (int i = 0; i < st; ++i) { const float keep = up ? s[i + st] : s[i], send = up ? s[i] : s[i + st]; s[i] = keep + __shfl_xor(send, st); } }
        const float aff = 1.0f / (1.0f + __expf(-s[0]));
        sa[rq * 64 + c.lane] = aff + rbl; sa[256 + rq * 64 + c.lane] = aff;
    }
    {
        const int r = c.lane & 15; float sel[16], aff[16];
#pragma unroll
        for (int k = 0; k < 4; ++k) { const f32x4 a = *(const LAS f32x4*)(sa + r * 16 + 4 * k), b = *(const LAS f32x4*)(sa + 256 + r * 16 + 4 * k);
#pragma unroll
            for (int i = 0; i < 4; ++i) { sel[4 * k + i] = a[i]; aff[4 * k + i] = b[i]; } }
        int bg = 0; float bs = -INFINITY;
#pragma unroll
        for (int g = 0; g < 4; ++g) { const float a0 = sel[4 * g], a1 = sel[4 * g + 1], a2 = sel[4 * g + 2], a3 = sel[4 * g + 3];
            const float m01 = fmaxf(a0, a1), n01 = fminf(a0, a1), m23 = fmaxf(a2, a3), n23 = fminf(a2, a3);
            const float top = fmaxf(m01, m23), second = fmaxf(fminf(m01, m23), (m01 >= m23) ? n01 : n23); const float gs = top + second;
            if (gs > bs) { bs = gs; bg = g; } }
        float s4[4], a4[4];
#pragma unroll
        for (int i = 0; i < 4; ++i) { s4[i] = sel[i]; a4[i] = aff[i]; }
#pragma unroll
        for (int g = 1; g < 4; ++g) if (g == bg) {
#pragma unroll
            for (int i = 0; i < 4; ++i) { s4[i] = sel[4 * g + i]; a4[i] = aff[4 * g + i]; } }
        int i0 = 0;
#pragma unroll
        for (int i = 1; i < 4; ++i) if (s4[i] > s4[i0]) i0 = i;
        int i1 = (i0 == 0) ? 1 : 0;
#pragma unroll
        for (int i = 0; i < 4; ++i) if (i != i0 && i != i1 && s4[i] > s4[i1]) i1 = i;
        float af0 = 0.f, af1 = 0.f;
#pragma unroll
        for (int i = 0; i < 4; ++i) { if (i == i0) af0 = a4[i]; if (i == i1) af1 = a4[i]; }
        const float inv = 1.0f / (af0 + af1);
        const int lo = i0 < i1 ? i0 : i1, hi = i0 < i1 ? i1 : i0; const float glo = (i0 < i1 ? af0 : af1) * inv, ghi = (i0 < i1 ? af1 : af0) * inv;
        const int pair = (lo == 0) ? (hi - 1) : (lo == 1 ? hi + 1 : 5);
        if (c.lane < 16) { const int rl = c.wave * 16 + r; rcls[rl] = bg * 6 + pair; rgate[rl * 2] = glo; rgate[rl * 2 + 1] = ghi; }
    }
    __syncthreads();
    if (c.tid < 128) rpos[c.tid] = atomicAdd((int*)(hist + rcls[c.tid]), 1);
    __syncthreads();
    unsigned* gcnt = (unsigned*)(p.ws + WS_CTL) + CW_CNT + 64 * layer;
    if (c.tid < NCLS) { const int n = hist[c.tid]; hist[32 + c.tid] = n ? (int)atomicAdd(gcnt + c.tid, (unsigned)n) : 0; }
    __syncthreads();
    if (c.tid < 128) { const int cl = rcls[c.tid], pos = hist[32 + cl] + rpos[c.tid], tok = rowb + c.tid;
        ((int*)(p.ws + WS_LIST))[(size_t)cl * T + pos] = tok;
        *(f32x2*)(wsf(p, WS_GATES) + (size_t)tok * 2) = (f32x2){rgate[c.tid * 2], rgate[c.tid * 2 + 1]}; }
}

__device__ __forceinline__ void moe_setup(const Params& p, const Ctx& c, int layer) {
    LAS int* ud = (LAS int*)(c.lds + UDESC_OFF); LAS int* ct = (LAS int*)(c.lds + CLSTAB_OFF);
    LAS int* rowtab = (LAS int*)(c.lds + ROWTAB_OFF); LAS float* gatetab = (LAS float*)(c.lds + GATETAB_OFF);
    const unsigned* gcnt = (const unsigned*)(p.ws + WS_CTL) + CW_CNT + 64 * layer;
    if (c.tid < NCLS) ct[c.tid] = (int)__hip_atomic_load(gcnt + c.tid, __ATOMIC_RELAXED, __HIP_MEMORY_SCOPE_AGENT);
    __syncthreads();
    if (c.tid == 0) { int acc = 0; for (int k = 0; k < NCLS; ++k) { ct[32 + k] = acc; acc += (ct[k] + 255) >> 8; } ct[32 + NCLS] = acc;
        const int total = acc * 4;
        for (int i = 0; i < 4; ++i) { const long L0 = (long)i * c.G + c.bid; int valid = 0, st = 0, pn = 0, elo = 0, ehi = 0, cls = 0, j = 0;
            if (L0 < total) { int L = (int)L0; { const int q = total / 8, r = total % 8, xcd = L % 8, off = L / 8; L = (xcd < r ? xcd * (q + 1) : r * (q + 1) + (xcd - r) * q) + off; }
                valid = 1; pn = L & 3; st = L >> 2; cls = 0; while (cls < NCLS - 1 && ct[32 + cls + 1] <= st) ++cls; j = st - ct[32 + cls];
                const int g = cls / 6, pr = cls % 6; const int lo = pr < 3 ? 0 : (pr < 5 ? 1 : 2), hi = pr < 3 ? pr + 1 : (pr < 5 ? pr - 1 : 3); elo = 4 * g + lo; ehi = 4 * g + hi; }
            ud[i * 16 + 0] = valid; ud[i * 16 + 1] = st; ud[i * 16 + 2] = pn; ud[i * 16 + 3] = elo; ud[i * 16 + 4] = ehi; ud[i * 16 + 5] = cls; ud[i * 16 + 6] = j; } }
    __syncthreads();
    const int* list = (const int*)(p.ws + WS_LIST); const float* gates = wsf(p, WS_GATES);
    for (int i = 0; i < 4; ++i) { if (!ud[i * 16]) continue; const int cls = ud[i * 16 + 5], j = ud[i * 16 + 6], n = ct[cls];
        if (c.tid < 256) { const int pos = j * 256 + c.tid; int tok = -1; f32x2 g = {0.f, 0.f};
            if (pos < n) { tok = list[(size_t)cls * T + pos]; g = *(const f32x2*)(gates + (size_t)tok * 2); }
            rowtab[i * 256 + c.tid] = tok; gatetab[(i * 256 + c.tid) * 2] = g.x; gatetab[(i * 256 + c.tid) * 2 + 1] = g.y; } }
    __syncthreads();
}

__device__ __forceinline__ void phase_n2(const Params& p, const Ctx& c) {
    const int row0 = (c.bid * NWAVES + c.wave) * 16; if (row0 >= T) return; const int b = row0 >> 13;
    f32x4 P1[4], S1[4], P2[4], S2[4];
    load_mod(p, p.in[I_NORMG] + 2 * D, 2, b, c.lane, P1, S1); load_mod(p, p.in[I_KVNG], 4, b, c.lane, P2, S2);
    const bf16_t* X = (const bf16_t*)p.out; bf16_t* h1 = wsb(p, WS_W0); bf16_t* hkv = wsb(p, WS_W1);
    for (int rr = 0, nr = (p.pad == 110) ? 32 : 16; rr < nr; ++rr) { const int r = rr & 15; const int row = row0 + r; f32x4 v[4], o[4]; load_row_b(X + (size_t)row * D, c.lane, v); const float rs = row_rstd(v);
#pragma unroll
        for (int j = 0; j < 4; ++j) { v[j] = v[j] * rs; o[j] = v[j] * P1[j] + S1[j]; }
        store_row_bf16(h1 + (size_t)row * D, c.lane, o);
#pragma unroll
        for (int j = 0; j < 4; ++j) o[j] = v[j] * P2[j] + S2[j];
        store_row_bf16(hkv + (size_t)row * D, c.lane, o); }
}
__device__ __forceinline__ void phase_final(const Params& p, const Ctx& c) {
    const int row0 = (c.bid * NWAVES + c.wave) * 16; if (row0 >= T) return;
    f32x4 g[4];
#pragma unroll
    for (int j = 0; j < 4; ++j) g[j] = *(const f32x4*)(p.in[I_FG] + 4 * c.lane + 256 * j);
    const bf16_t* X = wsb(p, WS_W1);
    for (int r = 0; r < 16; ++r) { float* rowp = p.out + (size_t)(row0 + r) * D; f32x4 v[4]; load_row_b(X + (size_t)(row0 + r) * D, c.lane, v); const float rs = row_rstd(v);
#pragma unroll
        for (int j = 0; j < 4; ++j) *(f32x4*)(rowp + 4 * c.lane + 256 * j) = v[j] * rs * g[j]; }
}
constexpr int AT_KSTR = 208;
constexpr int AT_KBUF = 64 * AT_KSTR, AT_VBUF = 8192;
__device__ __forceinline__ s16x4 vtr(const LAS unsigned char* pp) { typedef short v4i16_t __attribute__((ext_vector_type(4)));
    return __builtin_bit_cast(s16x4, __builtin_amdgcn_ds_read_tr16_b64_v4i16((LAS v4i16_t*)pp)); }
__device__ __forceinline__ void attn_unit(const Params& p, const Ctx& c, int b, int h, int qb) {
    const int tid = c.tid, lane = c.lane, wid = c.wave, r32 = lane & 31, hi = lane >> 5;
    const bf16_t* Q = wsb(p, WS_W2); const bf16_t* Kn = wsb(p, WS_W4); const bf16_t* V = wsb(p, WS_W5); const bf16_t* Kr = wsb(p, WS_KR); bf16_t* O = wsb(p, WS_W0);
    const size_t rowbase = (size_t)b * SEQ; const int q0 = qb * 256, qrow = q0 + 32 * wid + r32;
    LAS unsigned char* Kb = c.lds; LAS unsigned char* Vb = c.lds + 2 * AT_KBUF;
    bf16x8 qr[6];
#pragma unroll
    for (int d0 = 0; d0 < 6; ++d0) qr[d0] = *(const bf16x8*)(Q + (rowbase + qrow) * (NHEAD * QKD) + h * QKD + 16 * d0 + 8 * hi);
    const int NTL = (q0 + 256) / 64;
    const int lrow = tid >> 3, lch = tid & 7, lrow2 = (tid & 255) >> 2, lch2 = tid & 3;
    u32x4 kreg, vreg, rreg;
#define AT_LOAD(t) do { const size_t _r = rowbase + (size_t)(t) * 64; kreg = *(const u32x4*)(Kn + (_r + lrow) * D + h * HD + lch * 8); vreg = *(const u32x4*)(V + (_r + lrow) * D + h * HD + lch * 8); \
        if (tid < 256) rreg = *(const u32x4*)(Kr + (_r + lrow2) * ROPE + lch2 * 8); } while (0)
#define AT_STORE(buf) do { *(LAS u32x4*)(Kb + (buf) * AT_KBUF + lrow * AT_KSTR + lch * 16) = kreg; *(LAS u32x4*)(Vb + (buf) * AT_VBUF + (lch >> 2) * 4096 + lrow * 64 + (lch & 3) * 16) = vreg; \
        if (tid < 256) *(LAS u32x4*)(Kb + (buf) * AT_KBUF + lrow2 * AT_KSTR + 128 + lch2 * 16) = rreg; } while (0)
    AT_LOAD(0); AT_STORE(0);
#pragma unroll
    for (int d0 = 0; d0 < 6; ++d0) asm volatile("" : "+v"(qr[d0]));
    __syncthreads();
    f32x16 o0 = {}, o1 = {}, lacc = {}; float mref = 0.f;
    const bf16x8 onesrow = __builtin_bit_cast(bf16x8, (u32x4){r32 ? 0u : 0x3F803F80u, r32 ? 0u : 0x3F803F80u, r32 ? 0u : 0x3F803F80u, r32 ? 0u : 0x3F803F80u});
    bf16x8 qx = {}; const bf16x8 kx = __builtin_bit_cast(bf16x8, (u32x4){hi ? 0u : 0x3F80u, 0u, 0u, 0u});
    const int vlane = ((lane >> 4) & 1) * 32 + (lane & 3) * 8 + (4 * hi + ((lane & 15) >> 2)) * 64;
    for (int t = 0; t < NTL; ++t) {
        const int buf = t & 1;
        if (t + 1 < NTL) AT_LOAD(t + 1);
        if (64 * t <= q0 + 32 * wid + 31) {
            const LAS unsigned char* kb = Kb + buf * AT_KBUF; const LAS unsigned char* vb = Vb + buf * AT_VBUF;
            bf16x8 kf0[6], kf1[6];
#pragma unroll
            for (int d0 = 0; d0 < 6; ++d0) { kf0[d0] = *(const LAS bf16x8*)(kb + r32 * AT_KSTR + d0 * 32 + hi * 16); kf1[d0] = *(const LAS bf16x8*)(kb + (32 + r32) * AT_KSTR + d0 * 32 + hi * 16); }
            __builtin_amdgcn_sched_barrier(0);
            f32x16 s0 = __builtin_amdgcn_mfma_f32_32x32x16_bf16(kx, qx, (f32x16){}, 0, 0, 0), s1 = s0;
#pragma unroll
            for (int d0 = 0; d0 < 6; ++d0) { s0 = __builtin_amdgcn_mfma_f32_32x32x16_bf16(kf0[d0], qr[d0], s0, 0, 0, 0); s1 = __builtin_amdgcn_mfma_f32_32x32x16_bf16(kf1[d0], qr[d0], s1, 0, 0, 0); }
            if (64 * t + 63 > q0 + 32 * wid) {
                const int kb0 = 64 * t + 4 * hi;
#pragma unroll
                for (int r = 0; r < 16; ++r) { const int kv = kb0 + (r & 3) + 8 * (r >> 2); if (kv > qrow) s0[r] = -INFINITY; if (kv + 32 > qrow) s1[r] = -INFINITY; } }
            if (t == 0) {
                float mx = fmaxf(s0[0], s1[0]);
#pragma unroll
                for (int r = 1; r < 16; ++r) mx = fmaxf(fmaxf(mx, s0[r]), s1[r]);
                mx = fmaxf(mx, __shfl_xor(mx, 32));
                mref = bf2f((unsigned short)(cvtpk(mx, 0.f) & 0xffffu));
                qx = __builtin_bit_cast(bf16x8, (u32x4){hi ? 0u : (cvtpk(-mref, 0.f) & 0xffffu), 0u, 0u, 0u});
#pragma unroll
                for (int r = 0; r < 16; ++r) { s0[r] -= mref; s1[r] -= mref; } }
#pragma unroll
            for (int r = 0; r < 16; ++r) { s0[r] = __builtin_amdgcn_exp2f(s0[r]); s1[r] = __builtin_amdgcn_exp2f(s1[r]); }
            u32x4 pw[4];
#pragma unroll
            for (int s = 0; s < 2; ++s) { pw[s] = (u32x4){cvtpk(s0[8 * s], s0[8 * s + 1]), cvtpk(s0[8 * s + 2], s0[8 * s + 3]), cvtpk(s0[8 * s + 4], s0[8 * s + 5]), cvtpk(s0[8 * s + 6], s0[8 * s + 7])};
                pw[2 + s] = (u32x4){cvtpk(s1[8 * s], s1[8 * s + 1]), cvtpk(s1[8 * s + 2], s1[8 * s + 3]), cvtpk(s1[8 * s + 4], s1[8 * s + 5]), cvtpk(s1[8 * s + 6], s1[8 * s + 7])}; }
            s16x4 va0[4], va1[4], vc0[4], vc1[4];
#pragma unroll
            for (int s = 0; s < 4; ++s) { va0[s] = vtr(vb + vlane + s * 1024); va1[s] = vtr(vb + vlane + s * 1024 + 512); vc0[s] = vtr(vb + 4096 + vlane + s * 1024); vc1[s] = vtr(vb + 4096 + vlane + s * 1024 + 512); }
            __builtin_amdgcn_sched_barrier(0);
#pragma unroll
            for (int s = 0; s < 4; ++s) { const bf16x8 pb = __builtin_bit_cast(bf16x8, pw[s]);
                const bf16x8 va = {va0[s][0], va0[s][1], va0[s][2], va0[s][3], va1[s][0], va1[s][1], va1[s][2], va1[s][3]}, vc = {vc0[s][0], vc0[s][1], vc0[s][2], vc0[s][3], vc1[s][0], vc1[s][1], vc1[s][2], vc1[s][3]};
                o0 = __builtin_amdgcn_mfma_f32_32x32x16_bf16(va, pb, o0, 0, 0, 0); o1 = __builtin_amdgcn_mfma_f32_32x32x16_bf16(vc, pb, o1, 0, 0, 0);
                lacc = __builtin_amdgcn_mfma_f32_32x32x16_bf16(onesrow, pb, lacc, 0, 0, 0); }
            { const float lq = __shfl(lacc[0], r32);
              if (__builtin_expect(__any(lq > 0x1p40f), 0)) { asm volatile("; rare rescale path" ::: "memory"); const float dl = (lq > 0x1p40f) ? bf2f((unsigned short)(cvtpk(__log2f(lq), 0.f) & 0xffffu)) : 0.f;
                  const float mnew = bf2f((unsigned short)(cvtpk(mref + dl, 0.f) & 0xffffu)); const float de = mnew - mref; mref = mnew; const float alpha = __builtin_amdgcn_exp2f(-de);
                  qx = __builtin_bit_cast(bf16x8, (u32x4){hi ? 0u : (cvtpk(-mnew, 0.f) & 0xffffu), 0u, 0u, 0u});
#pragma unroll
                  for (int r = 0; r < 16; ++r) { o0[r] *= alpha; o1[r] *= alpha; lacc[r] *= alpha; } } }
        }
        if (t + 1 < NTL) AT_STORE(buf ^ 1);
        __syncthreads();
    }
    const float inv = 1.0f / __shfl(lacc[0], r32);
    bf16_t* orow = O + (rowbase + qrow) * D + h * HD;
#pragma unroll
    for (int g = 0; g < 4; ++g) { const f32x4 x0 = {o0[4 * g] * inv, o0[4 * g + 1] * inv, o0[4 * g + 2] * inv, o0[4 * g + 3] * inv}, x1 = {o1[4 * g] * inv, o1[4 * g + 1] * inv, o1[4 * g + 2] * inv, o1[4 * g + 3] * inv};
        *(u32x2*)(orow + 8 * g + 4 * hi) = pack4(x0); *(u32x2*)(orow + 32 + 8 * g + 4 * hi) = pack4(x1); }
#undef AT_LOAD
#undef AT_STORE
}
__device__ __forceinline__ void phase_attention(const Params& p, const Ctx& c) {
    const int v = (c.G % 8 == 0) ? (c.bid % 8) * (c.G / 8) + c.bid / 8 : c.bid; const int bh = v >> 2, s = v & 3;
    if (bh >= NB * NHEAD) return;
    for (int ii = 0, ni = (p.pad == 113) ? 16 : 8; ii < ni; ++ii) { const int i = ii & 7; const int qb = 8 * (i >> 1) + ((i & 1) ? 7 - s : s); attn_unit(p, c, bh >> 4, bh & 15, qb); }
}
constexpr int W32_NCH = SEQ / 32;
struct Pk { u32x4 f[2]; };
__device__ __forceinline__ Pk pk_tile(const f32x16& t) { Pk p;
#pragma unroll
    for (int s = 0; s < 2; ++s) p.f[s] = (u32x4){cvtpk(t[8 * s], t[8 * s + 1]), cvtpk(t[8 * s + 2], t[8 * s + 3]), cvtpk(t[8 * s + 4], t[8 * s + 5]), cvtpk(t[8 * s + 6], t[8 * s + 7])};
    return p; }
__device__ __forceinline__ f32x16 unpk_tile(const Pk& p) { f32x16 t;
#pragma unroll
    for (int s = 0; s < 2; ++s) { t[8 * s] = bflo(p.f[s].x); t[8 * s + 1] = bfhi(p.f[s].x); t[8 * s + 2] = bflo(p.f[s].y); t[8 * s + 3] = bfhi(p.f[s].y); t[8 * s + 4] = bflo(p.f[s].z); t[8 * s + 5] = bfhi(p.f[s].z); t[8 * s + 6] = bflo(p.f[s].w); t[8 * s + 7] = bfhi(p.f[s].w); }
    return t; }
__device__ __forceinline__ f32x16 mma2(f32x16 acc, const Pk& p2, const Pk& p1) {
#pragma unroll
    for (int s = 0; s < 2; ++s) acc = __builtin_amdgcn_mfma_f32_32x32x16_bf16(__builtin_bit_cast(bf16x8, p2.f[s]), __builtin_bit_cast(bf16x8, p1.f[s]), acc, 0, 0, 0);
    return acc; }
__device__ __forceinline__ Pk tri_pk(int t, int hi, int strict) { Pk p;
#pragma unroll
    for (int s = 0; s < 2; ++s) { unsigned w[4];
#pragma unroll
        for (int d = 0; d < 4; ++d) { const int k0 = 16 * s + 8 * (d >> 1) + 4 * hi + 2 * (d & 1) + strict; w[d] = (k0 <= t ? 0x3F80u : 0u) | (k0 + 1 <= t ? 0x3F800000u : 0u); }
        p.f[s] = (u32x4){w[0], w[1], w[2], w[3]}; }
    return p; }
__device__ __forceinline__ Pk ident_pk(int x, int hi) { Pk p;
#pragma unroll
    for (int s = 0; s < 2; ++s) { unsigned w[4];
#pragma unroll
        for (int d = 0; d < 4; ++d) { const int k0 = 16 * s + 8 * (d >> 1) + 4 * hi + 2 * (d & 1); w[d] = (k0 == x ? 0x3F80u : 0u) | (k0 + 1 == x ? 0x3F800000u : 0u); }
        p.f[s] = (u32x4){w[0], w[1], w[2], w[3]}; }
    return p; }
__device__ __forceinline__ bf16x8 glbfrag(const bf16_t* M, int ld, int row, int s, int hi) { return *(const bf16x8*)(M + (size_t)row * ld + 16 * s + 8 * hi); }
#define LDS_BARRIER() do { asm volatile("s_waitcnt lgkmcnt(0)" ::: "memory"); __builtin_amdgcn_s_barrier(); asm volatile("" ::: "memory"); } while (0)
#define W32_Y(r) (((r) & 3) + 8 * ((r) >> 2) + 4 * hi)
constexpr size_t WU = 64 * 64;

#define W32_YQ(r) (((r) & 3) + 8 * ((r) >> 2) + 4 * hq)
__device__ __forceinline__ void phase_wkv_a(const Params& p, const Ctx& c) {
    const int lane = c.lane, r32 = lane & 31, hi = lane >> 5;
    LAS float* cst = (LAS float*)c.lds;
    for (int i = c.tid; i < D; i += NTHREADS) { cst[i] = p.in[I_A0][i]; cst[D + i] = p.in[I_KK][i]; cst[2 * D + i] = p.in[I_KA][i]; cst[3 * D + i] = p.in[I_RK][i]; cst[4 * D + i] = p.in[I_W0][i]; }
    __syncthreads();
    bf16_t* Rg = wsb(p, WS_W3); bf16_t* Kg = wsb(p, WS_W4); const bf16_t* Vg = wsb(p, WS_W5); const bf16_t* L1 = wsb(p, WS_W6);
    const bf16_t* W2T = wsb(p, WS_W2T); const bf16_t* A2T = wsb(p, WS_A2T);
    bf16_t* PTg = wsb(p, WS_W0); bf16_t* Zg = (bf16_t*)p.out; bf16_t* QTg = wsb(p, WS_W2); float* bsg = wsf(p, WS_BSUM);
    const int gw = c.bid * NWAVES + c.wave;
    PT_M0(c, 3);
    for (int uu2 = (p.pad == 1) ? -8 : 0; uu2 < 8; ++uu2) { const int uu = uu2 & 7; const bool dry = uu2 < 0;
        int unit_ = gw * 8 + uu; asm volatile("" : "+s"(unit_));
        const int unit = unit_, bh = unit >> 8, chunk = unit & 255, b = bh >> 4, h = bh & 15;
        int hq = hi; asm volatile("" : "+v"(hq));
        const size_t row0 = (size_t)b * SEQ + (size_t)chunk * 32, tok = row0 + r32;
        const size_t tokoff = tok * D + h * 64 + 4 * hi; bf16_t* rp = Rg + tokoff; bf16_t* kp = Kg + tokoff; const bf16_t* vp = Vg + tokoff;
        const LAS float* cp = cst + h * 64 + 4 * hi;
        const bf16_t* l1p = L1 + tok * 256 + 8 * hi;
        float ss = 0.f;
#pragma unroll
        for (int yt = 0; yt < 2; ++yt)
#pragma unroll
            for (int q = 0; q < 4; ++q) { const u32x2 kw = *(const u32x2*)(kp + 32 * yt + 8 * q); const f32x4 kc = *(const LAS f32x4*)(cp + D + 32 * yt + 8 * q);
                const float k0 = bflo(kw.x) * kc[0], k1 = bfhi(kw.x) * kc[1], k2 = bflo(kw.y) * kc[2], k3 = bfhi(kw.y) * kc[3]; ss += (k0 * k0 + k1 * k1) + (k2 * k2 + k3 * k3); }
        ss += __shfl_xor(ss, 32); const float inrm = frcp(fmaxf(__builtin_amdgcn_sqrtf(ss), 1e-12f));
        float bs = 0.f, cwC[2];
        LAS unsigned char* park = c.lds + 5 * D * 4 + c.wave * 16384 + lane * 16;
#define PARK_ST(mat, yt_, fr, v) (*(LAS u32x4*)(park + (((mat) * 2 + (yt_)) * 2 + (fr)) * 1024) = (v))
#define PARK_LD(mat, yt_) Pk{{*(const LAS u32x4*)(park + (((mat) * 2 + (yt_)) * 2) * 1024), *(const LAS u32x4*)(park + (((mat) * 2 + (yt_)) * 2 + 1) * 1024)}}
#pragma unroll
        for (int yt = 0; yt < 2; ++yt) {
            Pk ldh, ldl;
            { const bf16_t* w2p = W2T + (size_t)(h * 64 + 32 * yt + r32) * 64 + 8 * hi; bf16x8 w2[4], fw[4];
#pragma unroll
              for (int s = 0; s < 4; ++s) { w2[s] = *(const bf16x8*)(w2p + 16 * s); fw[s] = *(const bf16x8*)(l1p + 16 * s); }
              f32x16 ldt = {};
#pragma unroll
              for (int s = 0; s < 4; ++s) ldt = __builtin_amdgcn_mfma_f32_32x32x16_bf16(fw[s], w2[s], ldt, 0, 0, 0);
              const float w0c = cst[4 * D + h * 64 + 32 * yt + r32]; f32x16 vh, vl; float sum = 0.f;
#pragma unroll
              for (int r = 0; r < 16; ++r) { const float x = -(w0c + ldt[r]); const float sp = fmaxf(x, 0.f) + __logf(1.0f + fexp(-fabsf(x))); const float ld = -fexp(-sp - 0.5f) * 1.4426950408889634f;
                  const float lh = bf2f((unsigned short)(cvtpk(ld, 0.f) & 0xffffu)); vh[r] = lh; vl[r] = ld - lh; sum += ld; }
              sum += __shfl_xor(sum, 32); cwC[yt] = fexp2(sum); ldh = pk_tile(vh); ldl = pk_tile(vl); }
            __builtin_amdgcn_sched_barrier(0);
            int tq = r32; asm volatile("" : "+v"(tq));
            const Pk tri = tri_pk(tq, hq, 0), tris = tri_pk(tq, hq, 1);
            const f32x16 cl = mma2(mma2((f32x16){}, ldh, tri), ldl, tri), cle = mma2(mma2((f32x16){}, ldh, tris), ldl, tris);
            __builtin_amdgcn_sched_barrier(0);
            f32x16 aTL = {};
            { const bf16_t* a2p = A2T + (size_t)(h * 64 + 32 * yt + r32) * 64 + 8 * hi; bf16x8 a2[4], fa[4];
#pragma unroll
              for (int s = 0; s < 4; ++s) { a2[s] = *(const bf16x8*)(a2p + 16 * s); fa[s] = *(const bf16x8*)(l1p + 64 + 16 * s); }
#pragma unroll
              for (int s = 0; s < 4; ++s) aTL = __builtin_amdgcn_mfma_f32_32x32x16_bf16(a2[s], fa[s], aTL, 0, 0, 0); }
            u32x2 rr[4], kk[4];
#pragma unroll
            for (int q = 0; q < 4; ++q) { rr[q] = *(const u32x2*)(rp + 32 * yt + 8 * q); kk[q] = *(const u32x2*)(kp + 32 * yt + 8 * q); }
            __builtin_amdgcn_sched_barrier(0);
            u32x4 fA, fB, fK, fR;
#pragma unroll
            for (int q = 0; q < 4; ++q) { const int c0 = 32 * yt + 8 * q;
                const f32x4 a0 = *(const LAS f32x4*)(cp + c0), kkc = *(const LAS f32x4*)(cp + D + c0), kac = *(const LAS f32x4*)(cp + 2 * D + c0), rkc = *(const LAS f32x4*)(cp + 3 * D + c0);
                const float kv[4] = {bflo(kk[q].x), bfhi(kk[q].x), bflo(kk[q].y), bfhi(kk[q].y)}, rv[4] = {bflo(rr[q].x), bfhi(rr[q].x), bflo(rr[q].y), bfhi(rr[q].y)};
                float at[4], bt[4], kt[4], rt[4];
#pragma unroll
                for (int i = 0; i < 4; ++i) { const int r = 4 * q + i; const float a = sigmoidf_(a0[i] + aTL[r]); const float kkv = kv[i] * kkc[i] * inrm, km = kv[i] * (1.0f + (a - 1.0f) * kac[i]);
                    const float cw = fexp2(cl[r]), cwm1 = fexp2(cle[r]), icw = fexp2(-cl[r]);
                    at[i] = -kkv * cwm1; bt[i] = kkv * a * icw; kt[i] = km * icw; rt[i] = rv[i] * cw; bs += rv[i] * km * rkc[i]; }
                if (q & 1) { fA.z = cvtpk(at[0], at[1]); fA.w = cvtpk(at[2], at[3]); fB.z = cvtpk(bt[0], bt[1]); fB.w = cvtpk(bt[2], bt[3]); fK.z = cvtpk(kt[0], kt[1]); fK.w = cvtpk(kt[2], kt[3]); fR.z = cvtpk(rt[0], rt[1]); fR.w = cvtpk(rt[2], rt[3]);
                             PARK_ST(0, yt, q >> 1, fA); PARK_ST(1, yt, q >> 1, fB); PARK_ST(2, yt, q >> 1, fK); PARK_ST(3, yt, q >> 1, fR); }
                else       { fA.x = cvtpk(at[0], at[1]); fA.y = cvtpk(at[2], at[3]); fB.x = cvtpk(bt[0], bt[1]); fB.y = cvtpk(bt[2], bt[3]); fK.x = cvtpk(kt[0], kt[1]); fK.y = cvtpk(kt[2], kt[3]); fR.x = cvtpk(rt[0], rt[1]); fR.y = cvtpk(rt[2], rt[3]); } }
            __builtin_amdgcn_sched_barrier(0); }
        bs += __shfl_xor(bs, 32);
        if (hi == 0 && !dry) bsg[tok * NHEAD + h] = bs;
        __builtin_amdgcn_sched_barrier(0);
#define W32_SB() __builtin_amdgcn_sched_barrier(0)
        int rq = r32; asm volatile("" : "+v"(rq));
        f32x16 MN = {}, MT = {}, X2 = {}; Pk pMbr, pMkr;
        asm volatile("s_waitcnt lgkmcnt(0)" ::: "memory");
        { const Pk a0_ = PARK_LD(0, 0), a1_ = PARK_LD(0, 1), b0_ = PARK_LD(1, 0), b1_ = PARK_LD(1, 1);
        MN = mma2(mma2(MN, a0_, b0_), a1_, b1_);
#pragma unroll
        for (int r = 0; r < 16; ++r) if (!(rq < W32_YQ(r))) MN[r] = 0.f;
        W32_SB();
        MT = mma2(mma2(MT, b0_, a0_), b1_, a1_); }
#pragma unroll
        for (int r = 0; r < 16; ++r) if (!(W32_YQ(r) < rq)) MT[r] = 0.f;
        W32_SB();
        { const Pk a0_ = PARK_LD(0, 0), a1_ = PARK_LD(0, 1), k0_ = PARK_LD(2, 0), k1_ = PARK_LD(2, 1);
        X2 = mma2(mma2(X2, a0_, k0_), a1_, k1_); }
#pragma unroll
        for (int r = 0; r < 16; ++r) if (!(rq < W32_YQ(r))) X2[r] = 0.f;
        W32_SB();
        { const Pk b0_ = PARK_LD(1, 0), b1_ = PARK_LD(1, 1), r0_ = PARK_LD(3, 0), r1_ = PARK_LD(3, 1);
          f32x16 m = mma2(mma2((f32x16){}, b0_, r0_), b1_, r1_);
#pragma unroll
          for (int r = 0; r < 16; ++r) if (!(W32_YQ(r) <= rq)) m[r] = 0.f;
          pMbr = pk_tile(m); }
        W32_SB();
        { const Pk k0_ = PARK_LD(2, 0), k1_ = PARK_LD(2, 1), r0_ = PARK_LD(3, 0), r1_ = PARK_LD(3, 1);
          f32x16 m = mma2(mma2((f32x16){}, k0_, r0_), k1_, r1_);
#pragma unroll
          for (int r = 0; r < 16; ++r) if (!(W32_YQ(r) <= rq)) m[r] = 0.f;
          pMkr = pk_tile(m); }
        W32_SB();
        const Pk idn = ident_pk(rq, hq);
        f32x16 X0 = mma2((f32x16){}, PARK_LD(0, 0), idn), X1 = mma2((f32x16){}, PARK_LD(0, 1), idn);
        W32_SB();
#define PARK_PK(mat, yt_, pk) do { const Pk _p = (pk); PARK_ST(mat, yt_, 0, _p.f[0]); PARK_ST(mat, yt_, 1, _p.f[1]); } while (0)
#pragma unroll
        for (int xt = 0; xt < 2; ++xt) {
            { const Pk t = pk_tile(mma2((f32x16){}, PARK_LD(1, xt), idn)); PARK_PK(1, xt, t); } W32_SB();
            { const Pk t = pk_tile(mma2((f32x16){}, PARK_LD(2, xt), idn)); PARK_PK(2, xt, t); } W32_SB();
            { u32x2 vv[4];
#pragma unroll
              for (int q = 0; q < 4; ++q) vv[q] = *(const u32x2*)(vp + 32 * xt + 8 * q);
              Pk pV; pV.f[0] = (u32x4){vv[0].x, vv[0].y, vv[1].x, vv[1].y}; pV.f[1] = (u32x4){vv[2].x, vv[2].y, vv[3].x, vv[3].y};
              const Pk t = pk_tile(mma2((f32x16){}, pV, idn)); PARK_PK(0, xt, t); } W32_SB(); }
        __builtin_amdgcn_sched_barrier(0);
#pragma unroll
        for (int kq = 0; kq < 5; ++kq) { const Pk pMN = pk_tile(MN), pMT = pk_tile(MT);
            X0 = mma2(X0, pMT, pk_tile(X0)); X1 = mma2(X1, pMT, pk_tile(X1)); X2 = mma2(X2, pMT, pk_tile(X2));
            if (kq < 4) { MN = mma2((f32x16){}, pMT, pMN); MT = mma2((f32x16){}, pMN, pMT); } }
        const Pk pW1[2] = {pk_tile(X0), pk_tile(X1)}, pW2 = pk_tile(X2);
        __builtin_amdgcn_sched_barrier(0);
        bf16_t* ptp = PTg + (size_t)unit * WU + lane * 4; bf16_t* zp = Zg + (size_t)unit * WU + lane * 4; bf16_t* qtp = QTg + (size_t)unit * 2048 + lane * 4;
        Pk pGT[2];
#pragma unroll
        for (int xt = 0; xt < 2; ++xt) {
#pragma unroll
            for (int yt = 0; yt < 2; ++yt) { f32x16 m = mma2((f32x16){}, pW1[yt], PARK_LD(1, xt));
#pragma unroll
                for (int r = 0; r < 16; ++r) m[r] = cwC[xt] * (m[r] + ((xt == yt && W32_YQ(r) == rq) ? 1.0f : 0.0f));
#pragma unroll
                for (int q = 0; q < 4; ++q) if (!dry) *(u32x2*)(ptp + ((xt * 2 + yt) * 4 + q) * 256) = pack4((f32x4){m[4 * q], m[4 * q + 1], m[4 * q + 2], m[4 * q + 3]}); }
            f32x16 g = mma2(unpk_tile(PARK_LD(2, xt)), pW2, PARK_LD(1, xt));
#pragma unroll
            for (int r = 0; r < 16; ++r) g[r] *= cwC[xt];
            pGT[xt] = pk_tile(g); }
        const Pk pHT = pk_tile(mma2(unpk_tile(pMkr), pW2, pMbr));
#pragma unroll
        for (int yt = 0; yt < 2; ++yt) {
            const f32x16 qv = mma2(unpk_tile(PARK_LD(3, yt)), pW1[yt], pMbr);
            const f32x16 yl = mma2((f32x16){}, PARK_LD(0, yt), pHT);
#pragma unroll
            for (int q = 0; q < 4; ++q) { if (dry) continue;
                *(u32x2*)(qtp + (yt * 4 + q) * 256) = pack4((f32x4){qv[4 * q], qv[4 * q + 1], qv[4 * q + 2], qv[4 * q + 3]}); *(u32x2*)(rp + 32 * yt + 8 * q) = pack4((f32x4){yl[4 * q], yl[4 * q + 1], yl[4 * q + 2], yl[4 * q + 3]}); } }
#pragma unroll
        for (int xt = 0; xt < 2; ++xt)
#pragma unroll
            for (int yt = 0; yt < 2; ++yt) { const f32x16 z = mma2((f32x16){}, pGT[yt], PARK_LD(0, xt));
#pragma unroll
                for (int q = 0; q < 4; ++q) if (!dry) *(u32x2*)(zp + ((xt * 2 + yt) * 4 + q) * 256) = pack4((f32x4){z[4 * q], z[4 * q + 1], z[4 * q + 2], z[4 * q + 3]}); }
    }
    __syncthreads(); PT_M1(c, 3);
}

constexpr int WKB_NS = 8, WKB_SLOT = 16384, WKB_QT = 8192, WKB_Z = 12288, WKB_YL = 14336;
__device__ __forceinline__ void phase_wkv_b(const Params& p, const Ctx& c, const XcdBarrier& bar) {
    {   LAS float* scr = (LAS float*)(c.lds + RING_OFF + c.wave * 16384);
        const int gw = c.bid * NWAVES + c.wave, NGW = c.G * NWAVES;
        constexpr int NM = 256 + 256 + 288 + 256 + 512;
        for (int it = gw; it < NM + 16 * 384; it += NGW) { int r = it;
            if (r < NM) { if (tjob(p, r, 5, 0, WS_DKV, 1024, 512, scr, c.lane)) continue; if (tjob(p, r, 6, 0, WS_DQ, 1024, 512, scr, c.lane)) continue; if (tjob(p, r, 7, 0, WS_UQ, 384, 1536, scr, c.lane)) continue;
                if (tjob(p, r, 8, 0, WS_UKV, 256, 2048, scr, c.lane)) continue; tjob(p, r, 9, 0, WS_MWO, 1024, 1024, scr, c.lane); continue; }
            r -= NM; const int e = r / 384; r = r % 384;
            if (r < 256) transpose_item(p, 10, 16 + e, wsb(p, WS_WGU1) + (size_t)e * 512 * 1024, 1024, scr, r / 16, r % 16, c.lane);
            else { r -= 256; transpose_item(p, 11, 16 + e, wsb(p, WS_WDN1) + (size_t)e * 1024 * 256, 256, scr, r / 32, r % 32, c.lane); } }
        __syncthreads(); }
#ifndef WKB_VAR
    PT_M0(c, 1);
#endif
    int pos_;
    {   const unsigned* xs = (const unsigned*)(p.ws + WS_CTL) + CW_XSLOT; const volatile LAS unsigned* MISC = (const volatile LAS unsigned*)(c.lds + MISC_OFF);
        const int x = (int)MISC[16], slot = (int)MISC[17]; int n[8];
#pragma unroll
        for (int j = 0; j < 8; ++j) n[j] = (int)__hip_atomic_load(xs + 64 * j, __ATOMIC_RELAXED, __HIP_MEMORY_SCOPE_AGENT);
        if (x < 8 && slot < 32) pos_ = x * 32 + slot;
        else { int ov = slot - (x < 8 ? 32 : 0);
#pragma unroll
            for (int j = 0; j < 8; ++j) if (j < x) ov += n[j] > 32 ? n[j] - 32 : 0;
            pos_ = -1;
#pragma unroll
            for (int j = 0; j < 8; ++j) { const int fr = n[j] < 32 ? 32 - n[j] : 0; if (pos_ < 0) { if (ov < fr) pos_ = j * 32 + n[j] + ov; else ov -= fr; } }
            if (pos_ < 0) pos_ = c.bid; }
        pos_ = __builtin_amdgcn_readfirstlane(pos_); }
    const int lane = c.lane, il = lane & 15, g = lane >> 4, bh = pos_ >> 2, qr = pos_ & 3, b = bh >> 4, h = bh & 15;
    const char* PTg = (const char*)(wsb(p, WS_W0) + (size_t)bh * W32_NCH * WU); const char* Zg = (const char*)((const bf16_t*)p.out + (size_t)bh * W32_NCH * WU);
    const char* QTg = (const char*)(wsb(p, WS_W2) + (size_t)bh * W32_NCH * 2048);
    bf16_t* Yg = wsb(p, WS_W3) + ((size_t)b * SEQ) * D + h * 64 + 16 * qr;
    LAS unsigned char* ring = c.lds;
#ifdef WKB_VAR
    for (int pass = 0; pass < 2; ++pass) { const bool dryb = pass > 0; if (dryb) { asm volatile("s_waitcnt vmcnt(0)" ::: "memory"); __syncthreads(); PT_M0(c, 1); if ((WKB_VAR & 32) && bh >= 32) break; if ((WKB_VAR & 64) && bh >= 16) break; }
#define WKB_VARV WKB_VAR
#else
    { const bool dryb = false;
#define WKB_VARV 0
#endif
    if (c.wave >= 2 && c.wave < 6) {
        const int lw = c.wave - 2;
        const char* src[4]; int dst[4]; size_t stride[4];
#pragma unroll
        for (int k = 0; k < 4; ++k) {
            if (lw < 2) { src[k] = PTg + (lw * 4 + k) * 1024 + lane * 16; dst[k] = (lw * 4 + k) * 1024; stride[k] = 8192; }
            else if (lw == 2) { src[k] = QTg + k * 1024 + lane * 16; dst[k] = WKB_QT + k * 1024; stride[k] = 4096; }
            else if (k < 2) { const int e = k * 64 + lane, m = e & 7, hi = (e >> 3) & 1, q = (e >> 4) & 3, yt = e >> 6;
                src[k] = Zg + ((((qr >> 1) * 2 + yt) * 4 + q) * 512 + (hi * 32 + 16 * (qr & 1) + 2 * m) * 8); dst[k] = WKB_Z + k * 1024; stride[k] = 8192; }
            else { src[k] = (const char*)(Yg + (size_t)(lane >> 1) * D) + (lane & 1) * 16; dst[k] = WKB_YL + (k - 2) * 1024; stride[k] = (size_t)32 * D * 2; } }
#define WKB_DMA(ch) do { const int ch_ = (ch) < W32_NCH ? (ch) : W32_NCH - 1; LAS unsigned char* d_ = ring + ((ch) & (WKB_NS - 1)) * WKB_SLOT; if (dryb && (WKB_VARV & 8)) break; \
        _Pragma("unroll") for (int k = 0; k < 4; ++k) __builtin_amdgcn_global_load_lds((const unsigned*)(src[k] + (size_t)ch_ * stride[k]), (LAS unsigned*)(d_ + dst[k]), 16, 0, 0); } while (0)
#pragma unroll
        for (int ch = 0; ch < WKB_NS; ++ch) WKB_DMA(ch);
        asm volatile("s_waitcnt vmcnt(24)" ::: "memory"); __builtin_amdgcn_s_barrier();
        __builtin_amdgcn_s_barrier();
        for (int ch = 0; ch < W32_NCH; ++ch) { WKB_DMA(ch + WKB_NS); asm volatile("s_waitcnt vmcnt(24)" ::: "memory"); __builtin_amdgcn_s_barrier(); }
        asm volatile("s_waitcnt vmcnt(0)" ::: "memory");
#undef WKB_DMA
    } else if (c.wave >= 1) {
        for (int ch = 0; ch <= W32_NCH + 1; ++ch) __builtin_amdgcn_s_barrier();
    } else {
        f32x4 S[4];
#pragma unroll
        for (int jt = 0; jt < 4; ++jt) S[jt] = (f32x4){0.f, 0.f, 0.f, 0.f};
        u32x2 Pa[16], Qa[8], Za[4], Ya[2], Pb[16], Qb[8], Zb[4], Yb[2];
        const int lq = (g >> 1) * 512 + (32 * (g & 1) + il) * 8;
#define WKB_LOADF(PF, QF, ZF, YF, ch) do { const LAS unsigned char* sl_ = ring + ((ch) & (WKB_NS - 1)) * WKB_SLOT; \
        _Pragma("unroll") for (int jt = 0; jt < 4; ++jt) _Pragma("unroll") for (int s = 0; s < 2; ++s) { const int o_ = (((jt >> 1) * 2 + s) * 4) * 512 + 16 * (jt & 1) * 8 + lq; \
            PF[(jt * 2 + s) * 2] = *(const LAS u32x2*)(sl_ + o_); PF[(jt * 2 + s) * 2 + 1] = *(const LAS u32x2*)(sl_ + o_ + 1024); } \
        _Pragma("unroll") for (int tt = 0; tt < 2; ++tt) _Pragma("unroll") for (int s = 0; s < 2; ++s) { const int o_ = WKB_QT + (s * 4) * 512 + 16 * tt * 8 + lq; \
            QF[(tt * 2 + s) * 2] = *(const LAS u32x2*)(sl_ + o_); QF[(tt * 2 + s) * 2 + 1] = *(const LAS u32x2*)(sl_ + o_ + 1024); } \
        _Pragma("unroll") for (int jt = 0; jt < 4; ++jt) ZF[jt] = *(const LAS u32x2*)(sl_ + WKB_Z + (((((jt >> 1) * 4 + 2 * (jt & 1) + (g >> 1)) * 2 + (g & 1)) * 8 + (il >> 1)) * 16 + (il & 1) * 8)); \
        _Pragma("unroll") for (int tt = 0; tt < 2; ++tt) YF[tt] = *(const LAS u32x2*)(sl_ + WKB_YL + (16 * tt + il) * 32 + 8 * g); } while (0)
#define WKB_FRAG(F, i_) __builtin_bit_cast(bf16x8, (u32x4){F[2 * (i_)].x, F[2 * (i_)].y, F[2 * (i_) + 1].x, F[2 * (i_) + 1].y})
#define WKB_STEP(PF, QF, ZF, YF, PN, QN, ZN, YN, ch) do { bf16x8 bf[2]; if (dryb && (WKB_VARV & 4)) { LDS_BARRIER(); break; } \
        _Pragma("unroll") for (int s = 0; s < 2; ++s) bf[s] = __builtin_bit_cast(bf16x8, (u32x4){cvtpk(S[2 * s][0], S[2 * s][1]), cvtpk(S[2 * s][2], S[2 * s][3]), cvtpk(S[2 * s + 1][0], S[2 * s + 1][1]), cvtpk(S[2 * s + 1][2], S[2 * s + 1][3])}); \
        WKB_LOADF(PN, QN, ZN, YN, (ch) + 1); \
        __builtin_amdgcn_sched_barrier(0); \
        _Pragma("unroll") for (int tt = 0; tt < 2; ++tt) { f32x4 d_ = {bflo(YF[tt].x), bfhi(YF[tt].x), bflo(YF[tt].y), bfhi(YF[tt].y)};        \
            _Pragma("unroll") for (int s = 0; s < 2; ++s) d_ = __builtin_amdgcn_mfma_f32_16x16x32_bf16(bf[s], WKB_FRAG(QF, tt * 2 + s), d_, 0, 0, 0); \
            if (!dryb) *(u32x2*)(Yg + (size_t)((ch) * 32 + 16 * tt + il) * D + 4 * g) = pack4(d_); } \
        _Pragma("unroll") for (int jt = 0; jt < 4; ++jt) { f32x4 n_ = {bflo(ZF[jt].x), bfhi(ZF[jt].x), bflo(ZF[jt].y), bfhi(ZF[jt].y)}; \
            _Pragma("unroll") for (int s = 0; s < 2; ++s) n_ = __builtin_amdgcn_mfma_f32_16x16x32_bf16(WKB_FRAG(PF, jt * 2 + s), bf[s], n_, 0, 0, 0); \
            S[jt] = n_; } \
        __builtin_amdgcn_sched_barrier(0); \
        LDS_BARRIER(); } while (0)
        __builtin_amdgcn_s_barrier();
        WKB_LOADF(Pa, Qa, Za, Ya, 0);
        LDS_BARRIER();
        for (int ch = 0; ch < W32_NCH; ch += 2) { WKB_STEP(Pa, Qa, Za, Ya, Pb, Qb, Zb, Yb, ch); WKB_STEP(Pb, Qb, Zb, Yb, Pa, Qa, Za, Ya, ch + 1); }
#undef WKB_LOADF
#undef WKB_FRAG
#undef WKB_STEP
    }
    }
    PT_M1(c, 1);
}

__device__ __forceinline__ void phase_wkv_c(const Params& p, const Ctx& c) {
    const int lane = c.lane, r32 = lane & 31, hi = lane >> 5, bh = c.bid >> 2, cq = c.bid & 3, b = bh >> 4, h = bh & 15;
    bf16_t* Yg = wsb(p, WS_W3); const bf16_t* Vg = wsb(p, WS_W5); const bf16_t* L1 = wsb(p, WS_W6); const float* bsg = wsf(p, WS_BSUM);
    LAS unsigned char* gl = c.lds; LAS float* lnc = (LAS float*)(c.lds + 20480);
    { const bf16_t* G2T = wsb(p, WS_G2T) + (size_t)h * 64 * 128;
      for (int i = c.tid; i < 64 * 16; i += NTHREADS) { const int r = i >> 4, k = i & 15; *(LAS u32x4*)(gl + r * 272 + k * 16) = *(const u32x4*)(G2T + r * 128 + k * 8); }
      if (c.tid < 64) { lnc[c.tid] = p.in[I_LNW][h * 64 + c.tid]; lnc[64 + c.tid] = p.in[I_LNB][h * 64 + c.tid]; } }
    __syncthreads();
    PT_M0(c, 4);
    const int row0 = b * SEQ + cq * 2048 + c.wave * 32 + r32;
    bf16x8 Lf[8]; u32x2 Ay[8], Av[8], By[8], Bv[8]; float Abs, Bbs;
#define WKC_LOADL(i) do { const int row_ = row0 + ((i) < 8 ? (i) : 7) * 256; \
        _Pragma("unroll") for (int s = 0; s < 8; ++s) Lf[s] = glbfrag(L1 + 128, 256, row_, s, hi); } while (0)
#define WKC_LOAD(YF, VF, BS, i) do { const int row_ = row0 + ((i) < 8 ? (i) : 7) * 256; \
        _Pragma("unroll") for (int k = 0; k < 8; ++k) { YF[k] = *(const u32x2*)(Yg + (size_t)row_ * D + h * 64 + 8 * k + 4 * hi); VF[k] = *(const u32x2*)(Vg + (size_t)row_ * D + h * 64 + 8 * k + 4 * hi); } \
        BS = bsg[(size_t)row_ * NHEAD + h]; } while (0)
#define WKC_COMP(YF, VF, BS, i) do { const int row_ = row0 + (i) * 256; f32x16 g[2], y[2]; \
        _Pragma("unroll") for (int yt = 0; yt < 2; ++yt) { g[yt] = (f32x16){}; \
            _Pragma("unroll") for (int s = 0; s < 8; ++s) g[yt] = __builtin_amdgcn_mfma_f32_32x32x16_bf16(*(const LAS bf16x8*)(gl + (32 * yt + r32) * 272 + (16 * s + 8 * hi) * 2), Lf[s], g[yt], 0, 0, 0); \
            __builtin_amdgcn_sched_barrier(0); } \
        WKC_LOADL((i) + 1);                                               \
        __builtin_amdgcn_sched_barrier(0); \
        _Pragma("unroll") for (int yt = 0; yt < 2; ++yt) _Pragma("unroll") for (int q = 0; q < 4; ++q) { const u32x2 wv = YF[yt * 4 + q]; y[yt][4 * q] = bflo(wv.x); y[yt][4 * q + 1] = bfhi(wv.x); y[yt][4 * q + 2] = bflo(wv.y); y[yt][4 * q + 3] = bfhi(wv.y); } \
        float sm = 0.f; \
        _Pragma("unroll") for (int r = 0; r < 16; ++r) sm += y[0][r] + y[1][r]; \
        sm += __shfl_xor(sm, 32); const float mean = sm * (1.0f / 64.0f); \
        float q2 = 0.f; \
        _Pragma("unroll") for (int r = 0; r < 16; ++r) { const float d0 = y[0][r] - mean, d1 = y[1][r] - mean; q2 += d0 * d0 + d1 * d1; } \
        q2 += __shfl_xor(q2, 32); const float rstd = rsqrtf(q2 * (1.0f / 64.0f) + GN_EPS); \
        _Pragma("unroll") for (int yt = 0; yt < 2; ++yt) _Pragma("unroll") for (int q = 0; q < 4; ++q) { const int ch = 32 * yt + 8 * q + 4 * hi; const f32x4 lw = *(const LAS f32x4*)(lnc + ch), lb = *(const LAS f32x4*)(lnc + 64 + ch); \
            const u32x2 vw = VF[yt * 4 + q]; const f32x4 vv = {bflo(vw.x), bfhi(vw.x), bflo(vw.y), bfhi(vw.y)}; f32x4 o; \
            _Pragma("unroll") for (int i2 = 0; i2 < 4; ++i2) o[i2] = ((y[yt][4 * q + i2] - mean) * rstd * lw[i2] + lb[i2] + BS * vv[i2]) * g[yt][4 * q + i2]; \
            *(u32x2*)(Yg + (size_t)row_ * D + h * 64 + ch) = pack4(o); __builtin_amdgcn_sched_barrier(0); } } while (0)
    WKC_LOADL(0); WKC_LOAD(Ay, Av, Abs, 0);
    for (int i = 0; i < 8; i += 2) { WKC_LOAD(By, Bv, Bbs, i + 1); WKC_COMP(Ay, Av, Abs, i); WKC_LOAD(Ay, Av, Abs, i + 2); WKC_COMP(By, Bv, Bbs, i + 1); }
#undef WKC_LOADL
#undef WKC_LOAD
#undef WKC_COMP
    __syncthreads(); PT_M1(c, 4);
}
#undef W32_Y
#ifndef WKA_PROBE
#define WKA_PROBE 0
#endif
#ifndef MK_N_LAUNCHES
#define MK_N_LAUNCHES 1
#endif
constexpr int N_PHASES = 19;
constexpr int N_LAUNCHES = MK_N_LAUNCHES;


__global__ void __launch_bounds__(NTHREADS, 2) fwd_kernel(Params p) {
    extern __shared__ __attribute__((aligned(16))) unsigned char lds_raw[];
    Ctx c; c.lds = (LAS unsigned char*)lds_raw; c.tid = threadIdx.x; c.lane = c.tid & 63; c.wave = __builtin_amdgcn_readfirstlane(c.tid >> 6); c.G = gridDim.x; c.bid = blockIdx.x;
    volatile LAS unsigned* MISC = (volatile LAS unsigned*)(c.lds + MISC_OFF);
    if (c.tid < 64) ((LAS unsigned*)(c.lds + MISC_OFF))[c.tid] = 0u;
#ifdef PT_CUSTOM
    if (c.tid < 4) ((LAS unsigned*)(c.lds + MISC_OFF + 512))[c.tid] = 0u;
#endif
    __syncthreads();
    unsigned* ctl = (unsigned*)(p.ws + WS_CTL);
    XcdBarrier bar; bar.bar = ctl + CW_BAR; bar.x = 0; bar.st = nullptr;
    if (N_LAUNCHES == 1) bar = xcd_barrier_post(ctl + CW_BAR, MISC + 8);
    if (c.tid == 0) { const unsigned x_ = xb_xcc_id(); MISC[16] = x_; MISC[17] = atomicAdd(ctl + CW_XSLOT + 64 * x_, 1u); }
    const int lo = p.ph_lo, hi = p.ph_hi;
#ifndef PH_MASK
#define PH_MASK 0x7ffff
#endif
#ifndef PROBE_DUP_EARLY
#define PROBE_DUP_EARLY -1
#endif
#define PHASE_ID 0
#define IN(k) ((((PH_MASK) >> (k)) & 1) && lo <= (k) && (k) < hi)
#ifdef PT_LO
#ifndef PT_MULT
#define PT_MULT 4
#endif
    unsigned long long pt0_ = 0, pt1_ = 0;
    if (PT_LO == 0) pt0_ = wall_clock64();
#define PT_STAMP(k) do { if ((k) + 1 == PT_LO) pt0_ = wall_clock64(); if ((k) == PT_HI) pt1_ = wall_clock64(); } while (0)
#else
#define PT_STAMP(k) do { } while (0)
#endif
#define SEAM(k) do { if (IN(k) && IN((k) + 1)) xcd_barrier(bar); PT_STAMP(k); } while (0)
    LAS unsigned char* ring = c.lds + RING_OFF;

    if (IN(0)) { phase_prologue(p, c); } SEAM(0);
    if (IN(1)) { phase_n0(p, c); } SEAM(1);
    if (IN(2)) {
#undef PHASE_ID
#define PHASE_ID 2
        { DenseSched S; S.init((const bf16_t*)p.out, D, wsb(p, WS_LD), 2048, T, 256, 2048, c.G, c.bid); S.rep = (p.pad == 100 + PHASE_ID) ? 2 : 1; S.pad = 1; S.nt0 = 16; S.a1d = -(long)(D * 2); S.b1d = 1024 * 2;
          EpiLoraDown E{wsb(p, WS_W6)}; pg8::gemm_phase<EpiLoraDown, DenseSched, false>(ring, S, E, D, 2048); }
        { DenseSched S; S.init(wsb(p, WS_W0), D, wsb(p, WS_WR), D, T, D, D, c.G, c.bid); S.rep = (p.pad == 100 + PHASE_ID) ? 2 : 1; EpiBf16 E{wsb(p, WS_W3), D}; pg8::gemm_phase<EpiBf16, DenseSched, false>(ring, S, E, D, D); }
        { DenseSched S; S.init(wsb(p, WS_W1), D, wsb(p, WS_WK), D, T, D, D, c.G, c.bid); S.rep = (p.pad == 100 + PHASE_ID) ? 2 : 1; EpiBf16 E{wsb(p, WS_W4), D}; pg8::gemm_phase<EpiBf16, DenseSched, false>(ring, S, E, D, D); }
        { DenseSched S; S.init(wsb(p, WS_W2), D, wsb(p, WS_WV), D, T, D, D, c.G, c.bid); S.rep = (p.pad == 100 + PHASE_ID) ? 2 : 1; EpiBf16 E{wsb(p, WS_W5), D}; pg8::gemm_phase<EpiBf16, DenseSched, false>(ring, S, E, D, D); }
    } SEAM(2);
#ifndef PROBE_DUP
#define PROBE_DUP -1
#define DUP(k, call) do { if (PROBE_DUP == (k)) { call; xcd_barrier(bar); } } while (0)
    if (IN(3)) { phase_wkv_a(p, c); } SEAM(3);
    if (IN(4)) { phase_wkv_b(p, c, bar); } SEAM(4);
    if (IN(5)) { phase_wkv_c(p, c); } SEAM(5);
#endif
    if (IN(6)) {
#undef PHASE_ID
#define PHASE_ID 6
        DenseSched S; S.init(wsb(p, WS_W3), D, wsb(p, WS_WO), D, T, D, D, c.G, c.bid); S.rep = (p.pad == 100 + PHASE_ID) ? 2 : 1; EpiResidT<true> E{p.in[I_X], (bf16_t*)p.out, wsf(p, WS_MOD) + 0 * 3072 + 2048};
        pg8::gemm_phase<EpiResidT<true>, DenseSched, false>(ring, S, E, D, D);
    } SEAM(6);
#define MOE_PHASES(layer, pb) do { \
        if (IN(pb)) { phase_router(p, c, layer); } SEAM(pb); \
        if (IN((pb) + 1)) { \
            moe_setup(p, c, layer); \
            MoeSched S{(LAS const int*)(c.lds + UDESC_OFF), (LAS const int*)(c.lds + ROWTAB_OFF), 0, (const char*)wsb(p, WS_W1), (const char*)wsb(p, (layer) ? WS_WGU1 : WS_WGU), (const char*)wsb(p, (layer) ? WS_WDN1 : WS_WDN)}; \
            EpiMoeUp E{wsb(p, WS_W2), (LAS const float*)(c.lds + GATETAB_OFF)}; \
            pg8::gemm_phase<EpiMoeUp, MoeSched, true>(ring, S, E, D, D); \
        } SEAM((pb) + 1); \
        if (IN((pb) + 2)) { \
            moe_setup(p, c, layer); \
            MoeSched S{(LAS const int*)(c.lds + UDESC_OFF), (LAS const int*)(c.lds + ROWTAB_OFF), 1, (const char*)wsb(p, WS_W2), (const char*)wsb(p, (layer) ? WS_WGU1 : WS_WGU), (const char*)wsb(p, (layer) ? WS_WDN1 : WS_WDN)}; \
            EpiMoeDown E{(const bf16_t*)p.out, (layer) ? wsb(p, WS_W1) : (bf16_t*)p.out, wsf(p, WS_MOD) + ((layer) * 2 + 1) * 3072 + 2048, (LAS const int*)(c.lds + ROWTAB_OFF)}; \
            pg8::gemm_phase<EpiMoeDown, MoeSched, false>(ring, S, E, 512, 256); \
        } SEAM((pb) + 2); } while (0)
    MOE_PHASES(0, 7);
            if (IN(10)) { phase_n2(p, c); } SEAM(10);
            if (IN(11)) {
#undef PHASE_ID
#define PHASE_ID 11
                { DenseSched S; S.init(wsb(p, WS_W1), D, wsb(p, WS_DKV), D, T, 512, D, c.G, c.bid); S.rep = (p.pad == 100 + PHASE_ID) ? 2 : 1; EpiDown E{wsb(p, WS_W6), KVLORA, 0, wsf(p, WS_SSQKV), 4, wsb(p, WS_KR), wsf(p, WS_TAB)};
                  pg8::gemm_phase<EpiDown, DenseSched, false>(ring, S, E, D, D); }
                { DenseSched S; S.init(wsb(p, WS_W0), D, wsb(p, WS_DQ), D, T, 512, D, c.G, c.bid); S.rep = (p.pad == 100 + PHASE_ID) ? 2 : 1; EpiDown E{wsb(p, WS_W6 + 16 * MiB), QLORA, 128, wsf(p, WS_SSQQ), 8, nullptr, nullptr};
                  pg8::gemm_phase<EpiDown, DenseSched, false>(ring, S, E, D, D); }
            } SEAM(11);
            if (IN(12)) {
#undef PHASE_ID
#define PHASE_ID 12
                { DenseSched S; S.init(wsb(p, WS_W6 + 16 * MiB), QLORA, wsb(p, WS_UQ), QLORA, T, 1536, QLORA, c.G, c.bid); S.rep = (p.pad == 100 + PHASE_ID) ? 2 : 1; EpiQ E{wsb(p, WS_W2), wsf(p, WS_SSQQ), wsf(p, WS_TAB)};
                  pg8::gemm_phase<EpiQ, DenseSched, false>(ring, S, E, QLORA, QLORA); }
                { DenseSched S; S.init(wsb(p, WS_W6), KVLORA, wsb(p, WS_UKV), KVLORA, T, 2048, KVLORA, c.G, c.bid); S.rep = (p.pad == 100 + PHASE_ID) ? 2 : 1; EpiKV E{wsb(p, WS_W4), wsb(p, WS_W5), wsf(p, WS_SSQKV)};
                  pg8::gemm_phase<EpiKV, DenseSched, false>(ring, S, E, KVLORA, KVLORA); }
            } SEAM(12);
            if (IN(13)) { phase_attention(p, c); } SEAM(13);
#if defined(PROBE_DUP) && PROBE_DUP == 13
            if (IN(13)) { phase_attention(p, c); } SEAM(13);
#endif
            if (IN(14)) {
#undef PHASE_ID
#define PHASE_ID 14
                DenseSched S; S.init(wsb(p, WS_W0), D, wsb(p, WS_MWO), D, T, D, D, c.G, c.bid); S.rep = (p.pad == 100 + PHASE_ID) ? 2 : 1; EpiResidT<false> E{p.out, (bf16_t*)p.out, wsf(p, WS_MOD) + 2 * 3072 + 2048};
                pg8::gemm_phase<EpiResidT<false>, DenseSched, false>(ring, S, E, D, D);
            } SEAM(14);
    MOE_PHASES(1, 15);
    if (IN(18)) { phase_final(p, c); }
#ifdef PT_CUSTOM
    { __syncthreads(); const unsigned long long t0_ = *(volatile LAS unsigned long long*)(c.lds + MISC_OFF + 512), t1_ = *(volatile LAS unsigned long long*)(c.lds + MISC_OFF + 520);
      const unsigned long long d_ = (t1_ - t0_) * PT_CUSTOM, ts_ = wall_clock64(); while (wall_clock64() - ts_ < d_) __builtin_amdgcn_s_sleep(8); }
#endif
#ifdef PT_LO
    { PT_STAMP(18); const unsigned long long d_ = (pt1_ - pt0_) * PT_MULT, ts_ = wall_clock64(); while (wall_clock64() - ts_ < d_) __builtin_amdgcn_s_sleep(8); }
#endif
#undef IN
#undef SEAM
}

extern "C" void kernel_launch(void* const* d_in, const int* in_sizes, int n_in, void* d_out, int out_size, void* d_ws, size_t ws_size, hipStream_t stream) {
    static int ready = 0;
    if (ready == 0) {
        ready = 1;
        if (n_in != N_IN || out_size != T * D || ws_size < WS_END) { fprintf(stderr, "kernel_launch: unexpected shapes (n_in %d, out %d, ws %zu)\n", n_in, out_size, ws_size); ready = -1; }
        else if (hipFuncSetAttribute((const void*)fwd_kernel, hipFuncAttributeMaxDynamicSharedMemorySize, LDS_BYTES) != hipSuccess) { fprintf(stderr, "kernel_launch: hipFuncSetAttribute failed\n"); ready = -1; }
        int per_cu = 0;
        if (ready > 0 && (hipOccupancyMaxActiveBlocksPerMultiprocessor(&per_cu, (const void*)fwd_kernel, NTHREADS, LDS_BYTES) != hipSuccess || per_cu < 1)) fprintf(stderr, "kernel_launch: occupancy query reports %d\n", per_cu);
        (void)hipGetLastError();
    }
    if (ready < 0) return;
    (void)hipMemsetAsync((char*)d_ws + WS_CTL, 0, CTL_ZERO_BYTES, stream);
    Params a{};
    for (int i = 0; i < N_IN; ++i) a.in[i] = (const float*)d_in[i];
    a.out = (float*)d_out; a.ws = (unsigned char*)d_ws; a.li = 0; a.pad = WKA_PROBE;
    const int grid = 256;
    if (N_LAUNCHES == 1) { a.ph_lo = 0; a.ph_hi = N_PHASES; hipLaunchKernelGGL(fwd_kernel, dim3(grid), dim3(NTHREADS), LDS_BYTES, stream, a); }
    else { for (int k = 0; k < N_PHASES; ++k) { a.ph_lo = k; a.ph_hi = k + 1; a.li = k; hipLaunchKernelGGL(fwd_kernel, dim3(grid), dim3(NTHREADS), LDS_BYTES, stream, a); } }
}
```

```cpp
#include <hip/hip_runtime.h>
#include <cstdio>
#include <cstdint>

#define LAS __attribute__((address_space(3)))
#define GAS __attribute__((address_space(1)))
typedef unsigned short bf16_t;
typedef short bf16x8 __attribute__((ext_vector_type(8)));
typedef short s16x4 __attribute__((ext_vector_type(4)));
typedef float f32x2 __attribute__((ext_vector_type(2)));
typedef float f32x4 __attribute__((ext_vector_type(4)));
typedef float f32x16 __attribute__((ext_vector_type(16)));
typedef unsigned u32x2 __attribute__((ext_vector_type(2)));
typedef unsigned u32x4 __attribute__((ext_vector_type(4)));
typedef __bf16 bf16x2_t __attribute__((ext_vector_type(2)));

__device__ __forceinline__ unsigned cvtpk(float lo, float hi) { f32x2 v = {lo, hi}; bf16x2_t b = __builtin_convertvector(v, bf16x2_t); return __builtin_bit_cast(unsigned, b); }
__device__ __forceinline__ float bf2f(unsigned short b) { return __uint_as_float((unsigned)b << 16); }
__device__ __forceinline__ float bflo(unsigned w) { return __uint_as_float(w << 16); }
__device__ __forceinline__ float bfhi(unsigned w) { return __uint_as_float(w & 0xffff0000u); }
__device__ __forceinline__ float wave_sum(float v) {
#pragma unroll
    for (int o = 1; o < 64; o <<= 1) v += __shfl_xor(v, o);
    return v;
}
__device__ __forceinline__ float fexp2(float x) { return __builtin_amdgcn_exp2f(x); }
__device__ __forceinline__ float fexp(float x) { return __builtin_amdgcn_exp2f(x * 1.4426950408889634f); }
__device__ __forceinline__ float frcp(float x) { return __builtin_amdgcn_rcpf(x); }
__device__ __forceinline__ float sigmoidf_(float x) { return frcp(1.0f + fexp(-x)); }

namespace pg8 {
constexpr int BM = 256, BK = 64, HALF = 128, HTB = HALF * BK * 2  , STAGE_BYTES = 8 * HTB;
__host__ __device__ __forceinline__ int lds_byte(int r, int c) { const int st = (r >> 4) * 2 + (c >> 5), rr = r & 15, cc = c & 31, ob = rr * 64 + cc * 2; return st * 1024 + (ob ^ (((ob >> 9) & 1) << 5)); }
__host__ __device__ __forceinline__ void stage_rc(int b, int& R, int& C) { const int st = b / 1024, sb = b % 1024, swz = sb ^ (((sb >> 9) & 1) << 5); R = (st >> 1) * 16 + swz / 64; C = (st & 1) * 32 + (swz % 64) / 2; }
__host__ __device__ __forceinline__ int perm32(int rho) { const int n = rho >> 4, i = rho & 15; return 8 * (i >> 2) + 4 * n + (i & 3); }

struct Unit { int pm, pn, aux, nt, nt0; const char* A0; const char* A1; const char* B0; const char* B1; };
__device__ __forceinline__ const char* tile_ptr(const char* p0, const char* p1, int nt0, int t) { return t < nt0 ? p0 + (size_t)t * 128 : p1 + (size_t)(t - nt0) * 128; }

template <class Epi, class Sched, bool GA>
__device__ __forceinline__ void gemm_phase(LAS unsigned char* lds, const Sched& S, const Epi& E, const int lda, const int ldb) {
    const int tid = threadIdx.x, wid = __builtin_amdgcn_readfirstlane(tid >> 6), lane = tid & 63, wr = wid >> 2, wc = wid & 3, fr = lane & 15, fq = lane >> 4;
    unsigned voffB[2]; int RA[2], CA[2];
#pragma unroll
    for (int i = 0; i < 2; ++i) { int R, C; stage_rc(tid * 16 + i * 8192, R, C); const int Rb = Epi::PERM ? ((R & ~31) + perm32(R & 31)) : R;
        voffB[i] = (unsigned)(Rb * ldb + C) * 2u; RA[i] = R; CA[i] = C; }
    const size_t hstepB = (size_t)HALF * ldb * 2;
    unsigned voC[2][2], voN[2][2];
    const unsigned ldsw = (unsigned)wid * 1024u;
    const int aoff = lds_byte(wr * 64 + fr, fq * 8), boff = lds_byte(wc * 32 + fr, fq * 8);
#define PG8_SA(b, h) (((b) * 2 + (h)) * HTB)
#define PG8_SB(b, h) ((4 + (b) * 2 + (h)) * HTB)
#define PG8_STAGE_B(bufoff, gbase) do { _Pragma("unroll") for (int _i = 0; _i < 2; ++_i) \
        __builtin_amdgcn_global_load_lds((const unsigned*)((const char*)(gbase) + voffB[_i]), (LAS unsigned*)(lds + (bufoff) + ldsw + _i * 8192), 16, 0, 0); } while (0)
#define PG8_STAGE_A(bufoff, gbase, VO, hh) do { _Pragma("unroll") for (int _i = 0; _i < 2; ++_i) \
        __builtin_amdgcn_global_load_lds((const unsigned*)((const char*)(gbase) + VO[hh][_i]), (LAS unsigned*)(lds + (bufoff) + ldsw + _i * 8192), 16, 0, 0); } while (0)
#define PG8_LDA(dst, b, h) do { _Pragma("unroll") for (int m = 0; m < 4; ++m) _Pragma("unroll") for (int k = 0; k < 2; ++k) dst[m][k] = *(const LAS bf16x8*)(lds + PG8_SA(b, h) + aoff + m * 2048 + k * 1024); } while (0)
#define PG8_LDB(dst, b, h) do { _Pragma("unroll") for (int n = 0; n < 2; ++n) _Pragma("unroll") for (int k = 0; k < 2; ++k) dst[n][k] = *(const LAS bf16x8*)(lds + PG8_SB(b, h) + boff + n * 2048 + k * 1024); } while (0)
#define PG8_MMA(ai, bj, At, Bt) do { __builtin_amdgcn_s_setprio(1); _Pragma("unroll") for (int m = 0; m < 4; ++m) _Pragma("unroll") for (int n = 0; n < 2; ++n) _Pragma("unroll") for (int k = 0; k < 2; ++k) \
        acc[ai][bj][m][n] = __builtin_amdgcn_mfma_f32_16x16x32_bf16(Bt[n][k], At[m][k], acc[ai][bj][m][n], 0, 0, 0); __builtin_amdgcn_s_setprio(0); } while (0)
#define PG8_WAIT_V(n) asm volatile("s_waitcnt vmcnt(" #n ")" ::: "memory")
#define PG8_WAIT_L(n) asm volatile("s_waitcnt lgkmcnt(" #n ")" ::: "memory")
#define PG8_BAR __builtin_amdgcn_s_barrier()
#define PG8_SCHED __builtin_amdgcn_sched_barrier(0)
#define PG8_SETVO(VO, ui_) do { _Pragma("unroll") for (int _h = 0; _h < 2; ++_h) _Pragma("unroll") for (int _i = 0; _i < 2; ++_i) { \
        if constexpr (GA) VO[_h][_i] = (unsigned)(S.row((ui_), _h * HALF + RA[_i]) * lda + CA[_i]) * 2u; else VO[_h][_i] = (unsigned)((_h * HALF + RA[_i]) * lda + CA[_i]) * 2u; } } while (0)
    Unit cur, nxt; int ui = 0;
    if (!S.next(0, cur)) return;
    PG8_SETVO(voC, 0);
#pragma unroll
    for (int _h = 0; _h < 2; ++_h)
#pragma unroll
        for (int _i = 0; _i < 2; ++_i) voN[_h][_i] = 0u;
    f32x4 acc[2][2][4][2];
#pragma unroll
    for (int a = 0; a < 2; ++a)
#pragma unroll
        for (int b = 0; b < 2; ++b)
#pragma unroll
            for (int m = 0; m < 4; ++m)
#pragma unroll
                for (int n = 0; n < 2; ++n) acc[a][b][m][n] = (f32x4){0.f, 0.f, 0.f, 0.f};
    bf16x8 At[4][2], B0[2][2], B1[2][2];
    {
        const char* cA = cur.A0; const char* cB = cur.B0;
        PG8_STAGE_B(PG8_SB(0, 0), cB); PG8_STAGE_B(PG8_SB(0, 1), cB + hstepB); PG8_STAGE_A(PG8_SA(0, 0), cA, voC, 0); PG8_STAGE_A(PG8_SA(0, 1), cA, voC, 1);
        if (wr == 1) PG8_BAR;
        PG8_WAIT_V(2); PG8_BAR;
        PG8_STAGE_B(PG8_SB(1, 0), cB + 128); PG8_STAGE_A(PG8_SA(1, 0), cA + 128, voC, 0); PG8_STAGE_B(PG8_SB(1, 1), cB + hstepB + 128);
        PG8_WAIT_V(6); PG8_BAR;
    }
    for (;;) {
        const bool has_next = S.next(ui + 1, nxt);
        if (has_next) { if constexpr (GA) { PG8_SETVO(voN, ui + 1);
#pragma unroll
                for (int _h = 0; _h < 2; ++_h)
#pragma unroll
                    for (int _i = 0; _i < 2; ++_i) voN[_h][_i] -= voC[_h][_i]; } }
        else { nxt = cur;
#pragma unroll
            for (int _h = 0; _h < 2; ++_h)
#pragma unroll
                for (int _i = 0; _i < 2; ++_i) voN[_h][_i] = 0u; }
        const int nt = cur.nt;
        for (int t = 0; t < nt; t += 2) {
            const bool last = (t == nt - 2);
            const char* a1 = tile_ptr(cur.A0, cur.A1, cur.nt0, t + 1);
            const char* a2 = last ? nxt.A0 : tile_ptr(cur.A0, cur.A1, cur.nt0, t + 2);
            const char* b2 = last ? nxt.B0 : tile_ptr(cur.B0, cur.B1, cur.nt0, t + 2);
            const char* a3 = a2 + 128; const char* b3 = b2 + 128;
            unsigned vo2[2][2];
#pragma unroll
            for (int _h = 0; _h < 2; ++_h)
#pragma unroll
                for (int _i = 0; _i < 2; ++_i) vo2[_h][_i] = GA ? voC[_h][_i] + (last ? 1u : 0u) * voN[_h][_i] : voC[_h][_i];
            PG8_LDB(B0, 0, 0); PG8_LDB(B1, 0, 1); PG8_SCHED; PG8_LDA(At, 0, 0); PG8_STAGE_A(PG8_SA(1, 1), a1, voC, 1);
            PG8_WAIT_V(8); PG8_WAIT_L(0); PG8_BAR; PG8_MMA(0, 0, At, B0); PG8_MMA(0, 1, At, B1); PG8_BAR; PG8_SCHED;
            PG8_LDA(At, 0, 1); PG8_STAGE_B(PG8_SB(0, 0), b2); PG8_STAGE_B(PG8_SB(0, 1), b2 + hstepB); PG8_STAGE_A(PG8_SA(0, 0), a2, vo2, 0);
            PG8_WAIT_V(8); PG8_WAIT_L(0); PG8_BAR; PG8_MMA(1, 0, At, B0); PG8_MMA(1, 1, At, B1); PG8_BAR; PG8_SCHED;
            PG8_LDB(B0, 1, 0); PG8_LDB(B1, 1, 1); PG8_SCHED; PG8_LDA(At, 1, 0); PG8_STAGE_A(PG8_SA(0, 1), a2, vo2, 1);
            PG8_WAIT_V(8); PG8_WAIT_L(0); PG8_BAR; PG8_MMA(0, 0, At, B0); PG8_MMA(0, 1, At, B1); PG8_BAR; PG8_SCHED;
            PG8_LDA(At, 1, 1); PG8_STAGE_B(PG8_SB(1, 0), b3); PG8_STAGE_B(PG8_SB(1, 1), b3 + hstepB); PG8_STAGE_A(PG8_SA(1, 0), a3, vo2, 0);
            PG8_WAIT_V(8); PG8_WAIT_L(0); PG8_BAR; PG8_MMA(1, 0, At, B0); PG8_MMA(1, 1, At, B1); PG8_BAR; PG8_SCHED;
        }
        if (wr == 0) PG8_BAR;
        E(acc, cur, wr, wc, fr, fq);
        if (!has_next) break;
#pragma unroll
        for (int a = 0; a < 2; ++a)
#pragma unroll
            for (int b = 0; b < 2; ++b)
#pragma unroll
                for (int m = 0; m < 4; ++m)
#pragma unroll
                    for (int n = 0; n < 2; ++n) acc[a][b][m][n] = (f32x4){0.f, 0.f, 0.f, 0.f};
        cur = nxt; ++ui;
        if constexpr (GA) {
#pragma unroll
            for (int _h = 0; _h < 2; ++_h)
#pragma unroll
                for (int _i = 0; _i < 2; ++_i) voC[_h][_i] += voN[_h][_i];
        }
        if (wr == 1) PG8_BAR;
    }
    PG8_WAIT_V(0);
    PG8_BAR;
#undef PG8_SA
#undef PG8_SB
#undef PG8_STAGE_A
#undef PG8_STAGE_B
#undef PG8_LDA
#undef PG8_LDB
#undef PG8_MMA
#undef PG8_WAIT_V
#undef PG8_WAIT_L
#undef PG8_BAR
#undef PG8_SCHED
#undef PG8_SETVO
}
}
constexpr int NB = 4, SEQ = 8192, D = 1024, T = NB * SEQ;
constexpr int NHEAD = 16, HD = 64;
constexpr int QLORA = 384, KVLORA = 256, ROPE = 32, QKD = 96;
constexpr int NEXP = 16, NCLS = 24, DEXP = 256;
constexpr int MODW = 14336;
constexpr float NORM_EPS = 1e-6f, GN_EPS = 64e-5f;
constexpr float QSCALE = 0.10206207261596577f * 1.4426950408889634f;
constexpr int NWAVES = 8, NTHREADS = 512;

constexpr size_t MiB = 1u << 20;
constexpr size_t SLOT = 64 * MiB;
constexpr size_t WS_W0 = 0, WS_W1 = SLOT, WS_W2 = 2 * SLOT, WS_W3 = 3 * SLOT, WS_W4 = 4 * SLOT, WS_W5 = 5 * SLOT, WS_W6 = 6 * SLOT;
constexpr size_t WS_MISC = 7 * SLOT;
constexpr size_t WS_CTL = WS_MISC, CTL_ZERO_BYTES = 1 * MiB;
constexpr size_t WS_MOD = WS_MISC + 1 * MiB;
constexpr size_t WS_TAB = WS_MISC + 2 * MiB;
constexpr size_t WS_LIST = WS_MISC + 6 * MiB;
constexpr size_t WS_GATES = WS_MISC + 56 * MiB;
constexpr size_t WS_SSQKV = WS_MISC + 9 * MiB + 512 * 1024;
constexpr size_t WS_SSQQ = WS_MISC + 10 * MiB;
constexpr size_t WS_KR = WS_MISC + 11 * MiB;
constexpr size_t WS_WR = WS_MISC + 13 * MiB, WS_WK = WS_MISC + 15 * MiB, WS_WV = WS_MISC + 17 * MiB;
constexpr size_t WS_LD = WS_MISC + 19 * MiB;
constexpr size_t WS_WO = WS_MISC + 20 * MiB;
constexpr size_t WS_DKV = WS_MISC + 22 * MiB;
constexpr size_t WS_DQ = WS_MISC + 23 * MiB;
constexpr size_t WS_UQ = WS_MISC + 24 * MiB;
constexpr size_t WS_UKV = WS_MISC + 26 * MiB;
constexpr size_t WS_MWO = WS_MISC + 27 * MiB;
constexpr size_t WS_WGU = WS_MISC + 29 * MiB;
constexpr size_t WS_WDN = WS_MISC + 45 * MiB;
constexpr size_t WS_W2T = WS_MISC + 53 * MiB;
constexpr size_t WS_A2T = WS_MISC + 53 * MiB + 256 * 1024;
constexpr size_t WS_G2T = WS_MISC + 53 * MiB + 512 * 1024;
constexpr size_t WS_BSUM = WS_MISC + 54 * MiB;
constexpr size_t WS_END = WS_MISC + 62 * MiB;
constexpr size_t WS_WGU1 = WS_W6 + 40 * MiB, WS_WDN1 = WS_W6 + 56 * MiB;
static_assert(WS_END <= 512 * MiB, "d_ws map");
constexpr int CW_BAR = 4096;
constexpr int CW_XSLOT = 20480;
constexpr int CW_ADA = 24576;
constexpr int CW_CNT = 16384;

constexpr int RING_OFF = 0, RING_BYTES = 131072;
constexpr int TAB_OFF = 131072;
constexpr int ROWTAB_OFF = TAB_OFF, GATETAB_OFF = TAB_OFF + 4096, UDESC_OFF = TAB_OFF + 12288, CLSTAB_OFF = UDESC_OFF + 256;
constexpr int MISC_OFF = 151552;
constexpr int LDS_BYTES = 155648;

#define XB_TMO      128
#define XB_XCNT(j)  (256  + 64 * (j))
#define XB_XSUB(j)  (1280 + 64 * (j))
#define XB_XGEN(j)  (2304 + 64 * (j))
#define XB_TOP      3328
#define XB_TOPGEN   3392
#define XCD_BAR_WORDS 3456
#define XB_SPIN_CAP (1u << 18)

__device__ __forceinline__ unsigned xb_ld(unsigned* p)              { return __hip_atomic_load(p, __ATOMIC_RELAXED, __HIP_MEMORY_SCOPE_AGENT); }
__device__ __forceinline__ unsigned xb_add(unsigned* p, unsigned v) { return __hip_atomic_fetch_add(p, v, __ATOMIC_RELAXED, __HIP_MEMORY_SCOPE_AGENT); }
__device__ __forceinline__ unsigned xb_xcc_id() { return (unsigned)__builtin_amdgcn_s_getreg((3 << 11) | 20) & 0xFu; }
#define XB_SPIN(cond, bar) do { unsigned _sp = 0; while (cond) { __builtin_amdgcn_s_sleep(1); \
    if ((++_sp & 255u) == 0u) { if (xb_ld(&(bar)[XB_TMO])) break; if (_sp > XB_SPIN_CAP) { atomicAdd(&(bar)[XB_TMO], 1u); break; } } } } while (0)

struct XcdBarrier { unsigned* bar; unsigned x; volatile LAS unsigned* st; };

__device__ __forceinline__ XcdBarrier xcd_barrier_post(unsigned* bar, volatile LAS unsigned* st) {
    XcdBarrier b; b.bar = bar; b.x = xb_xcc_id(); b.st = st;
    if (threadIdx.x == 0) (void)xb_add(&bar[XB_XCNT(b.x)], 1u);
    return b;
}
__device__ __forceinline__ void xcd_barrier_complete(unsigned* bar, unsigned x, unsigned& nloc, unsigned& nx) {
    const unsigned G = gridDim.x * gridDim.y * gridDim.z;
    unsigned sum, cnt, mine, sp = 0u;
    for (;;) {
        sum = 0u; cnt = 0u; mine = 0u;
#pragma unroll
        for (unsigned j = 0; j < 16; ++j) { const unsigned c = xb_ld(&bar[XB_XCNT(j)]); sum += c; cnt += (c > 0u) ? 1u : 0u; mine = (j == x) ? c : mine; }
        if (sum == G) break;
        __builtin_amdgcn_s_sleep(1);
        if ((++sp & 255u) == 0u) { if (xb_ld(&bar[XB_TMO])) break; if (sp > XB_SPIN_CAP) { atomicAdd(&bar[XB_TMO], 1u); break; } }
    }
    nloc = mine > 0u ? mine : 1u; nx = cnt > 0u ? cnt : 1u;
}
__device__ __forceinline__ void xcd_barrier_t0(const XcdBarrier& b) {
    {
        unsigned* bar = b.bar;
        __builtin_amdgcn_s_waitcnt(0);
        unsigned nloc = b.st[0], nx = b.st[1];
        if (nloc == 0u) { xcd_barrier_complete(bar, b.x, nloc, nx); b.st[0] = nloc; b.st[1] = nx; }
        const unsigned old = xb_add(&bar[XB_XSUB(b.x)], 1u);
        const unsigned gen = old / nloc;
        if (old + 1u == (gen + 1u) * nloc) {
            __builtin_amdgcn_fence(__ATOMIC_RELEASE, "agent");
            asm volatile("s_waitcnt vmcnt(0)" ::: "memory");
            const unsigned og = xb_add(&bar[XB_TOP], 1u);
            const unsigned tg = og / nx;
            if (og + 1u == (tg + 1u) * nx) xb_add(&bar[XB_TOPGEN], 1u);
            else XB_SPIN(xb_ld(&bar[XB_TOPGEN]) == tg, bar);
            __builtin_amdgcn_fence(__ATOMIC_ACQUIRE, "agent");
            xb_add(&bar[XB_XGEN(b.x)], 1u);
            asm volatile("s_waitcnt vmcnt(0)" ::: "memory");
        } else {
            XB_SPIN(xb_ld(&bar[XB_XGEN(b.x)]) == gen, bar);
            __builtin_amdgcn_fence(__ATOMIC_ACQUIRE, "agent");
            asm volatile("s_waitcnt vmcnt(0)" ::: "memory");
        }
    }
}
__device__ __forceinline__ void xcd_barrier(const XcdBarrier& b) {
    asm volatile("s_waitcnt vmcnt(0)" ::: "memory");
    __syncthreads();
    if (threadIdx.x == 0) xcd_barrier_t0(b);
    __syncthreads();
}

#ifdef PT_CUSTOM
#define PT_M0(c, id) do { if ((id) == PT_SEL && (c).tid == 0) *(volatile LAS unsigned long long*)((c).lds + MISC_OFF + 512) = wall_clock64(); } while (0)
#define PT_M1(c, id) do { if ((id) == PT_SEL && (c).tid == 0) *(volatile LAS unsigned long long*)((c).lds + MISC_OFF + 520) = wall_clock64(); } while (0)
#else
#define PT_M0(c, id) do { } while (0)
#define PT_M1(c, id) do { } while (0)
#endif
enum { I_X = 0, I_C, I_POS, I_ADAW, I_ADAB, I_NORMG, I_MU, I_WRKV, I_W0, I_W1, I_W2, I_A0, I_A1, I_A2, I_G1, I_G2, I_KK, I_KA, I_RK, I_LNW, I_LNB, I_RWO,
       I_KVADAW, I_KVADAB, I_KVNG, I_WDKV, I_GKV, I_WUK, I_WUV, I_WKR, I_WDQ, I_GQ, I_WUQ, I_WQR, I_MWO, I_RTW, I_RTB, I_WGU, I_WDOWN, I_FG, N_IN };
struct Params { const float* in[N_IN]; float* out; unsigned char* ws; int ph_lo, ph_hi, li, pad; };

struct Ctx {
    LAS unsigned char* lds;
    int tid, lane, wave, G, bid;
};
__device__ __forceinline__ bf16_t* wsb(const Params& p, size_t off) { return (bf16_t*)(p.ws + off); }
__device__ __forceinline__ float* wsf(const Params& p, size_t off) { return (float*)(p.ws + off); }
__device__ __forceinline__ int xcc_position(const Params& p, const Ctx& c) {
    const unsigned* xs = (const unsigned*)(p.ws + WS_CTL) + CW_XSLOT; const volatile LAS unsigned* MISC = (const volatile LAS unsigned*)(c.lds + MISC_OFF);
    const int x = (int)MISC[16], slot = (int)MISC[17]; int n[8], pos_;
#pragma unroll
    for (int j = 0; j < 8; ++j) n[j] = (int)__hip_atomic_load(xs + 64 * j, __ATOMIC_RELAXED, __HIP_MEMORY_SCOPE_AGENT);
    if (x < 8 && slot < 32) pos_ = x * 32 + slot;
    else { int ov = slot - (x < 8 ? 32 : 0);
#pragma unroll
        for (int j = 0; j < 8; ++j) if (j < x) ov += n[j] > 32 ? n[j] - 32 : 0;
        pos_ = -1;
#pragma unroll
        for (int j = 0; j < 8; ++j) { const int fr = n[j] < 32 ? 32 - n[j] : 0; if (pos_ < 0) { if (ov < fr) pos_ = j * 32 + n[j] + ov; else ov -= fr; } }
        if (pos_ < 0) pos_ = c.bid; }
    return __builtin_amdgcn_readfirstlane(pos_);
}
struct DenseSched {
    int nM, nN, nwg, G, c, nt, nt0, lda, pad, rep, skew, ngrp; const char* A; const char* B; size_t btile, aG, bG; long a1d, b1d;
    __device__ __forceinline__ void init(const void* A_, int lda_, const void* B_, int ldb_, int M, int N, int K, int G_, int c_) {
        nM = M / 256; nN = N / 256; nwg = nM * nN; G = G_; c = c_; nt = K / 64; nt0 = nt; lda = lda_; pad = 0; rep = 1; skew = 0; ngrp = 1; aG = 0; bG = 0; A = (const char*)A_; B = (const char*)B_;
        btile = (size_t)256 * ldb_ * 2; a1d = 0; b1d = 0; }
    __device__ __forceinline__ bool next(int i, pg8::Unit& u) const {
        long L0 = (long)i * G + c; if (skew) { if (c < 128) { if (i >= 1) return false; L0 = c; } else { if (i >= 3) return false; L0 = 128 + i * 128 + (c - 128); } }
        if (L0 >= (long)nwg * rep * ngrp) return false; const int grp = (ngrp > 1) ? (int)(L0 / nwg) : 0; const long L = (ngrp > 1) ? L0 - (long)grp * nwg : (L0 >= nwg ? L0 - nwg : L0);
        int wgid = (int)L; { const int q = nwg / 8, r = nwg % 8, xcd = wgid % 8, off = wgid / 8; wgid = (xcd < r ? xcd * (q + 1) : r * (q + 1) + (xcd - r) * q) + off; }
        const int nig = 8 * nN, gid = wgid / nig, fm = gid * 8, gsz = (nM - fm) < 8 ? (nM - fm) : 8;
        u.pm = fm + ((wgid % nig) % gsz); u.pn = (wgid % nig) / gsz; u.aux = grp; u.nt = nt; u.nt0 = nt0;
        const size_t arow = pad ? (size_t)((u.pm >> 5) * (SEQ + 1) + 1 + 256 * (u.pm & 31)) : (size_t)u.pm * 256;
        u.A0 = A + arow * (size_t)lda * 2 + (size_t)grp * aG; u.A1 = u.A0 + a1d; u.B0 = B + (size_t)u.pn * btile + (size_t)grp * bG; u.B1 = u.B0 + b1d; return true;
    }
    __device__ __forceinline__ int row(int, int) const { return 0; }
};

struct MoeSched {
    LAS const int* ud; LAS const int* rowtab; int down; const char* A; const char* Wgu; const char* Wdn;
    __device__ __forceinline__ bool next(int i, pg8::Unit& u) const {
        if (i >= 4) return false;
        const int valid = __builtin_amdgcn_readfirstlane(ud[i * 16 + 0]); if (!valid) return false;
        const int st = __builtin_amdgcn_readfirstlane(ud[i * 16 + 1]), pn = __builtin_amdgcn_readfirstlane(ud[i * 16 + 2]);
        const int elo = __builtin_amdgcn_readfirstlane(ud[i * 16 + 3]), ehi = __builtin_amdgcn_readfirstlane(ud[i * 16 + 4]);
        u.pm = st; u.pn = pn; u.aux = i;
        if (!down) { u.nt = 16; u.nt0 = 16; u.A0 = A; u.A1 = A; const int e = (pn >> 1) ? ehi : elo;
            u.B0 = Wgu + ((size_t)e * 512 + (size_t)(pn & 1) * 256) * 1024 * 2; u.B1 = u.B0; }
        else { u.nt = 8; u.nt0 = 4; u.A0 = A + (size_t)st * 256 * 512 * 2; u.A1 = u.A0 + 4 * 128;
            u.B0 = Wdn + ((size_t)elo * 1024 + (size_t)pn * 256) * 256 * 2; u.B1 = Wdn + ((size_t)ehi * 1024 + (size_t)pn * 256) * 256 * 2; }
        return true;
    }
    __device__ __forceinline__ int row(int i, int r) const { const int t = rowtab[i * 256 + r]; return t < 0 ? 0 : t; }
};

typedef f32x4 AccT[2][2][4][2];
#define EPI_ARGS const AccT& acc, const pg8::Unit& u, int wr, int wc, int fr, int fq
__device__ __forceinline__ u32x4 pack8(f32x4 a, f32x4 b) { u32x4 w; w.x = cvtpk(a[0], a[1]); w.y = cvtpk(a[2], a[3]); w.z = cvtpk(b[0], b[1]); w.w = cvtpk(b[2], b[3]); return w; }
__device__ __forceinline__ u32x2 pack4(f32x4 a) { u32x2 w; w.x = cvtpk(a[0], a[1]); w.y = cvtpk(a[2], a[3]); return w; }

struct EpiBf16 {
    static constexpr bool PERM = true; bf16_t* O; int ldc; size_t og;
    __device__ __forceinline__ void operator()(EPI_ARGS) const {
        const int row0 = u.pm * 256 + wr * 64 + fr, col0 = u.pn * 256 + wc * 32 + 8 * fq;
#pragma unroll
        for (int ai = 0; ai < 2; ++ai)
#pragma unroll
            for (int m = 0; m < 4; ++m) { bf16_t* rowp = O + (size_t)u.aux * og + (size_t)(row0 + ai * 128 + m * 16) * ldc + col0;
#pragma unroll
                for (int bj = 0; bj < 2; ++bj) *(u32x4*)(rowp + bj * 128) = pack8(acc[ai][bj][m][0], acc[ai][bj][m][1]); }
    }
};
struct EpiLoraDown {
    static constexpr bool PERM = true; bf16_t* O;
    __device__ __forceinline__ void operator()(EPI_ARGS) const {
        const int row0 = u.pm * 256 + wr * 64 + fr, col0 = wc * 32 + 8 * fq;
#pragma unroll
        for (int ai = 0; ai < 2; ++ai)
#pragma unroll
            for (int m = 0; m < 4; ++m) { bf16_t* rowp = O + (size_t)(row0 + ai * 128 + m * 16) * 256 + col0;
#pragma unroll
                for (int bj = 0; bj < 2; ++bj) { f32x4 v0 = acc[ai][bj][m][0], v1 = acc[ai][bj][m][1];
                    if (bj == 1) {
#pragma unroll
                        for (int i = 0; i < 4; ++i) { v0[i] = sigmoidf_(v0[i]); v1[i] = sigmoidf_(v1[i]); } }
                    else if (wc < 2) {
#pragma unroll
                        for (int i = 0; i < 4; ++i) { v0[i] = 1.0f - 2.0f * frcp(1.0f + fexp(2.0f * v0[i])); v1[i] = 1.0f - 2.0f * frcp(1.0f + fexp(2.0f * v1[i])); } }
                    *(u32x4*)(rowp + bj * 128) = pack8(v0, v1); } }
    }
};
__device__ __forceinline__ void unpack8(u32x4 w, f32x4& a, f32x4& b) { a = (f32x4){bflo(w.x), bfhi(w.x), bflo(w.y), bfhi(w.y)}; b = (f32x4){bflo(w.z), bfhi(w.z), bflo(w.w), bfhi(w.w)}; }
template <bool XF32>
struct EpiResidT {
    static constexpr bool PERM = true; const void* xin; bf16_t* xout; const float* gate;
    __device__ __forceinline__ void operator()(EPI_ARGS) const {
        const int row0 = u.pm * 256 + wr * 64 + fr, col0 = u.pn * 256 + wc * 32 + 8 * fq; const int b = u.pm >> 5;
        f32x4 gv[2][2];
#pragma unroll
        for (int bj = 0; bj < 2; ++bj)
#pragma unroll
            for (int n = 0; n < 2; ++n) gv[bj][n] = *(const f32x4*)(gate + (size_t)b * MODW + col0 + bj * 128 + n * 4);
#pragma unroll
        for (int ai = 0; ai < 2; ++ai)
#pragma unroll
            for (int m = 0; m < 4; ++m) { const size_t off = (size_t)(row0 + ai * 128 + m * 16) * D + col0;
#pragma unroll
                for (int bj = 0; bj < 2; ++bj) { f32x4 x0, x1;
                    if constexpr (XF32) { x0 = *(const f32x4*)((const float*)xin + off + bj * 128); x1 = *(const f32x4*)((const float*)xin + off + bj * 128 + 4); }
                    else unpack8(*(const u32x4*)((const bf16_t*)xin + off + bj * 128), x0, x1);
                    *(u32x4*)(xout + off + bj * 128) = pack8(x0 + gv[bj][0] * acc[ai][bj][m][0], x1 + gv[bj][1] * acc[ai][bj][m][1]); } }
    }
};
struct EpiMoeUp {
    static constexpr bool PERM = true; bf16_t* act; LAS const float* gatetab;
    __device__ __forceinline__ void operator()(EPI_ARGS) const {
        const int eidx = u.pn >> 1, half = u.pn & 1; const int rl0 = wr * 64 + fr, col0 = eidx * 256 + half * 128 + wc * 32 + 8 * fq;
#pragma unroll
        for (int ai = 0; ai < 2; ++ai)
#pragma unroll
            for (int m = 0; m < 4; ++m) { const int rl = rl0 + ai * 128 + m * 16; const float cb = gatetab[(u.aux * 256 + rl) * 2 + eidx];
                f32x4 o[2];
#pragma unroll
                for (int n = 0; n < 2; ++n)
#pragma unroll
                    for (int i = 0; i < 4; ++i) { const float g = acc[ai][0][m][n][i], up = acc[ai][1][m][n][i]; o[n][i] = g * sigmoidf_(g) * up * cb; }
                *(u32x4*)(act + (size_t)(u.pm * 256 + rl) * 512 + col0) = pack8(o[0], o[1]); }
    }
};
struct EpiMoeDown {
    static constexpr bool PERM = true; const bf16_t* Xin; bf16_t* Xout; const float* gate; LAS const int* rowtab;
    __device__ __forceinline__ void operator()(EPI_ARGS) const {
        const int rl0 = wr * 64 + fr, col0 = u.pn * 256 + wc * 32 + 8 * fq;
#pragma unroll
        for (int ai = 0; ai < 2; ++ai)
#pragma unroll
            for (int m = 0; m < 4; ++m) { const int rl = rl0 + ai * 128 + m * 16; const int tok = rowtab[u.aux * 256 + rl];
                if (tok >= 0) { const float* gp = gate + (size_t)(tok >> 13) * MODW + col0; const size_t off = (size_t)tok * D + col0;
#pragma unroll
                    for (int bj = 0; bj < 2; ++bj) { const f32x4 g0 = *(const f32x4*)(gp + bj * 128), g1 = *(const f32x4*)(gp + bj * 128 + 4); f32x4 x0, x1;
                        unpack8(*(const u32x4*)(Xin + off + bj * 128), x0, x1);
                        *(u32x4*)(Xout + off + bj * 128) = pack8(x0 + g0 * acc[ai][bj][m][0], x1 + g1 * acc[ai][bj][m][1]); } } }
    }
};
struct EpiDown {
    static constexpr bool PERM = true; bf16_t* O; int ldc; int ncols1; float* ssq; int ssq_ld; bf16_t* Kr; const float* tab;
    __device__ __forceinline__ void operator()(EPI_ARGS) const {
        const int row0 = u.pm * 256 + wr * 64 + fr;
#pragma unroll
        for (int ai = 0; ai < 2; ++ai)
#pragma unroll
            for (int m = 0; m < 4; ++m) { const int row = row0 + ai * 128 + m * 16;
                if (u.pn == 0 || ncols1 > 0) { float ss = 0.f;
#pragma unroll
                    for (int bj = 0; bj < 2; ++bj) { if (u.pn == 0 || bj * 128 < ncols1) { const f32x4 v0 = acc[ai][bj][m][0], v1 = acc[ai][bj][m][1];
                            ss += ((v0[0] * v0[0] + v0[1] * v0[1]) + (v0[2] * v0[2] + v0[3] * v0[3])) + ((v1[0] * v1[0] + v1[1] * v1[1]) + (v1[2] * v1[2] + v1[3] * v1[3]));
                            *(u32x4*)(O + (size_t)row * ldc + u.pn * 256 + bj * 128 + wc * 32 + 8 * fq) = pack8(v0, v1); } }
                    ss += __shfl_xor(ss, 16); ss += __shfl_xor(ss, 32);
                    if (fq == 0) ssq[(size_t)row * ssq_ld + u.pn * 4 + wc] = ss; }
                if (Kr != nullptr && u.pn == 1 && wc == 0) {
                    const int j0 = 8 * (fq & 1); f32x4 o[2];
#pragma unroll
                    for (int n = 0; n < 2; ++n) { const f32x4 c4 = *(const f32x4*)(tab + (size_t)row * 32 + j0 + 4 * n), s4 = *(const f32x4*)(tab + (size_t)row * 32 + 16 + j0 + 4 * n);
#pragma unroll
                        for (int i = 0; i < 4; ++i) { const unsigned vb = __float_as_uint(acc[ai][0][m][n][i]); auto rr = __builtin_amdgcn_permlane32_swap(vb, vb, false, false);
                            const float x1 = __uint_as_float(rr[0]), x2 = __uint_as_float(rr[1]); o[n][i] = (fq < 2) ? (x1 * c4[i] - x2 * s4[i]) : (x2 * c4[i] + x1 * s4[i]); } }
                    *(u32x4*)(Kr + (size_t)row * 32 + 8 * fq) = pack8(o[0], o[1]); } }
    }
};
struct EpiQ {
    static constexpr bool PERM = false; bf16_t* Q; const float* ssq; const float* tab; int pn0;
    __device__ __forceinline__ void operator()(EPI_ARGS) const {
        const int row0 = u.pm * 256 + wr * 64 + fr; const int upn = u.pn + pn0;
#pragma unroll
        for (int ai = 0; ai < 2; ++ai)
#pragma unroll
            for (int m = 0; m < 4; ++m) { const int row = row0 + ai * 128 + m * 16;
                const f32x4 sa = *(const f32x4*)(ssq + (size_t)row * 8), sb = *(const f32x4*)(ssq + (size_t)row * 8 + 4);
                const float sc = rsqrtf(((sa[0] + sa[1]) + (sa[2] + sa[3]) + (sb[0] + sb[1]) + (sb[2] + sb[3])) * (1.0f / QLORA) + NORM_EPS) * QSCALE;
                bf16_t* qrow = Q + (size_t)row * (NHEAD * QKD);
                if (upn < 4) {
#pragma unroll
                    for (int bj = 0; bj < 2; ++bj)
#pragma unroll
                        for (int n = 0; n < 2; ++n) { const int col = upn * 256 + bj * 128 + wc * 32 + n * 16 + 4 * fq;
                            *(u32x2*)(qrow + (col >> 6) * QKD + (col & 63)) = pack4(acc[ai][bj][m][n] * sc); }
                } else { const f32x4 c4 = *(const f32x4*)(tab + (size_t)row * 32 + 4 * fq), s4 = *(const f32x4*)(tab + (size_t)row * 32 + 16 + 4 * fq);
#pragma unroll
                    for (int bj = 0; bj < 2; ++bj) { const int h = (upn - 4) * 8 + bj * 4 + wc; const f32x4 x1 = acc[ai][bj][m][0] * sc, x2 = acc[ai][bj][m][1] * sc;
                        *(u32x2*)(qrow + h * QKD + 64 + 4 * fq) = pack4(x1 * c4 - x2 * s4); *(u32x2*)(qrow + h * QKD + 80 + 4 * fq) = pack4(x2 * c4 + x1 * s4); } } }
    }
};
struct EpiQn {
    static constexpr bool PERM = true; bf16_t* Q; const float* ssq;
    __device__ __forceinline__ void operator()(EPI_ARGS) const {
        const int row0 = u.pm * 256 + wr * 64 + fr;
#pragma unroll
        for (int ai = 0; ai < 2; ++ai)
#pragma unroll
            for (int m = 0; m < 4; ++m) { const int row = row0 + ai * 128 + m * 16;
                const f32x4 sa = *(const f32x4*)(ssq + (size_t)row * 8), sb = *(const f32x4*)(ssq + (size_t)row * 8 + 4);
                const float sc = rsqrtf(((sa[0] + sa[1]) + (sa[2] + sa[3]) + (sb[0] + sb[1]) + (sb[2] + sb[3])) * (1.0f / QLORA) + NORM_EPS) * QSCALE;
                bf16_t* qrow = Q + (size_t)row * (NHEAD * QKD);
#pragma unroll
                for (int bj = 0; bj < 2; ++bj) { const int col = u.pn * 256 + bj * 128 + wc * 32 + 8 * fq;
                    *(u32x4*)(qrow + (col >> 6) * QKD + (col & 63)) = pack8(acc[ai][bj][m][0] * sc, acc[ai][bj][m][1] * sc); } }
    }
};
struct EpiQr {
    static constexpr bool PERM = true; bf16_t* Q; const float* ssq; const float* tab;
    __device__ __forceinline__ void operator()(EPI_ARGS) const {
        const int row0 = u.pm * 256 + wr * 64 + fr; const int j0 = 8 * (fq & 1);
#pragma unroll
        for (int ai = 0; ai < 2; ++ai)
#pragma unroll
            for (int m = 0; m < 4; ++m) { const int row = row0 + ai * 128 + m * 16;
                const f32x4 sa = *(const f32x4*)(ssq + (size_t)row * 8), sb = *(const f32x4*)(ssq + (size_t)row * 8 + 4);
                const float sc = rsqrtf(((sa[0] + sa[1]) + (sa[2] + sa[3]) + (sb[0] + sb[1]) + (sb[2] + sb[3])) * (1.0f / QLORA) + NORM_EPS) * QSCALE;
                bf16_t* qrow = Q + (size_t)row * (NHEAD * QKD);
                f32x4 c4[2], s4[2];
#pragma unroll
                for (int n = 0; n < 2; ++n) { c4[n] = *(const f32x4*)(tab + (size_t)row * 32 + j0 + 4 * n); s4[n] = *(const f32x4*)(tab + (size_t)row * 32 + 16 + j0 + 4 * n); }
#pragma unroll
                for (int bj = 0; bj < 2; ++bj) { const int h = u.pn * 8 + bj * 4 + wc; f32x4 o[2];
#pragma unroll
                    for (int n = 0; n < 2; ++n)
#pragma unroll
                        for (int i = 0; i < 4; ++i) { const unsigned vb = __float_as_uint(acc[ai][bj][m][n][i] * sc); auto rr = __builtin_amdgcn_permlane32_swap(vb, vb, false, false);
                            const float x1 = __uint_as_float(rr[0]), x2 = __uint_as_float(rr[1]); o[n][i] = (fq < 2) ? (x1 * c4[n][i] - x2 * s4[n][i]) : (x2 * c4[n][i] + x1 * s4[n][i]); }
                    *(u32x4*)(qrow + h * QKD + 64 + 8 * fq) = pack8(o[0], o[1]); } }
    }
};
struct EpiKV {
    static constexpr bool PERM = true; bf16_t* Kn; bf16_t* V; const float* ssq;
    __device__ __forceinline__ void operator()(EPI_ARGS) const {
        const int row0 = u.pm * 256 + wr * 64 + fr; bf16_t* base = (u.pn < 4) ? Kn : V; const int col0 = (u.pn & 3) * 256 + wc * 32 + 8 * fq;
#pragma unroll
        for (int ai = 0; ai < 2; ++ai)
#pragma unroll
            for (int m = 0; m < 4; ++m) { const int row = row0 + ai * 128 + m * 16; const f32x4 sa = *(const f32x4*)(ssq + (size_t)row * 4);
                const float sc = rsqrtf(((sa[0] + sa[1]) + (sa[2] + sa[3])) * (1.0f / KVLORA) + NORM_EPS);
#pragma unroll
                for (int bj = 0; bj < 2; ++bj) *(u32x4*)(base + (size_t)row * D + col0 + bj * 128) = pack8(acc[ai][bj][m][0] * sc, acc[ai][bj][m][1] * sc); }
    }
};
__device__ __forceinline__ float srcval(const Params& p, int kind, int e, int k, int n) {
    switch (kind) {
    case 0: case 1: case 2: return p.in[I_WRKV][((size_t)kind * D + k) * D + n];
    case 3: { const int kk = k & 1023, hi = k >> 10; float w, mu;
        if (n < 64) { w = p.in[I_W1][kk * 64 + n]; mu = p.in[I_MU][1 * D + kk]; }
        else if (n < 128) { w = p.in[I_A1][kk * 64 + n - 64]; mu = p.in[I_MU][4 * D + kk]; }
        else { w = p.in[I_G1][kk * 128 + n - 128]; mu = p.in[I_MU][5 * D + kk]; }
        return w * (hi ? mu : 1.0f - mu); }
    case 4: return p.in[I_RWO][(size_t)k * D + n];
    case 5: return n < 256 ? p.in[I_WDKV][k * 256 + n] : (n < 288 ? p.in[I_WKR][k * 32 + n - 256] : 0.f);
    case 6: return n < 384 ? p.in[I_WDQ][k * 384 + n] : 0.f;
    case 7: return p.in[I_GQ][k] * (n < 1024 ? p.in[I_WUQ][(size_t)k * 1024 + n] : p.in[I_WQR][(size_t)k * 512 + n - 1024]);
    case 8: return p.in[I_GKV][k] * (n < 1024 ? p.in[I_WUK][(size_t)k * 1024 + n] : p.in[I_WUV][(size_t)k * 1024 + n - 1024]);
    case 9: return p.in[I_MWO][(size_t)k * D + n];
    case 10: { const int pp = n >> 8, w = n & 255; const int col = (w < 128) ? (128 * pp + w) : (256 + 128 * pp + (w - 128));
        return p.in[I_WGU][((size_t)e * D + k) * 512 + col]; }
    case 11: return p.in[I_WDOWN][((size_t)e * 256 + k) * D + n];
    case 12: return p.in[I_W2][(size_t)k * D + n];
    case 13: return p.in[I_A2][(size_t)k * D + n];
    default: return p.in[I_G2][(size_t)k * D + n];
    }
}
__device__ __forceinline__ void transpose_item(const Params& p, int kind, int e, bf16_t* dst, int ldd, LAS float* scr, int kb, int nb, int lane) {
    const int k0 = 64 * kb, n0 = 32 * nb;
#pragma unroll 4
    for (int i = 0; i < 32; ++i) { const int kk = 2 * i + (lane >> 5); scr[kk * 33 + (lane & 31)] = srcval(p, kind, e, k0 + kk, n0 + (lane & 31)); }
    asm volatile("s_waitcnt lgkmcnt(0)" ::: "memory");
    const int c = lane & 7;
#pragma unroll
    for (int j = 0; j < 4; ++j) { const int n = (lane >> 3) + 8 * j; const LAS float* s = scr + (8 * c) * 33 + n;
        u32x4 o; o.x = cvtpk(s[0 * 33], s[1 * 33]); o.y = cvtpk(s[2 * 33], s[3 * 33]); o.z = cvtpk(s[4 * 33], s[5 * 33]); o.w = cvtpk(s[6 * 33], s[7 * 33]);
        *(u32x4*)(dst + (size_t)(n0 + n) * ldd + k0 + 8 * c) = o; }
    asm volatile("s_waitcnt lgkmcnt(0)" ::: "memory");
}
__device__ __forceinline__ bool tjob(const Params& p, int& r, int kind, int e, size_t ws_off, int Kd, int Nd, LAS float* scr, int lane) {
    const int nkb = Kd / 64, nnb = Nd / 32, cnt = nkb * nnb;
    if (r < cnt) { transpose_item(p, kind, e, wsb(p, ws_off), Kd, scr, r / nnb, r % nnb, lane); return true; }
    r -= cnt; return false;
}
__device__ __forceinline__ void convert_moe_weights(const Params& p, const Ctx& c, int layer) {
    LAS float* scr = (LAS float*)(c.lds + RING_OFF + c.wave * 16384);
    const int gw = c.bid * NWAVES + c.wave, NGW = c.G * NWAVES;
    for (int it = gw; it < 16 * 384; it += NGW) { const int e = it / 384; int r = it % 384;
        if (r < 256) transpose_item(p, 10, layer * 16 + e, wsb(p, WS_WGU) + (size_t)e * 512 * 1024, 1024, scr, r / 16, r % 16, c.lane);
        else { r -= 256; transpose_item(p, 11, layer * 16 + e, wsb(p, WS_WDN) + (size_t)e * 1024 * 256, 256, scr, r / 32, r % 32, c.lane); } }
}
__device__ __forceinline__ void phase_prologue(const Params& p, const Ctx& c) {
    LAS float* sc = (LAS float*)(c.lds);
    LAS float* part = (LAS float*)(c.lds + 16384);
    for (int i = c.tid; i < NB * D; i += NTHREADS) { const float v = p.in[I_C][i]; sc[i] = v / (1.0f + __expf(-v)); }
    __syncthreads();
    const int prep = (p.pad == 100) ? 2 : 1;
    for (int it0 = c.bid; it0 < (MODW / 64) * prep; it0 += c.G) { const int it = it0 % (MODW / 64);
        const int col0 = it * 64, set = col0 < 12288 ? col0 / 3072 : 4, cin = col0 - (set < 4 ? set * 3072 : 12288);
        const float* W = set < 4 ? p.in[I_ADAW] + (size_t)set * D * 3072 : p.in[I_KVADAW]; const int ldw = set < 4 ? 3072 : 2048;
        const float* bias = set < 4 ? p.in[I_ADAB] + set * 3072 : p.in[I_KVADAB];
        float a0 = 0.f, a1 = 0.f, a2 = 0.f, a3 = 0.f;
#pragma unroll 8
        for (int kk = 0; kk < 128; ++kk) { const int k = c.wave * 128 + kk; const float w = W[(size_t)k * ldw + cin + c.lane];
            a0 += sc[k] * w; a1 += sc[D + k] * w; a2 += sc[2 * D + k] * w; a3 += sc[3 * D + k] * w; }
        part[(c.wave * 4 + 0) * 64 + c.lane] = a0; part[(c.wave * 4 + 1) * 64 + c.lane] = a1; part[(c.wave * 4 + 2) * 64 + c.lane] = a2; part[(c.wave * 4 + 3) * 64 + c.lane] = a3;
        __syncthreads();
        if (c.tid < 256) { const int b = c.tid >> 6, l = c.tid & 63; float s = bias[cin + l];
#pragma unroll
            for (int w = 0; w < 8; ++w) s += part[(w * 4 + b) * 64 + l];
            wsf(p, WS_MOD)[(size_t)b * MODW + col0 + l] = s; }
        __syncthreads();
    }
    asm volatile("s_waitcnt vmcnt(0)" ::: "memory");
    __syncthreads();
    if (c.tid == 0) { __builtin_amdgcn_fence(__ATOMIC_RELEASE, "agent"); asm volatile("s_waitcnt vmcnt(0)" ::: "memory");
        (void)__hip_atomic_fetch_add((unsigned*)(p.ws + WS_CTL) + CW_ADA, 1u, __ATOMIC_RELAXED, __HIP_MEMORY_SCOPE_AGENT); }
    LAS float* scr = (LAS float*)(c.lds + RING_OFF + c.wave * 16384);
    const int gw = c.bid * NWAVES + c.wave, NGW = c.G * NWAVES;
    constexpr int NITEMS = 3 * 512 + 256 + 512 + 32 + 32 + 64;
    for (int it = gw; it < NITEMS * prep; it += NGW) { int r = it % NITEMS;
        if (tjob(p, r, 0, 0, WS_WR, 1024, 1024, scr, c.lane)) continue;
        if (tjob(p, r, 1, 0, WS_WK, 1024, 1024, scr, c.lane)) continue;
        if (tjob(p, r, 2, 0, WS_WV, 1024, 1024, scr, c.lane)) continue;
        if (tjob(p, r, 3, 0, WS_LD, 2048, 256, scr, c.lane)) continue;
        if (tjob(p, r, 4, 0, WS_WO, 1024, 1024, scr, c.lane)) continue;
        if (tjob(p, r, 12, 0, WS_W2T, 64, 1024, scr, c.lane)) continue;
        if (tjob(p, r, 13, 0, WS_A2T, 64, 1024, scr, c.lane)) continue;
        tjob(p, r, 14, 0, WS_G2T, 128, 1024, scr, c.lane);
    }
    for (int q = 0; q < prep; ++q) convert_moe_weights(p, c, 0);
    const int* pos = (const int*)p.in[I_POS]; float* tab = wsf(p, WS_TAB);
    for (int i0 = c.bid * NTHREADS + c.tid; i0 < T * 16 * prep; i0 += c.G * NTHREADS) { const int i = i0 % (T * 16); const int t = i >> 4, f = i & 15;
        const float inv = powf(10000.0f, -(float)(2 * f) / 32.0f); float s, co; sincosf((float)pos[t] * inv, &s, &co);
        tab[(size_t)t * 32 + f] = co; tab[(size_t)t * 32 + 16 + f] = s; }
}

__device__ __forceinline__ void load_row(const float* rowp, int lane, f32x4 (&v)[4]) {
#pragma unroll
    for (int j = 0; j < 4; ++j) v[j] = *(const f32x4*)(rowp + 4 * lane + 256 * j);
}
__device__ __forceinline__ void load_row_b(const bf16_t* rowp, int lane, f32x4 (&v)[4]) {
#pragma unroll
    for (int j = 0; j < 4; ++j) { const u32x2 w = *(const u32x2*)(rowp + 4 * lane + 256 * j); v[j] = (f32x4){bflo(w.x), bfhi(w.x), bflo(w.y), bfhi(w.y)}; }
}
__device__ __forceinline__ float row_rstd(const f32x4 (&v)[4]) {
    float s = 0.f;
#pragma unroll
    for (int j = 0; j < 4; ++j) s += (v[j][0] * v[j][0] + v[j][1] * v[j][1]) + (v[j][2] * v[j][2] + v[j][3] * v[j][3]);
    return rsqrtf(wave_sum(s) * (1.0f / D) + NORM_EPS);
}
__device__ __forceinline__ void store_row_bf16(bf16_t* rowp, int lane, const f32x4 (&v)[4]) {
#pragma unroll
    for (int j = 0; j < 4; ++j) *(u32x2*)(rowp + 4 * lane + 256 * j) = pack4(v[j]);
}
__device__ __forceinline__ void load_mod(const Params& p, const float* g, int set, int b, int lane, f32x4 (&P)[4], f32x4 (&SH)[4]) {
    const float* m = wsf(p, WS_MOD) + (size_t)b * MODW + (set < 4 ? set * 3072 : 12288);
#pragma unroll
    for (int j = 0; j < 4; ++j) { const int o = 4 * lane + 256 * j; const f32x4 gg = *(const f32x4*)(g + o), sc = *(const f32x4*)(m + 1024 + o); SH[j] = *(const f32x4*)(m + o); P[j] = gg * (sc + 1.0f); }
}

__device__ __forceinline__ void phase_n0(const Params& p, const Ctx& c) {
    const int row0 = (c.bid * NWAVES + c.wave) * 16;
    if (row0 >= T) return;
    const int b = row0 >> 13, t0 = row0 & (SEQ - 1);
    f32x4 P[4], SH[4], mr[4], mk[4], mv[4];
    load_mod(p, p.in[I_NORMG] + 0 * D, 0, b, c.lane, P, SH);
#pragma unroll
    for (int j = 0; j < 4; ++j) { const int o = 4 * c.lane + 256 * j; mr[j] = *(const f32x4*)(p.in[I_MU] + 0 * D + o); mk[j] = *(const f32x4*)(p.in[I_MU] + 2 * D + o); mv[j] = *(const f32x4*)(p.in[I_MU] + 3 * D + o); }
    bf16_t* hpad = (bf16_t*)p.out; bf16_t* xr = wsb(p, WS_W0); bf16_t* xk = wsb(p, WS_W1); bf16_t* xv = wsb(p, WS_W2);
    f32x4 hp[4];
    if (t0 == 0) {
#pragma unroll
        for (int j = 0; j < 4; ++j) hp[j] = (f32x4){0.f, 0.f, 0.f, 0.f};
        store_row_bf16(hpad + (size_t)b * (SEQ + 1) * D, c.lane, hp);
    } else { f32x4 v[4]; load_row(p.in[I_X] + (size_t)(row0 - 1) * D, c.lane, v); const float rs = row_rstd(v);
#pragma unroll
        for (int j = 0; j < 4; ++j) hp[j] = v[j] * rs * P[j] + SH[j]; }
    for (int rr = 0, nr = (p.pad == 101) ? 32 : 16; rr < nr; ++rr) { const int r = rr & 15; const int row = row0 + r; f32x4 v[4], o[4]; load_row(p.in[I_X] + (size_t)row * D, c.lane, v); const float rs = row_rstd(v);
#pragma unroll
        for (int j = 0; j < 4; ++j) v[j] = v[j] * rs * P[j] + SH[j];
        store_row_bf16(hpad + ((size_t)b * (SEQ + 1) + 1 + t0 + r) * D, c.lane, v);
#pragma unroll
        for (int j = 0; j < 4; ++j) o[j] = v[j] + (hp[j] - v[j]) * mr[j];
        store_row_bf16(xr + (size_t)row * D, c.lane, o);
#pragma unroll
        for (int j = 0; j < 4; ++j) o[j] = v[j] + (hp[j] - v[j]) * mk[j];
        store_row_bf16(xk + (size_t)row * D, c.lane, o);
#pragma unroll
        for (int j = 0; j < 4; ++j) o[j] = v[j] + (hp[j] - v[j]) * mv[j];
        store_row_bf16(xv + (size_t)row * D, c.lane, o);
#pragma unroll
        for (int j = 0; j < 4; ++j) hp[j] = v[j]; }
}

__device__ __forceinline__ void router_prebuild(const Params& p, const Ctx& c, int layer) {
    LAS unsigned char* whi = c.lds; LAS unsigned char* wlo = c.lds + 32768; LAS int* hist = (LAS int*)(c.lds + 65536 + 4096);
    LAS float* Pl = (LAS float*)(c.lds + 90112); LAS float* SHl = (LAS float*)(c.lds + 94208); LAS float* ccp = (LAS float*)(c.lds + 98304);
    const int set = layer * 2 + 1; const int b = (c.bid * 128) >> 13; const int t = c.tid - 64;
    const float* mm = wsf(p, WS_MOD) + (size_t)b * MODW + set * 3072; const float* gn = p.in[I_NORMG] + (size_t)set * D; float cp[16];
#pragma unroll
    for (int e = 0; e < 16; ++e) cp[e] = 0.f;
#pragma unroll 1
    for (int k = t; k < D; k += NTHREADS - 64) { const float Pk = gn[k] * (mm[1024 + k] + 1.0f), Sk = mm[k]; Pl[k] = Pk; SHl[k] = Sk;
        const int fo = (((k >> 5) * 64 + ((k >> 3) & 3) * 16) * 8 + (k & 7)) * 2;
#pragma unroll
        for (int q = 0; q < 4; ++q) { const f32x4 w = *(const f32x4*)(p.in[I_RTW] + (size_t)k * 16 + 4 * q);
#pragma unroll
            for (int i = 0; i < 4; ++i) { const int e = 4 * q + i; const float wp = Pk * w[i]; const unsigned hb = cvtpk(wp, 0.f) & 0xffffu; const float hf = __uint_as_float(hb << 16);
                *(LAS unsigned short*)(whi + fo + e * 16) = (unsigned short)hb; *(LAS unsigned short*)(wlo + fo + e * 16) = (unsigned short)(cvtpk(wp - hf, 0.f) & 0xffffu);
                cp[e] += Sk * w[i]; } } }
#pragma unroll
    for (int e = 0; e < 16; ++e) { const float s_ = wave_sum(cp[e]); if (c.lane == 0) ccp[c.wave * 16 + e] = s_; }
    if (t < 16) ccp[t] = 0.f;
    if (t < 64) hist[t] = 0;
}

__device__ __forceinline__ void phase_router(const Params& p, const Ctx& c, int layer, bool prebuilt) {
    LAS unsigned char* whi = c.lds; LAS unsigned char* wlo = c.lds + 32768;
    LAS int* rcls = (LAS int*)(c.lds + 65536);
    LAS float* rgate = (LAS float*)(c.lds + 65536 + 512);
    LAS int* rpos = (LAS int*)(c.lds + 65536 + 2048);
    LAS int* hist = (LAS int*)(c.lds + 65536 + 4096);
    LAS float* Pl = (LAS float*)(c.lds + 90112); LAS float* SHl = (LAS float*)(c.lds + 94208); LAS float* ccp = (LAS float*)(c.lds + 98304);
    const int set = layer * 2 + 1; const int rowb = c.bid * 128; const int b = rowb >> 13;
    if (!prebuilt) { const float* mm = wsf(p, WS_MOD) + (size_t)b * MODW + set * 3072; const float* gn = p.in[I_NORMG] + (size_t)set * D; float cp[16];
#pragma unroll
        for (int e = 0; e < 16; ++e) cp[e] = 0.f;
#pragma unroll
        for (int r = 0; r < 2; ++r) { const int k = c.tid + r * NTHREADS; const float Pk = gn[k] * (mm[1024 + k] + 1.0f), Sk = mm[k]; Pl[k] = Pk; SHl[k] = Sk;
            const int fo = (((k >> 5) * 64 + ((k >> 3) & 3) * 16) * 8 + (k & 7)) * 2;
#pragma unroll
            for (int q = 0; q < 4; ++q) { const f32x4 w = *(const f32x4*)(p.in[I_RTW] + (size_t)k * 16 + 4 * q);
#pragma unroll
                for (int i = 0; i < 4; ++i) { const int e = 4 * q + i; const float wp = Pk * w[i]; const unsigned hb = cvtpk(wp, 0.f) & 0xffffu; const float hf = __uint_as_float(hb << 16);
                    *(LAS unsigned short*)(whi + fo + e * 16) = (unsigned short)hb; *(LAS unsigned short*)(wlo + fo + e * 16) = (unsigned short)(cvtpk(wp - hf, 0.f) & 0xffffu);
                    cp[e] += Sk * w[i]; } } }
#pragma unroll
        for (int e = 0; e < 16; ++e) { const float t = wave_sum(cp[e]); if (c.lane == 0) ccp[c.wave * 16 + e] = t; } }
    if (!prebuilt && c.tid < 64) hist[c.tid] = 0;
    __syncthreads();
    if (c.tid < 16) { float t = 0.f;
#pragma unroll
        for (int w = 0; w < 8; ++w) t += ccp[w * 16 + c.tid];
        ccp[128 + c.tid] = t; }
    __syncthreads();
    const bf16_t* X = (const bf16_t*)p.out; bf16_t* h2 = wsb(p, WS_W1);
    LAS float* sa = (LAS float*)(c.lds + 65536 + 8192) + c.wave * 512;
    if (layer == 0) PT_M0(c, 8);
    {   const int m = c.lane & 15, kg = c.lane >> 4; const size_t ro = (size_t)(rowb + c.wave * 16 + m) * D + 8 * kg;
        bf16x8 xa[32];
#pragma unroll
        for (int s2 = 0; s2 < 32; ++s2) xa[s2] = *(const bf16x8*)(X + ro + 32 * s2);
        __builtin_amdgcn_sched_barrier(0);
        float ss = 0.f;
#pragma unroll
        for (int s2 = 0; s2 < 32; ++s2) { const u32x4 w = __builtin_bit_cast(u32x4, xa[s2]);
            const float a0 = bflo(w.x), a1 = bfhi(w.x), a2 = bflo(w.y), a3 = bfhi(w.y), a4 = bflo(w.z), a5 = bfhi(w.z), a6 = bflo(w.w), a7 = bfhi(w.w);
            ss += ((a0 * a0 + a1 * a1) + (a2 * a2 + a3 * a3)) + ((a4 * a4 + a5 * a5) + (a6 * a6 + a7 * a7));
            if ((s2 & 3) == 3) __builtin_amdgcn_sched_barrier(0); }
        ss += __shfl_xor(ss, 16); ss += __shfl_xor(ss, 32);
        const float rs = rsqrtf(ss * (1.0f / D) + NORM_EPS);
        f32x4 acc = {0.f, 0.f, 0.f, 0.f};
#pragma unroll
        for (int s2 = 0; s2 < 32; ++s2) { acc = __builtin_amdgcn_mfma_f32_16x16x32_bf16(xa[s2], *(const LAS bf16x8*)(whi + (s2 * 64 + c.lane) * 16), acc, 0, 0, 0);
            acc = __builtin_amdgcn_mfma_f32_16x16x32_bf16(xa[s2], *(const LAS bf16x8*)(wlo + (s2 * 64 + c.lane) * 16), acc, 0, 0, 0);
            if ((s2 & 3) == 3) __builtin_amdgcn_sched_barrier(0); }
        __builtin_amdgcn_sched_barrier(0);
        const float cce = ccp[128 + m], rbe = p.in[I_RTB][m];
#pragma unroll
        for (int r = 0; r < 4; ++r) { const float rr = __shfl(rs, 4 * kg + r); const float lg = rr * acc[r] + cce; const float aff = 1.0f / (1.0f + __expf(-lg));
            sa[(4 * kg + r) * 16 + m] = aff + rbe; sa[256 + (4 * kg + r) * 16 + m] = aff; }
        __builtin_amdgcn_sched_barrier(0);
#pragma unroll 1
        for (int s4 = 0; s4 < 32; s4 += 4) { u32x4 w4[4];
#pragma unroll
            for (int u = 0; u < 4; ++u) w4[u] = *(const u32x4*)(X + ro + 32 * (s4 + u));
#pragma unroll
            for (int u = 0; u < 4; ++u) { const u32x4 w = w4[u]; const int k0 = 32 * (s4 + u) + 8 * kg;
                const f32x4 p0 = *(const LAS f32x4*)(Pl + k0), p1 = *(const LAS f32x4*)(Pl + k0 + 4), h0 = *(const LAS f32x4*)(SHl + k0), h1 = *(const LAS f32x4*)(SHl + k0 + 4);
                const f32x4 v0 = {bflo(w.x) * rs * p0[0] + h0[0], bfhi(w.x) * rs * p0[1] + h0[1], bflo(w.y) * rs * p0[2] + h0[2], bfhi(w.y) * rs * p0[3] + h0[3]};
                const f32x4 v1 = {bflo(w.z) * rs * p1[0] + h1[0], bfhi(w.z) * rs * p1[1] + h1[1], bflo(w.w) * rs * p1[2] + h1[2], bfhi(w.w) * rs * p1[3] + h1[3]};
                *(u32x4*)(h2 + ro + 32 * (s4 + u)) = pack8(v0, v1); } }
    }
    {
        const int r = c.lane & 15; float sel[16], aff[16];
#pragma unroll
        for (int k = 0; k < 4; ++k) { const f32x4 a = *(const LAS f32x4*)(sa + r * 16 + 4 * k), b = *(const LAS f32x4*)(sa + 256 + r * 16 + 4 * k);
#pragma unroll
            for (int i = 0; i < 4; ++i) { sel[4 * k + i] = a[i]; aff[4 * k + i] = b[i]; } }
        int bg = 0; float bs = -INFINITY;
#pragma unroll
        for (int g = 0; g < 4; ++g) { const float a0 = sel[4 * g], a1 = sel[4 * g + 1], a2 = sel[4 * g + 2], a3 = sel[4 * g + 3];
            const float m01 = fmaxf(a0, a1), n01 = fminf(a0, a1), m23 = fmaxf(a2, a3), n23 = fminf(a2, a3);
            const float top = fmaxf(m01, m23), second = fmaxf(fminf(m01, m23), (m01 >= m23) ? n01 : n23); const float gs = top + second;
            if (gs > bs) { bs = gs; bg = g; } }
        float s4[4], a4[4];
#pragma unroll
        for (int i = 0; i < 4; ++i) { s4[i] = sel[i]; a4[i] = aff[i]; }
#pragma unroll
        for (int g = 1; g < 4; ++g) if (g == bg) {
#pragma unroll
            for (int i = 0; i < 4; ++i) { s4[i] = sel[4 * g + i]; a4[i] = aff[4 * g + i]; } }
        int i0 = 0;
#pragma unroll
        for (int i = 1; i < 4; ++i) if (s4[i] > s4[i0]) i0 = i;
        int i1 = (i0 == 0) ? 1 : 0;
#pragma unroll
        for (int i = 0; i < 4; ++i) if (i != i0 && i != i1 && s4[i] > s4[i1]) i1 = i;
        float af0 = 0.f, af1 = 0.f;
#pragma unroll
        for (int i = 0; i < 4; ++i) { if (i == i0) af0 = a4[i]; if (i == i1) af1 = a4[i]; }
        const float inv = 1.0f / (af0 + af1);
        const int lo = i0 < i1 ? i0 : i1, hi = i0 < i1 ? i1 : i0; const float glo = (i0 < i1 ? af0 : af1) * inv, ghi = (i0 < i1 ? af1 : af0) * inv;
        const int pair = (lo == 0) ? (hi - 1) : (lo == 1 ? hi + 1 : 5);
        if (c.lane < 16) { const int rl = c.wave * 16 + r; rcls[rl] = bg * 6 + pair; rgate[rl * 2] = glo; rgate[rl * 2 + 1] = ghi; }
    }
    __syncthreads();
    if (layer == 0) PT_M1(c, 8);
    if (c.tid < 128) rpos[c.tid] = atomicAdd((int*)(hist + rcls[c.tid]), 1);
    __syncthreads();
    unsigned* gcnt = (unsigned*)(p.ws + WS_CTL) + CW_CNT + 64 * layer;
    if (c.tid < NCLS) { const int n = hist[c.tid]; hist[32 + c.tid] = n ? (int)atomicAdd(gcnt + c.tid, (unsigned)n) : 0; }
    __syncthreads();
    if (c.tid < 128) { const int cl = rcls[c.tid], pos = hist[32 + cl] + rpos[c.tid], tok = rowb + c.tid;
        ((int*)(p.ws + WS_LIST))[(size_t)cl * T + pos] = tok;
        *(f32x2*)(wsf(p, WS_GATES) + ((size_t)cl * T + pos) * 2) = (f32x2){rgate[c.tid * 2], rgate[c.tid * 2 + 1]}; }
}

__device__ __forceinline__ void moe_setup(const Params& p, const Ctx& c, int layer) {
    LAS int* ud = (LAS int*)(c.lds + UDESC_OFF); LAS int* ct = (LAS int*)(c.lds + CLSTAB_OFF);
    LAS int* rowtab = (LAS int*)(c.lds + ROWTAB_OFF); LAS float* gatetab = (LAS float*)(c.lds + GATETAB_OFF);
    const unsigned* gcnt = (const unsigned*)(p.ws + WS_CTL) + CW_CNT + 64 * layer;
    if (c.tid < NCLS) ct[c.tid] = (int)__hip_atomic_load(gcnt + c.tid, __ATOMIC_RELAXED, __HIP_MEMORY_SCOPE_AGENT);
    __syncthreads();
    int startk[NCLS + 1];
    { int acc = 0;
#pragma unroll
      for (int k = 0; k < NCLS; ++k) { startk[k] = acc; acc += (ct[k] + 255) >> 8; }
      startk[NCLS] = acc; }
    const int total = startk[NCLS] * 4;
    if (c.tid == 0) { ct[61] = total; }
    const int* list = (const int*)(p.ws + WS_LIST); const float* gates = wsf(p, WS_GATES);
#pragma unroll
    for (int i = 0; i < 4; ++i) { const long L0 = (long)i * c.G + c.bid; int valid = 0, st = 0, pn = 0, elo = 0, ehi = 0, cls = 0, j = 0;
        if (L0 < total) { int L = (int)L0; { const int q = total / 8, r = total % 8, xcd = L % 8, off = L / 8; L = (xcd < r ? xcd * (q + 1) : r * (q + 1) + (xcd - r) * q) + off; }
            valid = 1; pn = L & 3; st = L >> 2; int sb = 0;
#pragma unroll
            for (int k = 1; k < NCLS; ++k) { const bool le = startk[k] <= st; cls += le ? 1 : 0; sb = le ? startk[k] : sb; }
            j = st - sb;
            const int g = cls / 6, pr = cls % 6; const int lo = pr < 3 ? 0 : (pr < 5 ? 1 : 2), hi = pr < 3 ? pr + 1 : (pr < 5 ? pr - 1 : 3); elo = 4 * g + lo; ehi = 4 * g + hi; }
        if (c.tid == 0) { ud[i * 16 + 0] = valid; ud[i * 16 + 1] = st; ud[i * 16 + 2] = pn; ud[i * 16 + 3] = elo; ud[i * 16 + 4] = ehi; ud[i * 16 + 5] = cls; ud[i * 16 + 6] = j; }
        if (valid && c.tid < 256) { const int n = ct[cls]; const int pos = j * 256 + c.tid; int tok = -1; f32x2 g = {0.f, 0.f};
            if (pos < n) { tok = list[(size_t)cls * T + pos]; g = *(const f32x2*)(gates + ((size_t)cls * T + pos) * 2); }
            rowtab[i * 256 + c.tid] = tok; gatetab[(i * 256 + c.tid) * 2] = g.x; gatetab[(i * 256 + c.tid) * 2 + 1] = g.y; } }
    __syncthreads();
}

__device__ __forceinline__ void phase_n2(const Params& p, const Ctx& c) {
    const int row0 = (c.bid * NWAVES + c.wave) * 16; if (row0 >= T) return; const int b = row0 >> 13;
    f32x4 P1[4], S1[4], P2[4], S2[4];
    load_mod(p, p.in[I_NORMG] + 2 * D, 2, b, c.lane, P1, S1); load_mod(p, p.in[I_KVNG], 4, b, c.lane, P2, S2);
    const bf16_t* X = (const bf16_t*)p.out; bf16_t* h1 = wsb(p, WS_W0); bf16_t* hkv = wsb(p, WS_W1);
    for (int rr = 0, nr = (p.pad == 110) ? 32 : 16; rr < nr; ++rr) { const int r = rr & 15; const int row = row0 + r; f32x4 v[4], o[4]; load_row_b(X + (size_t)row * D, c.lane, v); const float rs = row_rstd(v);
#pragma unroll
        for (int j = 0; j < 4; ++j) { v[j] = v[j] * rs; o[j] = v[j] * P1[j] + S1[j]; }
        store_row_bf16(h1 + (size_t)row * D, c.lane, o);
#pragma unroll
        for (int j = 0; j < 4; ++j) o[j] = v[j] * P2[j] + S2[j];
        store_row_bf16(hkv + (size_t)row * D, c.lane, o); }
}
__device__ __forceinline__ void phase_final(const Params& p, const Ctx& c) {
    const int row0 = (c.bid * NWAVES + c.wave) * 16; if (row0 >= T) return;
    f32x4 g[4];
#pragma unroll
    for (int j = 0; j < 4; ++j) g[j] = *(const f32x4*)(p.in[I_FG] + 4 * c.lane + 256 * j);
    const bf16_t* X = wsb(p, WS_W1);
    for (int r = 0; r < 16; ++r) { float* rowp = p.out + (size_t)(row0 + r) * D; f32x4 v[4]; load_row_b(X + (size_t)(row0 + r) * D, c.lane, v); const float rs = row_rstd(v);
#pragma unroll
        for (int j = 0; j < 4; ++j) *(f32x4*)(rowp + 4 * c.lane + 256 * j) = v[j] * rs * g[j]; }
}
constexpr int AT_KSTR = 208;
constexpr int AT_KBUF = 64 * AT_KSTR, AT_VBUF = 8192;
__device__ __forceinline__ s16x4 vtr(const LAS unsigned char* pp) { typedef short v4i16_t __attribute__((ext_vector_type(4)));
    return __builtin_bit_cast(s16x4, __builtin_amdgcn_ds_read_tr16_b64_v4i16((LAS v4i16_t*)pp)); }
__device__ __forceinline__ void attn_unit(const Params& p, const Ctx& c, int b, int h, int qb) {
    const int tid = c.tid, lane = c.lane, wid = c.wave, r32 = lane & 31, hi = lane >> 5;
    const bf16_t* Q = wsb(p, WS_W2); const bf16_t* Kn = wsb(p, WS_W4); const bf16_t* V = wsb(p, WS_W5); const bf16_t* Kr = wsb(p, WS_KR); bf16_t* O = wsb(p, WS_W0);
    const size_t rowbase = (size_t)b * SEQ; const int q0 = qb * 256, qrow = q0 + 32 * wid + r32;
    LAS unsigned char* Kb = c.lds; LAS unsigned char* Vb = c.lds + 2 * AT_KBUF;
    bf16x8 qr[6];
#pragma unroll
    for (int d0 = 0; d0 < 6; ++d0) qr[d0] = *(const bf16x8*)(Q + (rowbase + qrow) * (NHEAD * QKD) + h * QKD + 16 * d0 + 8 * hi);
    const int NTL = (q0 + 256) / 64;
    const int lrow = tid >> 3, lch = tid & 7, lrow2 = (tid & 255) >> 2, lch2 = tid & 3;
    u32x4 kreg, vreg, rreg;
#define AT_LOAD(t) do { const size_t _r = rowbase + (size_t)(t) * 64; kreg = *(const u32x4*)(Kn + (_r + lrow) * D + h * HD + lch * 8); vreg = *(const u32x4*)(V + (_r + lrow) * D + h * HD + lch * 8); \
        if (tid < 256) rreg = *(const u32x4*)(Kr + (_r + lrow2) * ROPE + lch2 * 8); } while (0)
#define AT_STORE(buf) do { *(LAS u32x4*)(Kb + (buf) * AT_KBUF + lrow * AT_KSTR + lch * 16) = kreg; *(LAS u32x4*)(Vb + (buf) * AT_VBUF + (lch >> 2) * 4096 + lrow * 64 + (lch & 3) * 16) = vreg; \
        if (tid < 256) *(LAS u32x4*)(Kb + (buf) * AT_KBUF + lrow2 * AT_KSTR + 128 + lch2 * 16) = rreg; } while (0)
    AT_LOAD(0); AT_STORE(0);
#pragma unroll
    for (int d0 = 0; d0 < 6; ++d0) asm volatile("" : "+v"(qr[d0]));
    __syncthreads();
    f32x16 o0 = {}, o1 = {}, lacc = {}; float mref = 0.f;
    const bf16x8 onesrow = __builtin_bit_cast(bf16x8, (u32x4){r32 ? 0u : 0x3F803F80u, r32 ? 0u : 0x3F803F80u, r32 ? 0u : 0x3F803F80u, r32 ? 0u : 0x3F803F80u});
#ifdef ATT_REFSTEP
    bf16x8 qx = {}; const bf16x8 kx = __builtin_bit_cast(bf16x8, (u32x4){hi ? 0u : 0x3F80u, 0u, 0u, 0u});
#else
    f32x16 minit = {};
#endif
    const int vlane = ((lane >> 4) & 1) * 32 + (lane & 3) * 8 + (4 * hi + ((lane & 15) >> 2)) * 64;
    for (int t = 0; t < NTL; ++t) {
        const int buf = t & 1;
        if (t + 1 < NTL) AT_LOAD(t + 1);
        if (64 * t <= q0 + 32 * wid + 31) {
            const LAS unsigned char* kb = Kb + buf * AT_KBUF; const LAS unsigned char* vb = Vb + buf * AT_VBUF;
            bf16x8 kf0[6], kf1[6];
#pragma unroll
            for (int d0 = 0; d0 < 6; ++d0) { kf0[d0] = *(const LAS bf16x8*)(kb + r32 * AT_KSTR + d0 * 32 + hi * 16); kf1[d0] = *(const LAS bf16x8*)(kb + (32 + r32) * AT_KSTR + d0 * 32 + hi * 16); }
            __builtin_amdgcn_sched_barrier(0);
#ifdef ATT_PRIO
            __builtin_amdgcn_s_setprio(1);
#endif
#ifdef ATT_REFSTEP
            f32x16 s0 = __builtin_amdgcn_mfma_f32_32x32x16_bf16(kx, qx, (f32x16){}, 0, 0, 0), s1 = s0;
#pragma unroll
            for (int d0 = 0; d0 < 6; ++d0) {
#else
            f32x16 s0 = __builtin_amdgcn_mfma_f32_32x32x16_bf16(kf0[0], qr[0], minit, 0, 0, 0), s1 = __builtin_amdgcn_mfma_f32_32x32x16_bf16(kf1[0], qr[0], minit, 0, 0, 0);
#pragma unroll
            for (int d0 = 1; d0 < 6; ++d0) {
#endif
                s0 = __builtin_amdgcn_mfma_f32_32x32x16_bf16(kf0[d0], qr[d0], s0, 0, 0, 0); s1 = __builtin_amdgcn_mfma_f32_32x32x16_bf16(kf1[d0], qr[d0], s1, 0, 0, 0); }
#ifdef ATT_PRIO
            __builtin_amdgcn_s_setprio(0);
#endif
            if (64 * t + 63 > q0 + 32 * wid) {
                const int kb0 = 64 * t + 4 * hi;
#pragma unroll
                for (int r = 0; r < 16; ++r) { const int kv = kb0 + (r & 3) + 8 * (r >> 2); if (kv > qrow) s0[r] = -INFINITY; if (kv + 32 > qrow) s1[r] = -INFINITY; } }
            if (t == 0) {
                float mx = fmaxf(s0[0], s1[0]);
#pragma unroll
                for (int r = 1; r < 16; ++r) mx = fmaxf(fmaxf(mx, s0[r]), s1[r]);
                mx = fmaxf(mx, __shfl_xor(mx, 32));
                mref = bf2f((unsigned short)(cvtpk(mx, 0.f) & 0xffffu));
#ifdef ATT_REFSTEP
                qx = __builtin_bit_cast(bf16x8, (u32x4){hi ? 0u : (cvtpk(-mref, 0.f) & 0xffffu), 0u, 0u, 0u});
#pragma unroll
                for (int r = 0; r < 16; ++r) { s0[r] -= mref; s1[r] -= mref; } }
#else
#pragma unroll
                for (int r = 0; r < 16; ++r) { minit[r] = -mref; s0[r] -= mref; s1[r] -= mref; } }
#endif
#pragma unroll
            for (int r = 0; r < 16; ++r) { s0[r] = __builtin_amdgcn_exp2f(s0[r]); s1[r] = __builtin_amdgcn_exp2f(s1[r]); }
            u32x4 pw[4];
#pragma unroll
            for (int s = 0; s < 2; ++s) { pw[s] = (u32x4){cvtpk(s0[8 * s], s0[8 * s + 1]), cvtpk(s0[8 * s + 2], s0[8 * s + 3]), cvtpk(s0[8 * s + 4], s0[8 * s + 5]), cvtpk(s0[8 * s + 6], s0[8 * s + 7])};
                pw[2 + s] = (u32x4){cvtpk(s1[8 * s], s1[8 * s + 1]), cvtpk(s1[8 * s + 2], s1[8 * s + 3]), cvtpk(s1[8 * s + 4], s1[8 * s + 5]), cvtpk(s1[8 * s + 6], s1[8 * s + 7])}; }
            s16x4 va0[4], va1[4], vc0[4], vc1[4];
#pragma unroll
            for (int s = 0; s < 4; ++s) { va0[s] = vtr(vb + vlane + s * 1024); va1[s] = vtr(vb + vlane + s * 1024 + 512); vc0[s] = vtr(vb + 4096 + vlane + s * 1024); vc1[s] = vtr(vb + 4096 + vlane + s * 1024 + 512); }
            __builtin_amdgcn_sched_barrier(0);
#ifdef ATT_PRIO
            __builtin_amdgcn_s_setprio(1);
#endif
#pragma unroll
            for (int s = 0; s < 4; ++s) { const bf16x8 pb = __builtin_bit_cast(bf16x8, pw[s]);
                const bf16x8 va = {va0[s][0], va0[s][1], va0[s][2], va0[s][3], va1[s][0], va1[s][1], va1[s][2], va1[s][3]}, vc = {vc0[s][0], vc0[s][1], vc0[s][2], vc0[s][3], vc1[s][0], vc1[s][1], vc1[s][2], vc1[s][3]};
                o0 = __builtin_amdgcn_mfma_f32_32x32x16_bf16(va, pb, o0, 0, 0, 0); o1 = __builtin_amdgcn_mfma_f32_32x32x16_bf16(vc, pb, o1, 0, 0, 0);
                lacc = __builtin_amdgcn_mfma_f32_32x32x16_bf16(onesrow, pb, lacc, 0, 0, 0); }
#ifdef ATT_PRIO
            __builtin_amdgcn_s_setprio(0);
#endif
            { const float lq = __shfl(lacc[0], r32);
              if (__builtin_expect(__any(lq > 0x1p40f), 0)) { asm volatile("; rare rescale path" ::: "memory"); const float dl = (lq > 0x1p40f) ? bf2f((unsigned short)(cvtpk(__log2f(lq), 0.f) & 0xffffu)) : 0.f;
                  const float mnew = bf2f((unsigned short)(cvtpk(mref + dl, 0.f) & 0xffffu)); const float de = mnew - mref; mref = mnew; const float alpha = __builtin_amdgcn_exp2f(-de);
#ifdef ATT_REFSTEP
                  qx = __builtin_bit_cast(bf16x8, (u32x4){hi ? 0u : (cvtpk(-mnew, 0.f) & 0xffffu), 0u, 0u, 0u});
#pragma unroll
                  for (int r = 0; r < 16; ++r) { o0[r] *= alpha; o1[r] *= alpha; lacc[r] *= alpha; } } }
#else
#pragma unroll
                  for (int r = 0; r < 16; ++r) { minit[r] = -mnew; o0[r] *= alpha; o1[r] *= alpha; lacc[r] *= alpha; } } }
#endif
        }
        if (t + 1 < NTL) AT_STORE(buf ^ 1);
        __syncthreads();
    }
    const float inv = 1.0f / __shfl(lacc[0], r32);
    bf16_t* orow = O + (rowbase + qrow) * D + h * HD;
#pragma unroll
    for (int g = 0; g < 4; ++g) { const f32x4 x0 = {o0[4 * g] * inv, o0[4 * g + 1] * inv, o0[4 * g + 2] * inv, o0[4 * g + 3] * inv}, x1 = {o1[4 * g] * inv, o1[4 * g + 1] * inv, o1[4 * g + 2] * inv, o1[4 * g + 3] * inv};
        *(u32x2*)(orow + 8 * g + 4 * hi) = pack4(x0); *(u32x2*)(orow + 32 + 8 * g + 4 * hi) = pack4(x1); }
#undef AT_LOAD
#undef AT_STORE
}
__device__ __forceinline__ void phase_attention(const Params& p, const Ctx& c) {
    const int v = (c.G % 8 == 0) ? (c.bid % 8) * (c.G / 8) + c.bid / 8 : c.bid; const int bh = v >> 2, s = v & 3;
    if (bh >= NB * NHEAD) return;
    for (int ii = 0, ni = (p.pad == 113) ? 16 : 8; ii < ni; ++ii) { const int i = ii & 7; const int qb = 8 * (i >> 1) + ((i & 1) ? 7 - s : s); attn_unit(p, c, bh >> 4, bh & 15, qb); }
}
constexpr int W32_NCH = SEQ / 32;
struct Pk { u32x4 f[2]; };
__device__ __forceinline__ Pk pk_tile(const f32x16& t) { Pk p;
#pragma unroll
    for (int s = 0; s < 2; ++s) p.f[s] = (u32x4){cvtpk(t[8 * s], t[8 * s + 1]), cvtpk(t[8 * s + 2], t[8 * s + 3]), cvtpk(t[8 * s + 4], t[8 * s + 5]), cvtpk(t[8 * s + 6], t[8 * s + 7])};
    return p; }
__device__ __forceinline__ f32x16 unpk_tile(const Pk& p) { f32x16 t;
#pragma unroll
    for (int s = 0; s < 2; ++s) { t[8 * s] = bflo(p.f[s].x); t[8 * s + 1] = bfhi(p.f[s].x); t[8 * s + 2] = bflo(p.f[s].y); t[8 * s + 3] = bfhi(p.f[s].y); t[8 * s + 4] = bflo(p.f[s].z); t[8 * s + 5] = bfhi(p.f[s].z); t[8 * s + 6] = bflo(p.f[s].w); t[8 * s + 7] = bfhi(p.f[s].w); }
    return t; }
__device__ __forceinline__ f32x16 mma2(f32x16 acc, const Pk& p2, const Pk& p1) {
#pragma unroll
    for (int s = 0; s < 2; ++s) acc = __builtin_amdgcn_mfma_f32_32x32x16_bf16(__builtin_bit_cast(bf16x8, p2.f[s]), __builtin_bit_cast(bf16x8, p1.f[s]), acc, 0, 0, 0);
    return acc; }
__device__ __forceinline__ Pk tri_pk(int t, int hi, int strict) { Pk p;
#pragma unroll
    for (int s = 0; s < 2; ++s) { unsigned w[4];
#pragma unroll
        for (int d = 0; d < 4; ++d) { const int k0 = 16 * s + 8 * (d >> 1) + 4 * hi + 2 * (d & 1) + strict; w[d] = (k0 <= t ? 0x3F80u : 0u) | (k0 + 1 <= t ? 0x3F800000u : 0u); }
        p.f[s] = (u32x4){w[0], w[1], w[2], w[3]}; }
    return p; }
__device__ __forceinline__ Pk ident_pk(int x, int hi) { Pk p;
#pragma unroll
    for (int s = 0; s < 2; ++s) { unsigned w[4];
#pragma unroll
        for (int d = 0; d < 4; ++d) { const int k0 = 16 * s + 8 * (d >> 1) + 4 * hi + 2 * (d & 1); w[d] = (k0 == x ? 0x3F80u : 0u) | (k0 + 1 == x ? 0x3F800000u : 0u); }
        p.f[s] = (u32x4){w[0], w[1], w[2], w[3]}; }
    return p; }
__device__ __forceinline__ bf16x8 glbfrag(const bf16_t* M, int ld, int row, int s, int hi) { return *(const bf16x8*)(M + (size_t)row * ld + 16 * s + 8 * hi); }
#define LDS_BARRIER() do { asm volatile("s_waitcnt lgkmcnt(0)" ::: "memory"); __builtin_amdgcn_s_barrier(); asm volatile("" ::: "memory"); } while (0)
#define W32_Y(r) (((r) & 3) + 8 * ((r) >> 2) + 4 * hi)
constexpr size_t WU = 64 * 64;

#define W32_YQ(r) (((r) & 3) + 8 * ((r) >> 2) + 4 * hq)
#ifdef PT_CUSTOM
#define PTA_START() do { if (uu2 == 0 && PT_SEL >= 10 && PT_SEL <= 16) PT_M0(c, PT_SEL); } while (0)
#define PTA_AT(k) do { if (uu2 == 0) PT_M1(c, 10 + (k)); } while (0)
#else
#define PTA_START() do { } while (0)
#define PTA_AT(k) do { } while (0)
#endif
__device__ __forceinline__ void wkv_a_tables(const Params& p, const Ctx& c, int t0, int nth) {
    LAS float* cst = (LAS float*)c.lds; LAS unsigned char* w2l = c.lds + 2048; LAS unsigned char* a2l = c.lds + 2048 + 9216; const int hb = (c.bid >> 2) & 15;
    for (int j = t0; j < 512; j += nth) { const int r = j >> 3, k = j & 7; *(LAS u32x4*)(w2l + r * 144 + k * 16) = *(const u32x4*)(wsb(p, WS_W2T) + (size_t)(hb * 64 + r) * 64 + k * 8);
        *(LAS u32x4*)(a2l + r * 144 + k * 16) = *(const u32x4*)(wsb(p, WS_A2T) + (size_t)(hb * 64 + r) * 64 + k * 8);
        if (j < 64) { const int i = hb * 64 + j; cst[j] = p.in[I_A0][i]; cst[64 + j] = p.in[I_KK][i]; cst[128 + j] = p.in[I_KA][i]; cst[192 + j] = p.in[I_RK][i]; cst[256 + j] = p.in[I_W0][i]; } }
}
__device__ __forceinline__ void phase_wkv_a(const Params& p, const Ctx& c, bool prebuilt) {
    const int lane = c.lane, r32 = lane & 31, hi = lane >> 5;
    LAS float* cst = (LAS float*)c.lds; LAS unsigned char* w2l = c.lds + 2048; LAS unsigned char* a2l = c.lds + 2048 + 9216;
    if (!prebuilt) wkv_a_tables(p, c, c.tid, NTHREADS);
    __syncthreads();
    bf16_t* Rg = wsb(p, WS_W3); bf16_t* Kg = wsb(p, WS_W4); const bf16_t* Vg = wsb(p, WS_W5); const bf16_t* L1 = wsb(p, WS_W6);
    bf16_t* PTg = wsb(p, WS_W0); bf16_t* Zg = (bf16_t*)p.out; bf16_t* QTg = wsb(p, WS_W2); float* bsg = wsf(p, WS_BSUM);
    const int gw = c.bid * NWAVES + c.wave;
    PT_M0(c, 3);
    for (int uu2 = (p.pad == 1) ? -8 : 0; uu2 < 8; ++uu2) { const int uu = uu2 & 7; const bool dry = uu2 < 0;
        PTA_START();
        int unit_ = gw * 8 + uu; asm volatile("" : "+s"(unit_));
        const int unit = unit_, bh = unit >> 8, chunk = unit & 255, b = bh >> 4, h = bh & 15;
        int hq = hi; asm volatile("" : "+v"(hq));
        const size_t row0 = (size_t)b * SEQ + (size_t)chunk * 32, tok = row0 + r32;
        const size_t tokoff = tok * D + h * 64 + 4 * hi; bf16_t* rp = Rg + tokoff; bf16_t* kp = Kg + tokoff; const bf16_t* vp = Vg + tokoff;
        const LAS float* cp = cst + 4 * hi;
        const bf16_t* l1p = L1 + tok * 256 + 8 * hi;
        float ss = 0.f;
        { const bf16_t* kn = Kg + tok * D + h * 64 + 32 * hi; const LAS float* cn = cst + 64 + 32 * hi;
#pragma unroll
          for (int q = 0; q < 4; ++q) { const u32x4 kw = *(const u32x4*)(kn + 8 * q); const f32x4 kc0 = *(const LAS f32x4*)(cn + 8 * q), kc1 = *(const LAS f32x4*)(cn + 8 * q + 4);
              const float k0 = bflo(kw.x) * kc0[0], k1 = bfhi(kw.x) * kc0[1], k2 = bflo(kw.y) * kc0[2], k3 = bfhi(kw.y) * kc0[3], k4 = bflo(kw.z) * kc1[0], k5 = bfhi(kw.z) * kc1[1], k6 = bflo(kw.w) * kc1[2], k7 = bfhi(kw.w) * kc1[3];
              ss += ((k0 * k0 + k1 * k1) + (k2 * k2 + k3 * k3)) + ((k4 * k4 + k5 * k5) + (k6 * k6 + k7 * k7)); } }
        ss += __shfl_xor(ss, 32); const float inrm = frcp(fmaxf(__builtin_amdgcn_sqrtf(ss), 1e-12f));
        PTA_AT(0);
        float bs = 0.f, cwC[2];
        LAS unsigned char* park = c.lds + 5 * D * 4 + c.wave * 16384 + lane * 16;
#define PARK_ST(mat, yt_, fr, v) (*(LAS u32x4*)(park + (((mat) * 2 + (yt_)) * 2 + (fr)) * 1024) = (v))
#define PARK_LD(mat, yt_) Pk{{*(const LAS u32x4*)(park + (((mat) * 2 + (yt_)) * 2) * 1024), *(const LAS u32x4*)(park + (((mat) * 2 + (yt_)) * 2 + 1) * 1024)}}
#pragma unroll
        for (int yt = 0; yt < 2; ++yt) {
            Pk ldh, ldl;
            { const LAS unsigned char* w2p = w2l + (32 * yt + r32) * 144 + 16 * hi; bf16x8 w2[4], fw[4];
#pragma unroll
              for (int s = 0; s < 4; ++s) { w2[s] = *(const LAS bf16x8*)(w2p + 32 * s); fw[s] = *(const bf16x8*)(l1p + 16 * s); }
              f32x16 ldt = {};
#pragma unroll
              for (int s = 0; s < 4; ++s) ldt = __builtin_amdgcn_mfma_f32_32x32x16_bf16(fw[s], w2[s], ldt, 0, 0, 0);
              const float w0c = cst[256 + 32 * yt + r32]; f32x16 vh, vl; float sum = 0.f;
#pragma unroll
              for (int r = 0; r < 16; ++r) { const float x = -(w0c + ldt[r]); const float sp = fmaxf(x, 0.f) + __logf(1.0f + fexp(-fabsf(x))); const float ld = -fexp(-sp - 0.5f) * 1.4426950408889634f;
                  const float lh = bf2f((unsigned short)(cvtpk(ld, 0.f) & 0xffffu)); vh[r] = lh; vl[r] = ld - lh; sum += ld; }
              sum += __shfl_xor(sum, 32); cwC[yt] = fexp2(sum); ldh = pk_tile(vh); ldl = pk_tile(vl); }
            __builtin_amdgcn_sched_barrier(0);
            int tq = r32; asm volatile("" : "+v"(tq));
            const Pk tri = tri_pk(tq, hq, 0), tris = tri_pk(tq, hq, 1);
            const f32x16 cl = mma2(mma2((f32x16){}, ldh, tri), ldl, tri), cle = mma2(mma2((f32x16){}, ldh, tris), ldl, tris);
            __builtin_amdgcn_sched_barrier(0);
            f32x16 aTL = {};
            { const LAS unsigned char* a2p = a2l + (32 * yt + r32) * 144 + 16 * hi; bf16x8 a2[4], fa[4];
#pragma unroll
              for (int s = 0; s < 4; ++s) { a2[s] = *(const LAS bf16x8*)(a2p + 32 * s); fa[s] = *(const bf16x8*)(l1p + 64 + 16 * s); }
#pragma unroll
              for (int s = 0; s < 4; ++s) aTL = __builtin_amdgcn_mfma_f32_32x32x16_bf16(a2[s], fa[s], aTL, 0, 0, 0); }
            u32x2 rr[4], kk[4];
            if (yt == 0) {
                const bf16_t* rn = Rg + tok * D + h * 64 + 32 * hi; const bf16_t* kn = Kg + tok * D + h * 64 + 32 * hi; u32x4 wr_[4], wk_[4];
#pragma unroll
                for (int j = 0; j < 4; ++j) { wr_[j] = *(const u32x4*)(rn + 8 * j); wk_[j] = *(const u32x4*)(kn + 8 * j); }
                u32x2 rB[4], kB[4];
#pragma unroll
                for (int j = 0; j < 4; ++j) { auto a0 = __builtin_amdgcn_permlane32_swap(wr_[j].x, wr_[j].z, false, false); auto a1 = __builtin_amdgcn_permlane32_swap(wr_[j].y, wr_[j].w, false, false);
                    rr[j] = (u32x2){a0[0], a1[0]}; rB[j] = (u32x2){a0[1], a1[1]};
                    auto b0 = __builtin_amdgcn_permlane32_swap(wk_[j].x, wk_[j].z, false, false); auto b1 = __builtin_amdgcn_permlane32_swap(wk_[j].y, wk_[j].w, false, false);
                    kk[j] = (u32x2){b0[0], b1[0]}; kB[j] = (u32x2){b0[1], b1[1]}; }
                PARK_ST(3, 1, 0, ((u32x4){rB[0].x, rB[0].y, rB[1].x, rB[1].y})); PARK_ST(3, 1, 1, ((u32x4){rB[2].x, rB[2].y, rB[3].x, rB[3].y}));
                PARK_ST(2, 1, 0, ((u32x4){kB[0].x, kB[0].y, kB[1].x, kB[1].y})); PARK_ST(2, 1, 1, ((u32x4){kB[2].x, kB[2].y, kB[3].x, kB[3].y}));
            } else { const Pk tr_ = PARK_LD(3, 1), tk_ = PARK_LD(2, 1);
                rr[0] = (u32x2){tr_.f[0].x, tr_.f[0].y}; rr[1] = (u32x2){tr_.f[0].z, tr_.f[0].w}; rr[2] = (u32x2){tr_.f[1].x, tr_.f[1].y}; rr[3] = (u32x2){tr_.f[1].z, tr_.f[1].w};
                kk[0] = (u32x2){tk_.f[0].x, tk_.f[0].y}; kk[1] = (u32x2){tk_.f[0].z, tk_.f[0].w}; kk[2] = (u32x2){tk_.f[1].x, tk_.f[1].y}; kk[3] = (u32x2){tk_.f[1].z, tk_.f[1].w}; }
            __builtin_amdgcn_sched_barrier(0);
            u32x4 fA, fB, fK, fR;
#pragma unroll
            for (int q = 0; q < 4; ++q) { const int c0 = 32 * yt + 8 * q;
                const f32x4 a0 = *(const LAS f32x4*)(cp + c0), kkc = *(const LAS f32x4*)(cp + 64 + c0), kac = *(const LAS f32x4*)(cp + 128 + c0), rkc = *(const LAS f32x4*)(cp + 192 + c0);
                const float kv[4] = {bflo(kk[q].x), bfhi(kk[q].x), bflo(kk[q].y), bfhi(kk[q].y)}, rv[4] = {bflo(rr[q].x), bfhi(rr[q].x), bflo(rr[q].y), bfhi(rr[q].y)};
                float at[4], bt[4], kt[4], rt[4];
#pragma unroll
                for (int i = 0; i < 4; ++i) { const int r = 4 * q + i; const float a = sigmoidf_(a0[i] + aTL[r]); const float kkv = kv[i] * kkc[i] * inrm, km = kv[i] * (1.0f + (a - 1.0f) * kac[i]);
                    const float cw = fexp2(cl[r]), cwm1 = fexp2(cle[r]), icw = fexp2(-cl[r]);
                    at[i] = -kkv * cwm1; bt[i] = kkv * a * icw; kt[i] = km * icw; rt[i] = rv[i] * cw; bs += rv[i] * km * rkc[i]; }
                if (q & 1) { fA.z = cvtpk(at[0], at[1]); fA.w = cvtpk(at[2], at[3]); fB.z = cvtpk(bt[0], bt[1]); fB.w = cvtpk(bt[2], bt[3]); fK.z = cvtpk(kt[0], kt[1]); fK.w = cvtpk(kt[2], kt[3]); fR.z = cvtpk(rt[0], rt[1]); fR.w = cvtpk(rt[2], rt[3]);
                             PARK_ST(0, yt, q >> 1, fA); PARK_ST(1, yt, q >> 1, fB); PARK_ST(2, yt, q >> 1, fK); PARK_ST(3, yt, q >> 1, fR); }
                else       { fA.x = cvtpk(at[0], at[1]); fA.y = cvtpk(at[2], at[3]); fB.x = cvtpk(bt[0], bt[1]); fB.y = cvtpk(bt[2], bt[3]); fK.x = cvtpk(kt[0], kt[1]); fK.y = cvtpk(kt[2], kt[3]); fR.x = cvtpk(rt[0], rt[1]); fR.y = cvtpk(rt[2], rt[3]); } }
            __builtin_amdgcn_sched_barrier(0); }
        PTA_AT(1);
        bs += __shfl_xor(bs, 32);
        if (hi == 0 && !dry) bsg[((size_t)b * NHEAD + h) * SEQ + (size_t)chunk * 32 + r32] = bs;
        __builtin_amdgcn_sched_barrier(0);
#define W32_SB() __builtin_amdgcn_sched_barrier(0)
        int rq = r32; asm volatile("" : "+v"(rq));
        f32x16 MN = {}, MT = {}, X2 = {}; Pk pMbr, pMkr;
        asm volatile("s_waitcnt lgkmcnt(0)" ::: "memory");
        { const Pk a0_ = PARK_LD(0, 0), a1_ = PARK_LD(0, 1), b0_ = PARK_LD(1, 0), b1_ = PARK_LD(1, 1);
        MN = mma2(mma2(MN, a0_, b0_), a1_, b1_);
#pragma unroll
        for (int r = 0; r < 16; ++r) if (!(rq < W32_YQ(r))) MN[r] = 0.f;
        W32_SB();
        MT = mma2(mma2(MT, b0_, a0_), b1_, a1_); }
#pragma unroll
        for (int r = 0; r < 16; ++r) if (!(W32_YQ(r) < rq)) MT[r] = 0.f;
        W32_SB();
        { const Pk a0_ = PARK_LD(0, 0), a1_ = PARK_LD(0, 1), k0_ = PARK_LD(2, 0), k1_ = PARK_LD(2, 1);
        X2 = mma2(mma2(X2, a0_, k0_), a1_, k1_); }
#pragma unroll
        for (int r = 0; r < 16; ++r) if (!(rq < W32_YQ(r))) X2[r] = 0.f;
        W32_SB();
        { const Pk b0_ = PARK_LD(1, 0), b1_ = PARK_LD(1, 1), r0_ = PARK_LD(3, 0), r1_ = PARK_LD(3, 1);
          f32x16 m = mma2(mma2((f32x16){}, b0_, r0_), b1_, r1_);
#pragma unroll
          for (int r = 0; r < 16; ++r) if (!(W32_YQ(r) <= rq)) m[r] = 0.f;
          pMbr = pk_tile(m); }
        W32_SB();
        { const Pk k0_ = PARK_LD(2, 0), k1_ = PARK_LD(2, 1), r0_ = PARK_LD(3, 0), r1_ = PARK_LD(3, 1);
          f32x16 m = mma2(mma2((f32x16){}, k0_, r0_), k1_, r1_);
#pragma unroll
          for (int r = 0; r < 16; ++r) if (!(W32_YQ(r) <= rq)) m[r] = 0.f;
          pMkr = pk_tile(m); }
        W32_SB();
        PTA_AT(2);
        const Pk idn = ident_pk(rq, hq);
        u32x2 vvA[4], vvB[4];
        { const bf16_t* vn = Vg + tok * D + h * 64 + 32 * hi;
#pragma unroll
          for (int j = 0; j < 4; ++j) { const u32x4 w = *(const u32x4*)(vn + 8 * j);
              auto r0 = __builtin_amdgcn_permlane32_swap(w.x, w.z, false, false); auto r1 = __builtin_amdgcn_permlane32_swap(w.y, w.w, false, false);
              vvA[j] = (u32x2){r0[0], r1[0]}; vvB[j] = (u32x2){r0[1], r1[1]}; } }
        f32x16 X0 = mma2((f32x16){}, PARK_LD(0, 0), idn), X1 = mma2((f32x16){}, PARK_LD(0, 1), idn);
        W32_SB();
#define PARK_PK(mat, yt_, pk) do { const Pk _p = (pk); PARK_ST(mat, yt_, 0, _p.f[0]); PARK_ST(mat, yt_, 1, _p.f[1]); } while (0)
#pragma unroll
        for (int xt = 0; xt < 2; ++xt) {
            { const Pk t = pk_tile(mma2((f32x16){}, PARK_LD(1, xt), idn)); PARK_PK(1, xt, t); } W32_SB();
            { const Pk t = pk_tile(mma2((f32x16){}, PARK_LD(2, xt), idn)); PARK_PK(2, xt, t); } W32_SB();
            { u32x2 vv[4];
#pragma unroll
              for (int q = 0; q < 4; ++q) vv[q] = xt ? vvB[q] : vvA[q];
              Pk pV; pV.f[0] = (u32x4){vv[0].x, vv[0].y, vv[1].x, vv[1].y}; pV.f[1] = (u32x4){vv[2].x, vv[2].y, vv[3].x, vv[3].y};
              const Pk t = pk_tile(mma2((f32x16){}, pV, idn)); PARK_PK(0, xt, t); } W32_SB(); }
        __builtin_amdgcn_sched_barrier(0);
        PTA_AT(3);
#pragma unroll
        for (int kq = 0; kq < 5; ++kq) { const Pk pMN = pk_tile(MN), pMT = pk_tile(MT);
            X0 = mma2(X0, pMT, pk_tile(X0)); X1 = mma2(X1, pMT, pk_tile(X1)); X2 = mma2(X2, pMT, pk_tile(X2));
            if (kq < 4) { MN = mma2((f32x16){}, pMT, pMN); MT = mma2((f32x16){}, pMN, pMT); } }
        const Pk pW1[2] = {pk_tile(X0), pk_tile(X1)}, pW2 = pk_tile(X2);
        __builtin_amdgcn_sched_barrier(0);
        PTA_AT(4);
        bf16_t* ptp = PTg + (size_t)unit * WU + lane * 4; bf16_t* zp = Zg + (size_t)unit * WU + lane * 4; bf16_t* qtp = QTg + (size_t)unit * 2048 + lane * 4;
        Pk pGT[2];
#pragma unroll
        for (int xt = 0; xt < 2; ++xt) {
#pragma unroll
            for (int yt = 0; yt < 2; ++yt) { f32x16 m = mma2((f32x16){}, pW1[yt], PARK_LD(1, xt));
#pragma unroll
                for (int r = 0; r < 16; ++r) m[r] = cwC[xt] * (m[r] + ((xt == yt && W32_YQ(r) == rq) ? 1.0f : 0.0f));
#pragma unroll
                for (int q = 0; q < 4; ++q) if (!dry) *(u32x2*)(ptp + ((xt * 2 + yt) * 4 + q) * 256) = pack4((f32x4){m[4 * q], m[4 * q + 1], m[4 * q + 2], m[4 * q + 3]}); }
            f32x16 g = mma2(unpk_tile(PARK_LD(2, xt)), pW2, PARK_LD(1, xt));
#pragma unroll
            for (int r = 0; r < 16; ++r) g[r] *= cwC[xt];
            pGT[xt] = pk_tile(g); }
        const Pk pHT = pk_tile(mma2(unpk_tile(pMkr), pW2, pMbr));
        u32x2 ylp[4];
#pragma unroll
        for (int yt = 0; yt < 2; ++yt) {
            const f32x16 qv = mma2(unpk_tile(PARK_LD(3, yt)), pW1[yt], pMbr);
            const f32x16 yl = mma2((f32x16){}, PARK_LD(0, yt), pHT);
#pragma unroll
            for (int q = 0; q < 4; ++q) { const u32x2 yp = pack4((f32x4){yl[4 * q], yl[4 * q + 1], yl[4 * q + 2], yl[4 * q + 3]});
                if (!dry) *(u32x2*)(qtp + (yt * 4 + q) * 256) = pack4((f32x4){qv[4 * q], qv[4 * q + 1], qv[4 * q + 2], qv[4 * q + 3]});
                if (yt == 0) ylp[q] = yp;
                else { auto r0 = __builtin_amdgcn_permlane32_swap(ylp[q].x, yp.x, false, false); auto r1 = __builtin_amdgcn_permlane32_swap(ylp[q].y, yp.y, false, false);
                    if (!dry) *(u32x4*)(Rg + tok * D + h * 64 + 32 * hi + 8 * q) = (u32x4){r0[0], r1[0], r0[1], r1[1]}; } } }
#pragma unroll
        for (int xt = 0; xt < 2; ++xt)
#pragma unroll
            for (int yt = 0; yt < 2; ++yt) { const f32x16 z = mma2((f32x16){}, pGT[yt], PARK_LD(0, xt));
#pragma unroll
                for (int q = 0; q < 4; ++q) if (!dry) *(u32x2*)(zp + ((xt * 2 + yt) * 4 + q) * 256) = pack4((f32x4){z[4 * q], z[4 * q + 1], z[4 * q + 2], z[4 * q + 3]}); }
        PTA_AT(5);
    }
    __syncthreads(); PT_M1(c, 3);
}

constexpr int WCV_NM = 256 + 256 + 288 + 256 + 512, WCV_NITEM = WCV_NM + 16 * 384;
__device__ __forceinline__ void convert_late(const Params& p, const Ctx& c, int it0, int it1, int rank, int count) {
    LAS float* scr = (LAS float*)(c.lds + RING_OFF + c.wave * 16384);
    for (int it = it0 + rank * NWAVES + c.wave; it < it1; it += count * NWAVES) { int r = it;
        if (r < WCV_NM) { if (tjob(p, r, 5, 0, WS_DKV, 1024, 512, scr, c.lane)) continue; if (tjob(p, r, 6, 0, WS_DQ, 1024, 512, scr, c.lane)) continue; if (tjob(p, r, 7, 0, WS_UQ, 384, 1536, scr, c.lane)) continue;
            if (tjob(p, r, 8, 0, WS_UKV, 256, 2048, scr, c.lane)) continue; tjob(p, r, 9, 0, WS_MWO, 1024, 1024, scr, c.lane); continue; }
        r -= WCV_NM; const int e = r / 384; r = r % 384;
        if (r < 256) transpose_item(p, 10, 16 + e, wsb(p, WS_WGU1) + (size_t)e * 512 * 1024, 1024, scr, r / 16, r % 16, c.lane);
        else { r -= 256; transpose_item(p, 11, 16 + e, wsb(p, WS_WDN1) + (size_t)e * 1024 * 256, 256, scr, r / 32, r % 32, c.lane); } }
}
#ifndef WKB_LFV
#define WKB_LFV 3
#endif
#if WKB_LFV == 6
#define WKB_LFW "s_waitcnt vmcnt(12)"
#elif WKB_LFV == 3
#define WKB_LFW "s_waitcnt vmcnt(3)"
#elif WKB_LFV == 2
#define WKB_LFW "s_waitcnt vmcnt(0)"
#elif WKB_LFV == 5
#define WKB_LFW "s_waitcnt vmcnt(9)"
#else
#define WKB_LFW "s_waitcnt vmcnt(6)"
#endif
constexpr int WKB_NS = 8, WKB_LF = WKB_LFV, WKB_SLOT = 16384, WKB_QT = 8192, WKB_Z = 12288, WKB_YL = 14336;
__device__ __forceinline__ void phase_wkv_b(const Params& p, const Ctx& c, const XcdBarrier& bar) {
#ifndef WKB_VAR
    PT_M0(c, 1);
#endif
    const int pos_ = xcc_position(p, c);
    const int lane = c.lane, il = lane & 15, g = lane >> 4, bh = pos_ >> 2, qr = pos_ & 3, b = bh >> 4, h = bh & 15;
    const char* PTg = (const char*)(wsb(p, WS_W0) + (size_t)bh * W32_NCH * WU); const char* Zg = (const char*)((const bf16_t*)p.out + (size_t)bh * W32_NCH * WU);
    const char* QTg = (const char*)(wsb(p, WS_W2) + (size_t)bh * W32_NCH * 2048);
    bf16_t* Yg = wsb(p, WS_W3) + ((size_t)b * SEQ) * D + h * 64 + 16 * qr;
    LAS unsigned char* ring = c.lds;
#ifdef WKB_VAR
    for (int pass = 0; pass < 2; ++pass) { const bool dryb = pass > 0; if (dryb) { asm volatile("s_waitcnt vmcnt(0)" ::: "memory"); __syncthreads(); PT_M0(c, 1); if ((WKB_VAR & 32) && bh >= 32) break; if ((WKB_VAR & 64) && bh >= 16) break; }
#define WKB_VARV WKB_VAR
#else
    { const bool dryb = false;
#define WKB_VARV 0
#endif
    if (c.wave >= 2 && c.wave < 7) {
        const int lw = c.wave - 2;
#define WKB_SHARED(s_, SRC, DST, STR) do { const int s__ = (s_); if (s__ < 8) { SRC = PTg + s__ * 1024 + lane * 16; DST = s__ * 1024; STR = 8192; } else { SRC = QTg + (s__ - 8) * 1024 + lane * 16; DST = WKB_QT + (s__ - 8) * 1024; STR = 4096; } } while (0)
        if (lw == 0 || lw == 4) {
            const char* src[3]; int dst[3]; size_t stride[3];
            if (lw == 0) {
#pragma unroll
                for (int k = 0; k < 3; ++k) WKB_SHARED(3 * qr + k, src[k], dst[k], stride[k]);
            } else {
#pragma unroll
                for (int k = 0; k < 2; ++k) { const int e = k * 64 + lane, m = e & 7, hi = (e >> 3) & 1, q = (e >> 4) & 3, yt = e >> 6;
                    src[k] = Zg + ((((qr >> 1) * 2 + yt) * 4 + q) * 512 + (hi * 32 + 16 * (qr & 1) + 2 * m) * 8); dst[k] = WKB_Z + k * 1024; stride[k] = 8192; }
                src[2] = (const char*)(Yg + (size_t)(lane >> 1) * D) + (lane & 1) * 16; dst[2] = WKB_YL; stride[2] = (size_t)32 * D * 2; }
#define WKB_DMA(ch) do { const int ch_ = (ch) < W32_NCH ? (ch) : W32_NCH - 1; LAS unsigned char* d_ = ring + ((ch) & (WKB_NS - 1)) * WKB_SLOT; if (dryb && (WKB_VARV & 8)) break; \
            _Pragma("unroll") for (int k = 0; k < 3; ++k) __builtin_amdgcn_global_load_lds((const unsigned*)(src[k] + (size_t)ch_ * stride[k]), (LAS unsigned*)(d_ + dst[k]), 16, 0, 0); } while (0)
#pragma unroll
            for (int ch = 0; ch < WKB_NS; ++ch) WKB_DMA(ch);
            asm volatile("s_waitcnt vmcnt(18)" ::: "memory"); __builtin_amdgcn_s_barrier();
            __builtin_amdgcn_s_barrier();
            for (int ch = 0; ch < W32_NCH; ++ch) { WKB_DMA(ch + WKB_NS); asm volatile("s_waitcnt vmcnt(18)" ::: "memory"); __builtin_amdgcn_s_barrier(); }
            asm volatile("s_waitcnt vmcnt(0)" ::: "memory");
#undef WKB_DMA
        } else {
            const char* src[3]; int dst[3]; size_t stride[3];
#pragma unroll
            for (int k = 0; k < 3; ++k) { const int f = (lw - 1) * 3 + k; WKB_SHARED(f < 3 * qr ? f : f + 3, src[k], dst[k], stride[k]); }
#define WKB_DMA(ch) do { const int ch_ = (ch) < W32_NCH ? (ch) : W32_NCH - 1; LAS unsigned char* d_ = ring + ((ch) & (WKB_NS - 1)) * WKB_SLOT; if (dryb && (WKB_VARV & 8)) break; \
            _Pragma("unroll") for (int k = 0; k < 3; ++k) __builtin_amdgcn_global_load_lds((const unsigned*)(src[k] + (size_t)ch_ * stride[k]), (LAS unsigned*)(d_ + dst[k]), 16, 0, 0); } while (0)
#pragma unroll
            for (int ch = 0; ch < WKB_LF; ++ch) WKB_DMA(ch);
            asm volatile(WKB_LFW ::: "memory"); __builtin_amdgcn_s_barrier();
            __builtin_amdgcn_s_barrier();
            for (int ch = 0; ch < W32_NCH; ++ch) { WKB_DMA(ch + WKB_LF); asm volatile(WKB_LFW ::: "memory"); __builtin_amdgcn_s_barrier(); }
            asm volatile("s_waitcnt vmcnt(0)" ::: "memory");
#undef WKB_DMA
        }
#undef WKB_SHARED
    } else if (c.wave >= 7) {
        for (int ch = 0; ch <= W32_NCH + 1; ++ch) __builtin_amdgcn_s_barrier();
    } else {
        LAS unsigned char* bfb = c.lds + TAB_OFF + lane * 32;
        const int lq = (g >> 1) * 512 + (32 * (g & 1) + il) * 8;
#define WKB_FRAG(F, i_) __builtin_bit_cast(bf16x8, (u32x4){F[2 * (i_)].x, F[2 * (i_)].y, F[2 * (i_) + 1].x, F[2 * (i_) + 1].y})
        if (c.wave == 0) {
            f32x4 S[4];
            u32x2 Pa[16], Za[4], Pb[16], Zb[4]; bf16x8 bf[2];
#pragma unroll
            for (int s = 0; s < 2; ++s) { bf[s] = (bf16x8){0, 0, 0, 0, 0, 0, 0, 0}; *(LAS u32x4*)(bfb + s * 16) = (u32x4){0u, 0u, 0u, 0u}; }
#define WKB_LOADU(PF, ZF, ch) do { const LAS unsigned char* sl_ = ring + ((ch) & (WKB_NS - 1)) * WKB_SLOT; \
            _Pragma("unroll") for (int jt = 0; jt < 4; ++jt) _Pragma("unroll") for (int s = 0; s < 2; ++s) { const int o_ = (((jt >> 1) * 2 + s) * 4) * 512 + 16 * (jt & 1) * 8 + lq; \
                PF[(jt * 2 + s) * 2] = *(const LAS u32x2*)(sl_ + o_); PF[(jt * 2 + s) * 2 + 1] = *(const LAS u32x2*)(sl_ + o_ + 1024); } \
            _Pragma("unroll") for (int jt = 0; jt < 4; ++jt) ZF[jt] = *(const LAS u32x2*)(sl_ + WKB_Z + (((((jt >> 1) * 4 + 2 * (jt & 1) + (g >> 1)) * 2 + (g & 1)) * 8 + (il >> 1)) * 16 + (il & 1) * 8)); } while (0)
#define WKB_STEPU(PF, ZF, PN, ZN, ch) do { \
            WKB_LOADU(PN, ZN, (ch) + 1); \
            __builtin_amdgcn_sched_barrier(0); \
            _Pragma("unroll") for (int jt = 0; jt < 4; ++jt) { f32x4 n_ = {bflo(ZF[jt].x), bfhi(ZF[jt].x), bflo(ZF[jt].y), bfhi(ZF[jt].y)}; \
                _Pragma("unroll") for (int s = 0; s < 2; ++s) n_ = __builtin_amdgcn_mfma_f32_16x16x32_bf16(WKB_FRAG(PF, jt * 2 + s), bf[s], n_, 0, 0, 0); \
                S[jt] = n_; } \
            _Pragma("unroll") for (int s = 0; s < 2; ++s) { const u32x4 w_ = {cvtpk(S[2 * s][0], S[2 * s][1]), cvtpk(S[2 * s][2], S[2 * s][3]), cvtpk(S[2 * s + 1][0], S[2 * s + 1][1]), cvtpk(S[2 * s + 1][2], S[2 * s + 1][3])}; \
                bf[s] = __builtin_bit_cast(bf16x8, w_); *(LAS u32x4*)(bfb + (((ch) + 1) & 1) * 2048 + s * 16) = w_; }        \
            __builtin_amdgcn_sched_barrier(0); \
            LDS_BARRIER(); } while (0)
            __builtin_amdgcn_s_barrier();
            WKB_LOADU(Pa, Za, 0);
            LDS_BARRIER();
            for (int ch = 0; ch < W32_NCH; ch += 2) { WKB_STEPU(Pa, Za, Pb, Zb, ch); WKB_STEPU(Pb, Zb, Pa, Za, ch + 1); }
#undef WKB_LOADU
#undef WKB_STEPU
        } else if (c.wave == 1) {
            u32x2 Qa[8], Ya[2], Qb[8], Yb[2];
#define WKB_LOADY(QF, YF, ch) do { const LAS unsigned char* sl_ = ring + ((ch) & (WKB_NS - 1)) * WKB_SLOT; \
            _Pragma("unroll") for (int tt = 0; tt < 2; ++tt) _Pragma("unroll") for (int s = 0; s < 2; ++s) { const int o_ = WKB_QT + (s * 4) * 512 + 16 * tt * 8 + lq; \
                QF[(tt * 2 + s) * 2] = *(const LAS u32x2*)(sl_ + o_); QF[(tt * 2 + s) * 2 + 1] = *(const LAS u32x2*)(sl_ + o_ + 1024); } \
            _Pragma("unroll") for (int tt = 0; tt < 2; ++tt) YF[tt] = *(const LAS u32x2*)(sl_ + WKB_YL + (16 * tt + il) * 32 + 8 * g); } while (0)
#define WKB_STEPY(QF, YF, QN, YN, ch) do { bf16x8 bf[2]; \
            _Pragma("unroll") for (int s = 0; s < 2; ++s) bf[s] = *(const LAS bf16x8*)(bfb + ((ch) & 1) * 2048 + s * 16); \
            WKB_LOADY(QN, YN, (ch) + 1); \
            __builtin_amdgcn_sched_barrier(0); \
            _Pragma("unroll") for (int tt = 0; tt < 2; ++tt) { f32x4 d_ = {bflo(YF[tt].x), bfhi(YF[tt].x), bflo(YF[tt].y), bfhi(YF[tt].y)};        \
                _Pragma("unroll") for (int s = 0; s < 2; ++s) d_ = __builtin_amdgcn_mfma_f32_16x16x32_bf16(bf[s], WKB_FRAG(QF, tt * 2 + s), d_, 0, 0, 0); \
                if (!dryb) *(u32x2*)(Yg + (size_t)((ch) * 32 + 16 * tt + il) * D + 4 * g) = pack4(d_); } \
            __builtin_amdgcn_sched_barrier(0); \
            LDS_BARRIER(); } while (0)
            __builtin_amdgcn_s_barrier();
            WKB_LOADY(Qa, Ya, 0);
            LDS_BARRIER();
            for (int ch = 0; ch < W32_NCH; ch += 2) { WKB_STEPY(Qa, Ya, Qb, Yb, ch); WKB_STEPY(Qb, Yb, Qa, Ya, ch + 1); }
#undef WKB_LOADY
#undef WKB_STEPY
        }
#undef WKB_FRAG
    }
    }
    PT_M1(c, 1);
}

__device__ __forceinline__ void wkv_c_tables(const Params& p, const Ctx& c, int t0, int nth) {
    LAS unsigned char* gl = c.lds; LAS float* lnc = (LAS float*)(c.lds + 20480); const int h = (c.bid >> 2) & 15;
    const bf16_t* G2T = wsb(p, WS_G2T) + (size_t)h * 64 * 128;
    for (int i = t0; i < 64 * 16; i += nth) { const int r = i >> 4, k = i & 15; *(LAS u32x4*)(gl + r * 272 + k * 16) = *(const u32x4*)(G2T + r * 128 + k * 8);
        if (i < 64) { lnc[i] = p.in[I_LNW][h * 64 + i]; lnc[64 + i] = p.in[I_LNB][h * 64 + i]; } }
}
__device__ __forceinline__ void phase_wkv_c(const Params& p, const Ctx& c, bool prebuilt) {
    const int lane = c.lane, r32 = lane & 31, hi = lane >> 5, bh = c.bid >> 2, cq = c.bid & 3, b = bh >> 4, h = bh & 15;
    bf16_t* Yg = wsb(p, WS_W3); const bf16_t* Vg = wsb(p, WS_W5); const bf16_t* L1 = wsb(p, WS_W6); const float* bsg = wsf(p, WS_BSUM);
    LAS unsigned char* gl = c.lds; LAS float* lnc = (LAS float*)(c.lds + 20480);
    if (!prebuilt) wkv_c_tables(p, c, c.tid, NTHREADS);
    __syncthreads();
    PT_M0(c, 4);
    const int row0 = b * SEQ + cq * 2048 + c.wave * 32 + r32;
    bf16x8 Al[8], Bl[8]; u32x4 Ay[4], Av[4], By[4], Bv[4]; float Abs, Bbs;
#define WKC_LOAD(LF, YF, VF, BS, i) do { const int row_ = row0 + ((i) < 8 ? (i) : 7) * 256; \
        _Pragma("unroll") for (int s = 0; s < 8; ++s) LF[s] = glbfrag(L1 + 128, 256, row_, s, hi); \
        _Pragma("unroll") for (int k = 0; k < 4; ++k) { YF[k] = *(const u32x4*)(Yg + (size_t)row_ * D + h * 64 + 32 * hi + 8 * k); VF[k] = *(const u32x4*)(Vg + (size_t)row_ * D + h * 64 + 32 * hi + 8 * k); } \
        BS = bsg[((size_t)b * NHEAD + h) * SEQ + (size_t)(row_ - b * SEQ)]; } while (0)
#define WKC_COMP(LF, YF, VF, BS, i) do { const int row_ = row0 + (i) * 256; f32x16 g[2], y[2]; \
        _Pragma("unroll") for (int yt = 0; yt < 2; ++yt) { g[yt] = (f32x16){}; \
            _Pragma("unroll") for (int s = 0; s < 8; ++s) g[yt] = __builtin_amdgcn_mfma_f32_32x32x16_bf16(*(const LAS bf16x8*)(gl + (32 * yt + r32) * 272 + (16 * s + 8 * hi) * 2), LF[s], g[yt], 0, 0, 0); \
            __builtin_amdgcn_sched_barrier(0); } \
        u32x2 yk[8], vk[8];                                               \
        _Pragma("unroll") for (int j = 0; j < 4; ++j) { \
            { auto r0 = __builtin_amdgcn_permlane32_swap(YF[j].x, YF[j].z, false, false); auto r1 = __builtin_amdgcn_permlane32_swap(YF[j].y, YF[j].w, false, false); yk[j] = (u32x2){r0[0], r1[0]}; yk[4 + j] = (u32x2){r0[1], r1[1]}; } \
            { auto r0 = __builtin_amdgcn_permlane32_swap(VF[j].x, VF[j].z, false, false); auto r1 = __builtin_amdgcn_permlane32_swap(VF[j].y, VF[j].w, false, false); vk[j] = (u32x2){r0[0], r1[0]}; vk[4 + j] = (u32x2){r0[1], r1[1]}; } } \
        _Pragma("unroll") for (int yt = 0; yt < 2; ++yt) _Pragma("unroll") for (int q = 0; q < 4; ++q) { const u32x2 wv = yk[yt * 4 + q]; y[yt][4 * q] = bflo(wv.x); y[yt][4 * q + 1] = bfhi(wv.x); y[yt][4 * q + 2] = bflo(wv.y); y[yt][4 * q + 3] = bfhi(wv.y); } \
        float sm = 0.f; \
        _Pragma("unroll") for (int r = 0; r < 16; ++r) sm += y[0][r] + y[1][r]; \
        sm += __shfl_xor(sm, 32); const float mean = sm * (1.0f / 64.0f); \
        float q2 = 0.f; \
        _Pragma("unroll") for (int r = 0; r < 16; ++r) { const float d0 = y[0][r] - mean, d1 = y[1][r] - mean; q2 += d0 * d0 + d1 * d1; } \
        q2 += __shfl_xor(q2, 32); const float rstd = rsqrtf(q2 * (1.0f / 64.0f) + GN_EPS); \
        _Pragma("unroll") for (int q = 0; q < 4; ++q) { u32x2 ok[2]; \
            _Pragma("unroll") for (int yt = 0; yt < 2; ++yt) { const int ch = 32 * yt + 8 * q + 4 * hi; const f32x4 lw = *(const LAS f32x4*)(lnc + ch), lb = *(const LAS f32x4*)(lnc + 64 + ch); \
                const u32x2 vw = vk[yt * 4 + q]; const f32x4 vv = {bflo(vw.x), bfhi(vw.x), bflo(vw.y), bfhi(vw.y)}; f32x4 o; \
                _Pragma("unroll") for (int i2 = 0; i2 < 4; ++i2) o[i2] = ((y[yt][4 * q + i2] - mean) * rstd * lw[i2] + lb[i2] + BS * vv[i2]) * g[yt][4 * q + i2]; \
                ok[yt] = pack4(o); } \
            { auto r0 = __builtin_amdgcn_permlane32_swap(ok[0].x, ok[1].x, false, false); auto r1 = __builtin_amdgcn_permlane32_swap(ok[0].y, ok[1].y, false, false);     \
              *(u32x4*)(Yg + (size_t)row_ * D + h * 64 + 32 * hi + 8 * q) = (u32x4){r0[0], r1[0], r0[1], r1[1]}; } \
            __builtin_amdgcn_sched_barrier(0); } } while (0)
    WKC_LOAD(Al, Ay, Av, Abs, 0);
    for (int i = 0; i < 8; i += 2) { WKC_LOAD(Bl, By, Bv, Bbs, i + 1); WKC_COMP(Al, Ay, Av, Abs, i); WKC_LOAD(Al, Ay, Av, Abs, i + 2); WKC_COMP(Bl, By, Bv, Bbs, i + 1); }
#undef WKC_LOAD
#undef WKC_COMP
    __syncthreads(); PT_M1(c, 4);
}
#undef W32_Y
#ifndef WKA_PROBE
#define WKA_PROBE 0
#endif
#ifndef MK_N_LAUNCHES
#define MK_N_LAUNCHES 1
#endif
constexpr int N_PHASES = 19;
constexpr int N_LAUNCHES = MK_N_LAUNCHES;


__device__ __forceinline__ void moe_idle_convert(const Params& p, const Ctx& c, int it0, int it1) {
    const int total = ((LAS const int*)(c.lds + CLSTAB_OFF))[61], rounds = (total + c.G - 1) / c.G; int b0 = total - (rounds - 1) * c.G;
    if (rounds < 1 || c.G - b0 < 64) b0 = 0;
    if (c.bid >= b0) convert_late(p, c, it0, it1, c.bid - b0, c.G - b0);
}

__global__ void __launch_bounds__(NTHREADS, 2) fwd_kernel(Params p) {
    extern __shared__ __attribute__((aligned(16))) unsigned char lds_raw[];
    Ctx c; c.lds = (LAS unsigned char*)lds_raw; c.tid = threadIdx.x; c.lane = c.tid & 63; c.wave = __builtin_amdgcn_readfirstlane(c.tid >> 6); c.G = gridDim.x; c.bid = blockIdx.x;
    volatile LAS unsigned* MISC = (volatile LAS unsigned*)(c.lds + MISC_OFF);
    if (c.tid < 64) ((LAS unsigned*)(c.lds + MISC_OFF))[c.tid] = 0u;
#ifdef PT_CUSTOM
    if (c.tid < 4) ((LAS unsigned*)(c.lds + MISC_OFF + 512))[c.tid] = 0u;
#endif
    __syncthreads();
    unsigned* ctl = (unsigned*)(p.ws + WS_CTL);
    XcdBarrier bar; bar.bar = ctl + CW_BAR; bar.x = 0; bar.st = nullptr;
    if (N_LAUNCHES == 1) bar = xcd_barrier_post(ctl + CW_BAR, MISC + 8);
    if (c.tid == 0) { const unsigned x_ = xb_xcc_id(); MISC[16] = x_; MISC[17] = atomicAdd(ctl + CW_XSLOT + 64 * x_, 1u); }
    const int lo = p.ph_lo, hi = p.ph_hi;
#ifndef PH_MASK
#define PH_MASK 0x7ffff
#endif
#ifndef PROBE_DUP_EARLY
#define PROBE_DUP_EARLY -1
#endif
#define PHASE_ID 0
#define IN(k) ((((PH_MASK) >> (k)) & 1) && lo <= (k) && (k) < hi)
#ifdef PT_LO
#ifndef PT_MULT
#define PT_MULT 4
#endif
    unsigned long long pt0_ = 0, pt1_ = 0;
    if (PT_LO == 0) pt0_ = wall_clock64();
#define PT_STAMP(k) do { if ((k) + 1 == PT_LO) pt0_ = wall_clock64(); if ((k) == PT_HI) pt1_ = wall_clock64(); } while (0)
#else
#define PT_STAMP(k) do { } while (0)
#endif
#define SEAM(k) do { if (IN(k) && IN((k) + 1)) xcd_barrier(bar); PT_STAMP(k); } while (0)
#define SEAMX(k, work) do { if (IN(k) && IN((k) + 1)) { asm volatile("s_waitcnt vmcnt(0)" ::: "memory"); __syncthreads(); \
        if (c.wave == 0) { if (c.tid == 0) xcd_barrier_t0(bar); } else { work; } __syncthreads(); } PT_STAMP(k); } while (0)
#define SEAMW(k, layer) SEAMX(k, router_prebuild(p, c, layer))
    LAS unsigned char* ring = c.lds + RING_OFF;

    if (IN(0)) { phase_prologue(p, c); }
    if (IN(0) && IN(1)) {
        if (c.tid == 0) { const unsigned* ada = (const unsigned*)(p.ws + WS_CTL) + CW_ADA; unsigned sp = 0;
            while (__hip_atomic_load(ada, __ATOMIC_RELAXED, __HIP_MEMORY_SCOPE_AGENT) < (unsigned)c.G && ++sp < (1u << 22)) __builtin_amdgcn_s_sleep(2);
            __builtin_amdgcn_fence(__ATOMIC_ACQUIRE, "agent"); asm volatile("s_waitcnt vmcnt(0)" ::: "memory"); }
        __syncthreads(); }
    PT_STAMP(0);
    if (IN(1)) { phase_n0(p, c); } SEAM(1);
    if (IN(2)) {
#undef PHASE_ID
#define PHASE_ID 2
        { DenseSched S; S.init((const bf16_t*)p.out, D, wsb(p, WS_LD), 2048, T, 256, 2048, c.G, c.bid); S.rep = (p.pad == 100 + PHASE_ID) ? 2 : 1; S.pad = 1; S.nt0 = 16; S.a1d = -(long)(D * 2); S.b1d = 1024 * 2;
          EpiLoraDown E{wsb(p, WS_W6)}; pg8::gemm_phase<EpiLoraDown, DenseSched, false>(ring, S, E, D, 2048); }
        { DenseSched S; S.init(wsb(p, WS_W0), D, wsb(p, WS_WR), D, T, D, D, c.G, c.bid); S.ngrp = 3; S.aG = SLOT; S.bG = 2 * MiB;
          EpiBf16 E{wsb(p, WS_W3), D, SLOT / 2}; pg8::gemm_phase<EpiBf16, DenseSched, false>(ring, S, E, D, D); }
    } SEAMX(2, wkv_a_tables(p, c, c.tid - 64, NTHREADS - 64));
#ifndef PROBE_DUP
#define PROBE_DUP -1
#define DUP(k, call) do { if (PROBE_DUP == (k)) { call; xcd_barrier(bar); } } while (0)
    if (IN(3)) { phase_wkv_a(p, c, IN(2)); } SEAM(3);
    if (IN(4)) { phase_wkv_b(p, c, bar); } SEAMX(4, wkv_c_tables(p, c, c.tid - 64, NTHREADS - 64));
    if (IN(5)) { phase_wkv_c(p, c, IN(4)); } SEAM(5);
#endif
    if (IN(6)) {
#undef PHASE_ID
#define PHASE_ID 6
        DenseSched S; S.init(wsb(p, WS_W3), D, wsb(p, WS_WO), D, T, D, D, c.G, c.bid); S.rep = (p.pad == 100 + PHASE_ID) ? 2 : 1; EpiResidT<true> E{p.in[I_X], (bf16_t*)p.out, wsf(p, WS_MOD) + 0 * 3072 + 2048};
        pg8::gemm_phase<EpiResidT<true>, DenseSched, false>(ring, S, E, D, D);
    } SEAMW(6, 0);
#define MOE_PHASES(layer, pb) do { \
        if (IN(pb)) { phase_router(p, c, layer, IN((pb) - 1)); } SEAM(pb); \
        if (IN((pb) + 1)) { \
            moe_setup(p, c, layer); \
            MoeSched S{(LAS const int*)(c.lds + UDESC_OFF), (LAS const int*)(c.lds + ROWTAB_OFF), 0, (const char*)wsb(p, WS_W1), (const char*)wsb(p, (layer) ? WS_WGU1 : WS_WGU), (const char*)wsb(p, (layer) ? WS_WDN1 : WS_WDN)}; \
            EpiMoeUp E{wsb(p, WS_W2), (LAS const float*)(c.lds + GATETAB_OFF)}; \
            pg8::gemm_phase<EpiMoeUp, MoeSched, true>(ring, S, E, D, D); \
            if ((layer) == 0) moe_idle_convert(p, c, 0, 3700); \
        } SEAM((pb) + 1); \
        if (IN((pb) + 2)) { \
            if (!IN((pb) + 1)) moe_setup(p, c, layer);        \
            MoeSched S{(LAS const int*)(c.lds + UDESC_OFF), (LAS const int*)(c.lds + ROWTAB_OFF), 1, (const char*)wsb(p, WS_W2), (const char*)wsb(p, (layer) ? WS_WGU1 : WS_WGU), (const char*)wsb(p, (layer) ? WS_WDN1 : WS_WDN)}; \
            EpiMoeDown E{(const bf16_t*)p.out, (layer) ? wsb(p, WS_W1) : (bf16_t*)p.out, wsf(p, WS_MOD) + ((layer) * 2 + 1) * 3072 + 2048, (LAS const int*)(c.lds + ROWTAB_OFF)}; \
            pg8::gemm_phase<EpiMoeDown, MoeSched, false>(ring, S, E, 512, 256); \
            if ((layer) == 0) moe_idle_convert(p, c, 3700, WCV_NITEM); \
        } SEAM((pb) + 2); } while (0)
    MOE_PHASES(0, 7);
            if (IN(10)) { phase_n2(p, c); } SEAM(10);
            if (IN(11)) {
#undef PHASE_ID
#define PHASE_ID 11
                { DenseSched S; S.init(wsb(p, WS_W1), D, wsb(p, WS_DKV), D, T, 512, D, c.G, c.bid); S.rep = (p.pad == 100 + PHASE_ID) ? 2 : 1; EpiDown E{wsb(p, WS_W6), KVLORA, 0, wsf(p, WS_SSQKV), 4, wsb(p, WS_KR), wsf(p, WS_TAB)};
                  pg8::gemm_phase<EpiDown, DenseSched, false>(ring, S, E, D, D); }
                { DenseSched S; S.init(wsb(p, WS_W0), D, wsb(p, WS_DQ), D, T, 512, D, c.G, c.bid); S.rep = (p.pad == 100 + PHASE_ID) ? 2 : 1; EpiDown E{wsb(p, WS_W6 + 16 * MiB), QLORA, 128, wsf(p, WS_SSQQ), 8, nullptr, nullptr};
                  pg8::gemm_phase<EpiDown, DenseSched, false>(ring, S, E, D, D); }
            } SEAM(11);
            if (IN(12)) {
#undef PHASE_ID
#define PHASE_ID 12
                { DenseSched S; S.init(wsb(p, WS_W6 + 16 * MiB), QLORA, wsb(p, WS_UQ), QLORA, T, 1024, QLORA, c.G, c.bid); EpiQn E{wsb(p, WS_W2), wsf(p, WS_SSQQ)};
                  pg8::gemm_phase<EpiQn, DenseSched, false>(ring, S, E, QLORA, QLORA); }
                { DenseSched S; S.init(wsb(p, WS_W6 + 16 * MiB), QLORA, wsb(p, WS_UQ) + (size_t)1024 * QLORA, QLORA, T, 512, QLORA, c.G, c.bid); EpiQr E{wsb(p, WS_W2), wsf(p, WS_SSQQ), wsf(p, WS_TAB)};
                  pg8::gemm_phase<EpiQr, DenseSched, false>(ring, S, E, QLORA, QLORA); }
                { DenseSched S; S.init(wsb(p, WS_W6), KVLORA, wsb(p, WS_UKV), KVLORA, T, 2048, KVLORA, c.G, c.bid); S.rep = (p.pad == 100 + PHASE_ID) ? 2 : 1; EpiKV E{wsb(p, WS_W4), wsb(p, WS_W5), wsf(p, WS_SSQKV)};
                  pg8::gemm_phase<EpiKV, DenseSched, false>(ring, S, E, KVLORA, KVLORA); }
            } SEAM(12);
            if (IN(13)) { phase_attention(p, c); } SEAM(13);
#if defined(PROBE_DUP) && PROBE_DUP == 13
            if (IN(13)) { phase_attention(p, c); } SEAM(13);
#endif
            if (IN(14)) {
#undef PHASE_ID
#define PHASE_ID 14
                DenseSched S; S.init(wsb(p, WS_W0), D, wsb(p, WS_MWO), D, T, D, D, c.G, c.bid); S.rep = (p.pad == 100 + PHASE_ID) ? 2 : 1; EpiResidT<false> E{p.out, (bf16_t*)p.out, wsf(p, WS_MOD) + 2 * 3072 + 2048};
                pg8::gemm_phase<EpiResidT<false>, DenseSched, false>(ring, S, E, D, D);
            } SEAMW(14, 1);
    MOE_PHASES(1, 15);
#ifdef BAR_EXTRA
    for (int i_ = 0; i_ < BAR_EXTRA; ++i_) xcd_barrier(bar);
#endif
    if (IN(18)) { phase_final(p, c); }
#ifdef PT_CUSTOM
    { __syncthreads(); const unsigned long long t0_ = *(volatile LAS unsigned long long*)(c.lds + MISC_OFF + 512), t1_ = *(volatile LAS unsigned long long*)(c.lds + MISC_OFF + 520);
      const unsigned long long d_ = (t1_ - t0_) * PT_CUSTOM, ts_ = wall_clock64(); while (wall_clock64() - ts_ < d_) __builtin_amdgcn_s_sleep(8); }
#endif
#ifdef PT_LO
    { PT_STAMP(18); const unsigned long long d_ = (pt1_ - pt0_) * PT_MULT, ts_ = wall_clock64(); while (wall_clock64() - ts_ < d_) __builtin_amdgcn_s_sleep(8); }
#endif
#undef IN
#undef SEAM
}

extern "C" void kernel_launch(void* const* d_in, const int* in_sizes, int n_in, void* d_out, int out_size, void* d_ws, size_t ws_size, hipStream_t stream) {
    static int ready = 0;
    if (ready == 0) {
        ready = 1;
        if (n_in != N_IN || out_size != T * D || ws_size < WS_END) { fprintf(stderr, "kernel_launch: unexpected shapes (n_in %d, out %d, ws %zu)\n", n_in, out_size, ws_size); ready = -1; }
        else if (hipFuncSetAttribute((const void*)fwd_kernel, hipFuncAttributeMaxDynamicSharedMemorySize, LDS_BYTES) != hipSuccess) { fprintf(stderr, "kernel_launch: hipFuncSetAttribute failed\n"); ready = -1; }
        int per_cu = 0;
        if (ready > 0 && (hipOccupancyMaxActiveBlocksPerMultiprocessor(&per_cu, (const void*)fwd_kernel, NTHREADS, LDS_BYTES) != hipSuccess || per_cu < 1)) fprintf(stderr, "kernel_launch: occupancy query reports %d\n", per_cu);
        (void)hipGetLastError();
    }
    if (ready < 0) return;
    (void)hipMemsetAsync((char*)d_ws + WS_CTL, 0, CTL_ZERO_BYTES, stream);
    Params a{};
    for (int i = 0; i < N_IN; ++i) a.in[i] = (const float*)d_in[i];
    a.out = (float*)d_out; a.ws = (unsigned char*)d_ws; a.li = 0; a.pad = WKA_PROBE;
    const int grid = 256;
    if (N_LAUNCHES == 1) { a.ph_lo = 0; a.ph_hi = N_PHASES; hipLaunchKernelGGL(fwd_kernel, dim3(grid), dim3(NTHREADS), LDS_BYTES, stream, a); }
    else { for (int k = 0; k < N_PHASES; ++k) { a.ph_lo = k; a.ph_hi = k + 1; a.li = k; hipLaunchKernelGGL(fwd_kernel, dim3(grid), dim3(NTHREADS), LDS_BYTES, stream, a); } }
}
```
